# Optimizing an MI355X kernel written in HIP

```python
import jax, jax.numpy as jnp
from jax import lax
import numpy as np

D_MODEL = 1024
BATCH = 4
SEQ = 8192
DEPTH = 2

EPS = 1e-6
POOL_WINDOWS = (2, 4, 8, 16)
POOL_GROUPS = len(POOL_WINDOWS)
POOL_GROUP_DIM = D_MODEL // 8
POOL_DIM = POOL_GROUPS * POOL_GROUP_DIM
ATT_HEADS = 8
ATT_KV_HEADS = 2
HEAD_DIM = D_MODEL // 16
ATT_DIM = ATT_HEADS * HEAD_DIM
KV_DIM = ATT_KV_HEADS * HEAD_DIM
IDX_HEADS = 4
IDX_DIM = 64
TOPK_MAX = 256
Q_BLOCK = 128
ROPE_THETA = 500000.0
ROPE_DIM = HEAD_DIM // 4
HGRN_HEADS = 8
HGRN_DK = D_MODEL // HGRN_HEADS
HGRN_DV = D_MODEL // HGRN_HEADS
HGRN_WIDTH = HGRN_HEADS * HGRN_DK
HGRN_CHUNK = 64
D_FF = ((8 * D_MODEL // 3 + 255) // 256) * 256

AB_IN = POOL_DIM + ATT_DIM + 2 * KV_DIM + IDX_HEADS * IDX_DIM + IDX_DIM + IDX_HEADS
C_IN = 4 * HGRN_WIDTH
N_EVEN = (DEPTH + 1) // 2
N_ODD = DEPTH // 2

kernel_name = "hybrid_pool_dsa_hgrn2_trunk"


def rmsnorm(x, g):
    xf = x.astype(jnp.float32)
    y = xf * lax.rsqrt(jnp.mean(xf * xf, axis=-1, keepdims=True) + EPS)
    return (y * g.astype(jnp.float32)).astype(x.dtype)


def rope_tables(positions):
    inv = ROPE_THETA ** (-jnp.arange(0, ROPE_DIM, 2, dtype=jnp.float32) / ROPE_DIM)
    ang = positions.astype(jnp.float32)[..., None] * inv
    return jnp.cos(ang)[:, :, None, :], jnp.sin(ang)[:, :, None, :]


def partial_rope(x, cos, sin):
    half = ROPE_DIM // 2
    xr = x[..., :ROPE_DIM].astype(jnp.float32)
    x1, x2 = xr[..., :half], xr[..., half:]
    rot = jnp.concatenate([x1 * cos - x2 * sin, x2 * cos + x1 * sin], axis=-1)
    return jnp.concatenate([rot.astype(x.dtype), x[..., ROPE_DIM:]], axis=-1)


def pool_mixer(u, w_pool, pool_scale):
    L = u.shape[1]
    t = jnp.arange(L)
    outs = []
    for g, w in enumerate(POOL_WINDOWS):
        ug = u[..., g * POOL_GROUP_DIM:(g + 1) * POOL_GROUP_DIM].astype(jnp.float32)
        cs = jnp.cumsum(ug, axis=1)
        lag = jnp.pad(cs[:, :-w], ((0, 0), (w, 0), (0, 0)))
        cnt = jnp.minimum(t + 1, w).astype(jnp.float32)[None, :, None]
        pooled = (cs - lag) / cnt - ug
        outs.append(jnp.einsum('blc,cd->bld', pooled.astype(u.dtype), w_pool[g]))
    return jnp.concatenate(outs, axis=-1) * pool_scale


def sparse_attention(q, k, v, qi, ki, wi):
    B, L = q.shape[0], q.shape[1]
    topk = min(TOPK_MAX, L // 4)
    n_blocks = L // Q_BLOCK
    rep = ATT_HEADS // ATT_KV_HEADS
    key_pos = jnp.arange(L)
    scale = HEAD_DIM ** -0.5
    ki32 = ki.astype(jnp.float32)

    def block(i):
        start = i * Q_BLOCK
        qb = lax.dynamic_slice_in_dim(q, start, Q_BLOCK, axis=1)
        qib = lax.dynamic_slice_in_dim(qi, start, Q_BLOCK, axis=1).astype(jnp.float32)
        wib = lax.dynamic_slice_in_dim(wi, start, Q_BLOCK, axis=1).astype(jnp.float32)
        qpos = start + jnp.arange(Q_BLOCK)
        causal = key_pos[None, :] <= qpos[:, None]
        s_idx = jax.nn.relu(jnp.einsum('bqhd,bsd->bqhs', qib, ki32))
        s_idx = jnp.einsum('bqhs,bqh->bqs', s_idx, wib)
        s_idx = jnp.where(causal[None], s_idx, -jnp.inf)
        _, sel = lax.top_k(s_idx, topk)
        valid = sel <= qpos[None, :, None]
        kg = jax.vmap(lambda kb, ib: kb[ib])(k, sel)
        vg = jax.vmap(lambda vb, ib: vb[ib])(v, sel)
        qg = qb.reshape(B, Q_BLOCK, ATT_KV_HEADS, rep, HEAD_DIM)
        s = jnp.einsum('bqgrd,bqkgd->bqgrk', qg, kg).astype(jnp.float32) * scale
        s = jnp.where(valid[:, :, None, None, :], s, -jnp.inf)
        p = jax.nn.softmax(s, axis=-1).astype(v.dtype)
        o = jnp.einsum('bqgrk,bqkgd->bqgrd', p, vg)
        return o.reshape(B, Q_BLOCK, ATT_DIM)

    out = lax.map(block, jnp.arange(n_blocks))
    return out.transpose(1, 0, 2, 3).reshape(B, L, ATT_DIM)


def hgrn2_recurrence(q, k, v, logf):
    B, L, H, DK = q.shape
    DV = v.shape[-1]
    C = HGRN_CHUNK
    nc = L // C

    def to_chunks(a):
        return a.reshape(B, nc, C, H, a.shape[-1]).transpose(1, 0, 3, 2, 4)

    tri = jnp.tril(jnp.ones((C, C), dtype=bool))

    def step(S, xs):
        qc, kc, vc, gc = xs
        b = jnp.cumsum(gc, axis=2)
        rel = jnp.where(tri[:, :, None], b[:, :, :, None, :] - b[:, :, None, :, :], -jnp.inf)
        A = jnp.einsum('bhtd,bhsd,bhtsd->bhts', qc, kc, jnp.exp(rel))
        o = jnp.einsum('bhts,bhse->bhte', A, vc) + jnp.einsum('bhtd,bhde->bhte', qc * jnp.exp(b), S)
        b_last = b[:, :, -1:, :]
        S = jnp.exp(b_last[:, :, 0, :])[..., None] * S + jnp.einsum('bhsd,bhse->bhde', kc * jnp.exp(b_last - b), vc)
        return S, o

    S0 = jnp.zeros((B, H, DK, DV), jnp.float32)
    _, o = lax.scan(step, S0, (to_chunks(q), to_chunks(k), to_chunks(v), to_chunks(logf)))
    return o.transpose(1, 0, 3, 2, 4).reshape(B, L, H, DV)


def swiglu(h, w_gate_up, w_down):
    gu = h @ w_gate_up
    gate, up = gu[..., :D_FF], gu[..., D_FF:]
    return (jax.nn.silu(gate) * up) @ w_down


def setup_inputs(seed: int = 0) -> dict:
    key = jax.random.key(seed)
    ks = jax.random.split(key, 16)
    f32 = jnp.float32

    def nrm(k, shape, fan_in):
        return jax.random.normal(k, shape, f32) * (fan_in ** -0.5)

    def gain(k, shape):
        return 1.0 + 0.02 * jax.random.normal(k, shape, f32)

    x = jax.random.normal(ks[0], (BATCH, SEQ, D_MODEL), f32)
    offset = jax.random.randint(ks[1], (BATCH, 1), 0, 4096, dtype=jnp.int32)
    positions = (offset + jnp.arange(SEQ, dtype=jnp.int32)[None, :]).astype(jnp.int32)
    return {
        "x": x,
        "positions": positions,
        "ln_mix": gain(ks[2], (DEPTH, D_MODEL)),
        "ln_ffn": gain(ks[3], (DEPTH, D_MODEL)),
        "ln_final": gain(ks[4], (D_MODEL,)),
        "w_in_ab": nrm(ks[5], (N_EVEN, D_MODEL, AB_IN), D_MODEL),
        "w_pool": nrm(ks[6], (N_EVEN, POOL_GROUPS, POOL_GROUP_DIM, POOL_GROUP_DIM), POOL_GROUP_DIM),
        "pool_scale": 1.0 + 0.1 * jax.random.normal(ks[7], (N_EVEN, POOL_DIM), f32),
        "idx_k_norm": gain(ks[8], (N_EVEN, IDX_DIM)),
        "w_out_ab": nrm(ks[9], (N_EVEN, POOL_DIM + ATT_DIM, D_MODEL), POOL_DIM + ATT_DIM),
        "w_in_c": nrm(ks[10], (N_ODD, D_MODEL, C_IN), D_MODEL),
        "hgrn_lb": 0.1 * jax.random.normal(ks[11], (DEPTH, HGRN_WIDTH), f32),
        "hgrn_out_norm": gain(ks[12], (N_ODD, HGRN_DV)),
        "w_out_c": nrm(ks[13], (N_ODD, HGRN_WIDTH, D_MODEL), HGRN_WIDTH),
        "w_gate_up": nrm(ks[14], (DEPTH, D_MODEL, 2 * D_FF), D_MODEL),
        "w_down": nrm(ks[15], (DEPTH, D_FF, D_MODEL), D_FF),
    }


def reference(x, positions, ln_mix, ln_ffn, ln_final, w_in_ab, w_pool, pool_scale, idx_k_norm,
              w_out_ab, w_in_c, hgrn_lb, hgrn_out_norm, w_out_c, w_gate_up, w_down):
    B, L = x.shape[0], x.shape[1]
    cos, sin = rope_tables(positions)
    lb_soft = jax.nn.softmax(hgrn_lb.astype(jnp.float32), axis=0)
    lb_all = jnp.cumsum(lb_soft, axis=0) - lb_soft[0:1]
    idx_w_scale = (IDX_HEADS ** -0.5) * (IDX_DIM ** -0.5)

    for layer in range(DEPTH):
        h = rmsnorm(x, ln_mix[layer])
        if layer % 2 == 0:
            e = layer // 2
            p = h @ w_in_ab[e]
            o0 = POOL_DIM
            o1 = o0 + ATT_DIM
            o2 = o1 + KV_DIM
            o3 = o2 + KV_DIM
            o4 = o3 + IDX_HEADS * IDX_DIM
            o5 = o4 + IDX_DIM
            u_pool = p[..., :o0]
            q = partial_rope(p[..., o0:o1].reshape(B, L, ATT_HEADS, HEAD_DIM), cos, sin)
            k = partial_rope(p[..., o1:o2].reshape(B, L, ATT_KV_HEADS, HEAD_DIM), cos, sin)
            v = p[..., o2:o3].reshape(B, L, ATT_KV_HEADS, HEAD_DIM)
            qi = partial_rope(p[..., o3:o4].reshape(B, L, IDX_HEADS, IDX_DIM), cos, sin)
            ki = rmsnorm(p[..., o4:o5], idx_k_norm[e])
            ki = partial_rope(ki[:, :, None, :], cos, sin)[:, :, 0, :]
            wi = p[..., o5:] * idx_w_scale
            y_a = pool_mixer(u_pool, w_pool[e], pool_scale[e])
            y_b = sparse_attention(q, k, v, qi, ki, wi)
            x = x + jnp.concatenate([y_a, y_b], axis=-1) @ w_out_ab[e]
        else:
            o = layer // 2
            p = h @ w_in_c[o]
            qz = p[..., :HGRN_WIDTH].astype(jnp.float32) * (HGRN_DK ** -0.5)
            fz = p[..., HGRN_WIDTH:2 * HGRN_WIDTH].astype(jnp.float32)
            iz = p[..., 2 * HGRN_WIDTH:3 * HGRN_WIDTH].astype(jnp.float32)
            gz = p[..., 3 * HGRN_WIDTH:]
            lb = lb_all[layer]
            f = lb + (1.0 - lb) * jax.nn.sigmoid(fz)
            kf = 1.0 - f
            shp_k = (B, L, HGRN_HEADS, HGRN_DK)
            shp_v = (B, L, HGRN_HEADS, HGRN_DV)
            oc = hgrn2_recurrence(qz.reshape(shp_k), kf.reshape(shp_k), iz.reshape(shp_v), jnp.log(f).reshape(shp_k))
            oc = rmsnorm(oc.astype(x.dtype), hgrn_out_norm[o]) * jax.nn.silu(gz).reshape(shp_v)
            x = x + oc.reshape(B, L, HGRN_WIDTH) @ w_out_c[o]
        h = rmsnorm(x, ln_ffn[layer])
        x = x + swiglu(h, w_gate_up[layer], w_down[layer])
    return rmsnorm(x, ln_final)
```

```cpp
#include <hip/hip_runtime.h>
#include <cstdio>
#include <cstdint>

#ifndef N_LAUNCH_MODE
#define N_LAUNCH_MODE 1
#endif
#ifndef USE_SIMPLE_HGRN
#define USE_SIMPLE_HGRN 0
#endif
#ifndef USE_SIMPLE_ATTN
#define USE_SIMPLE_ATTN 0
#endif
#ifndef USE_SIMPLE_GEMM
#define USE_SIMPLE_GEMM 0
#endif

#define LAS __attribute__((address_space(3)))

constexpr int BATCH = 4, SEQ = 8192, DM = 1024, NTOK = BATCH * SEQ;
constexpr int NAB_REAL = 1604, NAB = 1792;
constexpr int DFF = 2816;
constexpr int NINC = 4096;
constexpr int PC_U = 0, PC_Q = 512, PC_K = 1024, PC_V = 1152, PC_QI = 1280, PC_KI = 1536, PC_WI = 1600;
constexpr float EPS = 1e-6f;
constexpr int TOPK = 256;

constexpr size_t MiB = 1u << 20;
constexpr size_t WS_CTL = 0, CTL_ZERO_BYTES = 1 * MiB;
constexpr size_t WS_ROPE = 1 * MiB;
constexpr size_t WS_PART = 3 * MiB;
constexpr size_t WS_LB = 5 * MiB;
constexpr size_t WS_W_INAB = 6 * MiB;
constexpr size_t WS_W_POOL = WS_W_INAB + (size_t)NAB * DM * 2;
constexpr size_t WS_W_OUTAB = 10 * MiB;
constexpr size_t WS_W_INC = 12 * MiB;
constexpr size_t WS_W_OUTC = 20 * MiB;
constexpr size_t WS_W_GU0 = 22 * MiB, WS_W_GU1 = 33 * MiB;
constexpr size_t WS_W_DN0 = 44 * MiB, WS_W_DN1 = WS_W_DN0 + (size_t)DM * DFF * 2;
constexpr size_t WS_XB = 56 * MiB;
constexpr size_t WS_Y = 120 * MiB;
constexpr size_t WS_P = 184 * MiB;
constexpr size_t WS_ACT = 184 * MiB;
constexpr size_t WS_L1Q = 184 * MiB, WS_L1K = 248 * MiB, WS_L1I = 312 * MiB, WS_L1G = 376 * MiB;
constexpr size_t WS_ORAW = 440 * MiB;
constexpr size_t WS_KV8 = 488 * MiB;
constexpr size_t WS_END = 512 * MiB;
static_assert(WS_W_POOL + 4 * 128 * 128 * 2 <= WS_W_OUTAB && WS_W_DN1 + (size_t)DM * DFF * 2 <= WS_XB && WS_P + (size_t)NTOK * NAB * 2 <= 360 * MiB && WS_ACT + (size_t)NTOK * DFF * 2 <= WS_L1G + 64 * MiB, "ws map");
constexpr int CW_BAR = 4096;

constexpr int LDS_BYTES = 163840;
constexpr int LDS_MISC = 163840 - 256;
namespace pg8 {
#define PG8_LAS __attribute__((address_space(3)))
typedef unsigned short bf16_t;
typedef short bf16x8 __attribute__((ext_vector_type(8)));
typedef float f32x4 __attribute__((ext_vector_type(4)));
typedef unsigned u32x4 __attribute__((ext_vector_type(4)));
constexpr int BM = 256, BK = 64, HALF = 128, HTB = HALF * BK * 2  , STAGE_BYTES = 8 * HTB, NXCD = 8, WGM = 8;

__host__ __device__ __forceinline__ int lds_byte(int r, int c) { const int st = (r >> 4) * 2 + (c >> 5), rr = r & 15, cc = c & 31, ob = rr * 64 + cc * 2; return st * 1024 + (ob ^ (((ob >> 9) & 1) << 5)); }
__host__ __device__ __forceinline__ void stage_rc(int b, int& R, int& C) { const int st = b / 1024, sb = b % 1024, swz = sb ^ (((sb >> 9) & 1) << 5); R = (st >> 1) * 16 + swz / 64; C = (st & 1) * 32 + (swz % 64) / 2; }
__host__ __device__ __forceinline__ int perm32(int rho) { const int n = rho >> 4, i = rho & 15; return 8 * (i >> 2) + 4 * n + (i & 3); }

struct Unit { int pm, pn; };
struct Gemm { const bf16_t* A; const bf16_t* Bt; int M, N, K; };

struct StaticOrder {
    int nM, nN, nwg, G, c;
    __host__ __device__ void init(int M, int N, int G_, int c_) { nM = M / BM; nN = N / BM; nwg = nM * nN; G = G_; c = c_; }
    __host__ __device__ bool next(int i, Unit& u) const {
        const long L = (long)i * G + c; if (L >= nwg) return false;
        int wgid = (int)L; { const int q = nwg / NXCD, r = nwg % NXCD, xcd = wgid % NXCD, off = wgid / NXCD; wgid = (xcd < r ? xcd * (q + 1) : r * (q + 1) + (xcd - r) * q) + off; }
        const int nig = WGM * nN, gid = wgid / nig, fm = gid * WGM, gsz = (nM - fm) < WGM ? (nM - fm) : WGM;
        u.pm = fm + ((wgid % nig) % gsz); u.pn = (wgid % nig) / gsz; return true;
    }
    __device__ __forceinline__ void a_ready(const Unit&) const {}
    __device__ __forceinline__ void done(const Unit&) const {}
};
typedef __bf16 bf16x2_t __attribute__((ext_vector_type(2)));
__device__ __forceinline__ unsigned cvt_pk_bf16(float lo, float hi) { const bf16x2_t v = {(__bf16)lo, (__bf16)hi}; return __builtin_bit_cast(unsigned, v); }

typedef float f32x2 __attribute__((ext_vector_type(2)));
typedef unsigned u32x2 __attribute__((ext_vector_type(2)));

__device__ __forceinline__ float row_rinv(const float* part, int row) {
    const f32x4* p = (const f32x4*)(part + (size_t)row * 16);
    const f32x4 a = p[0], b = p[1], c = p[2], d = p[3];
    const float s = (((a[0] + a[1]) + (a[2] + a[3])) + ((b[0] + b[1]) + (b[2] + b[3]))) + (((c[0] + c[1]) + (c[2] + c[3])) + ((d[0] + d[1]) + (d[2] + d[3])));
    return 1.0f / sqrtf(s * (1.0f / 1024.0f) + 1e-6f);
}
struct RinvTab {
    const float* part; PG8_LAS unsigned char* ldsb;
    __device__ __forceinline__ void prepare(int pm) const {
        PG8_LAS int* cpm = (PG8_LAS int*)(ldsb + 131072 + 1024); PG8_LAS float* rtab = (PG8_LAS float*)(ldsb + 131072);
        if (*cpm != pm) {
            asm volatile("s_waitcnt lgkmcnt(0)" ::: "memory"); __builtin_amdgcn_s_barrier(); asm volatile("" ::: "memory");
            if (threadIdx.x < 256) rtab[threadIdx.x] = row_rinv(part, pm * BM + (int)threadIdx.x);
            if (threadIdx.x == 0) *cpm = pm;
            asm volatile("s_waitcnt vmcnt(0) lgkmcnt(0)" ::: "memory"); __builtin_amdgcn_s_barrier(); asm volatile("" ::: "memory");
        }
    }
    __device__ __forceinline__ float get(int row_in_panel) const { return ((const PG8_LAS float*)(ldsb + 131072))[row_in_panel]; }
};
__device__ __forceinline__ float sigmoid_neg(float x) { return __builtin_amdgcn_rcpf(1.0f + __expf(x)); }
__device__ __forceinline__ float silu_f(float x) { return x * __builtin_amdgcn_rcpf(1.0f + __expf(-x)); }

struct EpiScaleBf16 {
    static constexpr bool PERM = true, AFTER_DRAIN = false;
    bf16_t* O; int ldc; RinvTab rt;
    __device__ __forceinline__ void operator()(const f32x4 (&acc)[2][2][4][2], const Unit& u, int wr, int wc, int fr, int fq) const {
        rt.prepare(u.pm);
        const int row0 = u.pm * BM + wr * 64 + fr, col0 = u.pn * BM + wc * 32 + 8 * fq;
#pragma unroll
        for (int ai = 0; ai < 2; ++ai)
#pragma unroll
            for (int m = 0; m < 4; ++m) { const int row = row0 + ai * HALF + m * 16; const float r = rt.get(row - u.pm * BM); bf16_t* rowp = O + (size_t)row * ldc + col0;
#pragma unroll
                for (int bj = 0; bj < 2; ++bj) { const f32x4 v0 = acc[ai][bj][m][0] * r, v1 = acc[ai][bj][m][1] * r;
                    u32x4 w; w.x = cvt_pk_bf16(v0[0], v0[1]); w.y = cvt_pk_bf16(v0[2], v0[3]); w.z = cvt_pk_bf16(v1[0], v1[1]); w.w = cvt_pk_bf16(v1[2], v1[3]);
                    *(u32x4*)(rowp + bj * HALF) = w; } }
    }
};
template <bool BASE_F32> struct EpiResidual {
    static constexpr bool PERM = true, AFTER_DRAIN = false;
    bf16_t* xb; float* part; const float* xin;
    __device__ __forceinline__ void operator()(const f32x4 (&acc)[2][2][4][2], const Unit& u, int wr, int wc, int fr, int fq) const {
        const int row0 = u.pm * BM + wr * 64 + fr, col0 = u.pn * BM + wc * 32 + 8 * fq;
#pragma unroll
        for (int ai = 0; ai < 2; ++ai)
#pragma unroll
            for (int m = 0; m < 4; ++m) { const int row = row0 + ai * HALF + m * 16; const size_t off = (size_t)row * 1024 + col0; float ss = 0.f;
#pragma unroll
                for (int bj = 0; bj < 2; ++bj) {
                    f32x4 x0, x1;
                    if (BASE_F32) { x0 = *(const f32x4*)(xin + off + bj * HALF) + acc[ai][bj][m][0]; x1 = *(const f32x4*)(xin + off + bj * HALF + 4) + acc[ai][bj][m][1]; }
                    else { const u32x4 b = *(const u32x4*)(xb + off + bj * HALF);
                    x0[0] = __uint_as_float(b.x << 16) + acc[ai][bj][m][0][0]; x0[1] = __uint_as_float(b.x & 0xffff0000u) + acc[ai][bj][m][0][1];
                    x0[2] = __uint_as_float(b.y << 16) + acc[ai][bj][m][0][2]; x0[3] = __uint_as_float(b.y & 0xffff0000u) + acc[ai][bj][m][0][3];
                    x1[0] = __uint_as_float(b.z << 16) + acc[ai][bj][m][1][0]; x1[1] = __uint_as_float(b.z & 0xffff0000u) + acc[ai][bj][m][1][1];
                    x1[2] = __uint_as_float(b.w << 16) + acc[ai][bj][m][1][2]; x1[3] = __uint_as_float(b.w & 0xffff0000u) + acc[ai][bj][m][1][3]; }
                    ss += ((x0[0] * x0[0] + x0[1] * x0[1]) + (x0[2] * x0[2] + x0[3] * x0[3])) + ((x1[0] * x1[0] + x1[1] * x1[1]) + (x1[2] * x1[2] + x1[3] * x1[3]));
                    u32x4 w; w.x = cvt_pk_bf16(x0[0], x0[1]); w.y = cvt_pk_bf16(x0[2], x0[3]); w.z = cvt_pk_bf16(x1[0], x1[1]); w.w = cvt_pk_bf16(x1[2], x1[3]);
                    *(u32x4*)(xb + off + bj * HALF) = w; }
                ss += __shfl_xor(ss, 16); ss += __shfl_xor(ss, 32);
                if (fq == 0) part[(size_t)row * 16 + u.pn * 4 + wc] = ss; }
    }
};
struct EpiSwiGLU {
    static constexpr bool PERM = true, AFTER_DRAIN = false;
    bf16_t* O; RinvTab rt;
    __device__ __forceinline__ void operator()(const f32x4 (&acc)[2][2][4][2], const Unit& u, int wr, int wc, int fr, int fq) const {
        rt.prepare(u.pm);
        const int row0 = u.pm * BM + wr * 64 + fr, f0 = u.pn * HALF + wc * 32 + 8 * fq;
#pragma unroll
        for (int ai = 0; ai < 2; ++ai)
#pragma unroll
            for (int m = 0; m < 4; ++m) { const int row = row0 + ai * HALF + m * 16; const float r = rt.get(row - u.pm * BM);
                float a[8];
#pragma unroll
                for (int n = 0; n < 2; ++n)
#pragma unroll
                    for (int j = 0; j < 4; ++j) { const float g = acc[ai][0][m][n][j] * r, up = acc[ai][1][m][n][j] * r; a[4 * n + j] = silu_f(g) * up; }
                u32x4 w; w.x = cvt_pk_bf16(a[0], a[1]); w.y = cvt_pk_bf16(a[2], a[3]); w.z = cvt_pk_bf16(a[4], a[5]); w.w = cvt_pk_bf16(a[6], a[7]);
                *(u32x4*)(O + (size_t)row * 2816 + f0) = w; }
    }
};
struct EpiHgrnIn {
    static constexpr bool PERM = true, AFTER_DRAIN = false;
    bf16_t *Q1, *K1, *I1, *G1; RinvTab rt; const float* lb;
    __device__ __forceinline__ void operator()(const f32x4 (&acc)[2][2][4][2], const Unit& u, int wr, int wc, int fr, int fq) const {
        rt.prepare(u.pm);
        const int sec = u.pn >> 2; const int row0 = u.pm * BM + wr * 64 + fr, col0 = (u.pn & 3) * BM + wc * 32 + 8 * fq;
        bf16_t* O = sec == 0 ? Q1 : sec == 1 ? K1 : sec == 2 ? I1 : G1;
        float lbc[2][8];
#pragma unroll
        for (int bj = 0; bj < 2; ++bj)
#pragma unroll
            for (int j = 0; j < 8; ++j) lbc[bj][j] = (sec == 1) ? (1.0f - lb[col0 + bj * HALF + j]) : 0.f;
#pragma unroll
        for (int ai = 0; ai < 2; ++ai)
#pragma unroll
            for (int m = 0; m < 4; ++m) { const int row = row0 + ai * HALF + m * 16; const float r = rt.get(row - u.pm * BM); bf16_t* rowp = O + (size_t)row * 1024 + col0;
#pragma unroll
                for (int bj = 0; bj < 2; ++bj) { float a[8];
#pragma unroll
                    for (int n = 0; n < 2; ++n)
#pragma unroll
                        for (int j = 0; j < 4; ++j) { const float v = acc[ai][bj][m][n][j] * r; float o;
                            if (sec == 0) o = v * 0.08838834764831845f; else if (sec == 1) o = lbc[bj][4 * n + j] * sigmoid_neg(v); else if (sec == 2) o = v; else o = silu_f(v);
                            a[4 * n + j] = o; }
                    u32x4 w; w.x = cvt_pk_bf16(a[0], a[1]); w.y = cvt_pk_bf16(a[2], a[3]); w.z = cvt_pk_bf16(a[4], a[5]); w.w = cvt_pk_bf16(a[6], a[7]);
                    *(u32x4*)(rowp + bj * HALF) = w; } }
    }
};

template <class Epi>
__device__ __forceinline__ void gemm_simple(const Gemm g, int G, int c, const Epi& E) {
    const int tid = threadIdx.x, wid = __builtin_amdgcn_readfirstlane(tid >> 6), lane = tid & 63, wr = wid >> 2, wc = wid & 3, fr = lane & 15, fq = lane >> 4;
    const int nN = g.N / BM, nunits = (g.M / BM) * nN, K = g.K;
    for (int ui = c; ui < nunits; ui += G) {
        Unit u; u.pm = ui / nN; u.pn = ui % nN;
        f32x4 acc[2][2][4][2];
#pragma unroll
        for (int a = 0; a < 2; ++a)
#pragma unroll
            for (int b = 0; b < 2; ++b)
#pragma unroll
                for (int m = 0; m < 4; ++m)
#pragma unroll
                    for (int n = 0; n < 2; ++n) acc[a][b][m][n] = (f32x4){0.f, 0.f, 0.f, 0.f};
        const bf16_t* Ab = g.A + (size_t)(u.pm * BM + wr * 64 + fr) * K + fq * 8;
        const bf16_t* Bb = g.Bt + (size_t)(u.pn * BM + wc * 32 + 8 * (fr >> 2) + (fr & 3)) * K + fq * 8;
        for (int kk = 0; kk < K; kk += 32) {
            bf16x8 a[2][4], b[2][2];
#pragma unroll
            for (int ai = 0; ai < 2; ++ai)
#pragma unroll
                for (int m = 0; m < 4; ++m) a[ai][m] = *(const bf16x8*)(Ab + (size_t)(ai * HALF + m * 16) * K + kk);
#pragma unroll
            for (int bj = 0; bj < 2; ++bj)
#pragma unroll
                for (int n = 0; n < 2; ++n) b[bj][n] = *(const bf16x8*)(Bb + (size_t)(bj * HALF + 4 * n) * K + kk);
#pragma unroll
            for (int ai = 0; ai < 2; ++ai)
#pragma unroll
                for (int bj = 0; bj < 2; ++bj)
#pragma unroll
                    for (int m = 0; m < 4; ++m)
#pragma unroll
                        for (int n = 0; n < 2; ++n) acc[ai][bj][m][n] = __builtin_amdgcn_mfma_f32_16x16x32_bf16(b[bj][n], a[ai][m], acc[ai][bj][m][n], 0, 0, 0);
        }
        E(acc, u, wr, wc, fr, fq);
    }
}
template <class Epi, class Sched, bool ALIGN_EPI = false, bool SP2 = false>
__device__ __forceinline__ void gemm_phase(PG8_LAS unsigned char* lds, const Gemm g, const Sched& S, const Epi& E) {
    const int tid = threadIdx.x, wid = __builtin_amdgcn_readfirstlane(tid >> 6), lane = tid & 63, wr = wid >> 2, wc = wid & 3, fr = lane & 15, fq = lane >> 4;
    const int K = g.K, nt = K / BK;
    unsigned voffA[2], voffB[2];
#pragma unroll
    for (int i = 0; i < 2; ++i) { int R, C; stage_rc(tid * 16 + i * 8192, R, C); const int Rb = Epi::PERM ? ((R & ~31) + perm32(R & 31)) : R;
        voffA[i] = (unsigned)(R * K + C) * 2u; voffB[i] = (unsigned)(Rb * K + C) * 2u; }
    const size_t kstep = (size_t)(BK * 2);
    const size_t hstep = (size_t)HALF * K * 2;
    const size_t tstep = 2 * hstep;
    const unsigned ldsw = (unsigned)wid * 1024u;
    const int aoff = lds_byte(wr * 64 + fr, fq * 8), boff = lds_byte(wc * 32 + fr, fq * 8);
#define PG8_SA(b, h) (((b) * 2 + (h)) * HTB)
#define PG8_SB(b, h) ((4 + (b) * 2 + (h)) * HTB)
#define PG8_STAGE(bufoff, gbase, voff) do { _Pragma("unroll") for (int _i = 0; _i < 2; ++_i) \
        __builtin_amdgcn_global_load_lds((const unsigned*)((const char*)(gbase) + (voff)[_i]), (PG8_LAS unsigned*)(lds + (bufoff) + ldsw + _i * 8192), 16, 0, 0); } while (0)
#define PG8_LDA(dst, b, h) do { _Pragma("unroll") for (int m = 0; m < 4; ++m) _Pragma("unroll") for (int k = 0; k < 2; ++k) dst[m][k] = *(const PG8_LAS bf16x8*)(lds + PG8_SA(b, h) + aoff + m * 2048 + k * 1024); } while (0)
#define PG8_LDB(dst, b, h) do { _Pragma("unroll") for (int n = 0; n < 2; ++n) _Pragma("unroll") for (int k = 0; k < 2; ++k) dst[n][k] = *(const PG8_LAS bf16x8*)(lds + PG8_SB(b, h) + boff + n * 2048 + k * 1024); } while (0)
#define PG8_MMA(ai, bj, At, Bt) do { __builtin_amdgcn_s_setprio(1); _Pragma("unroll") for (int m = 0; m < 4; ++m) _Pragma("unroll") for (int n = 0; n < 2; ++n) _Pragma("unroll") for (int k = 0; k < 2; ++k) \
        acc[ai][bj][m][n] = __builtin_amdgcn_mfma_f32_16x16x32_bf16(Bt[n][k], At[m][k], acc[ai][bj][m][n], 0, 0, 0); __builtin_amdgcn_s_setprio(0); } while (0)
#define PG8_WAIT_V(n) asm volatile("s_waitcnt vmcnt(" #n ")" ::: "memory")
#define PG8_WAIT_L(n) asm volatile("s_waitcnt lgkmcnt(" #n ")" ::: "memory")
#define PG8_BAR __builtin_amdgcn_s_barrier()
#define PG8_SCHED __builtin_amdgcn_sched_barrier(0)
    Unit cur, nxt; int ui = 0;
    if (!S.next(0, cur)) return;
    f32x4 acc[2][2][4][2];
#pragma unroll
    for (int a = 0; a < 2; ++a)
#pragma unroll
        for (int b = 0; b < 2; ++b)
#pragma unroll
            for (int m = 0; m < 4; ++m)
#pragma unroll
                for (int n = 0; n < 2; ++n) acc[a][b][m][n] = (f32x4){0.f, 0.f, 0.f, 0.f};
    bf16x8 At[4][2], B0[2][2], B1[2][2];
    const char* cA = (const char*)g.A + (size_t)cur.pm * tstep; const char* cB = (const char*)g.Bt + (size_t)cur.pn * tstep;
    S.a_ready(cur);
    if constexpr (SP2) {
        PG8_STAGE(PG8_SB(0, 0), cB, voffB); PG8_STAGE(PG8_SB(0, 1), cB + hstep, voffB); PG8_STAGE(PG8_SA(0, 0), cA, voffA); PG8_STAGE(PG8_SA(0, 1), cA + hstep, voffA);
        if (wr == 1) PG8_BAR;
        PG8_WAIT_V(2); PG8_BAR;
        PG8_STAGE(PG8_SB(1, 0), cB + kstep, voffB); PG8_STAGE(PG8_SA(1, 0), cA + kstep, voffA); PG8_STAGE(PG8_SB(1, 1), cB + hstep + kstep, voffB);
        PG8_WAIT_V(6); PG8_BAR;
    } else {
        PG8_STAGE(PG8_SB(0, 0), cB, voffB); PG8_STAGE(PG8_SA(0, 0), cA, voffA); PG8_STAGE(PG8_SB(0, 1), cB + hstep, voffB); PG8_STAGE(PG8_SA(0, 1), cA + hstep, voffA);
        if (wr == 1) PG8_BAR;
        PG8_WAIT_V(4); PG8_BAR;
        PG8_STAGE(PG8_SB(1, 0), cB + kstep, voffB); PG8_STAGE(PG8_SA(1, 0), cA + kstep, voffA); PG8_STAGE(PG8_SB(1, 1), cB + hstep + kstep, voffB);
        PG8_WAIT_V(6); PG8_BAR;
    }
    for (;;) {
        const bool has_next = S.next(ui + 1, nxt);
        const char* nA = has_next ? (const char*)g.A + (size_t)nxt.pm * tstep : cA; const char* nB = has_next ? (const char*)g.Bt + (size_t)nxt.pn * tstep : cB;
        for (int t = 0; t < nt; t += 2) {
            const bool last = (t == nt - 2);
            const char* a1 = cA + (size_t)(t + 1) * kstep;
            const char* a2 = last ? nA : cA + (size_t)(t + 2) * kstep; const char* b2 = last ? nB : cB + (size_t)(t + 2) * kstep;
            const char* a3 = a2 + kstep; const char* b3 = b2 + kstep;
            if (last && has_next) S.a_ready(nxt);
            if constexpr (SP2) {
            PG8_LDB(B0, 0, 0); PG8_LDB(B1, 0, 1); PG8_SCHED; PG8_LDA(At, 0, 0); PG8_STAGE(PG8_SA(1, 1), a1 + hstep, voffA);
            PG8_WAIT_V(8); PG8_WAIT_L(0); PG8_BAR; PG8_MMA(0, 0, At, B0); PG8_MMA(0, 1, At, B1); PG8_BAR; PG8_SCHED;
            PG8_LDA(At, 0, 1); PG8_STAGE(PG8_SB(0, 0), b2, voffB); PG8_STAGE(PG8_SB(0, 1), b2 + hstep, voffB); PG8_STAGE(PG8_SA(0, 0), a2, voffA);
            PG8_WAIT_V(8); PG8_WAIT_L(0); PG8_BAR; PG8_MMA(1, 0, At, B0); PG8_MMA(1, 1, At, B1); PG8_BAR; PG8_SCHED;
            PG8_LDB(B0, 1, 0); PG8_LDB(B1, 1, 1); PG8_SCHED; PG8_LDA(At, 1, 0); PG8_STAGE(PG8_SA(0, 1), a2 + hstep, voffA);
            PG8_WAIT_V(8); PG8_WAIT_L(0); PG8_BAR; PG8_MMA(0, 0, At, B0); PG8_MMA(0, 1, At, B1); PG8_BAR; PG8_SCHED;
            PG8_LDA(At, 1, 1); PG8_STAGE(PG8_SB(1, 0), b3, voffB); PG8_STAGE(PG8_SB(1, 1), b3 + hstep, voffB); PG8_STAGE(PG8_SA(1, 0), a3, voffA);
            PG8_WAIT_V(8); PG8_WAIT_L(0); PG8_BAR; PG8_MMA(1, 0, At, B0); PG8_MMA(1, 1, At, B1); PG8_BAR; PG8_SCHED;
            } else {
            PG8_LDB(B0, 0, 0); PG8_SCHED; PG8_LDA(At, 0, 0); PG8_STAGE(PG8_SA(1, 1), a1 + hstep, voffA);
            PG8_WAIT_L(8); PG8_BAR; PG8_WAIT_L(0); PG8_MMA(0, 0, At, B0); PG8_BAR; PG8_SCHED;
            PG8_LDB(B1, 0, 1); PG8_STAGE(PG8_SB(0, 0), b2, voffB);
            PG8_BAR; PG8_WAIT_L(0); PG8_MMA(0, 1, At, B1); PG8_BAR;
            PG8_LDA(At, 0, 1); PG8_STAGE(PG8_SA(0, 0), a2, voffA);
            PG8_BAR; PG8_WAIT_L(0); PG8_MMA(1, 0, At, B0); PG8_BAR; PG8_SCHED;
            PG8_STAGE(PG8_SB(0, 1), b2 + hstep, voffB);
            PG8_WAIT_V(6); PG8_BAR; PG8_MMA(1, 1, At, B1); PG8_BAR;
            PG8_LDB(B0, 1, 0); PG8_SCHED; PG8_LDA(At, 1, 0); PG8_STAGE(PG8_SA(0, 1), a2 + hstep, voffA);
            PG8_WAIT_L(8); PG8_BAR; PG8_WAIT_L(0); PG8_MMA(0, 0, At, B0); PG8_BAR; PG8_SCHED;
            PG8_LDB(B1, 1, 1); PG8_STAGE(PG8_SB(1, 0), b3, voffB);
            PG8_BAR; PG8_WAIT_L(0); PG8_MMA(0, 1, At, B1); PG8_BAR;
            PG8_LDA(At, 1, 1); PG8_STAGE(PG8_SA(1, 0), a3, voffA);
            PG8_BAR; PG8_WAIT_L(0); PG8_MMA(1, 0, At, B0); PG8_BAR; PG8_SCHED;
            PG8_STAGE(PG8_SB(1, 1), b3 + hstep, voffB);
            PG8_WAIT_V(6); PG8_BAR; PG8_MMA(1, 1, At, B1); PG8_BAR;
            }
        }
        if constexpr (ALIGN_EPI) { if (wr == 0) PG8_BAR; }
        if constexpr (!Epi::AFTER_DRAIN) { E(acc, cur, wr, wc, fr, fq); S.done(cur); }
        if (!has_next) break;
#pragma unroll
        for (int a = 0; a < 2; ++a)
#pragma unroll
            for (int b = 0; b < 2; ++b)
#pragma unroll
                for (int m = 0; m < 4; ++m)
#pragma unroll
                    for (int n = 0; n < 2; ++n) acc[a][b][m][n] = (f32x4){0.f, 0.f, 0.f, 0.f};
        cur = nxt; cA = nA; cB = nB; ++ui;
        if constexpr (ALIGN_EPI) { if (wr == 1) PG8_BAR; }
    }
    PG8_WAIT_V(0);
    if constexpr (!ALIGN_EPI) { if (wr == 0) PG8_BAR; }
    PG8_BAR;
    if constexpr (Epi::AFTER_DRAIN) { E.fused(acc, cur, wr, wc, fr, fq, lds, wid, lane); S.done(cur); }
#undef PG8_SA
#undef PG8_SB
#undef PG8_STAGE
#undef PG8_LDA
#undef PG8_LDB
#undef PG8_MMA
#undef PG8_WAIT_V
#undef PG8_WAIT_L
#undef PG8_BAR
#undef PG8_SCHED
}
}

#define XB_TMO      128
#define XB_XCNT(j)  (256  + 64 * (j))
#define XB_XSUB(j)  (1280 + 64 * (j))
#define XB_XGEN(j)  (2304 + 64 * (j))
#define XB_TOP      3328
#define XB_TOPGEN   3392
#define XCD_BAR_WORDS 3456
#define XB_SPIN_CAP (1u << 18)

__device__ __forceinline__ unsigned xb_ld(unsigned* p)              { return __hip_atomic_load(p, __ATOMIC_RELAXED, __HIP_MEMORY_SCOPE_AGENT); }
__device__ __forceinline__ unsigned xb_add(unsigned* p, unsigned v) { return __hip_atomic_fetch_add(p, v, __ATOMIC_RELAXED, __HIP_MEMORY_SCOPE_AGENT); }
__device__ __forceinline__ unsigned xb_xcc_id() { return (unsigned)__builtin_amdgcn_s_getreg((3 << 11) | 20) & 0xFu; }
#define XB_SPIN(cond, bar) do { unsigned _sp = 0; while (cond) { __builtin_amdgcn_s_sleep(1); \
    if ((++_sp & 255u) == 0u) { if (xb_ld(&(bar)[XB_TMO])) break; if (_sp > XB_SPIN_CAP) { atomicAdd(&(bar)[XB_TMO], 1u); break; } } } } while (0)

struct XcdBarrier {
    unsigned* bar; unsigned x;
    volatile LAS unsigned* st;
};

__device__ __forceinline__ XcdBarrier xcd_barrier_post(unsigned* bar, volatile LAS unsigned* st) {
    XcdBarrier b; b.bar = bar; b.x = xb_xcc_id(); b.st = st;
    if (threadIdx.x == 0) (void)xb_add(&bar[XB_XCNT(b.x)], 1u);
    return b;
}
__device__ __forceinline__ void xcd_barrier_complete(unsigned* bar, unsigned x, unsigned& nloc, unsigned& nx) {
    const unsigned G = gridDim.x * gridDim.y * gridDim.z;
    unsigned sum, cnt, mine, sp = 0u;
    for (;;) {
        sum = 0u; cnt = 0u; mine = 0u;
#pragma unroll
        for (unsigned j = 0; j < 16; ++j) { const unsigned c = xb_ld(&bar[XB_XCNT(j)]); sum += c; cnt += (c > 0u) ? 1u : 0u; mine = (j == x) ? c : mine; }
        if (sum == G) break;
        __builtin_amdgcn_s_sleep(1);
        if ((++sp & 255u) == 0u) { if (xb_ld(&bar[XB_TMO])) break; if (sp > XB_SPIN_CAP) { atomicAdd(&bar[XB_TMO], 1u); break; } }
    }
    nloc = mine > 0u ? mine : 1u; nx = cnt > 0u ? cnt : 1u;
}

__device__ __forceinline__ void xcd_barrier(const XcdBarrier& b) {
    asm volatile("s_waitcnt vmcnt(0)" ::: "memory");
    __syncthreads();
    if (threadIdx.x == 0) {
        unsigned* bar = b.bar;
        __builtin_amdgcn_s_waitcnt(0);
        unsigned nloc = b.st[0], nx = b.st[1];
        if (nloc == 0u) { xcd_barrier_complete(bar, b.x, nloc, nx); b.st[0] = nloc; b.st[1] = nx; }
        const unsigned old = xb_add(&bar[XB_XSUB(b.x)], 1u);
        const unsigned gen = old / nloc;
        if (old + 1u == (gen + 1u) * nloc) {
            __builtin_amdgcn_fence(__ATOMIC_RELEASE, "agent");
            asm volatile("s_waitcnt vmcnt(0)" ::: "memory");
            const unsigned og = xb_add(&bar[XB_TOP], 1u);
            const unsigned tg = og / nx;
            if (og + 1u == (tg + 1u) * nx) xb_add(&bar[XB_TOPGEN], 1u);
            else XB_SPIN(xb_ld(&bar[XB_TOPGEN]) == tg, bar);
            __builtin_amdgcn_fence(__ATOMIC_ACQUIRE, "agent");
            xb_add(&bar[XB_XGEN(b.x)], 1u);
            asm volatile("s_waitcnt vmcnt(0)" ::: "memory");
        } else {
            XB_SPIN(xb_ld(&bar[XB_XGEN(b.x)]) == gen, bar);
            __builtin_amdgcn_fence(__ATOMIC_ACQUIRE, "agent");
            asm volatile("s_waitcnt vmcnt(0)" ::: "memory");
        }
    }
    __syncthreads();
}

typedef unsigned short bf16_t;
typedef short bf16x8 __attribute__((ext_vector_type(8)));
typedef float f32x4 __attribute__((ext_vector_type(4)));
typedef unsigned u32x4 __attribute__((ext_vector_type(4)));
typedef unsigned u32x2 __attribute__((ext_vector_type(2)));

struct Ctx {
    const float* x; const int* positions; const float *ln_mix, *ln_ffn, *ln_final, *w_in_ab, *w_pool, *pool_scale, *idx_k_norm, *w_out_ab, *w_in_c, *hgrn_lb, *hgrn_out_norm, *w_out_c, *w_gate_up, *w_down;
    float* out;
    unsigned* ctl; float* rope; float* part; float* lbv;
    bf16_t *W_inab, *W_pool, *W_outab, *W_inc, *W_outc, *W_gu0, *W_gu1, *W_dn0, *W_dn1;
    bf16_t *XB, *Y, *P, *ACT, *L1Q, *L1K, *L1I, *L1G, *ORAW;
    int G, bid;
};

__device__ __forceinline__ float bf_lo(unsigned w) { return __uint_as_float(w << 16); }
__device__ __forceinline__ float bf_hi(unsigned w) { return __uint_as_float(w & 0xffff0000u); }
__device__ __forceinline__ float bf2f(bf16_t b) { return __uint_as_float(((unsigned)b) << 16); }
__device__ __forceinline__ unsigned pk2(float lo, float hi) { return pg8::cvt_pk_bf16(lo, hi); }
__device__ __forceinline__ float wave_sum(float v) {
#pragma unroll
    for (int o = 1; o < 64; o <<= 1) v += __shfl_xor(v, o);
    return v;
}

__device__ __forceinline__ unsigned pk4_fp8(float a, float b, float c, float d) { int w = 0; w = __builtin_amdgcn_cvt_pk_fp8_f32(a, b, w, false); w = __builtin_amdgcn_cvt_pk_fp8_f32(c, d, w, true); return (unsigned)w; }
__device__ __forceinline__ u32x2 bf8_to_fp8(u32x4 w) { u32x2 o; o.x = pk4_fp8(bf_lo(w.x), bf_hi(w.x), bf_lo(w.y), bf_hi(w.y)); o.y = pk4_fp8(bf_lo(w.z), bf_hi(w.z), bf_lo(w.w), bf_hi(w.w)); return o; }

struct RowMapId { __device__ __forceinline__ int operator()(int n) const { return n; } };
struct RowMapAB { __device__ __forceinline__ int operator()(int n) const {
    if (n < PC_Q || (n >= PC_V && n < PC_QI) || n >= PC_WI) return n;
    const int d = n & 63; if (d >= 16) return n;
    return n - d + ((d < 8) ? 2 * d : 2 * (d - 8) + 1); } };
struct RowMapGU { __device__ __forceinline__ int operator()(int n) const {
    if (n < DFF) return 256 * (n >> 7) + (n & 127);
    const int f = n - DFF; return 256 * (f >> 7) + 128 + (f & 127); } };

template <class RowMap>
__device__ __forceinline__ void transpose_item(const float* W, int K, int N, const float* kgain, const float* nscale, bf16_t* WT, RowMap map, LAS float* scr, int item, int lane) {
    const int nblk = (N + 31) >> 5, kb = item / nblk, nb = item - kb * nblk, k0 = 64 * kb, n0 = 32 * nb;
    const int nr = n0 + (lane & 31); const float ns = (nr < N && nscale) ? nscale[nr] : 1.0f;
    float wv[32];
    const int nrc = (nr < N) ? nr : N - 1;
#pragma unroll
    for (int i = 0; i < 32; ++i) wv[i] = W[(size_t)(k0 + 2 * i + (lane >> 5)) * N + nrc];
    float kg[32];
#pragma unroll
    for (int i = 0; i < 32; ++i) kg[i] = kgain ? kgain[k0 + 2 * i + (lane >> 5)] : 1.0f;
#pragma unroll
    for (int i = 0; i < 32; ++i) { const int kk = 2 * i + (lane >> 5); scr[kk * 33 + (lane & 31)] = (nr < N) ? wv[i] * kg[i] * ns : 0.f; }
    asm volatile("s_waitcnt lgkmcnt(0)" ::: "memory");
    const int c = lane & 7;
#pragma unroll
    for (int j = 0; j < 4; ++j) { const int nl = (lane >> 3) + 8 * j; const LAS float* s = scr + (8 * c) * 33 + nl;
        u32x4 o; o.x = pk2(s[0 * 33], s[1 * 33]); o.y = pk2(s[2 * 33], s[3 * 33]); o.z = pk2(s[4 * 33], s[5 * 33]); o.w = pk2(s[6 * 33], s[7 * 33]);
        if (n0 + nl < N) *(u32x4*)(WT + (size_t)map(n0 + nl) * K + k0 + 8 * c) = o; }
    asm volatile("s_waitcnt lgkmcnt(0)" ::: "memory");
}

__device__ __forceinline__ void rope_cs(int pos, int i, float& c, float& s) {
    const double inv = (i == 0) ? 1.0 : (i == 1) ? 0.19392274474868576 : (i == 2) ? 0.03760603093086393 : (i == 3) ? 0.007292664737217109 : (i == 4) ? 0.001414213562373095
                     : (i == 5) ? 0.0002742481756762073 : (i == 6) ? 5.318295896944988e-05 : 1.031338537721246e-05;
    const double a = (double)pos * inv;
    const double kq = rint(a * 0.63661977236758134308);
    double r = fma(-kq, 1.57079632679489655800e+00, a); r = fma(-kq, 6.12323399573676603587e-17, r);
    const double r2 = r * r;
    double sp = -7.6471637318198164759e-13; sp = fma(sp, r2, 1.6059043836821614599e-10); sp = fma(sp, r2, -2.5052108385441718775e-08); sp = fma(sp, r2, 2.7557319223985890653e-06);
    sp = fma(sp, r2, -1.9841269841269841270e-04); sp = fma(sp, r2, 8.3333333333333333333e-03); sp = fma(sp, r2, -1.6666666666666666667e-01); const double sn = fma(sp * r2, r, r);
    double cp = 4.7794773323873852974e-14; cp = fma(cp, r2, -1.1470745597729724714e-11); cp = fma(cp, r2, 2.0876756987868098979e-09); cp = fma(cp, r2, -2.7557319223985890653e-07);
    cp = fma(cp, r2, 2.4801587301587301587e-05); cp = fma(cp, r2, -1.3888888888888888889e-03); cp = fma(cp, r2, 4.1666666666666666667e-02); cp = fma(cp, r2, -0.5); const double cn = fma(cp, r2, 1.0);
    const int q = ((int)kq) & 3;
    const double cc = (q == 0) ? cn : (q == 1) ? -sn : (q == 2) ? -cn : sn;
    const double ss = (q == 0) ? sn : (q == 1) ? cn : (q == 2) ? -sn : -cn;
    c = (float)cc; s = (float)ss;
}

__device__ __forceinline__ void phase_prologue(const Ctx& C, LAS unsigned char* lds) {
    const int tid = threadIdx.x, lane = tid & 63, wave = __builtin_amdgcn_readfirstlane(tid >> 6);
    LAS float* scr = (LAS float*)(lds + wave * 16384);
    const int gw = C.bid * 8 + wave, NGW = C.G * 8;
    constexpr int I_AB = 16 * 51, I_PL = 2 * 4, I_SQ = 16 * 32, I_INC = 16 * 128, I_GU = 16 * 176, I_DN = 44 * 32;
    constexpr int NITEMS = I_AB + 4 * I_PL + I_SQ + I_INC + I_SQ + 2 * I_GU + 2 * I_DN;
    for (int it = gw; it < NITEMS; it += NGW) {
        int r = it;
        if (r < I_AB) { transpose_item(C.w_in_ab, 1024, NAB_REAL, C.ln_mix, nullptr, C.W_inab, RowMapAB(), scr, r, lane); continue; } r -= I_AB;
        if (r < 4 * I_PL) { const int g = r / I_PL; transpose_item(C.w_pool + g * 16384, 128, 128, nullptr, C.pool_scale + g * 128, C.W_pool + g * 16384, RowMapId(), scr, r - g * I_PL, lane); continue; } r -= 4 * I_PL;
        if (r < I_SQ) { transpose_item(C.w_out_ab, 1024, 1024, nullptr, nullptr, C.W_outab, RowMapId(), scr, r, lane); continue; } r -= I_SQ;
        if (r < I_INC) { transpose_item(C.w_in_c, 1024, NINC, C.ln_mix + 1024, nullptr, C.W_inc, RowMapId(), scr, r, lane); continue; } r -= I_INC;
        if (r < I_SQ) { transpose_item(C.w_out_c, 1024, 1024, nullptr, nullptr, C.W_outc, RowMapId(), scr, r, lane); continue; } r -= I_SQ;
        if (r < I_GU) { transpose_item(C.w_gate_up, 1024, 2 * DFF, C.ln_ffn, nullptr, C.W_gu0, RowMapGU(), scr, r, lane); continue; } r -= I_GU;
        if (r < I_GU) { transpose_item(C.w_gate_up + (size_t)1024 * 2 * DFF, 1024, 2 * DFF, C.ln_ffn + 1024, nullptr, C.W_gu1, RowMapGU(), scr, r, lane); continue; } r -= I_GU;
        if (r < I_DN) { transpose_item(C.w_down, DFF, 1024, nullptr, nullptr, C.W_dn0, RowMapId(), scr, r, lane); continue; } r -= I_DN;
        transpose_item(C.w_down + (size_t)DFF * 1024, DFF, 1024, nullptr, nullptr, C.W_dn1, RowMapId(), scr, r, lane);
    }
    const int gt = C.bid * 512 + tid, NGT = C.G * 512;
    for (int i = gt; i < (NAB - NAB_REAL) * 1024 / 8; i += NGT) ((u32x4*)(C.W_inab + (size_t)NAB_REAL * 1024))[i] = (u32x4){0u, 0u, 0u, 0u};
    for (int i = gt; i < NTOK * 8; i += NGT) { const int tok = i >> 3, f = i & 7; float c, s; rope_cs(C.positions[tok], f, c, s); C.rope[(size_t)tok * 16 + f] = c; C.rope[(size_t)tok * 16 + 8 + f] = s; }
    for (int i = gt; i < 1024; i += NGT) C.lbv[i] = 1.0f / (1.0f + expf(C.hgrn_lb[i] - C.hgrn_lb[1024 + i]));
    for (int row0 = 4 * gw; row0 < NTOK; row0 += 4 * NGW) {
        f32x4 v[4][4];
#pragma unroll
        for (int rr = 0; rr < 4; ++rr)
#pragma unroll
            for (int j = 0; j < 4; ++j) v[rr][j] = ((const f32x4*)(C.x + (size_t)(row0 + rr) * 1024) + lane)[64 * j];
#pragma unroll
        for (int rr = 0; rr < 4; ++rr) { const int row = row0 + rr; u32x2* o8 = (u32x2*)(C.XB + (size_t)row * 1024) + lane; float s = 0.f;
#pragma unroll
            for (int j = 0; j < 4; ++j) { const f32x4 x4 = v[rr][j]; s += (x4[0] * x4[0] + x4[1] * x4[1]) + (x4[2] * x4[2] + x4[3] * x4[3]); u32x2 w; w.x = pk2(x4[0], x4[1]); w.y = pk2(x4[2], x4[3]); o8[64 * j] = w; }
            s = wave_sum(s);
            if (lane < 16) C.part[(size_t)row * 16 + lane] = (lane == 0) ? s : 0.f; }
    }
}

__device__ __forceinline__ void phase_fixup_pool(const Ctx& C, LAS unsigned char* lds) {
    const int tid = threadIdx.x, lane = tid & 63, wid = __builtin_amdgcn_readfirstlane(tid >> 6);
    for (int tile = C.bid; tile < NTOK / 128; tile += C.G) {
        const int tok0 = tile * 128;
        for (int it = tid; it < 128 * 16; it += 512) {
            const int tl = it >> 4, slot = it & 15;
            const int tok = tok0 + tl;
            unsigned char* kv8 = (unsigned char*)C.ctl + WS_KV8 + (size_t)tok * 256;
            if (slot == 15) {
                const bf16_t* vp = C.P + (size_t)tok * NAB + PC_V;
#pragma unroll
                for (int q2 = 0; q2 < 8; ++q2) { const u32x2 a = bf8_to_fp8(*(const u32x4*)(vp + 16 * q2)), b = bf8_to_fp8(*(const u32x4*)(vp + 16 * q2 + 8)); *(u32x4*)(kv8 + 128 + 16 * q2) = (u32x4){a.x, a.y, b.x, b.y}; }
                continue; }
            const f32x4* rp = (const f32x4*)(C.rope + (size_t)tok * 16);
            const f32x4 c0 = rp[0], c1 = rp[1], s0 = rp[2], s1 = rp[3];
            const float cs[8] = {c0[0], c0[1], c0[2], c0[3], c1[0], c1[1], c1[2], c1[3]}, sn[8] = {s0[0], s0[1], s0[2], s0[3], s1[0], s1[1], s1[2], s1[3]};
            bf16_t* rowp = C.P + (size_t)tok * NAB;
            if (slot < 14) {
                const int col = (slot < 8) ? PC_Q + 64 * slot : (slot < 10) ? PC_K + 64 * (slot - 8) : PC_QI + 64 * (slot - 10);
                u32x4 w0 = *(u32x4*)(rowp + col), w1 = *(u32x4*)(rowp + col + 8);
                unsigned w[8] = {w0.x, w0.y, w0.z, w0.w, w1.x, w1.y, w1.z, w1.w};
#pragma unroll
                for (int i = 0; i < 8; ++i) { const float x1 = bf_lo(w[i]), x2 = bf_hi(w[i]); w[i] = pk2(x1 * cs[i] - x2 * sn[i], x2 * cs[i] + x1 * sn[i]); }
                *(u32x4*)(rowp + col) = (u32x4){w[0], w[1], w[2], w[3]}; *(u32x4*)(rowp + col + 8) = (u32x4){w[4], w[5], w[6], w[7]};
                if (slot == 8 || slot == 9) {
                    unsigned char* kd = kv8 + 64 * (slot - 8);
                    { const u32x2 a = bf8_to_fp8((u32x4){w[0], w[1], w[2], w[3]}), b = bf8_to_fp8((u32x4){w[4], w[5], w[6], w[7]}); *(u32x4*)kd = (u32x4){a.x, a.y, b.x, b.y}; }
#pragma unroll
                    for (int q2 = 1; q2 < 4; ++q2) { const u32x2 a = bf8_to_fp8(*(const u32x4*)(rowp + col + 16 * q2)), b = bf8_to_fp8(*(const u32x4*)(rowp + col + 16 * q2 + 8)); *(u32x4*)(kd + 16 * q2) = (u32x4){a.x, a.y, b.x, b.y}; } }
            } else {
                unsigned w[32];
#pragma unroll
                for (int q = 0; q < 8; ++q) { const u32x4 t = *(u32x4*)(rowp + PC_KI + 8 * q); w[4 * q] = t.x; w[4 * q + 1] = t.y; w[4 * q + 2] = t.z; w[4 * q + 3] = t.w; }
                float ss = 0.f;
#pragma unroll
                for (int i = 0; i < 32; ++i) { const float a = bf_lo(w[i]), b = bf_hi(w[i]); ss += a * a + b * b; }
                const float r = 1.0f / sqrtf(ss * (1.0f / 64.0f) + EPS);
#pragma unroll
                for (int i = 0; i < 32; ++i) {
                    const int d0 = (i < 8) ? i : 2 * i, d1 = (i < 8) ? i + 8 : 2 * i + 1;
                    float a = bf_lo(w[i]) * r * C.idx_k_norm[d0], b = bf_hi(w[i]) * r * C.idx_k_norm[d1];
                    if (i < 8) { const float x1 = a, x2 = b; a = x1 * cs[i] - x2 * sn[i]; b = x2 * cs[i] + x1 * sn[i]; }
                    w[i] = pk2(a, b); }
#pragma unroll
                for (int q = 0; q < 8; ++q) *(u32x4*)(rowp + PC_KI + 8 * q) = (u32x4){w[4 * q], w[4 * q + 1], w[4 * q + 2], w[4 * q + 3]};
            }
        }
        const int fr = lane & 15, fq = lane >> 4;
        const int tl0 = wid * 16 + fr, tok = tok0 + tl0, t = tok & (SEQ - 1);
        const bool hist = (tok0 & (SEQ - 1)) != 0;
        LAS unsigned char* ubuf = lds; LAS unsigned char* wbuf = lds + 39424;
        u32x4 ur[5], wv[4];
#define POOL_LOAD(gx) { _Pragma("unroll") for (int i = 0; i < 5; ++i) { int p = tid + 512 * i; p = p < 2288 ? p : 2287; const int r = p >> 4, pc = p & 15; const int trow = (r < 15 && !hist) ? tok0 : tok0 - 15 + r; \
            ur[i] = *(const u32x4*)(C.P + (size_t)trow * NAB + PC_U + (gx) * 128 + pc * 8); } \
        _Pragma("unroll") for (int i = 0; i < 4; ++i) wv[i] = *(const u32x4*)(C.W_pool + (gx) * 16384 + (tid + 512 * i) * 8); }
        POOL_LOAD(0)
#pragma unroll 1
        for (int g = 0; g < 4; ++g) {
            __syncthreads();
#pragma unroll
            for (int i = 0; i < 5; ++i) { const int p = tid + 512 * i; if (p < 2288) *(LAS u32x4*)(ubuf + (p >> 4) * 272 + (p & 15) * 16) = ur[i]; }
#pragma unroll
            for (int i = 0; i < 4; ++i) { const int p = tid + 512 * i, d = p >> 4; const int slot = (d & ~31) + 16 * ((d >> 2) & 1) + 4 * ((d >> 3) & 3) + (d & 3); *(LAS u32x4*)(wbuf + slot * 272 + (p & 15) * 16) = wv[i]; }
            __syncthreads();
            if (g < 3) POOL_LOAD(g + 1)
            const int win = 2 << g;
            const int cnt = (t + 1 < win) ? t + 1 : win; const float rc = 1.0f / (float)cnt;
            f32x4 acc[4][2];
#pragma unroll
            for (int a = 0; a < 4; ++a) { acc[a][0] = (f32x4){0.f, 0.f, 0.f, 0.f}; acc[a][1] = (f32x4){0.f, 0.f, 0.f, 0.f}; }
#pragma unroll
            for (int kk = 0; kk < 4; ++kk) {
                const LAS unsigned char* up = ubuf + (15 + tl0) * 272 + kk * 64 + fq * 16;
                float s[8], cur[8];
                { const u32x4 wx = *(const LAS u32x4*)up; cur[0] = bf_lo(wx.x); cur[1] = bf_hi(wx.x); cur[2] = bf_lo(wx.y); cur[3] = bf_hi(wx.y); cur[4] = bf_lo(wx.z); cur[5] = bf_hi(wx.z); cur[6] = bf_lo(wx.w); cur[7] = bf_hi(wx.w); }
#pragma unroll
                for (int i = 0; i < 8; ++i) s[i] = cur[i];
                for (int j = 1; j < win; ++j) {
                    const u32x4 wx = *(const LAS u32x4*)(up - j * 272); const float m = (j <= t) ? 1.0f : 0.0f;
                    s[0] += m * bf_lo(wx.x); s[1] += m * bf_hi(wx.x); s[2] += m * bf_lo(wx.y); s[3] += m * bf_hi(wx.y); s[4] += m * bf_lo(wx.z); s[5] += m * bf_hi(wx.z); s[6] += m * bf_lo(wx.w); s[7] += m * bf_hi(wx.w); }
                u32x4 af; af.x = pk2(s[0] * rc - cur[0], s[1] * rc - cur[1]); af.y = pk2(s[2] * rc - cur[2], s[3] * rc - cur[3]); af.z = pk2(s[4] * rc - cur[4], s[5] * rc - cur[5]); af.w = pk2(s[6] * rc - cur[6], s[7] * rc - cur[7]);
                const bf16x8 a = __builtin_bit_cast(bf16x8, af);
#pragma unroll
                for (int nn = 0; nn < 4; ++nn)
#pragma unroll
                    for (int n = 0; n < 2; ++n) {
                        const bf16x8 bfr = *(const LAS bf16x8*)(wbuf + (32 * nn + 16 * n + fr) * 272 + kk * 64 + fq * 16);
                        acc[nn][n] = __builtin_amdgcn_mfma_f32_16x16x32_bf16(bfr, a, acc[nn][n], 0, 0, 0); }
            }
#pragma unroll
            for (int nn = 0; nn < 4; ++nn) { u32x4 w; w.x = pk2(acc[nn][0][0], acc[nn][0][1]); w.y = pk2(acc[nn][0][2], acc[nn][0][3]); w.z = pk2(acc[nn][1][0], acc[nn][1][1]); w.w = pk2(acc[nn][1][2], acc[nn][1][3]);
                *(u32x4*)(C.Y + (size_t)tok * 1024 + g * 128 + 32 * nn + 8 * fq) = w; }
        }
#undef POOL_LOAD
    }
}

__device__ __forceinline__ unsigned fkey(float f) { const unsigned u = __float_as_uint(f); return u ^ ((unsigned)((int)u >> 31) | 0x80000000u); }

__device__ __forceinline__ void phase_attn_simple(const Ctx& C, LAS unsigned char* lds) {
    const int tid = threadIdx.x, lane = tid & 63, wid = tid >> 6;
    LAS unsigned* sc = (LAS unsigned*)lds;
    LAS float* qif = (LAS float*)(lds + 32768);
    LAS float* qf = (LAS float*)(lds + 32768 + 1024);
    LAS unsigned* hist = (LAS unsigned*)(lds + 32768 + 1024 + 2048);
    LAS unsigned* wsum = hist + 256;
    LAS unsigned* ctl = wsum + 16;
    LAS unsigned short* sel = (LAS unsigned short*)(ctl + 8);
    LAS float* pr = (LAS float*)(sel + 256);
    LAS float* red = pr + 2048;
    LAS float* red2 = red + 64;
    for (int qx = C.bid; qx < NTOK; qx += C.G) {
        const int tok = qx, b = tok >> 13, t = tok & (SEQ - 1), n = t + 1;
        const bf16_t* prow = C.P + (size_t)tok * NAB;
        const bf16_t* pb = C.P + (size_t)(b << 13) * NAB;
        __syncthreads();
        if (tid < 256) qif[tid] = bf2f(prow[PC_QI + tid]);
        qf[tid] = bf2f(prow[PC_Q + tid]);
        if (tid == 0) { ctl[0] = 0u; ctl[1] = TOPK; ctl[2] = 0u; }
        float wi[4];
#pragma unroll
        for (int h = 0; h < 4; ++h) wi[h] = bf2f(prow[PC_WI + h]) * 0.0625f;
        __syncthreads();
        for (int s = tid; s < n; s += 512) {
            asm volatile("" ::: "memory");
            const u32x4* kr = (const u32x4*)(pb + (size_t)s * NAB + PC_KI);
            float d0 = 0.f, d1 = 0.f, d2 = 0.f, d3 = 0.f;
#pragma unroll
            for (int q = 0; q < 8; ++q) { const u32x4 w = kr[q]; const float kv[8] = {bf_lo(w.x), bf_hi(w.x), bf_lo(w.y), bf_hi(w.y), bf_lo(w.z), bf_hi(w.z), bf_lo(w.w), bf_hi(w.w)};
#pragma unroll
                for (int j = 0; j < 8; ++j) { const int d = 8 * q + j; d0 += qif[d] * kv[j]; d1 += qif[64 + d] * kv[j]; d2 += qif[128 + d] * kv[j]; d3 += qif[192 + d] * kv[j]; } }
            float scv = 0.0f;
            scv = fmaf(wi[0], fmaxf(d0, 0.f), scv); scv = fmaf(wi[1], fmaxf(d1, 0.f), scv); scv = fmaf(wi[2], fmaxf(d2, 0.f), scv); scv = fmaf(wi[3], fmaxf(d3, 0.f), scv);
            sc[s] = fkey(scv);
        }
        __syncthreads();
        int nsel;
        if (n <= TOPK) { if (tid < n) sel[tid] = (unsigned short)tid; nsel = n; }
        else {
            nsel = TOPK;
            for (int pass = 0; pass < 4; ++pass) {
                const int shift = 24 - 8 * pass;
                if (tid < 256) hist[tid] = 0u;
                __syncthreads();
                const unsigned prefix = ctl[0]; const unsigned himask = (pass == 0) ? 0u : (0xffffffffu << (shift + 8));
                for (int s = tid; s < n; s += 512) { const unsigned k = sc[s]; if ((k & himask) == prefix) __hip_atomic_fetch_add(&hist[(k >> shift) & 255u], 1u, __ATOMIC_RELAXED, __HIP_MEMORY_SCOPE_WORKGROUP); }
                __syncthreads();
                if (wid == 0) {
                    const unsigned need = ctl[1];
                    const unsigned c0 = hist[255 - 4 * lane], c1 = hist[254 - 4 * lane], c2 = hist[253 - 4 * lane], c3 = hist[252 - 4 * lane];
                    const unsigned tot = c0 + c1 + c2 + c3; unsigned incl = tot;
#pragma unroll
                    for (int o = 1; o < 64; o <<= 1) { const unsigned v = __shfl_up(incl, o); if (lane >= o) incl += v; }
                    const unsigned excl = incl - tot;
                    if (excl < need && need <= incl) {
                        const unsigned r = need - excl; unsigned bin, above;
                        if (r <= c0) { bin = 255 - 4 * lane; above = excl; }
                        else if (r <= c0 + c1) { bin = 254 - 4 * lane; above = excl + c0; }
                        else if (r <= c0 + c1 + c2) { bin = 253 - 4 * lane; above = excl + c0 + c1; }
                        else { bin = 252 - 4 * lane; above = excl + c0 + c1 + c2; }
                        ctl[0] = prefix | (bin << shift); ctl[1] = need - above;
                    }
                }
                __syncthreads();
            }
            const unsigned T = ctl[0], mneed = ctl[1];
            unsigned ceq = 0;
#pragma unroll
            for (int j = 0; j < 16; ++j) { const int s = tid * 16 + j; if (s < n && sc[s] == T) ++ceq; }
            unsigned incl = ceq;
#pragma unroll
            for (int o = 1; o < 64; o <<= 1) { const unsigned v = __shfl_up(incl, o); if (lane >= o) incl += v; }
            if (lane == 63) wsum[wid] = incl;
            __syncthreads();
            unsigned base = 0;
            for (int w = 0; w < wid; ++w) base += wsum[w];
            unsigned rank = base + incl - ceq;
            for (int j = 0; j < 16; ++j) { const int s = tid * 16 + j;
                if (s < n) { const unsigned k = sc[s]; bool take = k > T; if (k == T) { take = rank < mneed; ++rank; }
                    if (take) { const unsigned slot = __hip_atomic_fetch_add(&ctl[2], 1u, __ATOMIC_RELAXED, __HIP_MEMORY_SCOPE_WORKGROUP); if (slot < TOPK) sel[slot] = (unsigned short)s; } } }
        }
        __syncthreads();
        {
            const int j = tid & 255, hh = tid >> 8;
            float sv[4] = {-INFINITY, -INFINITY, -INFINITY, -INFINITY};
            if (j < nsel) {
                const u32x4* kr = (const u32x4*)(pb + (size_t)sel[j] * NAB + PC_K + 64 * hh);
                float d[4] = {0.f, 0.f, 0.f, 0.f};
#pragma unroll
                for (int q = 0; q < 8; ++q) { const u32x4 w = kr[q]; const float kv[8] = {bf_lo(w.x), bf_hi(w.x), bf_lo(w.y), bf_hi(w.y), bf_lo(w.z), bf_hi(w.z), bf_lo(w.w), bf_hi(w.w)};
#pragma unroll
                    for (int e = 0; e < 8; ++e)
#pragma unroll
                        for (int r = 0; r < 4; ++r) d[r] += qf[(4 * hh + r) * 64 + 8 * q + e] * kv[e]; }
#pragma unroll
                for (int r = 0; r < 4; ++r) sv[r] = d[r] * 0.125f;
            }
#pragma unroll
            for (int r = 0; r < 4; ++r) { float m = sv[r];
#pragma unroll
                for (int o = 1; o < 64; o <<= 1) m = fmaxf(m, __shfl_xor(m, o));
                if (lane == 0) red[(4 * hh + r) * 8 + (wid & 3)] = m; }
            __syncthreads();
            float ev[4];
#pragma unroll
            for (int r = 0; r < 4; ++r) { const int h = 4 * hh + r; const float m = fmaxf(fmaxf(red[h * 8], red[h * 8 + 1]), fmaxf(red[h * 8 + 2], red[h * 8 + 3]));
                ev[r] = (j < nsel) ? __expf(sv[r] - m) : 0.f; float sm = ev[r];
#pragma unroll
                for (int o = 1; o < 64; o <<= 1) sm += __shfl_xor(sm, o);
                if (lane == 0) red2[h * 8 + (wid & 3)] = sm; }
            __syncthreads();
#pragma unroll
            for (int r = 0; r < 4; ++r) { const int h = 4 * hh + r; const float sm = (red2[h * 8] + red2[h * 8 + 1]) + (red2[h * 8 + 2] + red2[h * 8 + 3]);
                pr[h * 256 + j] = ev[r] / sm; }
        }
        __syncthreads();
        {
            const int h = tid >> 6, g = h >> 2; float o = 0.f;
            const bf16_t* vb = pb + PC_V + 64 * g + lane;
            for (int j = 0; j < nsel; ++j) o += pr[h * 256 + j] * bf2f(vb[(size_t)sel[j] * NAB]);
            C.Y[(size_t)tok * 1024 + 512 + tid] = (bf16_t)(pk2(o, 0.f) & 0xffffu);
        }
    }
}

__device__ __forceinline__ void phase_hgrn_simple(const Ctx& C) {
    const int tid = threadIdx.x, lane = tid & 63, wid = tid >> 6;
    for (int unit = C.bid; unit < BATCH * 8 * 8; unit += C.G) {
        const int b = unit >> 6, h = (unit >> 3) & 7, sl = unit & 7;
        const int e = sl * 16 + 2 * wid + (lane >> 5), dg = lane & 31;
        const size_t cq = (size_t)h * 128 + 4 * dg, cv = (size_t)h * 128 + e;
        float S0 = 0.f, S1 = 0.f, S2 = 0.f, S3 = 0.f;
        const size_t tok0 = (size_t)b * SEQ;
        for (int t0 = 0; t0 < SEQ; t0 += 8) {
            u32x2 qv[8], kv[8]; bf16_t vv[8];
#pragma unroll
            for (int u = 0; u < 8; ++u) { const size_t ro = (tok0 + t0 + u) * 1024; qv[u] = *(const u32x2*)(C.L1Q + ro + cq); kv[u] = *(const u32x2*)(C.L1K + ro + cq); vv[u] = C.L1I[ro + cv]; }
#pragma unroll
            for (int u = 0; u < 8; ++u) {
                const float k0 = bf_lo(kv[u].x), k1 = bf_hi(kv[u].x), k2 = bf_lo(kv[u].y), k3 = bf_hi(kv[u].y), v = bf2f(vv[u]);
                S0 = (1.0f - k0) * S0 + k0 * v; S1 = (1.0f - k1) * S1 + k1 * v; S2 = (1.0f - k2) * S2 + k2 * v; S3 = (1.0f - k3) * S3 + k3 * v;
                float o = (bf_lo(qv[u].x) * S0 + bf_hi(qv[u].x) * S1) + (bf_lo(qv[u].y) * S2 + bf_hi(qv[u].y) * S3);
#pragma unroll
                for (int off = 1; off < 32; off <<= 1) o += __shfl_xor(o, off);
                if (dg == 0) C.ORAW[(tok0 + t0 + u) * 1024 + cv] = (bf16_t)(pk2(o, 0.f) & 0xffffu);
            }
        }
    }
}
__device__ __forceinline__ void phase_hgrn_post(const Ctx& C) {
    const int tid = threadIdx.x, lane = tid & 63, wave = tid >> 6;
    const int gw = C.bid * 8 + wave, NGW = C.G * 8;
    for (int tok = gw; tok < NTOK; tok += NGW) {
        const size_t ro = (size_t)tok * 1024 + 16 * lane;
        const u32x4 a0 = *(const u32x4*)(C.ORAW + ro), a1 = *(const u32x4*)(C.ORAW + ro + 8), g0 = *(const u32x4*)(C.L1G + ro), g1 = *(const u32x4*)(C.L1G + ro + 8);
        const unsigned aw[8] = {a0.x, a0.y, a0.z, a0.w, a1.x, a1.y, a1.z, a1.w}, gwd[8] = {g0.x, g0.y, g0.z, g0.w, g1.x, g1.y, g1.z, g1.w};
        float ss = 0.f;
#pragma unroll
        for (int i = 0; i < 8; ++i) { const float x = bf_lo(aw[i]), y = bf_hi(aw[i]); ss += x * x + y * y; }
        ss += __shfl_xor(ss, 1); ss += __shfl_xor(ss, 2); ss += __shfl_xor(ss, 4);
        const float r = 1.0f / sqrtf(ss * (1.0f / 128.0f) + EPS);
        const float* nw = C.hgrn_out_norm + 16 * (lane & 7);
        unsigned ow[8];
#pragma unroll
        for (int i = 0; i < 8; ++i) ow[i] = pk2(bf_lo(aw[i]) * r * nw[2 * i] * bf_lo(gwd[i]), bf_hi(aw[i]) * r * nw[2 * i + 1] * bf_hi(gwd[i]));
        *(u32x4*)(C.Y + ro) = (u32x4){ow[0], ow[1], ow[2], ow[3]}; *(u32x4*)(C.Y + ro + 8) = (u32x4){ow[4], ow[5], ow[6], ow[7]};
    }
}
__device__ __forceinline__ void phase_final_norm(const Ctx& C) {
    const int gt = C.bid * 512 + threadIdx.x, NGT = C.G * 512;
    for (int i = gt; i < NTOK * 128; i += NGT) { const int row = i >> 7, c8 = (i & 127) * 8;
        const float r = pg8::row_rinv(C.part, row);
        const u32x4 b = *(const u32x4*)(C.XB + (size_t)row * 1024 + c8); const f32x4 g0 = *(const f32x4*)(C.ln_final + c8), g1 = *(const f32x4*)(C.ln_final + c8 + 4);
        f32x4 o0, o1; o0[0] = bf_lo(b.x) * r * g0[0]; o0[1] = bf_hi(b.x) * r * g0[1]; o0[2] = bf_lo(b.y) * r * g0[2]; o0[3] = bf_hi(b.y) * r * g0[3];
        o1[0] = bf_lo(b.z) * r * g1[0]; o1[1] = bf_hi(b.z) * r * g1[1]; o1[2] = bf_lo(b.w) * r * g1[2]; o1[3] = bf_hi(b.w) * r * g1[3];
        *(f32x4*)(C.out + (size_t)row * 1024 + c8) = o0; *(f32x4*)(C.out + (size_t)row * 1024 + c8 + 4) = o1; }
}

typedef float f32x16 __attribute__((ext_vector_type(16)));
typedef float f32x2 __attribute__((ext_vector_type(2)));
constexpr int AQ = 32;
constexpr int A_SEL = 131072;
constexpr int A_QS = A_SEL + AQ * 256 * 2;
constexpr int VROW = 144;

__device__ __forceinline__ float relu_f(float x) { const int b = __float_as_int(x); return __int_as_float(b > 0 ? b : 0); }
__device__ __forceinline__ unsigned score_x(float v) {
    const unsigned acb = __float_as_uint(__builtin_amdgcn_fmed3f(__builtin_fabsf(v), __uint_as_float(0x30000000u), __uint_as_float(0x3fffffffu)));
    return acb ^ (unsigned)((int)__float_as_uint(v) >> 31);
}
__device__ __forceinline__ void idx_tile16(const bf16x8 k0, const bf16x8 k1, const bf16x8 (&qb)[4][2], const float (&wq)[4], float (&sc)[4]) {
#pragma unroll
    for (int r = 0; r < 4; ++r) sc[r] = 0.0f;
#pragma unroll
    for (int h = 0; h < 4; ++h) { f32x4 a = (f32x4){0.f, 0.f, 0.f, 0.f};
        a = __builtin_amdgcn_mfma_f32_16x16x32_bf16(k0, qb[h][0], a, 0, 0, 0); a = __builtin_amdgcn_mfma_f32_16x16x32_bf16(k1, qb[h][1], a, 0, 0, 0);
#pragma unroll
        for (int r = 0; r < 4; ++r) sc[r] = fmaf(wq[h], relu_f(a[r]), sc[r]); }
}


__device__ __forceinline__ unsigned wave_incl_scan(unsigned v, int lane) {
    v += (unsigned)__builtin_amdgcn_update_dpp(0, (int)v, 0x111, 0xf, 0xf, false);
    v += (unsigned)__builtin_amdgcn_update_dpp(0, (int)v, 0x112, 0xf, 0xf, false);
    v += (unsigned)__builtin_amdgcn_update_dpp(0, (int)v, 0x114, 0xf, 0xf, false);
    v += (unsigned)__builtin_amdgcn_update_dpp(0, (int)v, 0x118, 0xf, 0xf, false);
    const unsigned r0 = (unsigned)__builtin_amdgcn_readlane((int)v, 15), r1 = (unsigned)__builtin_amdgcn_readlane((int)v, 31), r2 = (unsigned)__builtin_amdgcn_readlane((int)v, 47);
    const int row = lane >> 4;
    return v + (row >= 1 ? r0 : 0u) + (row >= 2 ? r1 : 0u) + (row >= 3 ? r2 : 0u);
}

__device__ __forceinline__ void phase_attn(const Ctx& C, LAS unsigned char* lds) {
    const int tid = threadIdx.x, lane0 = tid & 63, wid = __builtin_amdgcn_readfirstlane(tid >> 6);
    LAS unsigned* hist = (LAS unsigned*)lds;
    LAS unsigned short* sel = (LAS unsigned short*)(lds + A_SEL);
    LAS unsigned* tpool = (LAS unsigned*)(lds + 65536); constexpr int TCAP = 16384;
    LAS unsigned* dummy = (LAS unsigned*)(lds + A_QS + 1024) + tid;
    LAS unsigned* bmp = (LAS unsigned*)(lds + 32768);
    LAS int* q_bin = (LAS int*)(lds + A_QS); LAS int* q_need = q_bin + 32; LAS int* q_cnt = q_bin + 64; LAS int* q_off = q_bin + 96; LAS int* q_selc = q_bin + 128; LAS int* q_tiec = q_bin + 160;
    unsigned* pool = (unsigned*)((unsigned char*)C.ctl + (C.bid < 64 ? WS_XB + (size_t)C.bid * MiB : 296 * MiB + (size_t)(C.bid - 64) * MiB));
    const int nbw = C.G >> 2, ntile = SEQ / AQ, jb = C.bid >> 2;
    for (int ui = 0; ui * nbw < ntile; ++ui) {
        const int rank = ui * nbw + ((ui & 1) ? (nbw - 1 - jb) : jb);
        if (jb >= nbw || rank >= ntile) continue;
        const int tile = (ntile - 1) - rank, b = C.bid & 3, t0 = tile * AQ, tok0 = b * SEQ + t0;
        const bf16_t* pb = C.P + (size_t)(b * SEQ) * NAB;
        const unsigned char* kv8b = (const unsigned char*)C.ctl + WS_KV8 + (size_t)(b * SEQ) * 256;
        __syncthreads();
        int ln = lane0; asm volatile("" : "+v"(ln)); const int lane = ln;
        if (t0 < TOPK) {
            int tf = tid; asm volatile("" : "+v"(tf));
            for (int i = tf; i < AQ * 256; i += 512) { const int q = i >> 8, j = i & 255; sel[i] = (unsigned short)((j <= t0 + q) ? j : 0); }
        } else {
            { int tz = tid; asm volatile("" : "+v"(tz)); for (int i = tz; i < AQ * 1024 / 4; i += 512) ((LAS u32x4*)hist)[i] = (u32x4){0u, 0u, 0u, 0u}; }
            const int qc = ln & 15, fq = ln >> 4;
            bf16x8 qb[2][4][2]; float wq[2][4];
#pragma unroll
            for (int hf = 0; hf < 2; ++hf) { const bf16_t* qrow = C.P + (size_t)(tok0 + 16 * hf + qc) * NAB;
#pragma unroll
              for (int h = 0; h < 4; ++h) { wq[hf][h] = bf2f(qrow[PC_WI + h]) * 1.9073486328125e-06f;
#pragma unroll
                  for (int ks = 0; ks < 2; ++ks) qb[hf][h][ks] = *(const bf16x8*)(qrow + PC_QI + h * 64 + ks * 32 + 8 * fq); } }
            const int kdiag0 = 2 * tile;
            const bf16_t* kbase = pb + (size_t)qc * NAB + PC_KI + 8 * fq;
            __syncthreads();
            bf16x8 kr[4][2]; const int kmaxt = kdiag0 + 1;
#define IDX_RING_LOAD(j, ktx) { const int ktc_ = ((ktx) <= kmaxt) ? (ktx) : kmaxt; const bf16_t* kp_ = kbase + (size_t)(ktc_ * 16) * NAB; kr[j][0] = *(const bf16x8*)kp_; kr[j][1] = *(const bf16x8*)(kp_ + 32); }
#pragma unroll
            for (int j = 0; j < 4; ++j) IDX_RING_LOAD(j, wid + 8 * j)
            for (int kt0 = wid; kt0 <= kmaxt; kt0 += 32) {
#pragma unroll
                for (int j = 0; j < 4; ++j) { const int kt = kt0 + 8 * j;
                    if (kt <= kmaxt) {
#pragma unroll
                        for (int hf = 0; hf < 2; ++hf) if (kt <= kdiag0 + hf) {
                            float sc[4]; idx_tile16(kr[j][0], kr[j][1], qb[hf], wq[hf], sc);
                            const int qn = 16 * hf + qc; LAS unsigned* hrow = hist + qn * 1024;
                            if (kt != kdiag0 + hf) {
#pragma unroll
                                for (int r = 0; r < 4; ++r) { const unsigned x = score_x(sc[r]);
                                    __hip_atomic_fetch_add(&hrow[((x >> 19) & 0x3ffu) ^ (unsigned)qn], (x & 0x40000u) ? 65536u : 1u, __ATOMIC_RELAXED, __HIP_MEMORY_SCOPE_WORKGROUP); }
                            } else {
#pragma unroll
                                for (int r = 0; r < 4; ++r) { const unsigned x = score_x(sc[r]);
                                    __hip_atomic_fetch_add(&hrow[((x >> 19) & 0x3ffu) ^ (unsigned)qn], (4 * fq + r <= qc) ? ((x & 0x40000u) ? 65536u : 1u) : 0u, __ATOMIC_RELAXED, __HIP_MEMORY_SCOPE_WORKGROUP); } } } }
                    IDX_RING_LOAD(j, kt + 32) }
            }
            __syncthreads();
#if defined(DBG_REPEAT) && DBG_REPEAT == 35
#pragma unroll 1
            for (int i8 = 0; i8 < 8; ++i8) { const int i = i8 & 3; const int q = 4 * wid + i;
#else
#pragma unroll 1
            for (int i = 0; i < 4; ++i) { const int q = 4 * wid + i;
#endif
                unsigned hw[16]; unsigned tot = 0;
#pragma unroll
                for (int j = 0; j < 16; ++j) { hw[j] = hist[q * 1024 + ((1023 - 16 * lane - j) ^ q)]; tot += (hw[j] & 0xffffu) + (hw[j] >> 16); }
                const unsigned incl = wave_incl_scan(tot, lane);
                const unsigned excl = incl - tot;
                if (excl < TOPK && TOPK <= incl) {
                    unsigned run = excl; int fbin = -1; unsigned fabove = 0, fcnt = 0;
#pragma unroll
                    for (int j = 0; j < 16; ++j) {
                        const unsigned chi = hw[j] >> 16, clo = hw[j] & 0xffffu; const int wbin = 2 * (1023 - 16 * lane - j);
                        if (fbin < 0 && run + chi >= TOPK) { fbin = wbin + 1; fabove = run; fcnt = chi; } run += chi;
                        if (fbin < 0 && run + clo >= TOPK) { fbin = wbin; fabove = run; fcnt = clo; } run += clo; }
                    q_bin[q] = fbin; q_need[q] = TOPK - (int)fabove; q_cnt[q] = (int)fcnt; q_selc[q] = 0; q_tiec[q] = 0;
                } }
            __syncthreads();
            { int tz = tid; asm volatile("" : "+v"(tz)); for (int i = tz; i < AQ * 256 / 4; i += 512) ((LAS u32x4*)bmp)[i] = (u32x4){0u, 0u, 0u, 0u}; }
            if (tid < 32) { int tq = tid; asm volatile("" : "+v"(tq));
                int c = q_cnt[tq], incl = c;
#pragma unroll
                for (int o = 1; o < 32; o <<= 1) { const int v = __shfl_up(incl, o); if (tq >= o) incl += v; }
                q_off[tq] = incl - c; }
            __syncthreads();
            unsigned mybin[2]; int myoff[2];
#pragma unroll
            for (int hf = 0; hf < 2; ++hf) { mybin[hf] = (unsigned)q_bin[16 * hf + qc]; myoff[hf] = q_off[16 * hf + qc]; }
#if defined(DBG_REPEAT) && (DBG_REPEAT == 34 || DBG_REPEAT == 36)
#pragma unroll 1
            for (int rep34 = 0; rep34 < 2; ++rep34) {
            if (rep34 && DBG_REPEAT == 34) { __syncthreads(); if (tid < 32) q_tiec[tid] = 0; __syncthreads(); }
#endif
#pragma unroll
            for (int j = 0; j < 4; ++j) IDX_RING_LOAD(j, wid + 8 * j)
            for (int kt0 = wid; kt0 <= kmaxt; kt0 += 32) {
#pragma unroll
                for (int j = 0; j < 4; ++j) { const int kt = kt0 + 8 * j;
                    if (kt <= kmaxt) {
                unsigned entH[2][4]; bool istH[2][4]; int ntH[2], viH[2];
                const int s0 = kt * 16 + 4 * fq;
#pragma unroll
                for (int hf = 0; hf < 2; ++hf) if (kt <= kdiag0 + hf) {
                    float sc[4]; idx_tile16(kr[j][0], kr[j][1], qb[hf], wq[hf], sc);
                    const bool diag = kt == kdiag0 + hf; const int qn = 16 * hf + qc;
                    unsigned amask = 0u; int nt = 0;
#pragma unroll
                    for (int r = 0; r < 4; ++r) { const unsigned x = score_x(sc[r]); const unsigned bin = (x >> 18) & 0x7ffu;
                        amask |= (bin > mybin[hf]) ? (1u << r) : 0u; istH[hf][r] = bin == mybin[hf];
                        entH[hf][r] = (x << 13) | (unsigned)(8191 - (s0 + r)); }
                    if (diag) {
#pragma unroll
                        for (int r = 0; r < 4; ++r) { const bool v = 4 * fq + r <= qc; amask &= v ? ~0u : ~(1u << r); istH[hf][r] = istH[hf][r] && v; } }
#pragma unroll
                    for (int r = 0; r < 4; ++r) nt += istH[hf][r] ? 1 : 0;
                    __hip_atomic_fetch_or(&bmp[qn * 256 + (s0 >> 5)], amask << (s0 & 31), __ATOMIC_RELAXED, __HIP_MEMORY_SCOPE_WORKGROUP);
#if defined(DBG_REPEAT) && DBG_REPEAT == 36
                    int vi = myoff[hf]; if (rep34 == 0) vi += __hip_atomic_fetch_add(&q_tiec[qn], nt, __ATOMIC_RELAXED, __HIP_MEMORY_SCOPE_WORKGROUP);
                    if (rep34) { for (int r = 0; r < 4; ++r) istH[hf][r] = false; nt = 0; }
                    viH[hf] = vi;
#else
                    viH[hf] = myoff[hf] + __hip_atomic_fetch_add(&q_tiec[qn], nt, __ATOMIC_RELAXED, __HIP_MEMORY_SCOPE_WORKGROUP);
#endif
                    ntH[hf] = nt; }
#pragma unroll
                for (int hf = 0; hf < 2; ++hf) if (kt <= kdiag0 + hf) {
                    int vi = viH[hf];
                    if (__ballot(ntH[hf] > 0 && vi + ntH[hf] > TCAP) == 0ull) {
#pragma unroll
                        for (int r = 0; r < 4; ++r) { LAS unsigned* dst = istH[hf][r] ? (tpool + vi) : dummy; *dst = entH[hf][r]; vi += istH[hf][r] ? 1 : 0; }
                    } else {
#pragma unroll
                        for (int r = 0; r < 4; ++r) if (istH[hf][r]) { if (vi < TCAP) tpool[vi] = entH[hf][r]; else pool[vi] = entH[hf][r]; ++vi; } } }
                    }
                    IDX_RING_LOAD(j, kt + 32) }
            }
#if defined(DBG_REPEAT) && (DBG_REPEAT == 34 || DBG_REPEAT == 36)
            }
#endif
#undef IDX_RING_LOAD
            __syncthreads();
#if defined(DBG_REPEAT) && DBG_REPEAT == 33
#pragma unroll 1
            for (int rep33 = 0; rep33 < 2; ++rep33)
#endif
            {
                int cq[4], offq[4], Rq[4]; unsigned needq[4], thrq[4], actq[4], validq[4]; constexpr int NR = 10; unsigned ev[4][NR]; bool slowq[4];
#pragma unroll
                for (int i = 0; i < 4; ++i) { const int q = 4 * wid + i; cq[i] = q_cnt[q]; offq[i] = q_off[q]; const int m = q_need[q];
                    needq[i] = (unsigned)(m < cq[i] ? m : cq[i]);
                    slowq[i] = cq[i] > 64 * NR; Rq[i] = slowq[i] ? 0 : (cq[i] + 63) >> 6; thrq[i] = 0u; actq[i] = 0u; }
#pragma unroll
                for (int i = 0; i < 4; ++i)
#pragma unroll
                    for (int r = 0; r < NR; ++r) { const int e = lane + 64 * r; const bool in = e < cq[i] && !slowq[i]; const int vi = offq[i] + (e < cq[i] ? e : cq[i] - 1); const unsigned v = (vi < TCAP) ? tpool[vi] : pool[vi]; ev[i][r] = in ? v : 0u; actq[i] |= in ? (1u << r) : 0u; }
#pragma unroll
                for (int i = 0; i < 4; ++i) validq[i] = actq[i];
                const int Rmax = max(max(Rq[0], Rq[1]), max(Rq[2], Rq[3]));
#pragma unroll 1
                for (int p = 3; p >= 0; --p) { const int shift = 8 * p;
#pragma unroll
                    for (int i = 0; i < 4; ++i) *(LAS u32x4*)(lds + (wid * 4 + i) * 1024 + 16 * lane) = (u32x4){0u, 0u, 0u, 0u};
#pragma unroll
                    for (int r = 0; r < NR; ++r) if (r < Rmax) {
#pragma unroll
                        for (int i = 0; i < 4; ++i) { LAS unsigned* wh = (LAS unsigned*)(lds + (wid * 4 + i) * 1024); if ((actq[i] >> r) & 1u) __hip_atomic_fetch_add(&wh[(ev[i][r] >> shift) & 255u], 1u, __ATOMIC_RELAXED, __HIP_MEMORY_SCOPE_WORKGROUP); } }
                    u32x4 hv[4]; unsigned tot[4], incl[4];
#pragma unroll
                    for (int i = 0; i < 4; ++i) { hv[i] = *(const LAS u32x4*)(lds + (wid * 4 + i) * 1024 + 16 * (63 - lane)); tot[i] = (hv[i].x + hv[i].y) + (hv[i].z + hv[i].w); }
#pragma unroll
                    for (int i = 0; i < 4; ++i) incl[i] = wave_incl_scan(tot[i], lane);
#pragma unroll
                    for (int i = 0; i < 4; ++i) { const unsigned excl = incl[i] - tot[i], need = needq[i]; const bool cross = excl < need && need <= incl[i];
                        unsigned dig = 252u - 4u * (unsigned)lane, ab = excl + hv[i].w + hv[i].z + hv[i].y;
                        if (excl + hv[i].w >= need) { dig += 3u; ab = excl; } else if (excl + hv[i].w + hv[i].z >= need) { dig += 2u; ab = excl + hv[i].w; } else if (excl + hv[i].w + hv[i].z + hv[i].y >= need) { dig += 1u; ab = excl + hv[i].w + hv[i].z; }
                        const unsigned long long bm = __ballot(cross);
                        if (bm) { const int src = __ffsll(bm) - 1; dig = (unsigned)__shfl((int)dig, src); ab = (unsigned)__shfl((int)ab, src);
                            thrq[i] |= dig << shift; needq[i] = need - ab;
                            unsigned keep = 0u;
#pragma unroll
                            for (int r = 0; r < NR; ++r) keep |= (((ev[i][r] >> shift) & 255u) == dig) ? (1u << r) : 0u;
                            actq[i] &= keep; } }
                }
#pragma unroll
                for (int i = 0; i < 4; ++i) { LAS unsigned* bq = bmp + (4 * wid + i) * 256;
#pragma unroll
                    for (int r = 0; r < NR; ++r) if (r < Rmax) { if (((validq[i] >> r) & 1u) && ev[i][r] >= thrq[i]) { const unsigned ix = 8191u - (ev[i][r] & 8191u); __hip_atomic_fetch_or(&bq[ix >> 5], 1u << (ix & 31u), __ATOMIC_RELAXED, __HIP_MEMORY_SCOPE_WORKGROUP); } } }
#pragma unroll 1
                for (int i = 0; i < 4; ++i) if (slowq[i]) { const int c = cq[i], off = offq[i]; LAS unsigned* bq = bmp + (4 * wid + i) * 256;
                    unsigned need = needq[i], thr = 0u;
#pragma unroll 1
                    for (int bit = 31; bit >= 0; --bit) { unsigned cnt1 = 0; const unsigned hm = (bit == 31) ? 0u : (0xffffffffu << (bit + 1));
                        for (int e = lane; e < c; e += 64) { const int vi = off + e; const unsigned v = (vi < TCAP) ? tpool[vi] : pool[vi]; if ((v & hm) == thr && ((v >> bit) & 1u)) ++cnt1; }
#pragma unroll
                        for (int o = 1; o < 64; o <<= 1) cnt1 += __shfl_xor(cnt1, o);
                        if (cnt1 >= need) thr |= 1u << bit; else need -= cnt1; }
                    for (int e = lane; e < c; e += 64) { const int vi = off + e; const unsigned v = (vi < TCAP) ? tpool[vi] : pool[vi]; if (v >= thr) { const unsigned ix = 8191u - (v & 8191u); __hip_atomic_fetch_or(&bq[ix >> 5], 1u << (ix & 31u), __ATOMIC_RELAXED, __HIP_MEMORY_SCOPE_WORKGROUP); } } }
#if defined(DBG_REPEAT) && DBG_REPEAT == 37
#pragma unroll 1
                for (int rep37 = 0; rep37 < 2; ++rep37) {
#endif
                u32x4 bw[4]; unsigned cntb[4], inb[4];
#pragma unroll
                for (int i = 0; i < 4; ++i) { bw[i] = *(const LAS u32x4*)(bmp + (4 * wid + i) * 256 + 4 * lane); cntb[i] = (unsigned)((__popc(bw[i].x) + __popc(bw[i].y)) + (__popc(bw[i].z) + __popc(bw[i].w))); }
#pragma unroll
                for (int i = 0; i < 4; ++i) inb[i] = wave_incl_scan(cntb[i], lane);
                { int pos[4]; LAS unsigned short* const dmy = (LAS unsigned short*)dummy;
#pragma unroll
                  for (int i = 0; i < 4; ++i) pos[i] = (int)(inb[i] - cntb[i]);
#pragma unroll
                  for (int wi = 0; wi < 4; ++wi) { unsigned w[4];
#pragma unroll
                      for (int i = 0; i < 4; ++i) w[i] = (wi == 0) ? bw[i].x : (wi == 1) ? bw[i].y : (wi == 2) ? bw[i].z : bw[i].w;
                      const unsigned kbase_ = (unsigned)((4 * lane + wi) * 32);
                      while (__builtin_amdgcn_ballot_w64(((w[0] | w[1]) | (w[2] | w[3])) != 0u) != 0ull) {
#pragma unroll
                          for (int i = 0; i < 4; ++i) { const bool a = w[i] != 0u; const unsigned bp = (unsigned)__builtin_ctz(w[i] | 0x80000000u);
                              LAS unsigned short* dst = (a && pos[i] < 256) ? (sel + (4 * wid + i) * 256 + pos[i]) : dmy;
                              *dst = (unsigned short)(kbase_ + bp); pos[i] += a ? 1 : 0; w[i] &= w[i] - 1u; } } } }
#if defined(DBG_REPEAT) && DBG_REPEAT == 37
                }
#endif
            }
        }
        __syncthreads();
#ifndef A_EXP2
        LAS unsigned char* pbuf = lds + wid * 16384;
        LAS unsigned char* vbuf = pbuf + 4096;
        int ln2 = lane0; asm volatile("" : "+v"(ln2));
        const int hh = ln2 & 15, fq = ln2 >> 4;
        typedef int i32x2 __attribute__((ext_vector_type(2)));
        const unsigned char* kgb = kv8b + (ln2 & 7) * 16;
        LAS unsigned char* kstw = vbuf + (ln2 >> 3) * 144 + (ln2 & 7) * 16; const LAS unsigned char* kstr = vbuf + hh * 144 + 8 * fq;
        const unsigned char* vgb = kv8b + 128 + (ln2 & 3) * 16;
#define ATT_LOADK(kk, sqx, b4) { _Pragma("unroll") for (int i8 = 0; i8 < 8; ++i8) { const int kidx = (sqx)[64 * (b4) + 8 * i8 + (ln2 >> 3)]; kk[i8] = *(const u32x4*)(kgb + (size_t)kidx * 256); } }
#define ATT_MMAK(kk, b4) { _Pragma("unroll") for (int i8 = 0; i8 < 8; ++i8) *(LAS u32x4*)(kstw + i8 * (8 * 144)) = kk[i8]; \
    _Pragma("unroll") for (int j4 = 0; j4 < 4; ++j4) { f32x4 a = (f32x4){0.f, 0.f, 0.f, 0.f}; _Pragma("unroll") for (int k4 = 0; k4 < 4; ++k4) a = __builtin_amdgcn_mfma_f32_16x16x32_fp8_fp8(*(const LAS long*)(kstr + j4 * (16 * 144) + 32 * k4), qf[k4], a, 0, 0, 0); S[4 * (b4) + j4] = a; } }
#define ATT_LOADV(slot, sqx, chx) { _Pragma("unroll") for (int p2 = 0; p2 < 2; ++p2) { const unsigned char* vp = vgb + (size_t)(sqx)[32 * (chx) + (ln2 >> 2) + 16 * p2] * 256; vr[slot][0][p2] = *(const u32x4*)vp; vr[slot][1][p2] = *(const u32x4*)(vp + 64); } }
#define ATT_LOADQ(tokx) { _Pragma("unroll") for (int kk = 0; kk < 4; ++kk) { u32x4 w = (u32x4){0u, 0u, 0u, 0u}; if (hh < 8 && (hh >> 2) == (kk >> 1)) w = *(const u32x4*)(C.P + (size_t)(tokx) * NAB + PC_Q + hh * 64 + (kk & 1) * 32 + 8 * fq); qraw[kk] = w; } }
#if defined(DBG_REPEAT) && DBG_REPEAT == 31
#pragma unroll 1
        for (int rep31 = 0; rep31 < 2; ++rep31)
#endif
        {
        u32x4 kA[8], kB[8]; u32x4 qraw[4]; u32x4 vr[3][2][2];
        { const LAS unsigned short* sq0 = sel + (4 * wid) * 256; ATT_LOADQ(tok0 + 4 * wid) ATT_LOADK(kA, sq0, 0) ATT_LOADK(kB, sq0, 1) }
#pragma unroll 1
        for (int iq = 0; iq < 4; ++iq) {
            const int q = 4 * wid + iq, tok = tok0 + q, t = t0 + q, nsel = (t + 1 < TOPK) ? t + 1 : TOPK;
            const LAS unsigned short* sq = sel + q * 256;
            {
                long qf[4];
#pragma unroll
                for (int kk = 0; kk < 4; ++kk) { const u32x2 f8 = bf8_to_fp8(qraw[kk]); qf[kk] = (long)(((unsigned long long)f8.y << 32) | f8.x); }
                f32x4 S[16];
                ATT_MMAK(kA, 0) ATT_LOADK(kA, sq, 2)
                ATT_MMAK(kB, 1) ATT_LOADK(kB, sq, 3)
                ATT_MMAK(kA, 2) ATT_MMAK(kB, 3)
                ATT_LOADV(0, sq, 0) ATT_LOADV(1, sq, 1) ATT_LOADV(2, sq, 2)
                float mx = -INFINITY;
                if (nsel < TOPK) {
                    const int nrel = nsel - 4 * fq;
#pragma unroll
                    for (int tl = 0; tl < 16; ++tl)
#pragma unroll
                        for (int r = 0; r < 4; ++r) S[tl][r] = ((16 * tl + r) < nrel) ? S[tl][r] : -INFINITY; }
#pragma unroll
                for (int tl = 0; tl < 16; ++tl)
#pragma unroll
                    for (int r = 0; r < 4; ++r) mx = fmaxf(mx, S[tl][r]);
                mx = fmaxf(mx, __shfl_xor(mx, 16)); mx = fmaxf(mx, __shfl_xor(mx, 32));
                const float cexp = 0.125f * 1.44269504088896f, moff = -mx * cexp;
                float sm = 0.f;
#pragma unroll
                for (int tl = 0; tl < 16; ++tl)
#pragma unroll
                    for (int r = 0; r < 4; ++r) { const float e = __builtin_amdgcn_exp2f(fmaf(S[tl][r], cexp, moff)); S[tl][r] = e; sm += e; }
                sm += __shfl_xor(sm, 16); sm += __shfl_xor(sm, 32);
                const float inv = 1.0f / sm;
#pragma unroll
                for (int ch = 0; ch < 8; ++ch) { u32x2 w; w.x = pk4_fp8(S[2 * ch][0] * inv, S[2 * ch][1] * inv, S[2 * ch][2] * inv, S[2 * ch][3] * inv);
                    w.y = pk4_fp8(S[2 * ch + 1][0] * inv, S[2 * ch + 1][1] * inv, S[2 * ch + 1][2] * inv, S[2 * ch + 1][3] * inv); *(LAS u32x2*)(pbuf + ch * 512 + lane * 8) = w; }
            }
            if (iq < 3) { const LAS unsigned short* sqn = sq + 256; ATT_LOADK(kA, sqn, 0) ATT_LOADK(kB, sqn, 1) }
            f32x4 O[2][4];
#pragma unroll
            for (int g = 0; g < 2; ++g)
#pragma unroll
                for (int dt = 0; dt < 4; ++dt) O[g][dt] = (f32x4){0.f, 0.f, 0.f, 0.f};
            const int tq8 = hh >> 1, tp8 = hh & 1;
            const LAS unsigned char* vtr = vbuf + ((tq8 < 4) ? (4 * fq + tq8) : (16 + 4 * fq + tq8 - 4)) * 80 + tp8 * 8;
#pragma unroll
            for (int ch = 0; ch < 8; ++ch) {
                const long pf = *(const LAS long*)(pbuf + ch * 512 + lane * 8);
#pragma unroll
                for (int g = 0; g < 2; ++g) {
#pragma unroll
                    for (int p2 = 0; p2 < 2; ++p2) *(LAS u32x4*)(vbuf + ((ln2 >> 2) + 16 * p2) * 80 + (ln2 & 3) * 16) = vr[ch % 3][g][p2];
#pragma unroll
                    for (int dt = 0; dt < 4; ++dt) {
                        const i32x2 t8 = __builtin_amdgcn_ds_read_tr8_b64_v2i32((LAS i32x2*)(vtr + dt * 16));
                        const long vb = (long)(((unsigned long long)(unsigned)t8[1] << 32) | (unsigned)t8[0]);
                        O[g][dt] = __builtin_amdgcn_mfma_f32_16x16x32_fp8_fp8(pf, vb, O[g][dt], 0, 0, 0); }
                }
                if (ch + 3 < 8) ATT_LOADV(ch % 3, sq, ch + 3)
                if (ch == 5 && iq < 3) ATT_LOADQ(tok + 1)
            }
            if (fq < 2) {
#pragma unroll
                for (int dt = 0; dt < 4; ++dt)
#pragma unroll
                    for (int r = 0; r < 4; ++r) { const float ov = (fq == 0) ? O[0][dt][r] : O[1][dt][r];
                        *(LAS bf16_t*)(pbuf + ((4 * fq + r) * 64 + dt * 16 + hh) * 2) = (bf16_t)(pk2(ov, 0.f) & 0xffffu); }
            }
            asm volatile("" ::: "memory");
            { const u32x4 ow = *(const LAS u32x4*)(pbuf + ln2 * 16); *(u32x4*)(C.Y + (size_t)tok * 1024 + 512 + ln2 * 8) = ow; }
        }
        }
#undef ATT_LOADK
#undef ATT_MMAK
#undef ATT_LOADV
#undef ATT_LOADQ
#endif
    }
}


constexpr int H_QE = 0, H_KD = 17408, H_KET = 34816, H_VT = 53248, H_AL = 71680, H_ST = 80896, H_QTOT = 115712, H_BL = 117760, H_SSQ = 118272;
constexpr int PQ = 272, PT = 144;
constexpr size_t WS_HU = 440 * MiB, WS_HLB = 460 * MiB;

__device__ __forceinline__ bf16x8 ldsfrag(const LAS unsigned char* p) { return *(const LAS bf16x8*)p; }

constexpr int H_VRAW = 118784;
template <bool WITH_Q>
__device__ __forceinline__ void hgrn_load(const Ctx& C, size_t tokc, int h, int tid, u32x4 (&kr)[2], u32x4 (&vr)[2], u32x4 (&qr)[2]) {
#pragma unroll
    for (int j = 0; j < 2; ++j) { const int p = tid + 512 * j; const size_t off = (tokc + (size_t)(p >> 4)) * 1024 + (size_t)h * 128 + (p & 15) * 8;
        kr[j] = *(const u32x4*)(C.L1K + off); vr[j] = *(const u32x4*)(C.L1I + off); if (WITH_Q) qr[j] = *(const u32x4*)(C.L1Q + off); }
}
template <bool WITH_Q>
__device__ __forceinline__ float hgrn_stage(LAS unsigned char* lds, int tid, const u32x4 (&kr)[2], const u32x4 (&vr)[2], const u32x4 (&qr)[2]) {
    const int d = tid & 127, tq = tid >> 7;
#pragma unroll
    for (int j = 0; j < 2; ++j) { const int p = tid + 512 * j; const int ro = (p >> 4) * PQ + (p & 15) * 16;
        *(LAS u32x4*)(lds + H_KD + ro) = kr[j]; *(LAS u32x4*)(lds + H_VRAW + ro) = vr[j]; if (WITH_Q) *(LAS u32x4*)(lds + H_QE + ro) = qr[j]; }
    __syncthreads();
    float kf[16], vf[16], c[16];
#pragma unroll
    for (int i = 0; i < 16; ++i) { kf[i] = bf2f(*(const LAS bf16_t*)(lds + H_KD + (tq * 16 + i) * PQ + d * 2)); vf[i] = bf2f(*(const LAS bf16_t*)(lds + H_VRAW + (tq * 16 + i) * PQ + d * 2)); }
    float run = 0.f;
#pragma unroll
    for (int i = 0; i < 16; ++i) { run += __logf(1.0f - kf[i]); c[i] = run; }
    LAS float* qtot = (LAS float*)(lds + H_QTOT);
    qtot[tq * 128 + d] = run;
    { u32x4 w0, w1; w0.x = pk2(vf[0], vf[1]); w0.y = pk2(vf[2], vf[3]); w0.z = pk2(vf[4], vf[5]); w0.w = pk2(vf[6], vf[7]); w1.x = pk2(vf[8], vf[9]); w1.y = pk2(vf[10], vf[11]); w1.z = pk2(vf[12], vf[13]); w1.w = pk2(vf[14], vf[15]);
      *(LAS u32x4*)(lds + H_VT + d * PT + tq * 32) = w0; *(LAS u32x4*)(lds + H_VT + d * PT + tq * 32 + 16) = w1; }
    __syncthreads();
    float pre = 0.f, tot = 0.f;
#pragma unroll
    for (int q4 = 0; q4 < 4; ++q4) { const float x = qtot[q4 * 128 + d]; if (q4 < tq) pre += x; tot += x; }
    if (tq == 0) ((LAS float*)(lds + H_BL))[d] = tot;
    { float ke[16];
#pragma unroll
      for (int i = 0; i < 16; ++i) ke[i] = kf[i] * __expf(tot - (pre + c[i]));
      u32x4 w0, w1; w0.x = pk2(ke[0], ke[1]); w0.y = pk2(ke[2], ke[3]); w0.z = pk2(ke[4], ke[5]); w0.w = pk2(ke[6], ke[7]); w1.x = pk2(ke[8], ke[9]); w1.y = pk2(ke[10], ke[11]); w1.z = pk2(ke[12], ke[13]); w1.w = pk2(ke[14], ke[15]);
      *(LAS u32x4*)(lds + H_KET + d * PT + tq * 32) = w0; *(LAS u32x4*)(lds + H_KET + d * PT + tq * 32 + 16) = w1; }
    if (WITH_Q) {
#pragma unroll
        for (int i = 0; i < 16; ++i) { const float b = pre + c[i]; const float qv = bf2f(*(const LAS bf16_t*)(lds + H_QE + (tq * 16 + i) * PQ + d * 2));
            *(LAS bf16_t*)(lds + H_QE + (tq * 16 + i) * PQ + d * 2) = (bf16_t)(pk2(qv * __expf(b), 0.f) & 0xffffu);
            *(LAS bf16_t*)(lds + H_KD + (tq * 16 + i) * PQ + d * 2) = (bf16_t)(pk2(kf[i] * __expf(-b), 0.f) & 0xffffu); }
    }
    return tot;
}
__device__ __forceinline__ void hgrn_state_update(LAS unsigned char* lds, f32x4 (&S)[8], int wid, int l15, int fq) {
    const LAS float* bl = (const LAS float*)(lds + H_BL);
    float dec[4];
#pragma unroll
    for (int r = 0; r < 4; ++r) dec[r] = __expf(bl[16 * wid + 4 * fq + r]);
    const bf16x8 ka0 = ldsfrag(lds + H_KET + (16 * wid + l15) * PT + 16 * fq), ka1 = ldsfrag(lds + H_KET + (16 * wid + l15) * PT + 64 + 16 * fq);
#pragma unroll
    for (int et = 0; et < 8; ++et) {
#pragma unroll
        for (int r = 0; r < 4; ++r) S[et][r] *= dec[r];
        S[et] = __builtin_amdgcn_mfma_f32_16x16x32_bf16(ka0, ldsfrag(lds + H_VT + (et * 16 + l15) * PT + 16 * fq), S[et], 0, 0, 0);
        S[et] = __builtin_amdgcn_mfma_f32_16x16x32_bf16(ka1, ldsfrag(lds + H_VT + (et * 16 + l15) * PT + 64 + 16 * fq), S[et], 0, 0, 0); }
}

__device__ __forceinline__ void phase_hgrn_local(const Ctx& C, LAS unsigned char* lds) {
    const int tid = threadIdx.x, lane = tid & 63, wid = __builtin_amdgcn_readfirstlane(tid >> 6), l15 = lane & 15, fq = lane >> 4;
    float* Ug = (float*)((unsigned char*)C.ctl + WS_HU); float* LBg = (float*)((unsigned char*)C.ctl + WS_HLB);
    for (int item = C.bid; item < 256; item += C.G) {
        const int seg = item & 7, h = (item >> 3) & 7, b = item >> 6;
        if (seg == 7) continue;
        f32x4 S[8];
#pragma unroll
        for (int et = 0; et < 8; ++et) S[et] = (f32x4){0.f, 0.f, 0.f, 0.f};
        float lbacc = 0.f;
        u32x4 kr[2], vr[2], qr[2];
        hgrn_load<false>(C, (size_t)b * SEQ + (size_t)seg * 1024, h, tid, kr, vr, qr);
#pragma unroll 1
        for (int ch = 0; ch < 16; ++ch) {
            const size_t tokc = (size_t)b * SEQ + (size_t)seg * 1024 + (size_t)ch * 64;
            __syncthreads();
            lbacc += hgrn_stage<false>(lds, tid, kr, vr, qr);
            if (ch < 15) hgrn_load<false>(C, tokc + 64, h, tid, kr, vr, qr);
            __syncthreads();
            hgrn_state_update(lds, S, wid, l15, fq);
        }
#pragma unroll
        for (int et = 0; et < 8; ++et) *(f32x4*)(Ug + ((size_t)(item * 8 + wid) * 8 + et) * 256 + lane * 4) = S[et];
        if (tid < 128) LBg[item * 128 + tid] = lbacc;
    }
}

__device__ __forceinline__ void phase_hgrn_chunks(const Ctx& C, LAS unsigned char* lds) {
    const int tid = threadIdx.x, lane = tid & 63, wid = __builtin_amdgcn_readfirstlane(tid >> 6), l15 = lane & 15, fq = lane >> 4;
    const float* Ug = (const float*)((unsigned char*)C.ctl + WS_HU); const float* LBg = (const float*)((unsigned char*)C.ctl + WS_HLB);
    LAS float* ssq = (LAS float*)(lds + H_SSQ);
    for (int item = C.bid; item < 256; item += C.G) {
        const int seg = item & 7, h = (item >> 3) & 7, b = item >> 6;
        f32x4 S[8];
#pragma unroll
        for (int et = 0; et < 8; ++et) S[et] = (f32x4){0.f, 0.f, 0.f, 0.f};
#pragma unroll 1
        for (int j = 0; j < seg; ++j) { const int it = item - seg + j; float dec[4];
#pragma unroll
            for (int r = 0; r < 4; ++r) dec[r] = __expf(LBg[it * 128 + 16 * wid + 4 * fq + r]);
#pragma unroll
            for (int et = 0; et < 8; ++et) { const f32x4 u = *(const f32x4*)(Ug + ((size_t)(it * 8 + wid) * 8 + et) * 256 + lane * 4);
#pragma unroll
                for (int r = 0; r < 4; ++r) S[et][r] = S[et][r] * dec[r] + u[r]; } }
        __syncthreads();
        u32x4 kr[2], vr[2], qr[2];
        hgrn_load<true>(C, (size_t)b * SEQ + (size_t)seg * 1024, h, tid, kr, vr, qr);
#pragma unroll 1
        for (int ch = 0; ch < 16; ++ch) {
            const size_t tokc = (size_t)b * SEQ + (size_t)seg * 1024 + (size_t)ch * 64;
#pragma unroll
            for (int et = 0; et < 8; ++et) { u32x2 w; w.x = pk2(S[et][0], S[et][1]); w.y = pk2(S[et][2], S[et][3]); *(LAS u32x2*)(lds + H_ST + (et * 16 + l15) * PQ + (16 * wid + 4 * fq) * 2) = w; }
            (void)hgrn_stage<true>(lds, tid, kr, vr, qr);
            if (ch < 15) hgrn_load<true>(C, tokc + 64, h, tid, kr, vr, qr);
            u32x2 gw[4];
            { const size_t ro = (tokc + (wid & 3) * 16 + l15) * 1024 + (size_t)h * 128;
#pragma unroll
              for (int j = 0; j < 4; ++j) gw[j] = *(const u32x2*)(C.L1G + ro + (4 * (wid >> 2) + j) * 16 + 4 * fq); }
            __syncthreads();
            { const int ti = wid >> 1;
#pragma unroll
              for (int u = 0; u < 2; ++u) { const int si = 2 * (wid & 1) + u; u32x2 w = (u32x2){0u, 0u};
                  if (si <= ti) { f32x4 a = (f32x4){0.f, 0.f, 0.f, 0.f};
#pragma unroll
                      for (int kk = 0; kk < 4; ++kk) a = __builtin_amdgcn_mfma_f32_16x16x32_bf16(ldsfrag(lds + H_KD + (si * 16 + l15) * PQ + kk * 64 + 16 * fq), ldsfrag(lds + H_QE + (ti * 16 + l15) * PQ + kk * 64 + 16 * fq), a, 0, 0, 0);
                      if (si == ti) {
#pragma unroll
                          for (int r = 0; r < 4; ++r) if (4 * fq + r > l15) a[r] = 0.f; }
                      w.x = pk2(a[0], a[1]); w.y = pk2(a[2], a[3]); }
                  *(LAS u32x2*)(lds + H_AL + (ti * 16 + l15) * PT + (si * 16 + 4 * fq) * 2) = w; } }
            hgrn_state_update(lds, S, wid, l15, fq);
            __syncthreads();
            const int ti = wid & 3, eh = wid >> 2;
            f32x4 o[4];
            { const bf16x8 ab0 = ldsfrag(lds + H_AL + (ti * 16 + l15) * PT + 16 * fq), ab1 = ldsfrag(lds + H_AL + (ti * 16 + l15) * PT + 64 + 16 * fq);
              bf16x8 qb[4];
#pragma unroll
              for (int kk = 0; kk < 4; ++kk) qb[kk] = ldsfrag(lds + H_QE + (ti * 16 + l15) * PQ + kk * 64 + 16 * fq);
#pragma unroll
              for (int j = 0; j < 4; ++j) { const int et = 4 * eh + j; f32x4 a = (f32x4){0.f, 0.f, 0.f, 0.f};
                  a = __builtin_amdgcn_mfma_f32_16x16x32_bf16(ldsfrag(lds + H_VT + (et * 16 + l15) * PT + 16 * fq), ab0, a, 0, 0, 0);
                  a = __builtin_amdgcn_mfma_f32_16x16x32_bf16(ldsfrag(lds + H_VT + (et * 16 + l15) * PT + 64 + 16 * fq), ab1, a, 0, 0, 0);
#pragma unroll
                  for (int kk = 0; kk < 4; ++kk) a = __builtin_amdgcn_mfma_f32_16x16x32_bf16(ldsfrag(lds + H_ST + (et * 16 + l15) * PQ + kk * 64 + 16 * fq), qb[kk], a, 0, 0, 0);
                  o[j] = a; } }
            float sq = 0.f;
#pragma unroll
            for (int j = 0; j < 4; ++j) sq += (o[j][0] * o[j][0] + o[j][1] * o[j][1]) + (o[j][2] * o[j][2] + o[j][3] * o[j][3]);
            sq += __shfl_xor(sq, 16); sq += __shfl_xor(sq, 32);
            if (fq == 0) ssq[eh * 64 + ti * 16 + l15] = sq;
            __syncthreads();
            { const float tot = ssq[ti * 16 + l15] + ssq[64 + ti * 16 + l15]; const float rinv = 1.0f / sqrtf(tot * (1.0f / 128.0f) + EPS);
              const size_t ro = (tokc + ti * 16 + l15) * 1024 + (size_t)h * 128;
#pragma unroll
              for (int j = 0; j < 4; ++j) { const int e0 = (4 * eh + j) * 16 + 4 * fq; const f32x4 nw = *(const f32x4*)(C.hgrn_out_norm + e0);
                  u32x2 w; w.x = pk2(o[j][0] * rinv * nw[0] * bf_lo(gw[j].x), o[j][1] * rinv * nw[1] * bf_hi(gw[j].x)); w.y = pk2(o[j][2] * rinv * nw[2] * bf_lo(gw[j].y), o[j][3] * rinv * nw[3] * bf_hi(gw[j].y));
                  *(u32x2*)(C.Y + ro + e0) = w; } }
        }
    }
}

constexpr int NPHASES = 14;
struct Args { const void* in[16]; float* out; unsigned char* ws; int ph_lo, ph_hi; };


typedef const __attribute__((address_space(4))) Args* KArgP;
__device__ __forceinline__ void make_ctx(Ctx& C) {
    KArgP ka = (KArgP)__builtin_amdgcn_kernarg_segment_ptr(); asm volatile("" : "+s"(ka));
    C.x = (const float*)ka->in[0]; C.positions = (const int*)ka->in[1]; C.ln_mix = (const float*)ka->in[2]; C.ln_ffn = (const float*)ka->in[3]; C.ln_final = (const float*)ka->in[4];
    C.w_in_ab = (const float*)ka->in[5]; C.w_pool = (const float*)ka->in[6]; C.pool_scale = (const float*)ka->in[7]; C.idx_k_norm = (const float*)ka->in[8]; C.w_out_ab = (const float*)ka->in[9];
    C.w_in_c = (const float*)ka->in[10]; C.hgrn_lb = (const float*)ka->in[11]; C.hgrn_out_norm = (const float*)ka->in[12]; C.w_out_c = (const float*)ka->in[13]; C.w_gate_up = (const float*)ka->in[14]; C.w_down = (const float*)ka->in[15];
    C.out = ka->out;
    unsigned char* ws = ka->ws;
    C.ctl = (unsigned*)(ws + WS_CTL); C.rope = (float*)(ws + WS_ROPE); C.part = (float*)(ws + WS_PART); C.lbv = (float*)(ws + WS_LB);
    C.W_inab = (bf16_t*)(ws + WS_W_INAB); C.W_pool = (bf16_t*)(ws + WS_W_POOL); C.W_outab = (bf16_t*)(ws + WS_W_OUTAB); C.W_inc = (bf16_t*)(ws + WS_W_INC); C.W_outc = (bf16_t*)(ws + WS_W_OUTC);
    C.W_gu0 = (bf16_t*)(ws + WS_W_GU0); C.W_gu1 = (bf16_t*)(ws + WS_W_GU1); C.W_dn0 = (bf16_t*)(ws + WS_W_DN0); C.W_dn1 = (bf16_t*)(ws + WS_W_DN1);
    C.XB = (bf16_t*)(ws + WS_XB); C.Y = (bf16_t*)(ws + WS_Y); C.P = (bf16_t*)(ws + WS_P); C.ACT = (bf16_t*)(ws + WS_ACT);
    C.L1Q = (bf16_t*)(ws + WS_L1Q); C.L1K = (bf16_t*)(ws + WS_L1K); C.L1I = (bf16_t*)(ws + WS_L1I); C.L1G = (bf16_t*)(ws + WS_L1G); C.ORAW = (bf16_t*)(ws + WS_ORAW);
    C.G = gridDim.x; C.bid = blockIdx.x;
}

#if USE_SIMPLE_GEMM
#define RUN_GEMM(EpiT, gg, EE) pg8::gemm_simple<EpiT>(gg, C.G, C.bid, EE)
#else
#define RUN_GEMM(EpiT, gg, EE) do { if (threadIdx.x == 0) *(LAS int*)(lds + 131072 + 1024) = -1; __syncthreads(); pg8::StaticOrder S_; S_.init((gg).M, (gg).N, C.G, C.bid); pg8::gemm_phase<EpiT, pg8::StaticOrder, true, true>(lds, gg, S_, EE); } while (0)
#endif

__global__ void __launch_bounds__(512, 2) mega_fwd(Args a) {
    extern __shared__ __attribute__((aligned(16))) unsigned char lds_raw[];
    LAS unsigned char* lds = (LAS unsigned char*)lds_raw;
    unsigned* const ctl0 = (unsigned*)(a.ws + WS_CTL);

    volatile LAS unsigned* MISC = (volatile LAS unsigned*)(lds + LDS_MISC);
    if (threadIdx.x < 64) MISC[threadIdx.x] = 0u;
    __syncthreads();
    XcdBarrier bar; bar.bar = ctl0 + CW_BAR; bar.x = 0; bar.st = nullptr;
    if (N_LAUNCH_MODE == 1) bar = xcd_barrier_post(ctl0 + CW_BAR, MISC + 8);

    const int lo = a.ph_lo, hi = a.ph_hi;
#ifndef ONLY_PHASE
#define ONLY_PHASE -1
#endif
#define IN(k) (lo <= (k) && (k) < hi && (ONLY_PHASE < 0 || ONLY_PHASE == (k)))
#if defined(DBG_REPEAT) && DBG_REPEAT == 90
#define SEAM(k) do { if (N_LAUNCH_MODE == 1 && IN((k) + 1)) { xcd_barrier(bar); if ((k) == 5) for (int rr_ = 0; rr_ < 20; ++rr_) xcd_barrier(bar); } } while (0)
#else
#define SEAM(k) do { if (N_LAUNCH_MODE == 1 && IN((k) + 1)) xcd_barrier(bar); } while (0)
#endif

    if (IN(0)) { Ctx C; make_ctx(C); phase_prologue(C, lds); __syncthreads();
#if defined(DBG_REPEAT) && DBG_REPEAT == 0
        phase_prologue(C, lds); __syncthreads();
#endif
        SEAM(0); }
    if (IN(1)) { Ctx C; make_ctx(C); pg8::Gemm g{C.XB, C.W_inab, NTOK, NAB, 1024}; pg8::EpiScaleBf16 E{C.P, NAB, pg8::RinvTab{C.part, lds}}; RUN_GEMM(pg8::EpiScaleBf16, g, E);
#if defined(DBG_REPEAT) && DBG_REPEAT == 1
        RUN_GEMM(pg8::EpiScaleBf16, g, E);
#endif
        SEAM(1); }
    if (IN(2)) { Ctx C; make_ctx(C); phase_fixup_pool(C, lds);
#if defined(DBG_REPEAT) && DBG_REPEAT == 2
        phase_fixup_pool(C, lds);
#endif
        SEAM(2); }
#ifdef DBG_ZERO_ATTN
    if (IN(3)) { Ctx C; make_ctx(C); for (int i = C.bid * 512 + threadIdx.x; i < NTOK * 64; i += C.G * 512) { const int tok = i >> 6, c = i & 63; *(u32x4*)(C.Y + (size_t)tok * 1024 + 512 + 8 * c) = (u32x4){0u, 0u, 0u, 0u}; } SEAM(3); }
#else
#if USE_SIMPLE_ATTN
    if (IN(3)) { Ctx C; make_ctx(C); phase_attn_simple(C, lds); __syncthreads(); SEAM(3); }
#else
    if (IN(3)) { Ctx C; make_ctx(C); phase_attn(C, lds); __syncthreads();
#if defined(DBG_REPEAT) && DBG_REPEAT == 3
        phase_attn(C, lds); __syncthreads();
#endif
        SEAM(3); }
#endif
#endif
    if (IN(4)) { Ctx C; make_ctx(C); pg8::Gemm g{C.Y, C.W_outab, NTOK, 1024, 1024}; pg8::EpiResidual<true> E{C.XB, C.part, C.x}; RUN_GEMM(pg8::EpiResidual<true>, g, E); SEAM(4); }
    if (IN(5)) { Ctx C; make_ctx(C); pg8::Gemm g{C.XB, C.W_gu0, NTOK, 2 * DFF, 1024}; pg8::EpiSwiGLU E{C.ACT, pg8::RinvTab{C.part, lds}}; RUN_GEMM(pg8::EpiSwiGLU, g, E);
#if defined(DBG_REPEAT) && DBG_REPEAT == 5
        RUN_GEMM(pg8::EpiSwiGLU, g, E);
#endif
        SEAM(5); }
    if (IN(6)) { Ctx C; make_ctx(C); pg8::Gemm g{C.ACT, C.W_dn0, NTOK, 1024, DFF}; pg8::EpiResidual<false> E{C.XB, C.part, C.x}; RUN_GEMM(pg8::EpiResidual<false>, g, E); SEAM(6); }
    if (IN(7)) { Ctx C; make_ctx(C); pg8::Gemm g{C.XB, C.W_inc, NTOK, NINC, 1024}; pg8::EpiHgrnIn E{C.L1Q, C.L1K, C.L1I, C.L1G, pg8::RinvTab{C.part, lds}, C.lbv}; RUN_GEMM(pg8::EpiHgrnIn, g, E); SEAM(7); }
#if USE_SIMPLE_HGRN
    if (IN(8)) { Ctx C; make_ctx(C); phase_hgrn_simple(C); SEAM(8); }
    if (IN(9)) { Ctx C; make_ctx(C); phase_hgrn_post(C); SEAM(9); }
#else
    if (IN(8)) { Ctx C; make_ctx(C); phase_hgrn_local(C, lds); __syncthreads();
#if defined(DBG_REPEAT) && DBG_REPEAT == 8
        phase_hgrn_local(C, lds); __syncthreads();
#endif
        SEAM(8); }
    if (IN(9)) { Ctx C; make_ctx(C); phase_hgrn_chunks(C, lds); __syncthreads();
#if defined(DBG_REPEAT) && DBG_REPEAT == 9
        phase_hgrn_chunks(C, lds); __syncthreads();
#endif
        SEAM(9); }
#endif
    if (IN(10)) { Ctx C; make_ctx(C); pg8::Gemm g{C.Y, C.W_outc, NTOK, 1024, 1024}; pg8::EpiResidual<false> E{C.XB, C.part, C.x}; RUN_GEMM(pg8::EpiResidual<false>, g, E); SEAM(10); }
    if (IN(11)) { Ctx C; make_ctx(C); pg8::Gemm g{C.XB, C.W_gu1, NTOK, 2 * DFF, 1024}; pg8::EpiSwiGLU E{C.ACT, pg8::RinvTab{C.part, lds}}; RUN_GEMM(pg8::EpiSwiGLU, g, E); SEAM(11); }
    if (IN(12)) { Ctx C; make_ctx(C); pg8::Gemm g{C.ACT, C.W_dn1, NTOK, 1024, DFF}; pg8::EpiResidual<false> E{C.XB, C.part, C.x}; RUN_GEMM(pg8::EpiResidual<false>, g, E); SEAM(12); }
    if (IN(13)) { Ctx C; make_ctx(C); phase_final_norm(C); }
#ifdef DBG_STOP_AFTER
    if (IN(14)) { Ctx C; make_ctx(C); for (int i = C.bid * 512 + threadIdx.x; i < NTOK * 1024; i += C.G * 512) { const int tok = i >> 10, c = i & 1023; float v;
        if (DBG_STOP_AFTER <= 3) v = bf2f(C.P[(size_t)tok * NAB + c]) + bf2f(C.P[(size_t)tok * NAB + 768 + c]) + bf2f(C.Y[(size_t)tok * 1024 + (c & 511)]);
        else if (DBG_STOP_AFTER == 7 || DBG_STOP_AFTER == 8) v = bf2f(C.L1Q[i]) + bf2f(C.L1K[i]) + bf2f(C.L1I[i]) + bf2f(C.L1G[i]) + (DBG_STOP_AFTER == 8 ? bf2f(C.ORAW[i]) : 0.f);
        else if (DBG_STOP_AFTER == 9) v = bf2f(C.Y[i]);
        else if (DBG_STOP_AFTER == 5 || DBG_STOP_AFTER == 11) v = bf2f(C.ACT[(size_t)tok * DFF + c]) + bf2f(C.ACT[(size_t)tok * DFF + 1024 + c]) + bf2f(C.ACT[(size_t)tok * DFF + 1792 + c]);
        else v = C.out[i] + bf2f(C.XB[i]);
        C.out[i] = v; } }
#endif
#undef IN
#undef SEAM
}

extern "C" void kernel_launch(void* const* d_in, const int* in_sizes, int n_in, void* d_out, int out_size, void* d_ws, size_t ws_size, hipStream_t stream) {
    static int grid = 0;
    if (grid == 0) {
        if (n_in != 16 || in_sizes[0] != NTOK * DM || out_size != NTOK * DM || ws_size < WS_END) {
            fprintf(stderr, "kernel_launch: built for 16 inputs, x/out of %d floats, >= %zu bytes of workspace; got n_in %d, in0 %d, out %d, ws %zu; nothing launched\n", NTOK * DM, (size_t)WS_END, n_in, n_in > 0 ? in_sizes[0] : -1, out_size, ws_size);
            grid = -1; return; }
        int dev = 0, cus = 0, per_cu = 0;
        if (hipGetDevice(&dev) != hipSuccess || hipDeviceGetAttribute(&cus, hipDeviceAttributeMultiprocessorCount, dev) != hipSuccess) { fprintf(stderr, "kernel_launch: device query failed\n"); grid = -1; return; }
        if (hipFuncSetAttribute((const void*)mega_fwd, hipFuncAttributeMaxDynamicSharedMemorySize, LDS_BYTES) != hipSuccess) { fprintf(stderr, "kernel_launch: hipFuncSetAttribute failed\n"); grid = -1; return; }
        if (hipOccupancyMaxActiveBlocksPerMultiprocessor(&per_cu, (const void*)mega_fwd, 512, LDS_BYTES) != hipSuccess || per_cu < 1)
            fprintf(stderr, "kernel_launch: note: occupancy query reports %d workgroups per CU\n", per_cu);
        (void)hipGetLastError();
        grid = cus;
    }
    if (grid < 0) return;
    if (hipMemsetAsync((char*)d_ws + WS_CTL, 0, CTL_ZERO_BYTES, stream) != hipSuccess) { fprintf(stderr, "kernel_launch: hipMemsetAsync failed\n"); return; }
    Args a{};
    for (int i = 0; i < 16; ++i) a.in[i] = d_in[i];
    a.out = (float*)d_out; a.ws = (unsigned char*)d_ws;
    if (N_LAUNCH_MODE == 1) {
        a.ph_lo = 0; a.ph_hi = NPHASES;
        hipLaunchKernelGGL(mega_fwd, dim3(grid), dim3(512), LDS_BYTES, stream, a);
    } else {
#ifdef DBG_STOP_AFTER
        for (int p = 0; p <= DBG_STOP_AFTER; ++p) { a.ph_lo = p; a.ph_hi = p + 1; hipLaunchKernelGGL(mega_fwd, dim3(grid), dim3(512), LDS_BYTES, stream, a); }
        a.ph_lo = 14; a.ph_hi = 15; hipLaunchKernelGGL(mega_fwd, dim3(grid), dim3(512), LDS_BYTES, stream, a);
#else
        for (int p = 0; p < NPHASES; ++p) { a.ph_lo = p; a.ph_hi = p + 1; hipLaunchKernelGGL(mega_fwd, dim3(grid), dim3(512), LDS_BYTES, stream, a); }
#endif
    }
    const hipError_t le = hipPeekAtLastError();
    if (le != hipSuccess) fprintf(stderr, "kernel_launch: launch failed: %s\n", hipGetErrorName(le));
}
```

```cpp
#include <hip/hip_runtime.h>
#include <cstdio>
#include <cstdint>

#ifndef N_LAUNCH_MODE
#define N_LAUNCH_MODE 1
#endif
#ifndef USE_SIMPLE_HGRN
#define USE_SIMPLE_HGRN 0
#endif
#ifndef USE_SIMPLE_ATTN
#define USE_SIMPLE_ATTN 0
#endif
#ifndef USE_SIMPLE_GEMM
#define USE_SIMPLE_GEMM 0
#endif

#define LAS __attribute__((address_space(3)))

constexpr int BATCH = 4, SEQ = 8192, DM = 1024, NTOK = BATCH * SEQ;
constexpr int NAB_REAL = 1604, NAB = 1792;
constexpr int DFF = 2816;
constexpr int NINC = 4096;
constexpr int PC_U = 0, PC_Q = 512, PC_K = 1024, PC_V = 1152, PC_QI = 1280, PC_KI = 1536, PC_WI = 1600;
constexpr float EPS = 1e-6f;
constexpr int TOPK = 256;

constexpr size_t MiB = 1u << 20;
constexpr size_t WS_CTL = 0, CTL_ZERO_BYTES = 1 * MiB;
constexpr size_t WS_ROPE = 1 * MiB;
constexpr size_t WS_PART = 3 * MiB;
constexpr size_t WS_LB = 5 * MiB;
constexpr size_t WS_W_INAB = 6 * MiB;
constexpr size_t WS_W_POOL = WS_W_INAB + (size_t)NAB * DM * 2;
constexpr size_t WS_W_OUTAB = 10 * MiB;
constexpr size_t WS_W_INC = 12 * MiB;
constexpr size_t WS_W_OUTC = 20 * MiB;
constexpr size_t WS_W_GU0 = 22 * MiB, WS_W_GU1 = 33 * MiB;
constexpr size_t WS_W_DN0 = 44 * MiB, WS_W_DN1 = WS_W_DN0 + (size_t)DM * DFF * 2;
constexpr size_t WS_XB = 56 * MiB;
constexpr size_t WS_Y = 120 * MiB;
constexpr size_t WS_P = 184 * MiB;
constexpr size_t WS_ACT = 184 * MiB;
constexpr size_t WS_L1Q = 184 * MiB, WS_L1K = 248 * MiB, WS_L1I = 312 * MiB, WS_L1G = 376 * MiB;
constexpr size_t WS_ORAW = 440 * MiB;
constexpr size_t WS_KV8 = 488 * MiB;
constexpr size_t WS_END = 512 * MiB;
static_assert(WS_W_POOL + 4 * 128 * 128 * 2 <= WS_W_OUTAB && WS_W_DN1 + (size_t)DM * DFF * 2 <= WS_XB && WS_P + (size_t)NTOK * NAB * 2 <= 360 * MiB && WS_ACT + (size_t)NTOK * DFF * 2 <= WS_L1G + 64 * MiB, "ws map");
constexpr int CW_BAR = 4096;

constexpr int LDS_BYTES = 163840;
constexpr int LDS_MISC = 163840 - 256;
namespace pg8 {
#define PG8_LAS __attribute__((address_space(3)))
typedef unsigned short bf16_t;
typedef short bf16x8 __attribute__((ext_vector_type(8)));
typedef float f32x4 __attribute__((ext_vector_type(4)));
typedef unsigned u32x4 __attribute__((ext_vector_type(4)));
constexpr int BM = 256, BK = 64, HALF = 128, HTB = HALF * BK * 2  , STAGE_BYTES = 8 * HTB, NXCD = 8, WGM = 8;

__host__ __device__ __forceinline__ int lds_byte(int r, int c) { const int st = (r >> 4) * 2 + (c >> 5), rr = r & 15, cc = c & 31, ob = rr * 64 + cc * 2; return st * 1024 + (ob ^ (((ob >> 9) & 1) << 5)); }
__host__ __device__ __forceinline__ void stage_rc(int b, int& R, int& C) { const int st = b / 1024, sb = b % 1024, swz = sb ^ (((sb >> 9) & 1) << 5); R = (st >> 1) * 16 + swz / 64; C = (st & 1) * 32 + (swz % 64) / 2; }
__host__ __device__ __forceinline__ int perm32(int rho) { const int n = rho >> 4, i = rho & 15; return 8 * (i >> 2) + 4 * n + (i & 3); }

struct Unit { int pm, pn; };
struct Gemm { const bf16_t* A; const bf16_t* Bt; int M, N, K; };

struct StaticOrder {
    int nM, nN, nwg, G, c;
    __host__ __device__ void init(int M, int N, int G_, int c_) { nM = M / BM; nN = N / BM; nwg = nM * nN; G = G_; c = c_; }
    __host__ __device__ bool next(int i, Unit& u) const {
        const long L = (long)i * G + c; if (L >= nwg) return false;
        int wgid = (int)L; { const int q = nwg / NXCD, r = nwg % NXCD, xcd = wgid % NXCD, off = wgid / NXCD; wgid = (xcd < r ? xcd * (q + 1) : r * (q + 1) + (xcd - r) * q) + off; }
        const int nig = WGM * nN, gid = wgid / nig, fm = gid * WGM, gsz = (nM - fm) < WGM ? (nM - fm) : WGM;
        u.pm = fm + ((wgid % nig) % gsz); u.pn = (wgid % nig) / gsz; return true;
    }
    __device__ __forceinline__ void a_ready(const Unit&) const {}
    __device__ __forceinline__ void done(const Unit&) const {}
};
typedef __bf16 bf16x2_t __attribute__((ext_vector_type(2)));
__device__ __forceinline__ unsigned cvt_pk_bf16(float lo, float hi) { const bf16x2_t v = {(__bf16)lo, (__bf16)hi}; return __builtin_bit_cast(unsigned, v); }

typedef float f32x2 __attribute__((ext_vector_type(2)));
typedef unsigned u32x2 __attribute__((ext_vector_type(2)));

__device__ __forceinline__ float row_rinv(const float* part, int row) {
    const f32x4* p = (const f32x4*)(part + (size_t)row * 16);
    const f32x4 a = p[0], b = p[1], c = p[2], d = p[3];
    const float s = (((a[0] + a[1]) + (a[2] + a[3])) + ((b[0] + b[1]) + (b[2] + b[3]))) + (((c[0] + c[1]) + (c[2] + c[3])) + ((d[0] + d[1]) + (d[2] + d[3])));
    return 1.0f / sqrtf(s * (1.0f / 1024.0f) + 1e-6f);
}
struct RinvTab {
    const float* part; PG8_LAS unsigned char* ldsb;
    __device__ __forceinline__ void prepare(int pm) const {
        PG8_LAS int* cpm = (PG8_LAS int*)(ldsb + 131072 + 1024); PG8_LAS float* rtab = (PG8_LAS float*)(ldsb + 131072);
        if (*cpm != pm) {
            asm volatile("s_waitcnt lgkmcnt(0)" ::: "memory"); __builtin_amdgcn_s_barrier(); asm volatile("" ::: "memory");
            if (threadIdx.x < 256) rtab[threadIdx.x] = row_rinv(part, pm * BM + (int)threadIdx.x);
            if (threadIdx.x == 0) *cpm = pm;
            asm volatile("s_waitcnt vmcnt(0) lgkmcnt(0)" ::: "memory"); __builtin_amdgcn_s_barrier(); asm volatile("" ::: "memory");
        }
    }
    __device__ __forceinline__ float get(int row_in_panel) const { return ((const PG8_LAS float*)(ldsb + 131072))[row_in_panel]; }
};
__device__ __forceinline__ float sigmoid_neg(float x) { return __builtin_amdgcn_rcpf(1.0f + __expf(x)); }
__device__ __forceinline__ float silu_f(float x) { return x * __builtin_amdgcn_rcpf(1.0f + __expf(-x)); }

struct EpiScaleBf16 {
    static constexpr bool PERM = true, AFTER_DRAIN = false;
    bf16_t* O; int ldc; RinvTab rt;
    __device__ __forceinline__ void operator()(const f32x4 (&acc)[2][2][4][2], const Unit& u, int wr, int wc, int fr, int fq) const {
        rt.prepare(u.pm);
        const int row0 = u.pm * BM + wr * 64 + fr, col0 = u.pn * BM + wc * 32 + 8 * fq;
#pragma unroll
        for (int ai = 0; ai < 2; ++ai)
#pragma unroll
            for (int m = 0; m < 4; ++m) { const int row = row0 + ai * HALF + m * 16; const float r = rt.get(row - u.pm * BM); bf16_t* rowp = O + (size_t)row * ldc + col0;
#pragma unroll
                for (int bj = 0; bj < 2; ++bj) { const f32x4 v0 = acc[ai][bj][m][0] * r, v1 = acc[ai][bj][m][1] * r;
                    u32x4 w; w.x = cvt_pk_bf16(v0[0], v0[1]); w.y = cvt_pk_bf16(v0[2], v0[3]); w.z = cvt_pk_bf16(v1[0], v1[1]); w.w = cvt_pk_bf16(v1[2], v1[3]);
                    *(u32x4*)(rowp + bj * HALF) = w; } }
    }
};
template <bool BASE_F32> struct EpiResidual {
    static constexpr bool PERM = true, AFTER_DRAIN = false;
    bf16_t* xb; float* part; const float* xin;
    __device__ __forceinline__ void operator()(const f32x4 (&acc)[2][2][4][2], const Unit& u, int wr, int wc, int fr, int fq) const {
        const int row0 = u.pm * BM + wr * 64 + fr, col0 = u.pn * BM + wc * 32 + 8 * fq;
#pragma unroll
        for (int ai = 0; ai < 2; ++ai)
#pragma unroll
            for (int m = 0; m < 4; ++m) { const int row = row0 + ai * HALF + m * 16; const size_t off = (size_t)row * 1024 + col0; float ss = 0.f;
#pragma unroll
                for (int bj = 0; bj < 2; ++bj) {
                    f32x4 x0, x1;
                    if (BASE_F32) { x0 = *(const f32x4*)(xin + off + bj * HALF) + acc[ai][bj][m][0]; x1 = *(const f32x4*)(xin + off + bj * HALF + 4) + acc[ai][bj][m][1]; }
                    else { const u32x4 b = *(const u32x4*)(xb + off + bj * HALF);
                    x0[0] = __uint_as_float(b.x << 16) + acc[ai][bj][m][0][0]; x0[1] = __uint_as_float(b.x & 0xffff0000u) + acc[ai][bj][m][0][1];
                    x0[2] = __uint_as_float(b.y << 16) + acc[ai][bj][m][0][2]; x0[3] = __uint_as_float(b.y & 0xffff0000u) + acc[ai][bj][m][0][3];
                    x1[0] = __uint_as_float(b.z << 16) + acc[ai][bj][m][1][0]; x1[1] = __uint_as_float(b.z & 0xffff0000u) + acc[ai][bj][m][1][1];
                    x1[2] = __uint_as_float(b.w << 16) + acc[ai][bj][m][1][2]; x1[3] = __uint_as_float(b.w & 0xffff0000u) + acc[ai][bj][m][1][3]; }
                    ss += ((x0[0] * x0[0] + x0[1] * x0[1]) + (x0[2] * x0[2] + x0[3] * x0[3])) + ((x1[0] * x1[0] + x1[1] * x1[1]) + (x1[2] * x1[2] + x1[3] * x1[3]));
                    u32x4 w; w.x = cvt_pk_bf16(x0[0], x0[1]); w.y = cvt_pk_bf16(x0[2], x0[3]); w.z = cvt_pk_bf16(x1[0], x1[1]); w.w = cvt_pk_bf16(x1[2], x1[3]);
                    *(u32x4*)(xb + off + bj * HALF) = w; }
                ss += __shfl_xor(ss, 16); ss += __shfl_xor(ss, 32);
                if (fq == 0) part[(size_t)row * 16 + u.pn * 4 + wc] = ss; }
    }
};
struct EpiSwiGLU {
    static constexpr bool PERM = true, AFTER_DRAIN = false;
    bf16_t* O; RinvTab rt;
    __device__ __forceinline__ void operator()(const f32x4 (&acc)[2][2][4][2], const Unit& u, int wr, int wc, int fr, int fq) const {
        rt.prepare(u.pm);
        const int row0 = u.pm * BM + wr * 64 + fr, f0 = u.pn * HALF + wc * 32 + 8 * fq;
#pragma unroll
        for (int ai = 0; ai < 2; ++ai)
#pragma unroll
            for (int m = 0; m < 4; ++m) { const int row = row0 + ai * HALF + m * 16; const float r = rt.get(row - u.pm * BM);
                float a[8];
#pragma unroll
                for (int n = 0; n < 2; ++n)
#pragma unroll
                    for (int j = 0; j < 4; ++j) { const float g = acc[ai][0][m][n][j] * r, up = acc[ai][1][m][n][j] * r; a[4 * n + j] = silu_f(g) * up; }
                u32x4 w; w.x = cvt_pk_bf16(a[0], a[1]); w.y = cvt_pk_bf16(a[2], a[3]); w.z = cvt_pk_bf16(a[4], a[5]); w.w = cvt_pk_bf16(a[6], a[7]);
                *(u32x4*)(O + (size_t)row * 2816 + f0) = w; }
    }
};
struct EpiHgrnIn {
    static constexpr bool PERM = true, AFTER_DRAIN = false;
    bf16_t *Q1, *K1, *I1, *G1; RinvTab rt; const float* lb;
    __device__ __forceinline__ void operator()(const f32x4 (&acc)[2][2][4][2], const Unit& u, int wr, int wc, int fr, int fq) const {
        rt.prepare(u.pm);
        const int sec = u.pn >> 2; const int row0 = u.pm * BM + wr * 64 + fr, col0 = (u.pn & 3) * BM + wc * 32 + 8 * fq;
        bf16_t* O = sec == 0 ? Q1 : sec == 1 ? K1 : sec == 2 ? I1 : G1;
        float lbc[2][8];
#pragma unroll
        for (int bj = 0; bj < 2; ++bj)
#pragma unroll
            for (int j = 0; j < 8; ++j) lbc[bj][j] = (sec == 1) ? (1.0f - lb[col0 + bj * HALF + j]) : 0.f;
#pragma unroll
        for (int ai = 0; ai < 2; ++ai)
#pragma unroll
            for (int m = 0; m < 4; ++m) { const int row = row0 + ai * HALF + m * 16; const float r = rt.get(row - u.pm * BM); bf16_t* rowp = O + (size_t)row * 1024 + col0;
#pragma unroll
                for (int bj = 0; bj < 2; ++bj) { float a[8];
#pragma unroll
                    for (int n = 0; n < 2; ++n)
#pragma unroll
                        for (int j = 0; j < 4; ++j) { const float v = acc[ai][bj][m][n][j] * r; float o;
                            if (sec == 0) o = v * 0.08838834764831845f; else if (sec == 1) o = lbc[bj][4 * n + j] * sigmoid_neg(v); else if (sec == 2) o = v; else o = silu_f(v);
                            a[4 * n + j] = o; }
                    u32x4 w; w.x = cvt_pk_bf16(a[0], a[1]); w.y = cvt_pk_bf16(a[2], a[3]); w.z = cvt_pk_bf16(a[4], a[5]); w.w = cvt_pk_bf16(a[6], a[7]);
                    *(u32x4*)(rowp + bj * HALF) = w; } }
    }
};

template <class Epi>
__device__ __forceinline__ void gemm_simple(const Gemm g, int G, int c, const Epi& E) {
    const int tid = threadIdx.x, wid = __builtin_amdgcn_readfirstlane(tid >> 6), lane = tid & 63, wr = wid >> 2, wc = wid & 3, fr = lane & 15, fq = lane >> 4;
    const int nN = g.N / BM, nunits = (g.M / BM) * nN, K = g.K;
    for (int ui = c; ui < nunits; ui += G) {
        Unit u; u.pm = ui / nN; u.pn = ui % nN;
        f32x4 acc[2][2][4][2];
#pragma unroll
        for (int a = 0; a < 2; ++a)
#pragma unroll
            for (int b = 0; b < 2; ++b)
#pragma unroll
                for (int m = 0; m < 4; ++m)
#pragma unroll
                    for (int n = 0; n < 2; ++n) acc[a][b][m][n] = (f32x4){0.f, 0.f, 0.f, 0.f};
        const bf16_t* Ab = g.A + (size_t)(u.pm * BM + wr * 64 + fr) * K + fq * 8;
        const bf16_t* Bb = g.Bt + (size_t)(u.pn * BM + wc * 32 + 8 * (fr >> 2) + (fr & 3)) * K + fq * 8;
        for (int kk = 0; kk < K; kk += 32) {
            bf16x8 a[2][4], b[2][2];
#pragma unroll
            for (int ai = 0; ai < 2; ++ai)
#pragma unroll
                for (int m = 0; m < 4; ++m) a[ai][m] = *(const bf16x8*)(Ab + (size_t)(ai * HALF + m * 16) * K + kk);
#pragma unroll
            for (int bj = 0; bj < 2; ++bj)
#pragma unroll
                for (int n = 0; n < 2; ++n) b[bj][n] = *(const bf16x8*)(Bb + (size_t)(bj * HALF + 4 * n) * K + kk);
#pragma unroll
            for (int ai = 0; ai < 2; ++ai)
#pragma unroll
                for (int bj = 0; bj < 2; ++bj)
#pragma unroll
                    for (int m = 0; m < 4; ++m)
#pragma unroll
                        for (int n = 0; n < 2; ++n) acc[ai][bj][m][n] = __builtin_amdgcn_mfma_f32_16x16x32_bf16(b[bj][n], a[ai][m], acc[ai][bj][m][n], 0, 0, 0);
        }
        E(acc, u, wr, wc, fr, fq);
    }
}
template <class Epi, class Sched, bool ALIGN_EPI = false, bool SP2 = false>
__device__ __forceinline__ void gemm_phase(PG8_LAS unsigned char* lds, const Gemm g, const Sched& S, const Epi& E) {
    const int tid = threadIdx.x, wid = __builtin_amdgcn_readfirstlane(tid >> 6), lane = tid & 63, wr = wid >> 2, wc = wid & 3, fr = lane & 15, fq = lane >> 4;
    const int K = g.K, nt = K / BK;
    unsigned voffA[2], voffB[2];
#pragma unroll
    for (int i = 0; i < 2; ++i) { int R, C; stage_rc(tid * 16 + i * 8192, R, C); const int Rb = Epi::PERM ? ((R & ~31) + perm32(R & 31)) : R;
        voffA[i] = (unsigned)(R * K + C) * 2u; voffB[i] = (unsigned)(Rb * K + C) * 2u; }
    const size_t kstep = (size_t)(BK * 2);
    const size_t hstep = (size_t)HALF * K * 2;
    const size_t tstep = 2 * hstep;
    const unsigned ldsw = (unsigned)wid * 1024u;
    const int aoff = lds_byte(wr * 64 + fr, fq * 8), boff = lds_byte(wc * 32 + fr, fq * 8);
#define PG8_SA(b, h) (((b) * 2 + (h)) * HTB)
#define PG8_SB(b, h) ((4 + (b) * 2 + (h)) * HTB)
#define PG8_STAGE(bufoff, gbase, voff) do { _Pragma("unroll") for (int _i = 0; _i < 2; ++_i) \
        __builtin_amdgcn_global_load_lds((const unsigned*)((const char*)(gbase) + (voff)[_i]), (PG8_LAS unsigned*)(lds + (bufoff) + ldsw + _i * 8192), 16, 0, 0); } while (0)
#define PG8_LDA(dst, b, h) do { _Pragma("unroll") for (int m = 0; m < 4; ++m) _Pragma("unroll") for (int k = 0; k < 2; ++k) dst[m][k] = *(const PG8_LAS bf16x8*)(lds + PG8_SA(b, h) + aoff + m * 2048 + k * 1024); } while (0)
#define PG8_LDB(dst, b, h) do { _Pragma("unroll") for (int n = 0; n < 2; ++n) _Pragma("unroll") for (int k = 0; k < 2; ++k) dst[n][k] = *(const PG8_LAS bf16x8*)(lds + PG8_SB(b, h) + boff + n * 2048 + k * 1024); } while (0)
#define PG8_MMA(ai, bj, At, Bt) do { __builtin_amdgcn_s_setprio(1); _Pragma("unroll") for (int m = 0; m < 4; ++m) _Pragma("unroll") for (int n = 0; n < 2; ++n) _Pragma("unroll") for (int k = 0; k < 2; ++k) \
        acc[ai][bj][m][n] = __builtin_amdgcn_mfma_f32_16x16x32_bf16(Bt[n][k], At[m][k], acc[ai][bj][m][n], 0, 0, 0); __builtin_amdgcn_s_setprio(0); } while (0)
#define PG8_WAIT_V(n) asm volatile("s_waitcnt vmcnt(" #n ")" ::: "memory")
#define PG8_WAIT_L(n) asm volatile("s_waitcnt lgkmcnt(" #n ")" ::: "memory")
#define PG8_BAR __builtin_amdgcn_s_barrier()
#define PG8_SCHED __builtin_amdgcn_sched_barrier(0)
    Unit cur, nxt; int ui = 0;
    if (!S.next(0, cur)) return;
    f32x4 acc[2][2][4][2];
#pragma unroll
    for (int a = 0; a < 2; ++a)
#pragma unroll
        for (int b = 0; b < 2; ++b)
#pragma unroll
            for (int m = 0; m < 4; ++m)
#pragma unroll
                for (int n = 0; n < 2; ++n) acc[a][b][m][n] = (f32x4){0.f, 0.f, 0.f, 0.f};
    bf16x8 At[4][2], B0[2][2], B1[2][2];
    const char* cA = (const char*)g.A + (size_t)cur.pm * tstep; const char* cB = (const char*)g.Bt + (size_t)cur.pn * tstep;
    S.a_ready(cur);
    if constexpr (SP2) {
        PG8_STAGE(PG8_SB(0, 0), cB, voffB); PG8_STAGE(PG8_SB(0, 1), cB + hstep, voffB); PG8_STAGE(PG8_SA(0, 0), cA, voffA); PG8_STAGE(PG8_SA(0, 1), cA + hstep, voffA);
        if (wr == 1) PG8_BAR;
        PG8_WAIT_V(2); PG8_BAR;
        PG8_STAGE(PG8_SB(1, 0), cB + kstep, voffB); PG8_STAGE(PG8_SA(1, 0), cA + kstep, voffA); PG8_STAGE(PG8_SB(1, 1), cB + hstep + kstep, voffB);
        PG8_WAIT_V(6); PG8_BAR;
    } else {
        PG8_STAGE(PG8_SB(0, 0), cB, voffB); PG8_STAGE(PG8_SA(0, 0), cA, voffA); PG8_STAGE(PG8_SB(0, 1), cB + hstep, voffB); PG8_STAGE(PG8_SA(0, 1), cA + hstep, voffA);
        if (wr == 1) PG8_BAR;
        PG8_WAIT_V(4); PG8_BAR;
        PG8_STAGE(PG8_SB(1, 0), cB + kstep, voffB); PG8_STAGE(PG8_SA(1, 0), cA + kstep, voffA); PG8_STAGE(PG8_SB(1, 1), cB + hstep + kstep, voffB);
        PG8_WAIT_V(6); PG8_BAR;
    }
    for (;;) {
        const bool has_next = S.next(ui + 1, nxt);
        const char* nA = has_next ? (const char*)g.A + (size_t)nxt.pm * tstep : cA; const char* nB = has_next ? (const char*)g.Bt + (size_t)nxt.pn * tstep : cB;
        for (int t = 0; t < nt; t += 2) {
            const bool last = (t == nt - 2);
            const char* a1 = cA + (size_t)(t + 1) * kstep;
            const char* a2 = last ? nA : cA + (size_t)(t + 2) * kstep; const char* b2 = last ? nB : cB + (size_t)(t + 2) * kstep;
            const char* a3 = a2 + kstep; const char* b3 = b2 + kstep;
            if (last && has_next) S.a_ready(nxt);
            if constexpr (SP2) {
            PG8_LDB(B0, 0, 0); PG8_LDB(B1, 0, 1); PG8_SCHED; PG8_LDA(At, 0, 0); PG8_STAGE(PG8_SA(1, 1), a1 + hstep, voffA);
            PG8_WAIT_V(8); PG8_WAIT_L(0); PG8_BAR; PG8_MMA(0, 0, At, B0); PG8_MMA(0, 1, At, B1); PG8_BAR; PG8_SCHED;
            PG8_LDA(At, 0, 1); PG8_STAGE(PG8_SB(0, 0), b2, voffB); PG8_STAGE(PG8_SB(0, 1), b2 + hstep, voffB); PG8_STAGE(PG8_SA(0, 0), a2, voffA);
            PG8_WAIT_V(8); PG8_WAIT_L(0); PG8_BAR; PG8_MMA(1, 0, At, B0); PG8_MMA(1, 1, At, B1); PG8_BAR; PG8_SCHED;
            PG8_LDB(B0, 1, 0); PG8_LDB(B1, 1, 1); PG8_SCHED; PG8_LDA(At, 1, 0); PG8_STAGE(PG8_SA(0, 1), a2 + hstep, voffA);
            PG8_WAIT_V(8); PG8_WAIT_L(0); PG8_BAR; PG8_MMA(0, 0, At, B0); PG8_MMA(0, 1, At, B1); PG8_BAR; PG8_SCHED;
            PG8_LDA(At, 1, 1); PG8_STAGE(PG8_SB(1, 0), b3, voffB); PG8_STAGE(PG8_SB(1, 1), b3 + hstep, voffB); PG8_STAGE(PG8_SA(1, 0), a3, voffA);
            PG8_WAIT_V(8); PG8_WAIT_L(0); PG8_BAR; PG8_MMA(1, 0, At, B0); PG8_MMA(1, 1, At, B1); PG8_BAR; PG8_SCHED;
            } else {
            PG8_LDB(B0, 0, 0); PG8_SCHED; PG8_LDA(At, 0, 0); PG8_STAGE(PG8_SA(1, 1), a1 + hstep, voffA);
            PG8_WAIT_L(8); PG8_BAR; PG8_WAIT_L(0); PG8_MMA(0, 0, At, B0); PG8_BAR; PG8_SCHED;
            PG8_LDB(B1, 0, 1); PG8_STAGE(PG8_SB(0, 0), b2, voffB);
            PG8_BAR; PG8_WAIT_L(0); PG8_MMA(0, 1, At, B1); PG8_BAR;
            PG8_LDA(At, 0, 1); PG8_STAGE(PG8_SA(0, 0), a2, voffA);
            PG8_BAR; PG8_WAIT_L(0); PG8_MMA(1, 0, At, B0); PG8_BAR; PG8_SCHED;
            PG8_STAGE(PG8_SB(0, 1), b2 + hstep, voffB);
            PG8_WAIT_V(6); PG8_BAR; PG8_MMA(1, 1, At, B1); PG8_BAR;
            PG8_LDB(B0, 1, 0); PG8_SCHED; PG8_LDA(At, 1, 0); PG8_STAGE(PG8_SA(0, 1), a2 + hstep, voffA);
            PG8_WAIT_L(8); PG8_BAR; PG8_WAIT_L(0); PG8_MMA(0, 0, At, B0); PG8_BAR; PG8_SCHED;
            PG8_LDB(B1, 1, 1); PG8_STAGE(PG8_SB(1, 0), b3, voffB);
            PG8_BAR; PG8_WAIT_L(0); PG8_MMA(0, 1, At, B1); PG8_BAR;
            PG8_LDA(At, 1, 1); PG8_STAGE(PG8_SA(1, 0), a3, voffA);
            PG8_BAR; PG8_WAIT_L(0); PG8_MMA(1, 0, At, B0); PG8_BAR; PG8_SCHED;
            PG8_STAGE(PG8_SB(1, 1), b3 + hstep, voffB);
            PG8_WAIT_V(6); PG8_BAR; PG8_MMA(1, 1, At, B1); PG8_BAR;
            }
        }
        if constexpr (ALIGN_EPI) { if (wr == 0) PG8_BAR; }
        if constexpr (!Epi::AFTER_DRAIN) { E(acc, cur, wr, wc, fr, fq); S.done(cur); }
        if (!has_next) break;
#pragma unroll
        for (int a = 0; a < 2; ++a)
#pragma unroll
            for (int b = 0; b < 2; ++b)
#pragma unroll
                for (int m = 0; m < 4; ++m)
#pragma unroll
                    for (int n = 0; n < 2; ++n) acc[a][b][m][n] = (f32x4){0.f, 0.f, 0.f, 0.f};
        cur = nxt; cA = nA; cB = nB; ++ui;
        if constexpr (ALIGN_EPI) { if (wr == 1) PG8_BAR; }
    }
    PG8_WAIT_V(0);
    if constexpr (!ALIGN_EPI) { if (wr == 0) PG8_BAR; }
    PG8_BAR;
    if constexpr (Epi::AFTER_DRAIN) { E.fused(acc, cur, wr, wc, fr, fq, lds, wid, lane); S.done(cur); }
#undef PG8_SA
#undef PG8_SB
#undef PG8_STAGE
#undef PG8_LDA
#undef PG8_LDB
#undef PG8_MMA
#undef PG8_WAIT_V
#undef PG8_WAIT_L
#undef PG8_BAR
#undef PG8_SCHED
}
}

#define XB_TMO      128
#define XB_XCNT(j)  (256  + 64 * (j))
#define XB_XSUB(j)  (1280 + 64 * (j))
#define XB_XGEN(j)  (2304 + 64 * (j))
#define XB_TOP      3328
#define XB_TOPGEN   3392
#define XCD_BAR_WORDS 3456
#define XB_SPIN_CAP (1u << 18)

__device__ __forceinline__ unsigned xb_ld(unsigned* p)              { return __hip_atomic_load(p, __ATOMIC_RELAXED, __HIP_MEMORY_SCOPE_AGENT); }
__device__ __forceinline__ unsigned xb_add(unsigned* p, unsigned v) { return __hip_atomic_fetch_add(p, v, __ATOMIC_RELAXED, __HIP_MEMORY_SCOPE_AGENT); }
__device__ __forceinline__ unsigned xb_xcc_id() { return (unsigned)__builtin_amdgcn_s_getreg((3 << 11) | 20) & 0xFu; }
#define XB_SPIN(cond, bar) do { unsigned _sp = 0; while (cond) { __builtin_amdgcn_s_sleep(1); \
    if ((++_sp & 255u) == 0u) { if (xb_ld(&(bar)[XB_TMO])) break; if (_sp > XB_SPIN_CAP) { atomicAdd(&(bar)[XB_TMO], 1u); break; } } } } while (0)

struct XcdBarrier {
    unsigned* bar; unsigned x;
    volatile LAS unsigned* st;
};

__device__ __forceinline__ XcdBarrier xcd_barrier_post(unsigned* bar, volatile LAS unsigned* st) {
    XcdBarrier b; b.bar = bar; b.x = xb_xcc_id(); b.st = st;
    if (threadIdx.x == 0) (void)xb_add(&bar[XB_XCNT(b.x)], 1u);
    return b;
}
__device__ __forceinline__ void xcd_barrier_complete(unsigned* bar, unsigned x, unsigned& nloc, unsigned& nx) {
    const unsigned G = gridDim.x * gridDim.y * gridDim.z;
    unsigned sum, cnt, mine, sp = 0u;
    for (;;) {
        sum = 0u; cnt = 0u; mine = 0u;
#pragma unroll
        for (unsigned j = 0; j < 16; ++j) { const unsigned c = xb_ld(&bar[XB_XCNT(j)]); sum += c; cnt += (c > 0u) ? 1u : 0u; mine = (j == x) ? c : mine; }
        if (sum == G) break;
        __builtin_amdgcn_s_sleep(1);
        if ((++sp & 255u) == 0u) { if (xb_ld(&bar[XB_TMO])) break; if (sp > XB_SPIN_CAP) { atomicAdd(&bar[XB_TMO], 1u); break; } }
    }
    nloc = mine > 0u ? mine : 1u; nx = cnt > 0u ? cnt : 1u;
}

__device__ __forceinline__ void xcd_barrier(const XcdBarrier& b) {
    asm volatile("s_waitcnt vmcnt(0)" ::: "memory");
    __syncthreads();
    if (threadIdx.x == 0) {
        unsigned* bar = b.bar;
        __builtin_amdgcn_s_waitcnt(0);
        unsigned nloc = b.st[0], nx = b.st[1];
        if (nloc == 0u) { xcd_barrier_complete(bar, b.x, nloc, nx); b.st[0] = nloc; b.st[1] = nx; }
        const unsigned old = xb_add(&bar[XB_XSUB(b.x)], 1u);
        const unsigned gen = old / nloc;
        if (old + 1u == (gen + 1u) * nloc) {
            __builtin_amdgcn_fence(__ATOMIC_RELEASE, "agent");
            asm volatile("s_waitcnt vmcnt(0)" ::: "memory");
            const unsigned og = xb_add(&bar[XB_TOP], 1u);
            const unsigned tg = og / nx;
            if (og + 1u == (tg + 1u) * nx) xb_add(&bar[XB_TOPGEN], 1u);
            else XB_SPIN(xb_ld(&bar[XB_TOPGEN]) == tg, bar);
            __builtin_amdgcn_fence(__ATOMIC_ACQUIRE, "agent");
            xb_add(&bar[XB_XGEN(b.x)], 1u);
            asm volatile("s_waitcnt vmcnt(0)" ::: "memory");
        } else {
            XB_SPIN(xb_ld(&bar[XB_XGEN(b.x)]) == gen, bar);
            __builtin_amdgcn_fence(__ATOMIC_ACQUIRE, "agent");
            asm volatile("s_waitcnt vmcnt(0)" ::: "memory");
        }
    }
    __syncthreads();
}

typedef unsigned short bf16_t;
typedef short bf16x8 __attribute__((ext_vector_type(8)));
typedef float f32x4 __attribute__((ext_vector_type(4)));
typedef unsigned u32x4 __attribute__((ext_vector_type(4)));
typedef unsigned u32x2 __attribute__((ext_vector_type(2)));

struct Ctx {
    const float* x; const int* positions; const float *ln_mix, *ln_ffn, *ln_final, *w_in_ab, *w_pool, *pool_scale, *idx_k_norm, *w_out_ab, *w_in_c, *hgrn_lb, *hgrn_out_norm, *w_out_c, *w_gate_up, *w_down;
    float* out;
    unsigned* ctl; float* rope; float* part; float* lbv;
    bf16_t *W_inab, *W_pool, *W_outab, *W_inc, *W_outc, *W_gu0, *W_gu1, *W_dn0, *W_dn1;
    bf16_t *XB, *Y, *P, *ACT, *L1Q, *L1K, *L1I, *L1G, *ORAW;
    int G, bid;
};

__device__ __forceinline__ float bf_lo(unsigned w) { return __uint_as_float(w << 16); }
__device__ __forceinline__ float bf_hi(unsigned w) { return __uint_as_float(w & 0xffff0000u); }
__device__ __forceinline__ float bf2f(bf16_t b) { return __uint_as_float(((unsigned)b) << 16); }
__device__ __forceinline__ unsigned pk2(float lo, float hi) { return pg8::cvt_pk_bf16(lo, hi); }
__device__ __forceinline__ float wave_sum(float v) {
#pragma unroll
    for (int o = 1; o < 64; o <<= 1) v += __shfl_xor(v, o);
    return v;
}

__device__ __forceinline__ unsigned pk4_fp8(float a, float b, float c, float d) { int w = 0; w = __builtin_amdgcn_cvt_pk_fp8_f32(a, b, w, false); w = __builtin_amdgcn_cvt_pk_fp8_f32(c, d, w, true); return (unsigned)w; }
__device__ __forceinline__ u32x2 bf8_to_fp8(u32x4 w) { u32x2 o; o.x = pk4_fp8(bf_lo(w.x), bf_hi(w.x), bf_lo(w.y), bf_hi(w.y)); o.y = pk4_fp8(bf_lo(w.z), bf_hi(w.z), bf_lo(w.w), bf_hi(w.w)); return o; }

struct RowMapId { __device__ __forceinline__ int operator()(int n) const { return n; } };
struct RowMapAB { __device__ __forceinline__ int operator()(int n) const {
    if (n < PC_Q || (n >= PC_V && n < PC_QI) || n >= PC_WI) return n;
    const int d = n & 63; if (d >= 16) return n;
    return n - d + ((d < 8) ? 2 * d : 2 * (d - 8) + 1); } };
struct RowMapGU { __device__ __forceinline__ int operator()(int n) const {
    if (n < DFF) return 256 * (n >> 7) + (n & 127);
    const int f = n - DFF; return 256 * (f >> 7) + 128 + (f & 127); } };

template <class RowMap>
__device__ __forceinline__ void transpose_item(const float* W, int K, int N, const float* kgain, const float* nscale, bf16_t* WT, RowMap map, LAS float* scr, int item, int lane) {
    const int nblk = (N + 31) >> 5, kb = item / nblk, nb = item - kb * nblk, k0 = 64 * kb, n0 = 32 * nb;
    const int nr = n0 + (lane & 31); const float ns = (nr < N && nscale) ? nscale[nr] : 1.0f;
    float wv[32];
    const int nrc = (nr < N) ? nr : N - 1;
#pragma unroll
    for (int i = 0; i < 32; ++i) wv[i] = W[(size_t)(k0 + 2 * i + (lane >> 5)) * N + nrc];
    float kg[32];
#pragma unroll
    for (int i = 0; i < 32; ++i) kg[i] = kgain ? kgain[k0 + 2 * i + (lane >> 5)] : 1.0f;
#pragma unroll
    for (int i = 0; i < 32; ++i) { const int kk = 2 * i + (lane >> 5); scr[kk * 33 + (lane & 31)] = (nr < N) ? wv[i] * kg[i] * ns : 0.f; }
    asm volatile("s_waitcnt lgkmcnt(0)" ::: "memory");
    const int c = lane & 7;
#pragma unroll
    for (int j = 0; j < 4; ++j) { const int nl = (lane >> 3) + 8 * j; const LAS float* s = scr + (8 * c) * 33 + nl;
        u32x4 o; o.x = pk2(s[0 * 33], s[1 * 33]); o.y = pk2(s[2 * 33], s[3 * 33]); o.z = pk2(s[4 * 33], s[5 * 33]); o.w = pk2(s[6 * 33], s[7 * 33]);
        if (n0 + nl < N) *(u32x4*)(WT + (size_t)map(n0 + nl) * K + k0 + 8 * c) = o; }
    asm volatile("s_waitcnt lgkmcnt(0)" ::: "memory");
}

__device__ __forceinline__ void rope_cs(int pos, int i, float& c, float& s) {
    const double inv = (i == 0) ? 1.0 : (i == 1) ? 0.19392274474868576 : (i == 2) ? 0.03760603093086393 : (i == 3) ? 0.007292664737217109 : (i == 4) ? 0.001414213562373095
                     : (i == 5) ? 0.0002742481756762073 : (i == 6) ? 5.318295896944988e-05 : 1.031338537721246e-05;
    const double a = (double)pos * inv;
    const double kq = rint(a * 0.63661977236758134308);
    double r = fma(-kq, 1.57079632679489655800e+00, a); r = fma(-kq, 6.12323399573676603587e-17, r);
    const double r2 = r * r;
    double sp = -7.6471637318198164759e-13; sp = fma(sp, r2, 1.6059043836821614599e-10); sp = fma(sp, r2, -2.5052108385441718775e-08); sp = fma(sp, r2, 2.7557319223985890653e-06);
    sp = fma(sp, r2, -1.9841269841269841270e-04); sp = fma(sp, r2, 8.3333333333333333333e-03); sp = fma(sp, r2, -1.6666666666666666667e-01); const double sn = fma(sp * r2, r, r);
    double cp = 4.7794773323873852974e-14; cp = fma(cp, r2, -1.1470745597729724714e-11); cp = fma(cp, r2, 2.0876756987868098979e-09); cp = fma(cp, r2, -2.7557319223985890653e-07);
    cp = fma(cp, r2, 2.4801587301587301587e-05); cp = fma(cp, r2, -1.3888888888888888889e-03); cp = fma(cp, r2, 4.1666666666666666667e-02); cp = fma(cp, r2, -0.5); const double cn = fma(cp, r2, 1.0);
    const int q = ((int)kq) & 3;
    const double cc = (q == 0) ? cn : (q == 1) ? -sn : (q == 2) ? -cn : sn;
    const double ss = (q == 0) ? sn : (q == 1) ? cn : (q == 2) ? -sn : -cn;
    c = (float)cc; s = (float)ss;
}

__device__ __forceinline__ void phase_prologue(const Ctx& C, LAS unsigned char* lds) {
    const int tid = threadIdx.x, lane = tid & 63, wave = __builtin_amdgcn_readfirstlane(tid >> 6);
    LAS float* scr = (LAS float*)(lds + wave * 16384);
    const int gw = C.bid * 8 + wave, NGW = C.G * 8;
    constexpr int I_AB = 16 * 51, I_PL = 2 * 4, I_SQ = 16 * 32, I_INC = 16 * 128, I_GU = 16 * 176, I_DN = 44 * 32;
    constexpr int NITEMS = I_AB + 4 * I_PL + I_SQ + I_INC + I_SQ + 2 * I_GU + 2 * I_DN;
    for (int it = gw; it < NITEMS; it += NGW) {
        int r = it;
        if (r < I_AB) { transpose_item(C.w_in_ab, 1024, NAB_REAL, C.ln_mix, nullptr, C.W_inab, RowMapAB(), scr, r, lane); continue; } r -= I_AB;
        if (r < 4 * I_PL) { const int g = r / I_PL; transpose_item(C.w_pool + g * 16384, 128, 128, nullptr, C.pool_scale + g * 128, C.W_pool + g * 16384, RowMapId(), scr, r - g * I_PL, lane); continue; } r -= 4 * I_PL;
        if (r < I_SQ) { transpose_item(C.w_out_ab, 1024, 1024, nullptr, nullptr, C.W_outab, RowMapId(), scr, r, lane); continue; } r -= I_SQ;
        if (r < I_INC) { transpose_item(C.w_in_c, 1024, NINC, C.ln_mix + 1024, nullptr, C.W_inc, RowMapId(), scr, r, lane); continue; } r -= I_INC;
        if (r < I_SQ) { transpose_item(C.w_out_c, 1024, 1024, nullptr, nullptr, C.W_outc, RowMapId(), scr, r, lane); continue; } r -= I_SQ;
        if (r < I_GU) { transpose_item(C.w_gate_up, 1024, 2 * DFF, C.ln_ffn, nullptr, C.W_gu0, RowMapGU(), scr, r, lane); continue; } r -= I_GU;
        if (r < I_GU) { transpose_item(C.w_gate_up + (size_t)1024 * 2 * DFF, 1024, 2 * DFF, C.ln_ffn + 1024, nullptr, C.W_gu1, RowMapGU(), scr, r, lane); continue; } r -= I_GU;
        if (r < I_DN) { transpose_item(C.w_down, DFF, 1024, nullptr, nullptr, C.W_dn0, RowMapId(), scr, r, lane); continue; } r -= I_DN;
        transpose_item(C.w_down + (size_t)DFF * 1024, DFF, 1024, nullptr, nullptr, C.W_dn1, RowMapId(), scr, r, lane);
    }
    const int gt = C.bid * 512 + tid, NGT = C.G * 512;
    for (int i = gt; i < (NAB - NAB_REAL) * 1024 / 8; i += NGT) ((u32x4*)(C.W_inab + (size_t)NAB_REAL * 1024))[i] = (u32x4){0u, 0u, 0u, 0u};
    for (int i = gt; i < NTOK * 8; i += NGT) { const int tok = i >> 3, f = i & 7; float c, s; rope_cs(C.positions[tok], f, c, s); C.rope[(size_t)tok * 16 + f] = c; C.rope[(size_t)tok * 16 + 8 + f] = s; }
    for (int i = gt; i < 1024; i += NGT) C.lbv[i] = 1.0f / (1.0f + expf(C.hgrn_lb[i] - C.hgrn_lb[1024 + i]));
    for (int row0 = 4 * gw; row0 < NTOK; row0 += 4 * NGW) {
        f32x4 v[4][4];
#pragma unroll
        for (int rr = 0; rr < 4; ++rr)
#pragma unroll
            for (int j = 0; j < 4; ++j) v[rr][j] = ((const f32x4*)(C.x + (size_t)(row0 + rr) * 1024) + lane)[64 * j];
#pragma unroll
        for (int rr = 0; rr < 4; ++rr) { const int row = row0 + rr; u32x2* o8 = (u32x2*)(C.XB + (size_t)row * 1024) + lane; float s = 0.f;
#pragma unroll
            for (int j = 0; j < 4; ++j) { const f32x4 x4 = v[rr][j]; s += (x4[0] * x4[0] + x4[1] * x4[1]) + (x4[2] * x4[2] + x4[3] * x4[3]); u32x2 w; w.x = pk2(x4[0], x4[1]); w.y = pk2(x4[2], x4[3]); o8[64 * j] = w; }
            s = wave_sum(s);
            if (lane < 16) C.part[(size_t)row * 16 + lane] = (lane == 0) ? s : 0.f; }
    }
}

__device__ __forceinline__ void phase_fixup_pool(const Ctx& C, LAS unsigned char* lds) {
    const int tid = threadIdx.x, lane = tid & 63, wid = __builtin_amdgcn_readfirstlane(tid >> 6);
    for (int tile = C.bid; tile < NTOK / 128; tile += C.G) {
        const int tok0 = tile * 128;
        for (int it = tid; it < 128 * 16; it += 512) {
            const int tl = it >> 4, slot = it & 15;
            const int tok = tok0 + tl;
            unsigned char* kv8 = (unsigned char*)C.ctl + WS_KV8 + (size_t)tok * 256;
            if (slot == 15) {
                const bf16_t* vp = C.P + (size_t)tok * NAB + PC_V;
#pragma unroll
                for (int q2 = 0; q2 < 8; ++q2) { const u32x2 a = bf8_to_fp8(*(const u32x4*)(vp + 16 * q2)), b = bf8_to_fp8(*(const u32x4*)(vp + 16 * q2 + 8)); *(u32x4*)(kv8 + 128 + 16 * q2) = (u32x4){a.x, a.y, b.x, b.y}; }
                continue; }
            const f32x4* rp = (const f32x4*)(C.rope + (size_t)tok * 16);
            const f32x4 c0 = rp[0], c1 = rp[1], s0 = rp[2], s1 = rp[3];
            const float cs[8] = {c0[0], c0[1], c0[2], c0[3], c1[0], c1[1], c1[2], c1[3]}, sn[8] = {s0[0], s0[1], s0[2], s0[3], s1[0], s1[1], s1[2], s1[3]};
            bf16_t* rowp = C.P + (size_t)tok * NAB;
            if (slot < 14) {
                const int col = (slot < 8) ? PC_Q + 64 * slot : (slot < 10) ? PC_K + 64 * (slot - 8) : PC_QI + 64 * (slot - 10);
                u32x4 w0 = *(u32x4*)(rowp + col), w1 = *(u32x4*)(rowp + col + 8);
                unsigned w[8] = {w0.x, w0.y, w0.z, w0.w, w1.x, w1.y, w1.z, w1.w};
#pragma unroll
                for (int i = 0; i < 8; ++i) { const float x1 = bf_lo(w[i]), x2 = bf_hi(w[i]); w[i] = pk2(x1 * cs[i] - x2 * sn[i], x2 * cs[i] + x1 * sn[i]); }
                *(u32x4*)(rowp + col) = (u32x4){w[0], w[1], w[2], w[3]}; *(u32x4*)(rowp + col + 8) = (u32x4){w[4], w[5], w[6], w[7]};
                if (slot == 8 || slot == 9) {
                    unsigned char* kd = kv8 + 64 * (slot - 8);
                    { const u32x2 a = bf8_to_fp8((u32x4){w[0], w[1], w[2], w[3]}), b = bf8_to_fp8((u32x4){w[4], w[5], w[6], w[7]}); *(u32x4*)kd = (u32x4){a.x, a.y, b.x, b.y}; }
#pragma unroll
                    for (int q2 = 1; q2 < 4; ++q2) { const u32x2 a = bf8_to_fp8(*(const u32x4*)(rowp + col + 16 * q2)), b = bf8_to_fp8(*(const u32x4*)(rowp + col + 16 * q2 + 8)); *(u32x4*)(kd + 16 * q2) = (u32x4){a.x, a.y, b.x, b.y}; } }
            } else {
                unsigned w[32];
#pragma unroll
                for (int q = 0; q < 8; ++q) { const u32x4 t = *(u32x4*)(rowp + PC_KI + 8 * q); w[4 * q] = t.x; w[4 * q + 1] = t.y; w[4 * q + 2] = t.z; w[4 * q + 3] = t.w; }
                float ss = 0.f;
#pragma unroll
                for (int i = 0; i < 32; ++i) { const float a = bf_lo(w[i]), b = bf_hi(w[i]); ss += a * a + b * b; }
                const float r = 1.0f / sqrtf(ss * (1.0f / 64.0f) + EPS);
#pragma unroll
                for (int i = 0; i < 32; ++i) {
                    const int d0 = (i < 8) ? i : 2 * i, d1 = (i < 8) ? i + 8 : 2 * i + 1;
                    float a = bf_lo(w[i]) * r * C.idx_k_norm[d0], b = bf_hi(w[i]) * r * C.idx_k_norm[d1];
                    if (i < 8) { const float x1 = a, x2 = b; a = x1 * cs[i] - x2 * sn[i]; b = x2 * cs[i] + x1 * sn[i]; }
                    w[i] = pk2(a, b); }
#pragma unroll
                for (int q = 0; q < 8; ++q) *(u32x4*)(rowp + PC_KI + 8 * q) = (u32x4){w[4 * q], w[4 * q + 1], w[4 * q + 2], w[4 * q + 3]};
            }
        }
        const int fr = lane & 15, fq = lane >> 4;
        const int tl0 = wid * 16 + fr, tok = tok0 + tl0, t = tok & (SEQ - 1);
        const bool hist = (tok0 & (SEQ - 1)) != 0;
        LAS unsigned char* ubuf = lds; LAS unsigned char* wbuf = lds + 39424;
        u32x4 ur[5], wv[4];
#define POOL_LOAD(gx) { _Pragma("unroll") for (int i = 0; i < 5; ++i) { int p = tid + 512 * i; p = p < 2288 ? p : 2287; const int r = p >> 4, pc = p & 15; const int trow = (r < 15 && !hist) ? tok0 : tok0 - 15 + r; \
            ur[i] = *(const u32x4*)(C.P + (size_t)trow * NAB + PC_U + (gx) * 128 + pc * 8); } \
        _Pragma("unroll") for (int i = 0; i < 4; ++i) wv[i] = *(const u32x4*)(C.W_pool + (gx) * 16384 + (tid + 512 * i) * 8); }
        POOL_LOAD(0)
#pragma unroll 1
        for (int g = 0; g < 4; ++g) {
            __syncthreads();
#pragma unroll
            for (int i = 0; i < 5; ++i) { const int p = tid + 512 * i; if (p < 2288) *(LAS u32x4*)(ubuf + (p >> 4) * 272 + (p & 15) * 16) = ur[i]; }
#pragma unroll
            for (int i = 0; i < 4; ++i) { const int p = tid + 512 * i, d = p >> 4; const int slot = (d & ~31) + 16 * ((d >> 2) & 1) + 4 * ((d >> 3) & 3) + (d & 3); *(LAS u32x4*)(wbuf + slot * 272 + (p & 15) * 16) = wv[i]; }
            __syncthreads();
            if (g < 3) POOL_LOAD(g + 1)
            const int win = 2 << g;
            const int cnt = (t + 1 < win) ? t + 1 : win; const float rc = 1.0f / (float)cnt;
            f32x4 acc[4][2];
#pragma unroll
            for (int a = 0; a < 4; ++a) { acc[a][0] = (f32x4){0.f, 0.f, 0.f, 0.f}; acc[a][1] = (f32x4){0.f, 0.f, 0.f, 0.f}; }
#pragma unroll
            for (int kk = 0; kk < 4; ++kk) {
                const LAS unsigned char* up = ubuf + (15 + tl0) * 272 + kk * 64 + fq * 16;
                float s[8], cur[8];
                { const u32x4 wx = *(const LAS u32x4*)up; cur[0] = bf_lo(wx.x); cur[1] = bf_hi(wx.x); cur[2] = bf_lo(wx.y); cur[3] = bf_hi(wx.y); cur[4] = bf_lo(wx.z); cur[5] = bf_hi(wx.z); cur[6] = bf_lo(wx.w); cur[7] = bf_hi(wx.w); }
#pragma unroll
                for (int i = 0; i < 8; ++i) s[i] = cur[i];
                for (int j = 1; j < win; ++j) {
                    const u32x4 wx = *(const LAS u32x4*)(up - j * 272); const float m = (j <= t) ? 1.0f : 0.0f;
                    s[0] += m * bf_lo(wx.x); s[1] += m * bf_hi(wx.x); s[2] += m * bf_lo(wx.y); s[3] += m * bf_hi(wx.y); s[4] += m * bf_lo(wx.z); s[5] += m * bf_hi(wx.z); s[6] += m * bf_lo(wx.w); s[7] += m * bf_hi(wx.w); }
                u32x4 af; af.x = pk2(s[0] * rc - cur[0], s[1] * rc - cur[1]); af.y = pk2(s[2] * rc - cur[2], s[3] * rc - cur[3]); af.z = pk2(s[4] * rc - cur[4], s[5] * rc - cur[5]); af.w = pk2(s[6] * rc - cur[6], s[7] * rc - cur[7]);
                const bf16x8 a = __builtin_bit_cast(bf16x8, af);
#pragma unroll
                for (int nn = 0; nn < 4; ++nn)
#pragma unroll
                    for (int n = 0; n < 2; ++n) {
                        const bf16x8 bfr = *(const LAS bf16x8*)(wbuf + (32 * nn + 16 * n + fr) * 272 + kk * 64 + fq * 16);
                        acc[nn][n] = __builtin_amdgcn_mfma_f32_16x16x32_bf16(bfr, a, acc[nn][n], 0, 0, 0); }
            }
#pragma unroll
            for (int nn = 0; nn < 4; ++nn) { u32x4 w; w.x = pk2(acc[nn][0][0], acc[nn][0][1]); w.y = pk2(acc[nn][0][2], acc[nn][0][3]); w.z = pk2(acc[nn][1][0], acc[nn][1][1]); w.w = pk2(acc[nn][1][2], acc[nn][1][3]);
                *(u32x4*)(C.Y + (size_t)tok * 1024 + g * 128 + 32 * nn + 8 * fq) = w; }
        }
#undef POOL_LOAD
    }
}

__device__ __forceinline__ unsigned fkey(float f) { const unsigned u = __float_as_uint(f); return u ^ ((unsigned)((int)u >> 31) | 0x80000000u); }

__device__ __forceinline__ void phase_attn_simple(const Ctx& C, LAS unsigned char* lds) {
    const int tid = threadIdx.x, lane = tid & 63, wid = tid >> 6;
    LAS unsigned* sc = (LAS unsigned*)lds;
    LAS float* qif = (LAS float*)(lds + 32768);
    LAS float* qf = (LAS float*)(lds + 32768 + 1024);
    LAS unsigned* hist = (LAS unsigned*)(lds + 32768 + 1024 + 2048);
    LAS unsigned* wsum = hist + 256;
    LAS unsigned* ctl = wsum + 16;
    LAS unsigned short* sel = (LAS unsigned short*)(ctl + 8);
    LAS float* pr = (LAS float*)(sel + 256);
    LAS float* red = pr + 2048;
    LAS float* red2 = red + 64;
    for (int qx = C.bid; qx < NTOK; qx += C.G) {
        const int tok = qx, b = tok >> 13, t = tok & (SEQ - 1), n = t + 1;
        const bf16_t* prow = C.P + (size_t)tok * NAB;
        const bf16_t* pb = C.P + (size_t)(b << 13) * NAB;
        __syncthreads();
        if (tid < 256) qif[tid] = bf2f(prow[PC_QI + tid]);
        qf[tid] = bf2f(prow[PC_Q + tid]);
        if (tid == 0) { ctl[0] = 0u; ctl[1] = TOPK; ctl[2] = 0u; }
        float wi[4];
#pragma unroll
        for (int h = 0; h < 4; ++h) wi[h] = bf2f(prow[PC_WI + h]) * 0.0625f;
        __syncthreads();
        for (int s = tid; s < n; s += 512) {
            asm volatile("" ::: "memory");
            const u32x4* kr = (const u32x4*)(pb + (size_t)s * NAB + PC_KI);
            float d0 = 0.f, d1 = 0.f, d2 = 0.f, d3 = 0.f;
#pragma unroll
            for (int q = 0; q < 8; ++q) { const u32x4 w = kr[q]; const float kv[8] = {bf_lo(w.x), bf_hi(w.x), bf_lo(w.y), bf_hi(w.y), bf_lo(w.z), bf_hi(w.z), bf_lo(w.w), bf_hi(w.w)};
#pragma unroll
                for (int j = 0; j < 8; ++j) { const int d = 8 * q + j; d0 += qif[d] * kv[j]; d1 += qif[64 + d] * kv[j]; d2 += qif[128 + d] * kv[j]; d3 += qif[192 + d] * kv[j]; } }
            float scv = 0.0f;
            scv = fmaf(wi[0], fmaxf(d0, 0.f), scv); scv = fmaf(wi[1], fmaxf(d1, 0.f), scv); scv = fmaf(wi[2], fmaxf(d2, 0.f), scv); scv = fmaf(wi[3], fmaxf(d3, 0.f), scv);
            sc[s] = fkey(scv);
        }
        __syncthreads();
        int nsel;
        if (n <= TOPK) { if (tid < n) sel[tid] = (unsigned short)tid; nsel = n; }
        else {
            nsel = TOPK;
            for (int pass = 0; pass < 4; ++pass) {
                const int shift = 24 - 8 * pass;
                if (tid < 256) hist[tid] = 0u;
                __syncthreads();
                const unsigned prefix = ctl[0]; const unsigned himask = (pass == 0) ? 0u : (0xffffffffu << (shift + 8));
                for (int s = tid; s < n; s += 512) { const unsigned k = sc[s]; if ((k & himask) == prefix) __hip_atomic_fetch_add(&hist[(k >> shift) & 255u], 1u, __ATOMIC_RELAXED, __HIP_MEMORY_SCOPE_WORKGROUP); }
                __syncthreads();
                if (wid == 0) {
                    const unsigned need = ctl[1];
                    const unsigned c0 = hist[255 - 4 * lane], c1 = hist[254 - 4 * lane], c2 = hist[253 - 4 * lane], c3 = hist[252 - 4 * lane];
                    const unsigned tot = c0 + c1 + c2 + c3; unsigned incl = tot;
#pragma unroll
                    for (int o = 1; o < 64; o <<= 1) { const unsigned v = __shfl_up(incl, o); if (lane >= o) incl += v; }
                    const unsigned excl = incl - tot;
                    if (excl < need && need <= incl) {
                        const unsigned r = need - excl; unsigned bin, above;
                        if (r <= c0) { bin = 255 - 4 * lane; above = excl; }
                        else if (r <= c0 + c1) { bin = 254 - 4 * lane; above = excl + c0; }
                        else if (r <= c0 + c1 + c2) { bin = 253 - 4 * lane; above = excl + c0 + c1; }
                        else { bin = 252 - 4 * lane; above = excl + c0 + c1 + c2; }
                        ctl[0] = prefix | (bin << shift); ctl[1] = need - above;
                    }
                }
                __syncthreads();
            }
            const unsigned T = ctl[0], mneed = ctl[1];
            unsigned ceq = 0;
#pragma unroll
            for (int j = 0; j < 16; ++j) { const int s = tid * 16 + j; if (s < n && sc[s] == T) ++ceq; }
            unsigned incl = ceq;
#pragma unroll
            for (int o = 1; o < 64; o <<= 1) { const unsigned v = __shfl_up(incl, o); if (lane >= o) incl += v; }
            if (lane == 63) wsum[wid] = incl;
            __syncthreads();
            unsigned base = 0;
            for (int w = 0; w < wid; ++w) base += wsum[w];
            unsigned rank = base + incl - ceq;
            for (int j = 0; j < 16; ++j) { const int s = tid * 16 + j;
                if (s < n) { const unsigned k = sc[s]; bool take = k > T; if (k == T) { take = rank < mneed; ++rank; }
                    if (take) { const unsigned slot = __hip_atomic_fetch_add(&ctl[2], 1u, __ATOMIC_RELAXED, __HIP_MEMORY_SCOPE_WORKGROUP); if (slot < TOPK) sel[slot] = (unsigned short)s; } } }
        }
        __syncthreads();
        {
            const int j = tid & 255, hh = tid >> 8;
            float sv[4] = {-INFINITY, -INFINITY, -INFINITY, -INFINITY};
            if (j < nsel) {
                const u32x4* kr = (const u32x4*)(pb + (size_t)sel[j] * NAB + PC_K + 64 * hh);
                float d[4] = {0.f, 0.f, 0.f, 0.f};
#pragma unroll
                for (int q = 0; q < 8; ++q) { const u32x4 w = kr[q]; const float kv[8] = {bf_lo(w.x), bf_hi(w.x), bf_lo(w.y), bf_hi(w.y), bf_lo(w.z), bf_hi(w.z), bf_lo(w.w), bf_hi(w.w)};
#pragma unroll
                    for (int e = 0; e < 8; ++e)
#pragma unroll
                        for (int r = 0; r < 4; ++r) d[r] += qf[(4 * hh + r) * 64 + 8 * q + e] * kv[e]; }
#pragma unroll
                for (int r = 0; r < 4; ++r) sv[r] = d[r] * 0.125f;
            }
#pragma unroll
            for (int r = 0; r < 4; ++r) { float m = sv[r];
#pragma unroll
                for (int o = 1; o < 64; o <<= 1) m = fmaxf(m, __shfl_xor(m, o));
                if (lane == 0) red[(4 * hh + r) * 8 + (wid & 3)] = m; }
            __syncthreads();
            float ev[4];
#pragma unroll
            for (int r = 0; r < 4; ++r) { const int h = 4 * hh + r; const float m = fmaxf(fmaxf(red[h * 8], red[h * 8 + 1]), fmaxf(red[h * 8 + 2], red[h * 8 + 3]));
                ev[r] = (j < nsel) ? __expf(sv[r] - m) : 0.f; float sm = ev[r];
#pragma unroll
                for (int o = 1; o < 64; o <<= 1) sm += __shfl_xor(sm, o);
                if (lane == 0) red2[h * 8 + (wid & 3)] = sm; }
            __syncthreads();
#pragma unroll
            for (int r = 0; r < 4; ++r) { const int h = 4 * hh + r; const float sm = (red2[h * 8] + red2[h * 8 + 1]) + (red2[h * 8 + 2] + red2[h * 8 + 3]);
                pr[h * 256 + j] = ev[r] / sm; }
        }
        __syncthreads();
        {
            const int h = tid >> 6, g = h >> 2; float o = 0.f;
            const bf16_t* vb = pb + PC_V + 64 * g + lane;
            for (int j = 0; j < nsel; ++j) o += pr[h * 256 + j] * bf2f(vb[(size_t)sel[j] * NAB]);
            C.Y[(size_t)tok * 1024 + 512 + tid] = (bf16_t)(pk2(o, 0.f) & 0xffffu);
        }
    }
}

__device__ __forceinline__ void phase_hgrn_simple(const Ctx& C) {
    const int tid = threadIdx.x, lane = tid & 63, wid = tid >> 6;
    for (int unit = C.bid; unit < BATCH * 8 * 8; unit += C.G) {
        const int b = unit >> 6, h = (unit >> 3) & 7, sl = unit & 7;
        const int e = sl * 16 + 2 * wid + (lane >> 5), dg = lane & 31;
        const size_t cq = (size_t)h * 128 + 4 * dg, cv = (size_t)h * 128 + e;
        float S0 = 0.f, S1 = 0.f, S2 = 0.f, S3 = 0.f;
        const size_t tok0 = (size_t)b * SEQ;
        for (int t0 = 0; t0 < SEQ; t0 += 8) {
            u32x2 qv[8], kv[8]; bf16_t vv[8];
#pragma unroll
            for (int u = 0; u < 8; ++u) { const size_t ro = (tok0 + t0 + u) * 1024; qv[u] = *(const u32x2*)(C.L1Q + ro + cq); kv[u] = *(const u32x2*)(C.L1K + ro + cq); vv[u] = C.L1I[ro + cv]; }
#pragma unroll
            for (int u = 0; u < 8; ++u) {
                const float k0 = bf_lo(kv[u].x), k1 = bf_hi(kv[u].x), k2 = bf_lo(kv[u].y), k3 = bf_hi(kv[u].y), v = bf2f(vv[u]);
                S0 = (1.0f - k0) * S0 + k0 * v; S1 = (1.0f - k1) * S1 + k1 * v; S2 = (1.0f - k2) * S2 + k2 * v; S3 = (1.0f - k3) * S3 + k3 * v;
                float o = (bf_lo(qv[u].x) * S0 + bf_hi(qv[u].x) * S1) + (bf_lo(qv[u].y) * S2 + bf_hi(qv[u].y) * S3);
#pragma unroll
                for (int off = 1; off < 32; off <<= 1) o += __shfl_xor(o, off);
                if (dg == 0) C.ORAW[(tok0 + t0 + u) * 1024 + cv] = (bf16_t)(pk2(o, 0.f) & 0xffffu);
            }
        }
    }
}
__device__ __forceinline__ void phase_hgrn_post(const Ctx& C) {
    const int tid = threadIdx.x, lane = tid & 63, wave = tid >> 6;
    const int gw = C.bid * 8 + wave, NGW = C.G * 8;
    for (int tok = gw; tok < NTOK; tok += NGW) {
        const size_t ro = (size_t)tok * 1024 + 16 * lane;
        const u32x4 a0 = *(const u32x4*)(C.ORAW + ro), a1 = *(const u32x4*)(C.ORAW + ro + 8), g0 = *(const u32x4*)(C.L1G + ro), g1 = *(const u32x4*)(C.L1G + ro + 8);
        const unsigned aw[8] = {a0.x, a0.y, a0.z, a0.w, a1.x, a1.y, a1.z, a1.w}, gwd[8] = {g0.x, g0.y, g0.z, g0.w, g1.x, g1.y, g1.z, g1.w};
        float ss = 0.f;
#pragma unroll
        for (int i = 0; i < 8; ++i) { const float x = bf_lo(aw[i]), y = bf_hi(aw[i]); ss += x * x + y * y; }
        ss += __shfl_xor(ss, 1); ss += __shfl_xor(ss, 2); ss += __shfl_xor(ss, 4);
        const float r = 1.0f / sqrtf(ss * (1.0f / 128.0f) + EPS);
        const float* nw = C.hgrn_out_norm + 16 * (lane & 7);
        unsigned ow[8];
#pragma unroll
        for (int i = 0; i < 8; ++i) ow[i] = pk2(bf_lo(aw[i]) * r * nw[2 * i] * bf_lo(gwd[i]), bf_hi(aw[i]) * r * nw[2 * i + 1] * bf_hi(gwd[i]));
        *(u32x4*)(C.Y + ro) = (u32x4){ow[0], ow[1], ow[2], ow[3]}; *(u32x4*)(C.Y + ro + 8) = (u32x4){ow[4], ow[5], ow[6], ow[7]};
    }
}
__device__ __forceinline__ void phase_final_norm(const Ctx& C) {
    const bool grp = C.G == 256;
    const int gt = grp ? (C.bid >> 3) * 512 + (int)threadIdx.x : C.bid * 512 + (int)threadIdx.x, NGT = grp ? 32 * 512 : C.G * 512, NEL = grp ? 4096 * 128 : NTOK * 128, rbase = grp ? 4096 * (C.bid & 7) : 0;
    for (int i = gt; i < NEL; i += NGT) { const int row = rbase + (i >> 7), c8 = (i & 127) * 8;
        const float r = pg8::row_rinv(C.part, row);
        const u32x4 b = *(const u32x4*)(C.XB + (size_t)row * 1024 + c8); const f32x4 g0 = *(const f32x4*)(C.ln_final + c8), g1 = *(const f32x4*)(C.ln_final + c8 + 4);
        f32x4 o0, o1; o0[0] = bf_lo(b.x) * r * g0[0]; o0[1] = bf_hi(b.x) * r * g0[1]; o0[2] = bf_lo(b.y) * r * g0[2]; o0[3] = bf_hi(b.y) * r * g0[3];
        o1[0] = bf_lo(b.z) * r * g1[0]; o1[1] = bf_hi(b.z) * r * g1[1]; o1[2] = bf_lo(b.w) * r * g1[2]; o1[3] = bf_hi(b.w) * r * g1[3];
        *(f32x4*)(C.out + (size_t)row * 1024 + c8) = o0; *(f32x4*)(C.out + (size_t)row * 1024 + c8 + 4) = o1; }
}

typedef float f32x16 __attribute__((ext_vector_type(16)));
typedef float f32x2 __attribute__((ext_vector_type(2)));
constexpr int AQ = 32;
constexpr int A_SEL = 131072;
constexpr int A_QS = A_SEL + AQ * 256 * 2;
constexpr int VROW = 144;

__device__ __forceinline__ float relu_f(float x) { const int b = __float_as_int(x); return __int_as_float(b > 0 ? b : 0); }
__device__ __forceinline__ void idx_tile16(const bf16x8 k0, const bf16x8 k1, const bf16x8 (&qb)[4][2], const float (&wq)[4], float (&sc)[4]) {
#pragma unroll
    for (int r = 0; r < 4; ++r) sc[r] = 0.0f;
#pragma unroll
    for (int h = 0; h < 4; ++h) { f32x4 a = (f32x4){0.f, 0.f, 0.f, 0.f};
        a = __builtin_amdgcn_mfma_f32_16x16x32_bf16(k0, qb[h][0], a, 0, 0, 0); a = __builtin_amdgcn_mfma_f32_16x16x32_bf16(k1, qb[h][1], a, 0, 0, 0);
#pragma unroll
        for (int r = 0; r < 4; ++r) sc[r] = fmaf(wq[h], relu_f(a[r]), sc[r]); }
}


__device__ __forceinline__ unsigned wave_incl_scan(unsigned v, int lane) {
    v += (unsigned)__builtin_amdgcn_update_dpp(0, (int)v, 0x111, 0xf, 0xf, false);
    v += (unsigned)__builtin_amdgcn_update_dpp(0, (int)v, 0x112, 0xf, 0xf, false);
    v += (unsigned)__builtin_amdgcn_update_dpp(0, (int)v, 0x114, 0xf, 0xf, false);
    v += (unsigned)__builtin_amdgcn_update_dpp(0, (int)v, 0x118, 0xf, 0xf, false);
    const unsigned r0 = (unsigned)__builtin_amdgcn_readlane((int)v, 15), r1 = (unsigned)__builtin_amdgcn_readlane((int)v, 31), r2 = (unsigned)__builtin_amdgcn_readlane((int)v, 47);
    const int row = lane >> 4;
    return v + (row >= 1 ? r0 : 0u) + (row >= 2 ? r1 : 0u) + (row >= 3 ? r2 : 0u);
}

__device__ __forceinline__ void phase_attn(const Ctx& C, LAS unsigned char* lds) {
    const int tid = threadIdx.x, lane0 = tid & 63, wid = __builtin_amdgcn_readfirstlane(tid >> 6);
    LAS unsigned* hist = (LAS unsigned*)lds;
    LAS unsigned short* sel = (LAS unsigned short*)(lds + A_SEL);
    LAS unsigned* tpool = (LAS unsigned*)(lds + 65536); constexpr int TCAP = 16384;
    LAS unsigned* dummy = (LAS unsigned*)(lds + A_QS + 1024) + tid;
    LAS unsigned* bmp = (LAS unsigned*)(lds + 32768);
    LAS int* q_bin = (LAS int*)(lds + A_QS); LAS int* q_need = q_bin + 32; LAS int* q_cnt = q_bin + 64; LAS int* q_off = q_bin + 96; LAS int* q_selc = q_bin + 128; LAS int* q_tiec = q_bin + 160;
    unsigned* pool = (unsigned*)((unsigned char*)C.ctl + (C.bid < 64 ? WS_XB + (size_t)C.bid * MiB : 296 * MiB + (size_t)(C.bid - 64) * MiB));
    const int nbw = C.G >> 2, ntile = SEQ / AQ, jb = C.bid >> 2;
    for (int ui = 0; ui * nbw < ntile; ++ui) {
        const int rank = ui * nbw + ((ui & 1) ? (nbw - 1 - jb) : jb);
        if (jb >= nbw || rank >= ntile) continue;
        const int tile = (ntile - 1) - rank, b = C.bid & 3, t0 = tile * AQ, tok0 = b * SEQ + t0;
        const bf16_t* pb = C.P + (size_t)(b * SEQ) * NAB;
        const unsigned char* kv8b = (const unsigned char*)C.ctl + WS_KV8 + (size_t)(b * SEQ) * 256;
        __syncthreads();
        int ln = lane0; asm volatile("" : "+v"(ln)); const int lane = ln;
        if (t0 < TOPK) {
            int tf = tid; asm volatile("" : "+v"(tf));
            for (int i = tf; i < AQ * 256; i += 512) { const int q = i >> 8, j = i & 255; sel[i] = (unsigned short)((j <= t0 + q) ? j : 0); }
        } else {
            for (int i = tid; i < AQ * 1024 / 4; i += 512) ((LAS u32x4*)hist)[i] = (u32x4){0u, 0u, 0u, 0u};
            const int qc = ln & 15, fq = ln >> 4;
            bf16x8 qb[2][4][2]; float wq[2][4];
#pragma unroll
            for (int hf = 0; hf < 2; ++hf) { const bf16_t* qrow = C.P + (size_t)(tok0 + 16 * hf + qc) * NAB;
#pragma unroll
              for (int h = 0; h < 4; ++h) { wq[hf][h] = bf2f(qrow[PC_WI + h]) * 0.0625f;
#pragma unroll
                  for (int ks = 0; ks < 2; ++ks) qb[hf][h][ks] = *(const bf16x8*)(qrow + PC_QI + h * 64 + ks * 32 + 8 * fq); } }
            const int kdiag0 = 2 * tile;
            const bf16_t* kbase = pb + (size_t)qc * NAB + PC_KI + 8 * fq;
            __syncthreads();
            bf16x8 kr[4][2]; const int kmaxt = kdiag0 + 1;
#define IDX_RING_LOAD(j, ktx) { const int ktc_ = ((ktx) <= kmaxt) ? (ktx) : kmaxt; const bf16_t* kp_ = kbase + (size_t)(ktc_ * 16) * NAB; kr[j][0] = *(const bf16x8*)kp_; kr[j][1] = *(const bf16x8*)(kp_ + 32); }
#pragma unroll
            for (int j = 0; j < 4; ++j) IDX_RING_LOAD(j, wid + 8 * j)
            for (int kt0 = wid; kt0 <= kmaxt; kt0 += 32) {
#pragma unroll
                for (int j = 0; j < 4; ++j) { const int kt = kt0 + 8 * j;
                    if (kt <= kmaxt) {
#pragma unroll
                        for (int hf = 0; hf < 2; ++hf) if (kt <= kdiag0 + hf) {
                            float sc[4]; idx_tile16(kr[j][0], kr[j][1], qb[hf], wq[hf], sc);
                            const int qn = 16 * hf + qc; LAS unsigned* hrow = hist + qn * 1024;
                            if (kt != kdiag0 + hf) {
#pragma unroll
                                for (int r = 0; r < 4; ++r) { const unsigned bin = fkey(sc[r]) >> 21;
                                    __hip_atomic_fetch_add(&hrow[(bin >> 1) ^ (unsigned)qn], (bin & 1u) ? 65536u : 1u, __ATOMIC_RELAXED, __HIP_MEMORY_SCOPE_WORKGROUP); }
                            } else {
#pragma unroll
                                for (int r = 0; r < 4; ++r) { const unsigned bin = fkey(sc[r]) >> 21;
                                    __hip_atomic_fetch_add(&hrow[(bin >> 1) ^ (unsigned)qn], (4 * fq + r <= qc) ? ((bin & 1u) ? 65536u : 1u) : 0u, __ATOMIC_RELAXED, __HIP_MEMORY_SCOPE_WORKGROUP); } } } }
                    IDX_RING_LOAD(j, kt + 32) }
            }
            __syncthreads();
#if defined(DBG_REPEAT) && DBG_REPEAT == 35
#pragma unroll 1
            for (int i8 = 0; i8 < 8; ++i8) { const int i = i8 & 3; const int q = 4 * wid + i;
#else
#pragma unroll 1
            for (int i = 0; i < 4; ++i) { const int q = 4 * wid + i;
#endif
                unsigned hw[16]; unsigned tot = 0;
#pragma unroll
                for (int j = 0; j < 16; ++j) { hw[j] = hist[q * 1024 + ((1023 - 16 * lane - j) ^ q)]; tot += (hw[j] & 0xffffu) + (hw[j] >> 16); }
                const unsigned incl = wave_incl_scan(tot, lane);
                const unsigned excl = incl - tot;
                if (excl < TOPK && TOPK <= incl) {
                    unsigned run = excl; int fbin = -1; unsigned fabove = 0, fcnt = 0;
#pragma unroll
                    for (int j = 0; j < 16; ++j) {
                        const unsigned chi = hw[j] >> 16, clo = hw[j] & 0xffffu; const int wbin = 2 * (1023 - 16 * lane - j);
                        if (fbin < 0 && run + chi >= TOPK) { fbin = wbin + 1; fabove = run; fcnt = chi; } run += chi;
                        if (fbin < 0 && run + clo >= TOPK) { fbin = wbin; fabove = run; fcnt = clo; } run += clo; }
                    q_bin[q] = fbin; q_need[q] = TOPK - (int)fabove; q_cnt[q] = (int)fcnt; q_selc[q] = 0; q_tiec[q] = 0;
                } }
            __syncthreads();
            for (int i = tid; i < AQ * 256 / 4; i += 512) ((LAS u32x4*)bmp)[i] = (u32x4){0u, 0u, 0u, 0u};
            if (tid < 32) { int tq = tid; asm volatile("" : "+v"(tq));
                int c = q_cnt[tq], incl = c;
#pragma unroll
                for (int o = 1; o < 32; o <<= 1) { const int v = __shfl_up(incl, o); if (tq >= o) incl += v; }
                q_off[tq] = incl - c; }
            __syncthreads();
            unsigned mybin[2]; int myoff[2];
#pragma unroll
            for (int hf = 0; hf < 2; ++hf) { mybin[hf] = (unsigned)q_bin[16 * hf + qc]; myoff[hf] = q_off[16 * hf + qc]; }
#if defined(DBG_REPEAT) && (DBG_REPEAT == 34 || DBG_REPEAT == 36)
#pragma unroll 1
            for (int rep34 = 0; rep34 < 2; ++rep34) {
            if (rep34 && DBG_REPEAT == 34) { __syncthreads(); if (tid < 32) q_tiec[tid] = 0; __syncthreads(); }
#endif
#pragma unroll
            for (int j = 0; j < 4; ++j) IDX_RING_LOAD(j, wid + 8 * j)
            for (int kt0 = wid; kt0 <= kmaxt; kt0 += 32) {
#pragma unroll
                for (int j = 0; j < 4; ++j) { const int kt = kt0 + 8 * j;
                    if (kt <= kmaxt) {
#pragma unroll
                for (int hf = 0; hf < 2; ++hf) if (kt <= kdiag0 + hf) {
                    float sc[4]; idx_tile16(kr[j][0], kr[j][1], qb[hf], wq[hf], sc);
                    const bool diag = kt == kdiag0 + hf; const int qn = 16 * hf + qc; const int s0 = kt * 16 + 4 * fq;
                    unsigned amask = 0u, ent[4]; int nt = 0; bool ist[4];
#pragma unroll
                    for (int r = 0; r < 4; ++r) { const unsigned key = fkey(sc[r]); const unsigned bin = key >> 21;
                        amask |= (bin > mybin[hf]) ? (1u << r) : 0u; ist[r] = bin == mybin[hf];
                        ent[r] = (((key >> 2) & 0x7ffffu) << 13) | (unsigned)(8191 - (s0 + r)); }
                    if (diag) {
#pragma unroll
                        for (int r = 0; r < 4; ++r) { const bool v = 4 * fq + r <= qc; amask &= v ? ~0u : ~(1u << r); ist[r] = ist[r] && v; } }
#pragma unroll
                    for (int r = 0; r < 4; ++r) nt += ist[r] ? 1 : 0;
                    __hip_atomic_fetch_or(&bmp[qn * 256 + (s0 >> 5)], amask << (s0 & 31), __ATOMIC_RELAXED, __HIP_MEMORY_SCOPE_WORKGROUP);
#if defined(DBG_REPEAT) && DBG_REPEAT == 36
                    int vi = myoff[hf]; if (rep34 == 0) vi += __hip_atomic_fetch_add(&q_tiec[qn], nt, __ATOMIC_RELAXED, __HIP_MEMORY_SCOPE_WORKGROUP);
                    if (rep34) { for (int r = 0; r < 4; ++r) ist[r] = false; nt = 0; }
#else
                    int vi = myoff[hf] + __hip_atomic_fetch_add(&q_tiec[qn], nt, __ATOMIC_RELAXED, __HIP_MEMORY_SCOPE_WORKGROUP);
#endif
                    if (__ballot(nt > 0 && vi + nt > TCAP) == 0ull) {
#pragma unroll
                        for (int r = 0; r < 4; ++r) { LAS unsigned* dst = ist[r] ? (tpool + vi) : dummy; *dst = ent[r]; vi += ist[r] ? 1 : 0; }
                    } else {
#pragma unroll
                        for (int r = 0; r < 4; ++r) if (ist[r]) { if (vi < TCAP) tpool[vi] = ent[r]; else pool[vi] = ent[r]; ++vi; } } }
                    }
                    IDX_RING_LOAD(j, kt + 32) }
            }
#if defined(DBG_REPEAT) && (DBG_REPEAT == 34 || DBG_REPEAT == 36)
            }
#endif
#undef IDX_RING_LOAD
            __syncthreads();
#if defined(DBG_REPEAT) && DBG_REPEAT == 33
#pragma unroll 1
            for (int rep33 = 0; rep33 < 2; ++rep33)
#endif
            {
                int cq[4], offq[4], Rq[4]; unsigned needq[4], thrq[4], actq[4], validq[4]; constexpr int NR = 10; unsigned ev[4][NR]; bool slowq[4];
#pragma unroll
                for (int i = 0; i < 4; ++i) { const int q = 4 * wid + i; cq[i] = q_cnt[q]; offq[i] = q_off[q]; const int m = q_need[q];
                    needq[i] = (unsigned)(m < cq[i] ? m : cq[i]);
                    slowq[i] = cq[i] > 64 * NR; Rq[i] = slowq[i] ? 0 : (cq[i] + 63) >> 6; thrq[i] = 0u; actq[i] = 0u; }
#pragma unroll
                for (int i = 0; i < 4; ++i)
#pragma unroll
                    for (int r = 0; r < NR; ++r) { const int e = lane + 64 * r; const bool in = e < cq[i] && !slowq[i]; const int vi = offq[i] + (e < cq[i] ? e : cq[i] - 1); const unsigned v = (vi < TCAP) ? tpool[vi] : pool[vi]; ev[i][r] = in ? v : 0u; actq[i] |= in ? (1u << r) : 0u; }
#pragma unroll
                for (int i = 0; i < 4; ++i) validq[i] = actq[i];
                const int Rmax = max(max(Rq[0], Rq[1]), max(Rq[2], Rq[3]));
#pragma unroll 1
                for (int p = 3; p >= 0; --p) { const int shift = 8 * p;
#pragma unroll
                    for (int i = 0; i < 4; ++i) *(LAS u32x4*)(lds + (wid * 4 + i) * 1024 + 16 * lane) = (u32x4){0u, 0u, 0u, 0u};
#pragma unroll
                    for (int r = 0; r < NR; ++r) if (r < Rmax) {
#pragma unroll
                        for (int i = 0; i < 4; ++i) { LAS unsigned* wh = (LAS unsigned*)(lds + (wid * 4 + i) * 1024); if ((actq[i] >> r) & 1u) __hip_atomic_fetch_add(&wh[(ev[i][r] >> shift) & 255u], 1u, __ATOMIC_RELAXED, __HIP_MEMORY_SCOPE_WORKGROUP); } }
                    u32x4 hv[4]; unsigned tot[4], incl[4];
#pragma unroll
                    for (int i = 0; i < 4; ++i) { hv[i] = *(const LAS u32x4*)(lds + (wid * 4 + i) * 1024 + 16 * (63 - lane)); tot[i] = (hv[i].x + hv[i].y) + (hv[i].z + hv[i].w); }
#pragma unroll
                    for (int i = 0; i < 4; ++i) incl[i] = wave_incl_scan(tot[i], lane);
#pragma unroll
                    for (int i = 0; i < 4; ++i) { const unsigned excl = incl[i] - tot[i], need = needq[i]; const bool cross = excl < need && need <= incl[i];
                        unsigned dig = 252u - 4u * (unsigned)lane, ab = excl + hv[i].w + hv[i].z + hv[i].y;
                        if (excl + hv[i].w >= need) { dig += 3u; ab = excl; } else if (excl + hv[i].w + hv[i].z >= need) { dig += 2u; ab = excl + hv[i].w; } else if (excl + hv[i].w + hv[i].z + hv[i].y >= need) { dig += 1u; ab = excl + hv[i].w + hv[i].z; }
                        const unsigned long long bm = __ballot(cross);
                        if (bm) { const int src = __ffsll(bm) - 1; dig = (unsigned)__shfl((int)dig, src); ab = (unsigned)__shfl((int)ab, src);
                            thrq[i] |= dig << shift; needq[i] = need - ab;
                            unsigned keep = 0u;
#pragma unroll
                            for (int r = 0; r < NR; ++r) keep |= (((ev[i][r] >> shift) & 255u) == dig) ? (1u << r) : 0u;
                            actq[i] &= keep; } }
                }
#pragma unroll
                for (int i = 0; i < 4; ++i) { LAS unsigned* bq = bmp + (4 * wid + i) * 256;
#pragma unroll
                    for (int r = 0; r < NR; ++r) if (r < Rmax) { if (((validq[i] >> r) & 1u) && ev[i][r] >= thrq[i]) { const unsigned ix = 8191u - (ev[i][r] & 8191u); __hip_atomic_fetch_or(&bq[ix >> 5], 1u << (ix & 31u), __ATOMIC_RELAXED, __HIP_MEMORY_SCOPE_WORKGROUP); } } }
#pragma unroll 1
                for (int i = 0; i < 4; ++i) if (slowq[i]) { const int c = cq[i], off = offq[i]; LAS unsigned* bq = bmp + (4 * wid + i) * 256;
                    unsigned need = needq[i], thr = 0u;
#pragma unroll 1
                    for (int bit = 31; bit >= 0; --bit) { unsigned cnt1 = 0; const unsigned hm = (bit == 31) ? 0u : (0xffffffffu << (bit + 1));
                        for (int e = lane; e < c; e += 64) { const int vi = off + e; const unsigned v = (vi < TCAP) ? tpool[vi] : pool[vi]; if ((v & hm) == thr && ((v >> bit) & 1u)) ++cnt1; }
#pragma unroll
                        for (int o = 1; o < 64; o <<= 1) cnt1 += __shfl_xor(cnt1, o);
                        if (cnt1 >= need) thr |= 1u << bit; else need -= cnt1; }
                    for (int e = lane; e < c; e += 64) { const int vi = off + e; const unsigned v = (vi < TCAP) ? tpool[vi] : pool[vi]; if (v >= thr) { const unsigned ix = 8191u - (v & 8191u); __hip_atomic_fetch_or(&bq[ix >> 5], 1u << (ix & 31u), __ATOMIC_RELAXED, __HIP_MEMORY_SCOPE_WORKGROUP); } } }
                u32x4 bw[4]; unsigned cntb[4], inb[4];
#pragma unroll
                for (int i = 0; i < 4; ++i) { bw[i] = *(const LAS u32x4*)(bmp + (4 * wid + i) * 256 + 4 * lane); cntb[i] = (unsigned)((__popc(bw[i].x) + __popc(bw[i].y)) + (__popc(bw[i].z) + __popc(bw[i].w))); }
#pragma unroll
                for (int i = 0; i < 4; ++i) inb[i] = wave_incl_scan(cntb[i], lane);
#pragma unroll
                for (int i = 0; i < 4; ++i) { LAS unsigned short* sq = sel + (4 * wid + i) * 256; int pos = (int)(inb[i] - cntb[i]); const unsigned w4[4] = {bw[i].x, bw[i].y, bw[i].z, bw[i].w};
#pragma unroll
                    for (int wi = 0; wi < 4; ++wi) { unsigned w = w4[wi]; while (w) { const int bp = __ffs((int)w) - 1; if (pos < 256) sq[pos] = (unsigned short)((4 * lane + wi) * 32 + bp); ++pos; w &= w - 1u; } } }
            }
        }
        __syncthreads();
#ifndef A_EXP2
        LAS unsigned char* pbuf = lds + wid * 16384;
        LAS unsigned char* vbuf = pbuf + 4096;
        int ln2 = lane0; asm volatile("" : "+v"(ln2));
        const int hh = ln2 & 15, fq = ln2 >> 4;
        typedef int i32x2 __attribute__((ext_vector_type(2)));
        const unsigned char* kgb = kv8b + (ln2 & 7) * 16;
        LAS unsigned char* kstw = vbuf + (ln2 >> 3) * 144 + (ln2 & 7) * 16; const LAS unsigned char* kstr = vbuf + hh * 144 + 8 * fq;
        const unsigned char* vgb = kv8b + 128 + (ln2 & 3) * 16;
#define ATT_LOADK(kk, sqx, b4) { _Pragma("unroll") for (int i8 = 0; i8 < 8; ++i8) { const int kidx = (sqx)[64 * (b4) + 8 * i8 + (ln2 >> 3)]; kk[i8] = *(const u32x4*)(kgb + (size_t)kidx * 256); } }
#define ATT_MMAK(kk, b4) { _Pragma("unroll") for (int i8 = 0; i8 < 8; ++i8) *(LAS u32x4*)(kstw + i8 * (8 * 144)) = kk[i8]; \
    _Pragma("unroll") for (int j4 = 0; j4 < 4; ++j4) { f32x4 a = (f32x4){0.f, 0.f, 0.f, 0.f}; _Pragma("unroll") for (int k4 = 0; k4 < 4; ++k4) a = __builtin_amdgcn_mfma_f32_16x16x32_fp8_fp8(*(const LAS long*)(kstr + j4 * (16 * 144) + 32 * k4), qf[k4], a, 0, 0, 0); S[4 * (b4) + j4] = a; } }
#define ATT_LOADV(slot, sqx, chx) { _Pragma("unroll") for (int p2 = 0; p2 < 2; ++p2) { const unsigned char* vp = vgb + (size_t)(sqx)[32 * (chx) + (ln2 >> 2) + 16 * p2] * 256; vr[slot][0][p2] = *(const u32x4*)vp; vr[slot][1][p2] = *(const u32x4*)(vp + 64); } }
#define ATT_LOADQ(tokx) { _Pragma("unroll") for (int kk = 0; kk < 4; ++kk) { u32x4 w = (u32x4){0u, 0u, 0u, 0u}; if (hh < 8 && (hh >> 2) == (kk >> 1)) w = *(const u32x4*)(C.P + (size_t)(tokx) * NAB + PC_Q + hh * 64 + (kk & 1) * 32 + 8 * fq); qraw[kk] = w; } }
#if defined(DBG_REPEAT) && DBG_REPEAT == 31
#pragma unroll 1
        for (int rep31 = 0; rep31 < 2; ++rep31)
#endif
        {
        u32x4 kA[8], kB[8]; u32x4 qraw[4]; u32x4 vr[3][2][2];
        { const LAS unsigned short* sq0 = sel + (4 * wid) * 256; ATT_LOADQ(tok0 + 4 * wid) ATT_LOADK(kA, sq0, 0) ATT_LOADK(kB, sq0, 1) }
#pragma unroll 1
        for (int iq = 0; iq < 4; ++iq) {
            const int q = 4 * wid + iq, tok = tok0 + q, t = t0 + q, nsel = (t + 1 < TOPK) ? t + 1 : TOPK;
            const LAS unsigned short* sq = sel + q * 256;
            {
                long qf[4];
#pragma unroll
                for (int kk = 0; kk < 4; ++kk) { const u32x2 f8 = bf8_to_fp8(qraw[kk]); qf[kk] = (long)(((unsigned long long)f8.y << 32) | f8.x); }
                f32x4 S[16];
                ATT_MMAK(kA, 0) ATT_LOADK(kA, sq, 2)
                ATT_MMAK(kB, 1) ATT_LOADK(kB, sq, 3)
                ATT_MMAK(kA, 2) ATT_MMAK(kB, 3)
                ATT_LOADV(0, sq, 0) ATT_LOADV(1, sq, 1) ATT_LOADV(2, sq, 2)
                float mx = -INFINITY;
                if (nsel < TOPK) {
                    const int nrel = nsel - 4 * fq;
#pragma unroll
                    for (int tl = 0; tl < 16; ++tl)
#pragma unroll
                        for (int r = 0; r < 4; ++r) S[tl][r] = ((16 * tl + r) < nrel) ? S[tl][r] : -INFINITY; }
#pragma unroll
                for (int tl = 0; tl < 16; ++tl)
#pragma unroll
                    for (int r = 0; r < 4; ++r) mx = fmaxf(mx, S[tl][r]);
                mx = fmaxf(mx, __shfl_xor(mx, 16)); mx = fmaxf(mx, __shfl_xor(mx, 32));
                const float cexp = 0.125f * 1.44269504088896f, moff = -mx * cexp;
                float sm = 0.f;
#pragma unroll
                for (int tl = 0; tl < 16; ++tl)
#pragma unroll
                    for (int r = 0; r < 4; ++r) { const float e = __builtin_amdgcn_exp2f(fmaf(S[tl][r], cexp, moff)); S[tl][r] = e; sm += e; }
                sm += __shfl_xor(sm, 16); sm += __shfl_xor(sm, 32);
                const float inv = 1.0f / sm;
#pragma unroll
                for (int ch = 0; ch < 8; ++ch) { u32x2 w; w.x = pk4_fp8(S[2 * ch][0] * inv, S[2 * ch][1] * inv, S[2 * ch][2] * inv, S[2 * ch][3] * inv);
                    w.y = pk4_fp8(S[2 * ch + 1][0] * inv, S[2 * ch + 1][1] * inv, S[2 * ch + 1][2] * inv, S[2 * ch + 1][3] * inv); *(LAS u32x2*)(pbuf + ch * 512 + lane * 8) = w; }
            }
            if (iq < 3) { const LAS unsigned short* sqn = sq + 256; ATT_LOADK(kA, sqn, 0) ATT_LOADK(kB, sqn, 1) }
            f32x4 O[2][4];
#pragma unroll
            for (int g = 0; g < 2; ++g)
#pragma unroll
                for (int dt = 0; dt < 4; ++dt) O[g][dt] = (f32x4){0.f, 0.f, 0.f, 0.f};
            const int tq8 = hh >> 1, tp8 = hh & 1;
            const LAS unsigned char* vtr = vbuf + ((tq8 < 4) ? (4 * fq + tq8) : (16 + 4 * fq + tq8 - 4)) * 80 + tp8 * 8;
#pragma unroll
            for (int ch = 0; ch < 8; ++ch) {
                const long pf = *(const LAS long*)(pbuf + ch * 512 + lane * 8);
#pragma unroll
                for (int g = 0; g < 2; ++g) {
#pragma unroll
                    for (int p2 = 0; p2 < 2; ++p2) *(LAS u32x4*)(vbuf + ((ln2 >> 2) + 16 * p2) * 80 + (ln2 & 3) * 16) = vr[ch % 3][g][p2];
#pragma unroll
                    for (int dt = 0; dt < 4; ++dt) {
                        const i32x2 t8 = __builtin_amdgcn_ds_read_tr8_b64_v2i32((LAS i32x2*)(vtr + dt * 16));
                        const long vb = (long)(((unsigned long long)(unsigned)t8[1] << 32) | (unsigned)t8[0]);
                        O[g][dt] = __builtin_amdgcn_mfma_f32_16x16x32_fp8_fp8(pf, vb, O[g][dt], 0, 0, 0); }
                }
                if (ch + 3 < 8) ATT_LOADV(ch % 3, sq, ch + 3)
                if (ch == 5 && iq < 3) ATT_LOADQ(tok + 1)
            }
            if (fq < 2) {
#pragma unroll
                for (int dt = 0; dt < 4; ++dt)
#pragma unroll
                    for (int r = 0; r < 4; ++r) { const float ov = (fq == 0) ? O[0][dt][r] : O[1][dt][r];
                        *(LAS bf16_t*)(pbuf + ((4 * fq + r) * 64 + dt * 16 + hh) * 2) = (bf16_t)(pk2(ov, 0.f) & 0xffffu); }
            }
            asm volatile("" ::: "memory");
            { const u32x4 ow = *(const LAS u32x4*)(pbuf + ln2 * 16); *(u32x4*)(C.Y + (size_t)tok * 1024 + 512 + ln2 * 8) = ow; }
        }
        }
#undef ATT_LOADK
#undef ATT_MMAK
#undef ATT_LOADV
#undef ATT_LOADQ
#endif
    }
}


constexpr int H_QE = 0, H_KD = 17408, H_KET = 34816, H_VT = 53248, H_AL = 71680, H_ST = 80896, H_QTOT = 115712, H_BL = 117760, H_SSQ = 118272;
constexpr int PQ = 272, PT = 144;
constexpr size_t WS_HU = 440 * MiB, WS_HLB = 460 * MiB;

__device__ __forceinline__ bf16x8 ldsfrag(const LAS unsigned char* p) { return *(const LAS bf16x8*)p; }

constexpr int H_VRAW = 118784;
__device__ __forceinline__ int hgrn_item_of(int c, int G) {
    if (G != 256) return c;
    const int x = c & 7, j = c >> 3; const int b = x >> 1, seg = 4 * (x & 1) + (j >> 3), h = j & 7;
    return (b << 6) | (h << 3) | seg;
}
template <bool WITH_Q>
__device__ __forceinline__ void hgrn_load(const Ctx& C, size_t tokc, int h, int tid, u32x4 (&kr)[2], u32x4 (&vr)[2], u32x4 (&qr)[2]) {
#pragma unroll
    for (int j = 0; j < 2; ++j) { const int p = tid + 512 * j; const size_t off = (tokc + (size_t)(p >> 4)) * 1024 + (size_t)h * 128 + (p & 15) * 8;
        kr[j] = *(const u32x4*)(C.L1K + off); vr[j] = *(const u32x4*)(C.L1I + off); if (WITH_Q) qr[j] = *(const u32x4*)(C.L1Q + off); }
}
template <bool WITH_Q>
__device__ __forceinline__ float hgrn_stage(LAS unsigned char* lds, int tid, const u32x4 (&kr)[2], const u32x4 (&vr)[2], const u32x4 (&qr)[2]) {
    const int d = tid & 127, tq = tid >> 7;
#pragma unroll
    for (int j = 0; j < 2; ++j) { const int p = tid + 512 * j; const int ro = (p >> 4) * PQ + (p & 15) * 16;
        *(LAS u32x4*)(lds + H_KD + ro) = kr[j]; *(LAS u32x4*)(lds + H_VRAW + ro) = vr[j]; if (WITH_Q) *(LAS u32x4*)(lds + H_QE + ro) = qr[j]; }
    __syncthreads();
    float kf[16], vf[16], c[16];
#pragma unroll
    for (int i = 0; i < 16; ++i) { kf[i] = bf2f(*(const LAS bf16_t*)(lds + H_KD + (tq * 16 + i) * PQ + d * 2)); vf[i] = bf2f(*(const LAS bf16_t*)(lds + H_VRAW + (tq * 16 + i) * PQ + d * 2)); }
    float run = 0.f;
#pragma unroll
    for (int i = 0; i < 16; ++i) { run += __logf(1.0f - kf[i]); c[i] = run; }
    LAS float* qtot = (LAS float*)(lds + H_QTOT);
    qtot[tq * 128 + d] = run;
    { u32x4 w0, w1; w0.x = pk2(vf[0], vf[1]); w0.y = pk2(vf[2], vf[3]); w0.z = pk2(vf[4], vf[5]); w0.w = pk2(vf[6], vf[7]); w1.x = pk2(vf[8], vf[9]); w1.y = pk2(vf[10], vf[11]); w1.z = pk2(vf[12], vf[13]); w1.w = pk2(vf[14], vf[15]);
      *(LAS u32x4*)(lds + H_VT + d * PT + tq * 32) = w0; *(LAS u32x4*)(lds + H_VT + d * PT + tq * 32 + 16) = w1; }
    __syncthreads();
    float pre = 0.f, tot = 0.f;
#pragma unroll
    for (int q4 = 0; q4 < 4; ++q4) { const float x = qtot[q4 * 128 + d]; if (q4 < tq) pre += x; tot += x; }
    if (tq == 0) ((LAS float*)(lds + H_BL))[d] = tot;
    { float ke[16];
#pragma unroll
      for (int i = 0; i < 16; ++i) ke[i] = kf[i] * __expf(tot - (pre + c[i]));
      u32x4 w0, w1; w0.x = pk2(ke[0], ke[1]); w0.y = pk2(ke[2], ke[3]); w0.z = pk2(ke[4], ke[5]); w0.w = pk2(ke[6], ke[7]); w1.x = pk2(ke[8], ke[9]); w1.y = pk2(ke[10], ke[11]); w1.z = pk2(ke[12], ke[13]); w1.w = pk2(ke[14], ke[15]);
      *(LAS u32x4*)(lds + H_KET + d * PT + tq * 32) = w0; *(LAS u32x4*)(lds + H_KET + d * PT + tq * 32 + 16) = w1; }
    if (WITH_Q) {
#pragma unroll
        for (int i = 0; i < 16; ++i) { const float b = pre + c[i]; const float qv = bf2f(*(const LAS bf16_t*)(lds + H_QE + (tq * 16 + i) * PQ + d * 2));
            *(LAS bf16_t*)(lds + H_QE + (tq * 16 + i) * PQ + d * 2) = (bf16_t)(pk2(qv * __expf(b), 0.f) & 0xffffu);
            *(LAS bf16_t*)(lds + H_KD + (tq * 16 + i) * PQ + d * 2) = (bf16_t)(pk2(kf[i] * __expf(-b), 0.f) & 0xffffu); }
    }
    return tot;
}
__device__ __forceinline__ void hgrn_state_update(LAS unsigned char* lds, f32x4 (&S)[8], int wid, int l15, int fq) {
    const LAS float* bl = (const LAS float*)(lds + H_BL);
    float dec[4];
#pragma unroll
    for (int r = 0; r < 4; ++r) dec[r] = __expf(bl[16 * wid + 4 * fq + r]);
    const bf16x8 ka0 = ldsfrag(lds + H_KET + (16 * wid + l15) * PT + 16 * fq), ka1 = ldsfrag(lds + H_KET + (16 * wid + l15) * PT + 64 + 16 * fq);
#pragma unroll
    for (int et = 0; et < 8; ++et) {
#pragma unroll
        for (int r = 0; r < 4; ++r) S[et][r] *= dec[r];
        S[et] = __builtin_amdgcn_mfma_f32_16x16x32_bf16(ka0, ldsfrag(lds + H_VT + (et * 16 + l15) * PT + 16 * fq), S[et], 0, 0, 0);
        S[et] = __builtin_amdgcn_mfma_f32_16x16x32_bf16(ka1, ldsfrag(lds + H_VT + (et * 16 + l15) * PT + 64 + 16 * fq), S[et], 0, 0, 0); }
}

__device__ __forceinline__ void phase_hgrn_local(const Ctx& C, LAS unsigned char* lds) {
    const int tid = threadIdx.x, lane = tid & 63, wid = __builtin_amdgcn_readfirstlane(tid >> 6), l15 = lane & 15, fq = lane >> 4;
    float* Ug = (float*)((unsigned char*)C.ctl + WS_HU); float* LBg = (float*)((unsigned char*)C.ctl + WS_HLB);
    for (int it0 = C.bid; it0 < 256; it0 += C.G) {
        const int item = hgrn_item_of(it0, C.G); const int seg = item & 7, h = (item >> 3) & 7, b = item >> 6;
        if (seg == 7) continue;
        f32x4 S[8];
#pragma unroll
        for (int et = 0; et < 8; ++et) S[et] = (f32x4){0.f, 0.f, 0.f, 0.f};
        float lbacc = 0.f;
        u32x4 kr[2], vr[2], qr[2];
        hgrn_load<false>(C, (size_t)b * SEQ + (size_t)seg * 1024, h, tid, kr, vr, qr);
#pragma unroll 1
        for (int ch = 0; ch < 16; ++ch) {
            const size_t tokc = (size_t)b * SEQ + (size_t)seg * 1024 + (size_t)ch * 64;
            __syncthreads();
            lbacc += hgrn_stage<false>(lds, tid, kr, vr, qr);
            if (ch < 15) hgrn_load<false>(C, tokc + 64, h, tid, kr, vr, qr);
            __syncthreads();
            hgrn_state_update(lds, S, wid, l15, fq);
        }
#pragma unroll
        for (int et = 0; et < 8; ++et) *(f32x4*)(Ug + ((size_t)(item * 8 + wid) * 8 + et) * 256 + lane * 4) = S[et];
        if (tid < 128) LBg[item * 128 + tid] = lbacc;
    }
}

__device__ __forceinline__ void phase_hgrn_chunks(const Ctx& C, LAS unsigned char* lds) {
    const int tid = threadIdx.x, lane = tid & 63, wid = __builtin_amdgcn_readfirstlane(tid >> 6), l15 = lane & 15, fq = lane >> 4;
    const float* Ug = (const float*)((unsigned char*)C.ctl + WS_HU); const float* LBg = (const float*)((unsigned char*)C.ctl + WS_HLB);
    LAS float* ssq = (LAS float*)(lds + H_SSQ);
    for (int it0 = C.bid; it0 < 256; it0 += C.G) {
        const int item = hgrn_item_of(it0, C.G); const int seg = item & 7, h = (item >> 3) & 7, b = item >> 6;
        f32x4 S[8];
#pragma unroll
        for (int et = 0; et < 8; ++et) S[et] = (f32x4){0.f, 0.f, 0.f, 0.f};
#pragma unroll 1
        for (int j = 0; j < seg; ++j) { const int it = item - seg + j; float dec[4];
#pragma unroll
            for (int r = 0; r < 4; ++r) dec[r] = __expf(LBg[it * 128 + 16 * wid + 4 * fq + r]);
#pragma unroll
            for (int et = 0; et < 8; ++et) { const f32x4 u = *(const f32x4*)(Ug + ((size_t)(it * 8 + wid) * 8 + et) * 256 + lane * 4);
#pragma unroll
                for (int r = 0; r < 4; ++r) S[et][r] = S[et][r] * dec[r] + u[r]; } }
        __syncthreads();
        u32x4 kr[2], vr[2], qr[2];
        hgrn_load<true>(C, (size_t)b * SEQ + (size_t)seg * 1024, h, tid, kr, vr, qr);
#pragma unroll 1
        for (int ch = 0; ch < 16; ++ch) {
            const size_t tokc = (size_t)b * SEQ + (size_t)seg * 1024 + (size_t)ch * 64;
#pragma unroll
            for (int et = 0; et < 8; ++et) { u32x2 w; w.x = pk2(S[et][0], S[et][1]); w.y = pk2(S[et][2], S[et][3]); *(LAS u32x2*)(lds + H_ST + (et * 16 + l15) * PQ + (16 * wid + 4 * fq) * 2) = w; }
            (void)hgrn_stage<true>(lds, tid, kr, vr, qr);
            if (ch < 15) hgrn_load<true>(C, tokc + 64, h, tid, kr, vr, qr);
            u32x2 gw[4];
            { const size_t ro = (tokc + (wid & 3) * 16 + l15) * 1024 + (size_t)h * 128;
#pragma unroll
              for (int j = 0; j < 4; ++j) gw[j] = *(const u32x2*)(C.L1G + ro + (4 * (wid >> 2) + j) * 16 + 4 * fq); }
            __syncthreads();
            { const int ti = wid >> 1;
#pragma unroll
              for (int u = 0; u < 2; ++u) { const int si = 2 * (wid & 1) + u; u32x2 w = (u32x2){0u, 0u};
                  if (si <= ti) { f32x4 a = (f32x4){0.f, 0.f, 0.f, 0.f};
#pragma unroll
                      for (int kk = 0; kk < 4; ++kk) a = __builtin_amdgcn_mfma_f32_16x16x32_bf16(ldsfrag(lds + H_KD + (si * 16 + l15) * PQ + kk * 64 + 16 * fq), ldsfrag(lds + H_QE + (ti * 16 + l15) * PQ + kk * 64 + 16 * fq), a, 0, 0, 0);
                      if (si == ti) {
#pragma unroll
                          for (int r = 0; r < 4; ++r) if (4 * fq + r > l15) a[r] = 0.f; }
                      w.x = pk2(a[0], a[1]); w.y = pk2(a[2], a[3]); }
                  *(LAS u32x2*)(lds + H_AL + (ti * 16 + l15) * PT + (si * 16 + 4 * fq) * 2) = w; } }
            hgrn_state_update(lds, S, wid, l15, fq);
            __syncthreads();
            const int ti = wid & 3, eh = wid >> 2;
            f32x4 o[4];
            { const bf16x8 ab0 = ldsfrag(lds + H_AL + (ti * 16 + l15) * PT + 16 * fq), ab1 = ldsfrag(lds + H_AL + (ti * 16 + l15) * PT + 64 + 16 * fq);
              bf16x8 qb[4];
#pragma unroll
              for (int kk = 0; kk < 4; ++kk) qb[kk] = ldsfrag(lds + H_QE + (ti * 16 + l15) * PQ + kk * 64 + 16 * fq);
#pragma unroll
              for (int j = 0; j < 4; ++j) { const int et = 4 * eh + j; f32x4 a = (f32x4){0.f, 0.f, 0.f, 0.f};
                  a = __builtin_amdgcn_mfma_f32_16x16x32_bf16(ldsfrag(lds + H_VT + (et * 16 + l15) * PT + 16 * fq), ab0, a, 0, 0, 0);
                  a = __builtin_amdgcn_mfma_f32_16x16x32_bf16(ldsfrag(lds + H_VT + (et * 16 + l15) * PT + 64 + 16 * fq), ab1, a, 0, 0, 0);
#pragma unroll
                  for (int kk = 0; kk < 4; ++kk) a = __builtin_amdgcn_mfma_f32_16x16x32_bf16(ldsfrag(lds + H_ST + (et * 16 + l15) * PQ + kk * 64 + 16 * fq), qb[kk], a, 0, 0, 0);
                  o[j] = a; } }
            float sq = 0.f;
#pragma unroll
            for (int j = 0; j < 4; ++j) sq += (o[j][0] * o[j][0] + o[j][1] * o[j][1]) + (o[j][2] * o[j][2] + o[j][3] * o[j][3]);
            sq += __shfl_xor(sq, 16); sq += __shfl_xor(sq, 32);
            if (fq == 0) ssq[eh * 64 + ti * 16 + l15] = sq;
            __syncthreads();
            { const float tot = ssq[ti * 16 + l15] + ssq[64 + ti * 16 + l15]; const float rinv = 1.0f / sqrtf(tot * (1.0f / 128.0f) + EPS);
              const size_t ro = (tokc + ti * 16 + l15) * 1024 + (size_t)h * 128;
#pragma unroll
              for (int j = 0; j < 4; ++j) { const int e0 = (4 * eh + j) * 16 + 4 * fq; const f32x4 nw = *(const f32x4*)(C.hgrn_out_norm + e0);
                  u32x2 w; w.x = pk2(o[j][0] * rinv * nw[0] * bf_lo(gw[j].x), o[j][1] * rinv * nw[1] * bf_hi(gw[j].x)); w.y = pk2(o[j][2] * rinv * nw[2] * bf_lo(gw[j].y), o[j][3] * rinv * nw[3] * bf_hi(gw[j].y));
                  *(u32x2*)(C.Y + ro + e0) = w; } }
        }
    }
}

constexpr int NPHASES = 14;
struct Args { const void* in[16]; float* out; unsigned char* ws; int ph_lo, ph_hi; };


typedef const __attribute__((address_space(4))) Args* KArgP;
__device__ __forceinline__ void make_ctx(Ctx& C) {
    KArgP ka = (KArgP)__builtin_amdgcn_kernarg_segment_ptr(); asm volatile("" : "+s"(ka));
    C.x = (const float*)ka->in[0]; C.positions = (const int*)ka->in[1]; C.ln_mix = (const float*)ka->in[2]; C.ln_ffn = (const float*)ka->in[3]; C.ln_final = (const float*)ka->in[4];
    C.w_in_ab = (const float*)ka->in[5]; C.w_pool = (const float*)ka->in[6]; C.pool_scale = (const float*)ka->in[7]; C.idx_k_norm = (const float*)ka->in[8]; C.w_out_ab = (const float*)ka->in[9];
    C.w_in_c = (const float*)ka->in[10]; C.hgrn_lb = (const float*)ka->in[11]; C.hgrn_out_norm = (const float*)ka->in[12]; C.w_out_c = (const float*)ka->in[13]; C.w_gate_up = (const float*)ka->in[14]; C.w_down = (const float*)ka->in[15];
    C.out = ka->out;
    unsigned char* ws = ka->ws;
    C.ctl = (unsigned*)(ws + WS_CTL); C.rope = (float*)(ws + WS_ROPE); C.part = (float*)(ws + WS_PART); C.lbv = (float*)(ws + WS_LB);
    C.W_inab = (bf16_t*)(ws + WS_W_INAB); C.W_pool = (bf16_t*)(ws + WS_W_POOL); C.W_outab = (bf16_t*)(ws + WS_W_OUTAB); C.W_inc = (bf16_t*)(ws + WS_W_INC); C.W_outc = (bf16_t*)(ws + WS_W_OUTC);
    C.W_gu0 = (bf16_t*)(ws + WS_W_GU0); C.W_gu1 = (bf16_t*)(ws + WS_W_GU1); C.W_dn0 = (bf16_t*)(ws + WS_W_DN0); C.W_dn1 = (bf16_t*)(ws + WS_W_DN1);
    C.XB = (bf16_t*)(ws + WS_XB); C.Y = (bf16_t*)(ws + WS_Y); C.P = (bf16_t*)(ws + WS_P); C.ACT = (bf16_t*)(ws + WS_ACT);
    C.L1Q = (bf16_t*)(ws + WS_L1Q); C.L1K = (bf16_t*)(ws + WS_L1K); C.L1I = (bf16_t*)(ws + WS_L1I); C.L1G = (bf16_t*)(ws + WS_L1G); C.ORAW = (bf16_t*)(ws + WS_ORAW);
    C.G = gridDim.x; C.bid = blockIdx.x;
}

#if USE_SIMPLE_GEMM
#define RUN_GEMM(EpiT, gg, EE) pg8::gemm_simple<EpiT>(gg, C.G, C.bid, EE)
#else
#define RUN_GEMM(EpiT, gg, EE) do { if (threadIdx.x == 0) *(LAS int*)(lds + 131072 + 1024) = -1; __syncthreads(); pg8::StaticOrder S_; S_.init((gg).M, (gg).N, C.G, C.bid); pg8::gemm_phase<EpiT, pg8::StaticOrder, true, true>(lds, gg, S_, EE); } while (0)
#endif

__device__ __forceinline__ void xcd_barrier_local(const XcdBarrier& b) {
    asm volatile("s_waitcnt vmcnt(0)" ::: "memory");
    __syncthreads();
    if (threadIdx.x == 0) {
        unsigned* bar = b.bar;
        __builtin_amdgcn_s_waitcnt(0);
        const unsigned nloc = b.st[0];
        const unsigned old = xb_add(&bar[XB_XSUB(b.x)], 1u);
        const unsigned gen = old / nloc;
        if (old + 1u == (gen + 1u) * nloc) xb_add(&bar[XB_XGEN(b.x)], 1u);
        else XB_SPIN(xb_ld(&bar[XB_XGEN(b.x)]) == gen, bar);
        __builtin_amdgcn_fence(__ATOMIC_ACQUIRE, "agent");
        asm volatile("s_waitcnt vmcnt(0)" ::: "memory");
    }
    __syncthreads();
}
constexpr int CW_TAB = 8192;

__global__ void __launch_bounds__(512, 2) mega_fwd(Args a) {
    extern __shared__ __attribute__((aligned(16))) unsigned char lds_raw[];
    LAS unsigned char* lds = (LAS unsigned char*)lds_raw;
    unsigned* const ctl0 = (unsigned*)(a.ws + WS_CTL);

    volatile LAS unsigned* MISC = (volatile LAS unsigned*)(lds + LDS_MISC);
    if (threadIdx.x < 64) MISC[threadIdx.x] = 0u;
    __syncthreads();
    XcdBarrier bar; bar.bar = ctl0 + CW_BAR; bar.x = 0; bar.st = nullptr;
    if (N_LAUNCH_MODE == 1) bar = xcd_barrier_post(ctl0 + CW_BAR, MISC + 8);
    if (N_LAUNCH_MODE == 1 && threadIdx.x == 0) __hip_atomic_store(&ctl0[CW_TAB + blockIdx.x], xb_xcc_id() + 1u, __ATOMIC_RELAXED, __HIP_MEMORY_SCOPE_AGENT);

    const int lo = a.ph_lo, hi = a.ph_hi;
#ifndef ONLY_PHASE
#define ONLY_PHASE -1
#endif
#define IN(k) (lo <= (k) && (k) < hi && (ONLY_PHASE < 0 || ONLY_PHASE == (k)))
#if defined(DBG_REPEAT) && DBG_REPEAT == 90
#define SEAM(k) do { if (N_LAUNCH_MODE == 1 && IN((k) + 1)) { xcd_barrier(bar); if ((k) == 5) for (int rr_ = 0; rr_ < 20; ++rr_) xcd_barrier(bar); } } while (0)
#else
#define SEAM(k) do { if (N_LAUNCH_MODE == 1 && IN((k) + 1)) xcd_barrier(bar); } while (0)
#endif

#if USE_SIMPLE_GEMM || USE_SIMPLE_ATTN || USE_SIMPLE_HGRN
#define SEAM_L(k) SEAM(k)
#else
#define SEAM_L(k) do { if (N_LAUNCH_MODE == 1 && IN((k) + 1)) { if (MISC[10]) xcd_barrier_local(bar); else xcd_barrier(bar); } } while (0)
#endif
    if (IN(0)) { Ctx C; make_ctx(C); phase_prologue(C, lds); __syncthreads();
#if defined(DBG_REPEAT) && DBG_REPEAT == 0
        phase_prologue(C, lds); __syncthreads();
#endif
        SEAM(0);
        if (N_LAUNCH_MODE == 1 && lo == 0) {
            if (threadIdx.x < 64) { bool ok = (gridDim.x == 256u);
                for (unsigned t = threadIdx.x; t < gridDim.x && t < 256u; t += 64u) { const unsigned v = xb_ld(&ctl0[CW_TAB + t]), r = xb_ld(&ctl0[CW_TAB + (t & 7u)]); ok = ok && v != 0u && v == r; }
                unsigned m = 0u;
                for (unsigned i = 0; i < 8u; ++i) m |= 1u << (xb_ld(&ctl0[CW_TAB + i]) & 31u);
                ok = ok && __popc(m) == 8;
                const bool all = __ballot(ok) == ~0ull;
                if (threadIdx.x == 0) MISC[10] = all ? 1u : 0u; }
            __syncthreads(); } }
    if (IN(1)) { Ctx C; make_ctx(C); pg8::Gemm g{C.XB, C.W_inab, NTOK, NAB, 1024}; pg8::EpiScaleBf16 E{C.P, NAB, pg8::RinvTab{C.part, lds}}; RUN_GEMM(pg8::EpiScaleBf16, g, E);
#if defined(DBG_REPEAT) && DBG_REPEAT == 1
        RUN_GEMM(pg8::EpiScaleBf16, g, E);
#endif
        SEAM(1); }
    if (IN(2)) { Ctx C; make_ctx(C); phase_fixup_pool(C, lds);
#if defined(DBG_REPEAT) && DBG_REPEAT == 2
        phase_fixup_pool(C, lds);
#endif
        SEAM(2); }
#ifdef DBG_ZERO_ATTN
    if (IN(3)) { Ctx C; make_ctx(C); for (int i = C.bid * 512 + threadIdx.x; i < NTOK * 64; i += C.G * 512) { const int tok = i >> 6, c = i & 63; *(u32x4*)(C.Y + (size_t)tok * 1024 + 512 + 8 * c) = (u32x4){0u, 0u, 0u, 0u}; } SEAM(3); }
#else
#if USE_SIMPLE_ATTN
    if (IN(3)) { Ctx C; make_ctx(C); phase_attn_simple(C, lds); __syncthreads(); SEAM(3); }
#else
    if (IN(3)) { Ctx C; make_ctx(C); phase_attn(C, lds); __syncthreads();
#if defined(DBG_REPEAT) && DBG_REPEAT == 3
        phase_attn(C, lds); __syncthreads();
#endif
        SEAM(3); }
#endif
#endif
    if (IN(4)) { Ctx C; make_ctx(C); pg8::Gemm g{C.Y, C.W_outab, NTOK, 1024, 1024}; pg8::EpiResidual<true> E{C.XB, C.part, C.x}; RUN_GEMM(pg8::EpiResidual<true>, g, E); SEAM_L(4); }
    if (IN(5)) { Ctx C; make_ctx(C); pg8::Gemm g{C.XB, C.W_gu0, NTOK, 2 * DFF, 1024}; pg8::EpiSwiGLU E{C.ACT, pg8::RinvTab{C.part, lds}}; RUN_GEMM(pg8::EpiSwiGLU, g, E);
#if defined(DBG_REPEAT) && DBG_REPEAT == 5
        RUN_GEMM(pg8::EpiSwiGLU, g, E);
#endif
        SEAM_L(5); }
    if (IN(6)) { Ctx C; make_ctx(C); pg8::Gemm g{C.ACT, C.W_dn0, NTOK, 1024, DFF}; pg8::EpiResidual<false> E{C.XB, C.part, C.x}; RUN_GEMM(pg8::EpiResidual<false>, g, E); SEAM_L(6); }
    if (IN(7)) { Ctx C; make_ctx(C); pg8::Gemm g{C.XB, C.W_inc, NTOK, NINC, 1024}; pg8::EpiHgrnIn E{C.L1Q, C.L1K, C.L1I, C.L1G, pg8::RinvTab{C.part, lds}, C.lbv}; RUN_GEMM(pg8::EpiHgrnIn, g, E); SEAM_L(7); }
#if USE_SIMPLE_HGRN
    if (IN(8)) { Ctx C; make_ctx(C); phase_hgrn_simple(C); SEAM(8); }
    if (IN(9)) { Ctx C; make_ctx(C); phase_hgrn_post(C); SEAM_L(9); }
#else
    if (IN(8)) { Ctx C; make_ctx(C); phase_hgrn_local(C, lds); __syncthreads();
#if defined(DBG_REPEAT) && DBG_REPEAT == 8
        phase_hgrn_local(C, lds); __syncthreads();
#endif
        SEAM(8); }
    if (IN(9)) { Ctx C; make_ctx(C); phase_hgrn_chunks(C, lds); __syncthreads();
#if defined(DBG_REPEAT) && DBG_REPEAT == 9
        phase_hgrn_chunks(C, lds); __syncthreads();
#endif
        SEAM_L(9); }
#endif
    if (IN(10)) { Ctx C; make_ctx(C); pg8::Gemm g{C.Y, C.W_outc, NTOK, 1024, 1024}; pg8::EpiResidual<false> E{C.XB, C.part, C.x}; RUN_GEMM(pg8::EpiResidual<false>, g, E); SEAM_L(10); }
    if (IN(11)) { Ctx C; make_ctx(C); pg8::Gemm g{C.XB, C.W_gu1, NTOK, 2 * DFF, 1024}; pg8::EpiSwiGLU E{C.ACT, pg8::RinvTab{C.part, lds}}; RUN_GEMM(pg8::EpiSwiGLU, g, E); SEAM_L(11); }
    if (IN(12)) { Ctx C; make_ctx(C); pg8::Gemm g{C.ACT, C.W_dn1, NTOK, 1024, DFF}; pg8::EpiResidual<false> E{C.XB, C.part, C.x}; RUN_GEMM(pg8::EpiResidual<false>, g, E); SEAM_L(12); }
    if (IN(13)) { Ctx C; make_ctx(C); phase_final_norm(C); }
#ifdef DBG_STOP_AFTER
    if (IN(14)) { Ctx C; make_ctx(C); for (int i = C.bid * 512 + threadIdx.x; i < NTOK * 1024; i += C.G * 512) { const int tok = i >> 10, c = i & 1023; float v;
        if (DBG_STOP_AFTER <= 3) v = bf2f(C.P[(size_t)tok * NAB + c]) + bf2f(C.P[(size_t)tok * NAB + 768 + c]) + bf2f(C.Y[(size_t)tok * 1024 + (c & 511)]);
        else if (DBG_STOP_AFTER == 7 || DBG_STOP_AFTER == 8) v = bf2f(C.L1Q[i]) + bf2f(C.L1K[i]) + bf2f(C.L1I[i]) + bf2f(C.L1G[i]) + (DBG_STOP_AFTER == 8 ? bf2f(C.ORAW[i]) : 0.f);
        else if (DBG_STOP_AFTER == 9) v = bf2f(C.Y[i]);
        else if (DBG_STOP_AFTER == 5 || DBG_STOP_AFTER == 11) v = bf2f(C.ACT[(size_t)tok * DFF + c]) + bf2f(C.ACT[(size_t)tok * DFF + 1024 + c]) + bf2f(C.ACT[(size_t)tok * DFF + 1792 + c]);
        else v = C.out[i] + bf2f(C.XB[i]);
        C.out[i] = v; } }
#endif
#undef IN
#undef SEAM
#undef SEAM_L
}

extern "C" void kernel_launch(void* const* d_in, const int* in_sizes, int n_in, void* d_out, int out_size, void* d_ws, size_t ws_size, hipStream_t stream) {
    static int grid = 0;
    if (grid == 0) {
        if (n_in != 16 || in_sizes[0] != NTOK * DM || out_size != NTOK * DM || ws_size < WS_END) {
            fprintf(stderr, "kernel_launch: built for 16 inputs, x/out of %d floats, >= %zu bytes of workspace; got n_in %d, in0 %d, out %d, ws %zu; nothing launched\n", NTOK * DM, (size_t)WS_END, n_in, n_in > 0 ? in_sizes[0] : -1, out_size, ws_size);
            grid = -1; return; }
        int dev = 0, cus = 0, per_cu = 0;
        if (hipGetDevice(&dev) != hipSuccess || hipDeviceGetAttribute(&cus, hipDeviceAttributeMultiprocessorCount, dev) != hipSuccess) { fprintf(stderr, "kernel_launch: device query failed\n"); grid = -1; return; }
        if (hipFuncSetAttribute((const void*)mega_fwd, hipFuncAttributeMaxDynamicSharedMemorySize, LDS_BYTES) != hipSuccess) { fprintf(stderr, "kernel_launch: hipFuncSetAttribute failed\n"); grid = -1; return; }
        if (hipOccupancyMaxActiveBlocksPerMultiprocessor(&per_cu, (const void*)mega_fwd, 512, LDS_BYTES) != hipSuccess || per_cu < 1)
            fprintf(stderr, "kernel_launch: note: occupancy query reports %d workgroups per CU\n", per_cu);
        (void)hipGetLastError();
        grid = cus;
    }
    if (grid < 0) return;
    if (hipMemsetAsync((char*)d_ws + WS_CTL, 0, CTL_ZERO_BYTES, stream) != hipSuccess) { fprintf(stderr, "kernel_launch: hipMemsetAsync failed\n"); return; }
    Args a{};
    for (int i = 0; i < 16; ++i) a.in[i] = d_in[i];
    a.out = (float*)d_out; a.ws = (unsigned char*)d_ws;
    if (N_LAUNCH_MODE == 1) {
        a.ph_lo = 0; a.ph_hi = NPHASES;
        hipLaunchKernelGGL(mega_fwd, dim3(grid), dim3(512), LDS_BYTES, stream, a);
    } else {
#ifdef DBG_STOP_AFTER
        for (int p = 0; p <= DBG_STOP_AFTER; ++p) { a.ph_lo = p; a.ph_hi = p + 1; hipLaunchKernelGGL(mega_fwd, dim3(grid), dim3(512), LDS_BYTES, stream, a); }
        a.ph_lo = 14; a.ph_hi = 15; hipLaunchKernelGGL(mega_fwd, dim3(grid), dim3(512), LDS_BYTES, stream, a);
#else
        for (int p = 0; p < NPHASES; ++p) { a.ph_lo = p; a.ph_hi = p + 1; hipLaunchKernelGGL(mega_fwd, dim3(grid), dim3(512), LDS_BYTES, stream, a); }
#endif
    }
    const hipError_t le = hipPeekAtLastError();
    if (le != hipSuccess) fprintf(stderr, "kernel_launch: launch failed: %s\n", hipGetErrorName(le));
}
```

```cpp
#include <hip/hip_runtime.h>
#include <cstdio>
#include <cstdint>

#ifndef N_LAUNCH_MODE
#define N_LAUNCH_MODE 1
#endif
#ifndef USE_SIMPLE_HGRN
#define USE_SIMPLE_HGRN 0
#endif
#ifndef USE_SIMPLE_ATTN
#define USE_SIMPLE_ATTN 0
#endif
#ifndef USE_SIMPLE_GEMM
#define USE_SIMPLE_GEMM 0
#endif

#define LAS __attribute__((address_space(3)))

constexpr int BATCH = 4, SEQ = 8192, DM = 1024, NTOK = BATCH * SEQ;
constexpr int NAB_REAL = 1604, NAB = 1792;
constexpr int DFF = 2816;
constexpr int NINC = 4096;
constexpr int PC_U = 0, PC_Q = 512, PC_K = 1024, PC_V = 1152, PC_QI = 1280, PC_KI = 1536, PC_WI = 1600;
constexpr float EPS = 1e-6f;
constexpr int TOPK = 256;

constexpr size_t MiB = 1u << 20;
constexpr size_t WS_CTL = 0, CTL_ZERO_BYTES = 1 * MiB;
constexpr size_t WS_ROPE = 1 * MiB;
constexpr size_t WS_PART = 3 * MiB;
constexpr size_t WS_LB = 5 * MiB;
constexpr size_t WS_W_INAB = 6 * MiB;
constexpr size_t WS_W_POOL = WS_W_INAB + (size_t)NAB * DM * 2;
constexpr size_t WS_W_OUTAB = 10 * MiB;
constexpr size_t WS_W_INC = 12 * MiB;
constexpr size_t WS_W_OUTC = 20 * MiB;
constexpr size_t WS_W_GU0 = 22 * MiB, WS_W_GU1 = 33 * MiB;
constexpr size_t WS_W_DN0 = 44 * MiB, WS_W_DN1 = WS_W_DN0 + (size_t)DM * DFF * 2;
constexpr size_t WS_XB = 56 * MiB;
constexpr size_t WS_Y = 120 * MiB;
constexpr size_t WS_P = 184 * MiB;
constexpr size_t WS_ACT = 184 * MiB;
constexpr size_t WS_L1Q = 184 * MiB, WS_L1K = 248 * MiB, WS_L1I = 312 * MiB, WS_L1G = 376 * MiB;
constexpr size_t WS_ORAW = 440 * MiB;
constexpr size_t WS_KV8 = 488 * MiB;
constexpr size_t WS_END = 512 * MiB;
static_assert(WS_W_POOL + 4 * 128 * 128 * 2 <= WS_W_OUTAB && WS_W_DN1 + (size_t)DM * DFF * 2 <= WS_XB && WS_P + (size_t)NTOK * NAB * 2 <= 360 * MiB && WS_ACT + (size_t)NTOK * DFF * 2 <= WS_L1G + 64 * MiB, "ws map");
constexpr int CW_BAR = 4096;

constexpr int LDS_BYTES = 163840;
constexpr int LDS_MISC = 163840 - 256;
namespace pg8 {
#define PG8_LAS __attribute__((address_space(3)))
typedef unsigned short bf16_t;
typedef short bf16x8 __attribute__((ext_vector_type(8)));
typedef float f32x4 __attribute__((ext_vector_type(4)));
typedef unsigned u32x4 __attribute__((ext_vector_type(4)));
constexpr int BM = 256, BK = 64, HALF = 128, HTB = HALF * BK * 2  , STAGE_BYTES = 8 * HTB, NXCD = 8, WGM = 8;

__host__ __device__ __forceinline__ int lds_byte(int r, int c) { const int st = (r >> 4) * 2 + (c >> 5), rr = r & 15, cc = c & 31, ob = rr * 64 + cc * 2; return st * 1024 + (ob ^ (((ob >> 9) & 1) << 5)); }
__host__ __device__ __forceinline__ void stage_rc(int b, int& R, int& C) { const int st = b / 1024, sb = b % 1024, swz = sb ^ (((sb >> 9) & 1) << 5); R = (st >> 1) * 16 + swz / 64; C = (st & 1) * 32 + (swz % 64) / 2; }
__host__ __device__ __forceinline__ int perm32(int rho) { const int n = rho >> 4, i = rho & 15; return 8 * (i >> 2) + 4 * n + (i & 3); }

struct Unit { int pm, pn; };
struct Gemm { const bf16_t* A; const bf16_t* Bt; int M, N, K; };

struct StaticOrder {
    int nM, nN, nwg, G, c;
    __host__ __device__ void init(int M, int N, int G_, int c_) { nM = M / BM; nN = N / BM; nwg = nM * nN; G = G_; c = c_; }
    __host__ __device__ bool next(int i, Unit& u) const {
        const long L = (long)i * G + c; if (L >= nwg) return false;
        int wgid = (int)L; { const int q = nwg / NXCD, r = nwg % NXCD, xcd = wgid % NXCD, off = wgid / NXCD; wgid = (xcd < r ? xcd * (q + 1) : r * (q + 1) + (xcd - r) * q) + off; }
        const int nig = WGM * nN, gid = wgid / nig, fm = gid * WGM, gsz = (nM - fm) < WGM ? (nM - fm) : WGM;
        u.pm = fm + ((wgid % nig) % gsz); u.pn = (wgid % nig) / gsz; return true;
    }
    __device__ __forceinline__ void a_ready(const Unit&) const {}
    __device__ __forceinline__ void done(const Unit&) const {}
};
typedef __bf16 bf16x2_t __attribute__((ext_vector_type(2)));
__device__ __forceinline__ unsigned cvt_pk_bf16(float lo, float hi) { const bf16x2_t v = {(__bf16)lo, (__bf16)hi}; return __builtin_bit_cast(unsigned, v); }

typedef float f32x2 __attribute__((ext_vector_type(2)));
typedef unsigned u32x2 __attribute__((ext_vector_type(2)));

__device__ __forceinline__ float row_rinv(const float* part, int row) {
    const f32x4* p = (const f32x4*)(part + (size_t)row * 16);
    const f32x4 a = p[0], b = p[1], c = p[2], d = p[3];
    const float s = (((a[0] + a[1]) + (a[2] + a[3])) + ((b[0] + b[1]) + (b[2] + b[3]))) + (((c[0] + c[1]) + (c[2] + c[3])) + ((d[0] + d[1]) + (d[2] + d[3])));
    return 1.0f / sqrtf(s * (1.0f / 1024.0f) + 1e-6f);
}
struct RinvTab {
    const float* part; PG8_LAS unsigned char* ldsb;
    __device__ __forceinline__ void prepare(int pm) const {
        PG8_LAS int* cpm = (PG8_LAS int*)(ldsb + 131072 + 1024); PG8_LAS float* rtab = (PG8_LAS float*)(ldsb + 131072);
        if (*cpm != pm) {
            asm volatile("s_waitcnt lgkmcnt(0)" ::: "memory"); __builtin_amdgcn_s_barrier(); asm volatile("" ::: "memory");
            if (threadIdx.x < 256) rtab[threadIdx.x] = row_rinv(part, pm * BM + (int)threadIdx.x);
            if (threadIdx.x == 0) *cpm = pm;
            asm volatile("s_waitcnt vmcnt(0) lgkmcnt(0)" ::: "memory"); __builtin_amdgcn_s_barrier(); asm volatile("" ::: "memory");
        }
    }
    __device__ __forceinline__ float get(int row_in_panel) const { return ((const PG8_LAS float*)(ldsb + 131072))[row_in_panel]; }
};
__device__ __forceinline__ float sigmoid_neg(float x) { return __builtin_amdgcn_rcpf(1.0f + __expf(x)); }
__device__ __forceinline__ float silu_f(float x) { return x * __builtin_amdgcn_rcpf(1.0f + __expf(-x)); }

struct EpiScaleBf16 {
    static constexpr bool PERM = true, AFTER_DRAIN = false;
    bf16_t* O; int ldc; RinvTab rt;
    __device__ __forceinline__ void operator()(const f32x4 (&acc)[2][2][4][2], const Unit& u, int wr, int wc, int fr, int fq) const {
        rt.prepare(u.pm);
        const int row0 = u.pm * BM + wr * 64 + fr, col0 = u.pn * BM + wc * 32 + 8 * fq;
#pragma unroll
        for (int ai = 0; ai < 2; ++ai)
#pragma unroll
            for (int m = 0; m < 4; ++m) { const int row = row0 + ai * HALF + m * 16; const float r = rt.get(row - u.pm * BM); bf16_t* rowp = O + (size_t)row * ldc + col0;
#pragma unroll
                for (int bj = 0; bj < 2; ++bj) { const f32x4 v0 = acc[ai][bj][m][0] * r, v1 = acc[ai][bj][m][1] * r;
                    u32x4 w; w.x = cvt_pk_bf16(v0[0], v0[1]); w.y = cvt_pk_bf16(v0[2], v0[3]); w.z = cvt_pk_bf16(v1[0], v1[1]); w.w = cvt_pk_bf16(v1[2], v1[3]);
                    *(u32x4*)(rowp + bj * HALF) = w; } }
    }
};
template <bool BASE_F32> struct EpiResidual {
    static constexpr bool PERM = true, AFTER_DRAIN = false;
    bf16_t* xb; float* part; const float* xin;
    __device__ __forceinline__ void operator()(const f32x4 (&acc)[2][2][4][2], const Unit& u, int wr, int wc, int fr, int fq) const {
        const int row0 = u.pm * BM + wr * 64 + fr, col0 = u.pn * BM + wc * 32 + 8 * fq;
#pragma unroll
        for (int ai = 0; ai < 2; ++ai)
#pragma unroll
            for (int m = 0; m < 4; ++m) { const int row = row0 + ai * HALF + m * 16; const size_t off = (size_t)row * 1024 + col0; float ss = 0.f;
#pragma unroll
                for (int bj = 0; bj < 2; ++bj) {
                    f32x4 x0, x1;
                    if (BASE_F32) { x0 = *(const f32x4*)(xin + off + bj * HALF) + acc[ai][bj][m][0]; x1 = *(const f32x4*)(xin + off + bj * HALF + 4) + acc[ai][bj][m][1]; }
                    else { const u32x4 b = *(const u32x4*)(xb + off + bj * HALF);
                    x0[0] = __uint_as_float(b.x << 16) + acc[ai][bj][m][0][0]; x0[1] = __uint_as_float(b.x & 0xffff0000u) + acc[ai][bj][m][0][1];
                    x0[2] = __uint_as_float(b.y << 16) + acc[ai][bj][m][0][2]; x0[3] = __uint_as_float(b.y & 0xffff0000u) + acc[ai][bj][m][0][3];
                    x1[0] = __uint_as_float(b.z << 16) + acc[ai][bj][m][1][0]; x1[1] = __uint_as_float(b.z & 0xffff0000u) + acc[ai][bj][m][1][1];
                    x1[2] = __uint_as_float(b.w << 16) + acc[ai][bj][m][1][2]; x1[3] = __uint_as_float(b.w & 0xffff0000u) + acc[ai][bj][m][1][3]; }
                    ss += ((x0[0] * x0[0] + x0[1] * x0[1]) + (x0[2] * x0[2] + x0[3] * x0[3])) + ((x1[0] * x1[0] + x1[1] * x1[1]) + (x1[2] * x1[2] + x1[3] * x1[3]));
                    u32x4 w; w.x = cvt_pk_bf16(x0[0], x0[1]); w.y = cvt_pk_bf16(x0[2], x0[3]); w.z = cvt_pk_bf16(x1[0], x1[1]); w.w = cvt_pk_bf16(x1[2], x1[3]);
                    *(u32x4*)(xb + off + bj * HALF) = w; }
                ss += __shfl_xor(ss, 16); ss += __shfl_xor(ss, 32);
                if (fq == 0) part[(size_t)row * 16 + u.pn * 4 + wc] = ss; }
    }
};
struct EpiSwiGLU {
    static constexpr bool PERM = true, AFTER_DRAIN = false;
    bf16_t* O; RinvTab rt;
    __device__ __forceinline__ void operator()(const f32x4 (&acc)[2][2][4][2], const Unit& u, int wr, int wc, int fr, int fq) const {
        rt.prepare(u.pm);
        const int row0 = u.pm * BM + wr * 64 + fr, f0 = u.pn * HALF + wc * 32 + 8 * fq;
#pragma unroll
        for (int ai = 0; ai < 2; ++ai)
#pragma unroll
            for (int m = 0; m < 4; ++m) { const int row = row0 + ai * HALF + m * 16; const float r = rt.get(row - u.pm * BM);
                float a[8];
#pragma unroll
                for (int n = 0; n < 2; ++n)
#pragma unroll
                    for (int j = 0; j < 4; ++j) { const float g = acc[ai][0][m][n][j] * r, up = acc[ai][1][m][n][j] * r; a[4 * n + j] = silu_f(g) * up; }
                u32x4 w; w.x = cvt_pk_bf16(a[0], a[1]); w.y = cvt_pk_bf16(a[2], a[3]); w.z = cvt_pk_bf16(a[4], a[5]); w.w = cvt_pk_bf16(a[6], a[7]);
                *(u32x4*)(O + (size_t)row * 2816 + f0) = w; }
    }
};
struct EpiHgrnIn {
    static constexpr bool PERM = true, AFTER_DRAIN = false;
    bf16_t *Q1, *K1, *I1, *G1; RinvTab rt; const float* lb;
    __device__ __forceinline__ void operator()(const f32x4 (&acc)[2][2][4][2], const Unit& u, int wr, int wc, int fr, int fq) const {
        rt.prepare(u.pm);
        const int sec = u.pn >> 2; const int row0 = u.pm * BM + wr * 64 + fr, col0 = (u.pn & 3) * BM + wc * 32 + 8 * fq;
        bf16_t* O = sec == 0 ? Q1 : sec == 1 ? K1 : sec == 2 ? I1 : G1;
        float lbc[2][8];
#pragma unroll
        for (int bj = 0; bj < 2; ++bj)
#pragma unroll
            for (int j = 0; j < 8; ++j) lbc[bj][j] = (sec == 1) ? (1.0f - lb[col0 + bj * HALF + j]) : 0.f;
#pragma unroll
        for (int ai = 0; ai < 2; ++ai)
#pragma unroll
            for (int m = 0; m < 4; ++m) { const int row = row0 + ai * HALF + m * 16; const float r = rt.get(row - u.pm * BM); bf16_t* rowp = O + (size_t)row * 1024 + col0;
#pragma unroll
                for (int bj = 0; bj < 2; ++bj) { float a[8];
#pragma unroll
                    for (int n = 0; n < 2; ++n)
#pragma unroll
                        for (int j = 0; j < 4; ++j) { const float v = acc[ai][bj][m][n][j] * r; float o;
                            if (sec == 0) o = v * 0.08838834764831845f; else if (sec == 1) o = lbc[bj][4 * n + j] * sigmoid_neg(v); else if (sec == 2) o = v; else o = silu_f(v);
                            a[4 * n + j] = o; }
                    u32x4 w; w.x = cvt_pk_bf16(a[0], a[1]); w.y = cvt_pk_bf16(a[2], a[3]); w.z = cvt_pk_bf16(a[4], a[5]); w.w = cvt_pk_bf16(a[6], a[7]);
                    *(u32x4*)(rowp + bj * HALF) = w; } }
    }
};

template <class Epi>
__device__ __forceinline__ void gemm_simple(const Gemm g, int G, int c, const Epi& E) {
    const int tid = threadIdx.x, wid = __builtin_amdgcn_readfirstlane(tid >> 6), lane = tid & 63, wr = wid >> 2, wc = wid & 3, fr = lane & 15, fq = lane >> 4;
    const int nN = g.N / BM, nunits = (g.M / BM) * nN, K = g.K;
    for (int ui = c; ui < nunits; ui += G) {
        Unit u; u.pm = ui / nN; u.pn = ui % nN;
        f32x4 acc[2][2][4][2];
#pragma unroll
        for (int a = 0; a < 2; ++a)
#pragma unroll
            for (int b = 0; b < 2; ++b)
#pragma unroll
                for (int m = 0; m < 4; ++m)
#pragma unroll
                    for (int n = 0; n < 2; ++n) acc[a][b][m][n] = (f32x4){0.f, 0.f, 0.f, 0.f};
        const bf16_t* Ab = g.A + (size_t)(u.pm * BM + wr * 64 + fr) * K + fq * 8;
        const bf16_t* Bb = g.Bt + (size_t)(u.pn * BM + wc * 32 + 8 * (fr >> 2) + (fr & 3)) * K + fq * 8;
        for (int kk = 0; kk < K; kk += 32) {
            bf16x8 a[2][4], b[2][2];
#pragma unroll
            for (int ai = 0; ai < 2; ++ai)
#pragma unroll
                for (int m = 0; m < 4; ++m) a[ai][m] = *(const bf16x8*)(Ab + (size_t)(ai * HALF + m * 16) * K + kk);
#pragma unroll
            for (int bj = 0; bj < 2; ++bj)
#pragma unroll
                for (int n = 0; n < 2; ++n) b[bj][n] = *(const bf16x8*)(Bb + (size_t)(bj * HALF + 4 * n) * K + kk);
#pragma unroll
            for (int ai = 0; ai < 2; ++ai)
#pragma unroll
                for (int bj = 0; bj < 2; ++bj)
#pragma unroll
                    for (int m = 0; m < 4; ++m)
#pragma unroll
                        for (int n = 0; n < 2; ++n) acc[ai][bj][m][n] = __builtin_amdgcn_mfma_f32_16x16x32_bf16(b[bj][n], a[ai][m], acc[ai][bj][m][n], 0, 0, 0);
        }
        E(acc, u, wr, wc, fr, fq);
    }
}
template <class Epi, class Sched, bool ALIGN_EPI = false, bool SP2 = false>
__device__ __forceinline__ void gemm_phase(PG8_LAS unsigned char* lds, const Gemm g, const Sched& S, const Epi& E) {
    const int tid = threadIdx.x, wid = __builtin_amdgcn_readfirstlane(tid >> 6), lane = tid & 63, wr = wid >> 2, wc = wid & 3, fr = lane & 15, fq = lane >> 4;
    const int K = g.K, nt = K / BK;
    unsigned voffA[2], voffB[2];
#pragma unroll
    for (int i = 0; i < 2; ++i) { int R, C; stage_rc(tid * 16 + i * 8192, R, C); const int Rb = Epi::PERM ? ((R & ~31) + perm32(R & 31)) : R;
        voffA[i] = (unsigned)(R * K + C) * 2u; voffB[i] = (unsigned)(Rb * K + C) * 2u; }
    const size_t kstep = (size_t)(BK * 2);
    const size_t hstep = (size_t)HALF * K * 2;
    const size_t tstep = 2 * hstep;
    const unsigned ldsw = (unsigned)wid * 1024u;
    const int aoff = lds_byte(wr * 64 + fr, fq * 8), boff = lds_byte(wc * 32 + fr, fq * 8);
#define PG8_SA(b, h) (((b) * 2 + (h)) * HTB)
#define PG8_SB(b, h) ((4 + (b) * 2 + (h)) * HTB)
#define PG8_STAGE(bufoff, gbase, voff) do { _Pragma("unroll") for (int _i = 0; _i < 2; ++_i) \
        __builtin_amdgcn_global_load_lds((const unsigned*)((const char*)(gbase) + (voff)[_i]), (PG8_LAS unsigned*)(lds + (bufoff) + ldsw + _i * 8192), 16, 0, 0); } while (0)
#define PG8_LDA(dst, b, h) do { _Pragma("unroll") for (int m = 0; m < 4; ++m) _Pragma("unroll") for (int k = 0; k < 2; ++k) dst[m][k] = *(const PG8_LAS bf16x8*)(lds + PG8_SA(b, h) + aoff + m * 2048 + k * 1024); } while (0)
#define PG8_LDB(dst, b, h) do { _Pragma("unroll") for (int n = 0; n < 2; ++n) _Pragma("unroll") for (int k = 0; k < 2; ++k) dst[n][k] = *(const PG8_LAS bf16x8*)(lds + PG8_SB(b, h) + boff + n * 2048 + k * 1024); } while (0)
#define PG8_MMA(ai, bj, At, Bt) do { __builtin_amdgcn_s_setprio(1); _Pragma("unroll") for (int m = 0; m < 4; ++m) _Pragma("unroll") for (int n = 0; n < 2; ++n) _Pragma("unroll") for (int k = 0; k < 2; ++k) \
        acc[ai][bj][m][n] = __builtin_amdgcn_mfma_f32_16x16x32_bf16(Bt[n][k], At[m][k], acc[ai][bj][m][n], 0, 0, 0); __builtin_amdgcn_s_setprio(0); } while (0)
#define PG8_WAIT_V(n) asm volatile("s_waitcnt vmcnt(" #n ")" ::: "memory")
#define PG8_WAIT_L(n) asm volatile("s_waitcnt lgkmcnt(" #n ")" ::: "memory")
#define PG8_BAR __builtin_amdgcn_s_barrier()
#define PG8_SCHED __builtin_amdgcn_sched_barrier(0)
    Unit cur, nxt; int ui = 0;
    if (!S.next(0, cur)) return;
    f32x4 acc[2][2][4][2];
#pragma unroll
    for (int a = 0; a < 2; ++a)
#pragma unroll
        for (int b = 0; b < 2; ++b)
#pragma unroll
            for (int m = 0; m < 4; ++m)
#pragma unroll
                for (int n = 0; n < 2; ++n) acc[a][b][m][n] = (f32x4){0.f, 0.f, 0.f, 0.f};
    bf16x8 At[4][2], B0[2][2], B1[2][2];
    const char* cA = (const char*)g.A + (size_t)cur.pm * tstep; const char* cB = (const char*)g.Bt + (size_t)cur.pn * tstep;
    S.a_ready(cur);
    if constexpr (SP2) {
        PG8_STAGE(PG8_SB(0, 0), cB, voffB); PG8_STAGE(PG8_SB(0, 1), cB + hstep, voffB); PG8_STAGE(PG8_SA(0, 0), cA, voffA); PG8_STAGE(PG8_SA(0, 1), cA + hstep, voffA);
        if (wr == 1) PG8_BAR;
        PG8_WAIT_V(2); PG8_BAR;
        PG8_STAGE(PG8_SB(1, 0), cB + kstep, voffB); PG8_STAGE(PG8_SA(1, 0), cA + kstep, voffA); PG8_STAGE(PG8_SB(1, 1), cB + hstep + kstep, voffB);
        PG8_WAIT_V(6); PG8_BAR;
    } else {
        PG8_STAGE(PG8_SB(0, 0), cB, voffB); PG8_STAGE(PG8_SA(0, 0), cA, voffA); PG8_STAGE(PG8_SB(0, 1), cB + hstep, voffB); PG8_STAGE(PG8_SA(0, 1), cA + hstep, voffA);
        if (wr == 1) PG8_BAR;
        PG8_WAIT_V(4); PG8_BAR;
        PG8_STAGE(PG8_SB(1, 0), cB + kstep, voffB); PG8_STAGE(PG8_SA(1, 0), cA + kstep, voffA); PG8_STAGE(PG8_SB(1, 1), cB + hstep + kstep, voffB);
        PG8_WAIT_V(6); PG8_BAR;
    }
    for (;;) {
        const bool has_next = S.next(ui + 1, nxt);
        const char* nA = has_next ? (const char*)g.A + (size_t)nxt.pm * tstep : cA; const char* nB = has_next ? (const char*)g.Bt + (size_t)nxt.pn * tstep : cB;
        for (int t = 0; t < nt; t += 2) {
            const bool last = (t == nt - 2);
            const char* a1 = cA + (size_t)(t + 1) * kstep;
            const char* a2 = last ? nA : cA + (size_t)(t + 2) * kstep; const char* b2 = last ? nB : cB + (size_t)(t + 2) * kstep;
            const char* a3 = a2 + kstep; const char* b3 = b2 + kstep;
            if (last && has_next) S.a_ready(nxt);
            if constexpr (SP2) {
            PG8_LDB(B0, 0, 0); PG8_LDB(B1, 0, 1); PG8_SCHED; PG8_LDA(At, 0, 0); PG8_STAGE(PG8_SA(1, 1), a1 + hstep, voffA);
            PG8_WAIT_V(8); PG8_WAIT_L(0); PG8_BAR; PG8_MMA(0, 0, At, B0); PG8_MMA(0, 1, At, B1); PG8_BAR; PG8_SCHED;
            PG8_LDA(At, 0, 1); PG8_STAGE(PG8_SB(0, 0), b2, voffB); PG8_STAGE(PG8_SB(0, 1), b2 + hstep, voffB); PG8_STAGE(PG8_SA(0, 0), a2, voffA);
            PG8_WAIT_V(8); PG8_WAIT_L(0); PG8_BAR; PG8_MMA(1, 0, At, B0); PG8_MMA(1, 1, At, B1); PG8_BAR; PG8_SCHED;
            PG8_LDB(B0, 1, 0); PG8_LDB(B1, 1, 1); PG8_SCHED; PG8_LDA(At, 1, 0); PG8_STAGE(PG8_SA(0, 1), a2 + hstep, voffA);
            PG8_WAIT_V(8); PG8_WAIT_L(0); PG8_BAR; PG8_MMA(0, 0, At, B0); PG8_MMA(0, 1, At, B1); PG8_BAR; PG8_SCHED;
            PG8_LDA(At, 1, 1); PG8_STAGE(PG8_SB(1, 0), b3, voffB); PG8_STAGE(PG8_SB(1, 1), b3 + hstep, voffB); PG8_STAGE(PG8_SA(1, 0), a3, voffA);
            PG8_WAIT_V(8); PG8_WAIT_L(0); PG8_BAR; PG8_MMA(1, 0, At, B0); PG8_MMA(1, 1, At, B1); PG8_BAR; PG8_SCHED;
            } else {
            PG8_LDB(B0, 0, 0); PG8_SCHED; PG8_LDA(At, 0, 0); PG8_STAGE(PG8_SA(1, 1), a1 + hstep, voffA);
            PG8_WAIT_L(8); PG8_BAR; PG8_WAIT_L(0); PG8_MMA(0, 0, At, B0); PG8_BAR; PG8_SCHED;
            PG8_LDB(B1, 0, 1); PG8_STAGE(PG8_SB(0, 0), b2, voffB);
            PG8_BAR; PG8_WAIT_L(0); PG8_MMA(0, 1, At, B1); PG8_BAR;
            PG8_LDA(At, 0, 1); PG8_STAGE(PG8_SA(0, 0), a2, voffA);
            PG8_BAR; PG8_WAIT_L(0); PG8_MMA(1, 0, At, B0); PG8_BAR; PG8_SCHED;
            PG8_STAGE(PG8_SB(0, 1), b2 + hstep, voffB);
            PG8_WAIT_V(6); PG8_BAR; PG8_MMA(1, 1, At, B1); PG8_BAR;
            PG8_LDB(B0, 1, 0); PG8_SCHED; PG8_LDA(At, 1, 0); PG8_STAGE(PG8_SA(0, 1), a2 + hstep, voffA);
            PG8_WAIT_L(8); PG8_BAR; PG8_WAIT_L(0); PG8_MMA(0, 0, At, B0); PG8_BAR; PG8_SCHED;
            PG8_LDB(B1, 1, 1); PG8_STAGE(PG8_SB(1, 0), b3, voffB);
            PG8_BAR; PG8_WAIT_L(0); PG8_MMA(0, 1, At, B1); PG8_BAR;
            PG8_LDA(At, 1, 1); PG8_STAGE(PG8_SA(1, 0), a3, voffA);
            PG8_BAR; PG8_WAIT_L(0); PG8_MMA(1, 0, At, B0); PG8_BAR; PG8_SCHED;
            PG8_STAGE(PG8_SB(1, 1), b3 + hstep, voffB);
            PG8_WAIT_V(6); PG8_BAR; PG8_MMA(1, 1, At, B1); PG8_BAR;
            }
        }
        if constexpr (ALIGN_EPI) { if (wr == 0) PG8_BAR; }
        if constexpr (!Epi::AFTER_DRAIN) { E(acc, cur, wr, wc, fr, fq); S.done(cur); }
        if (!has_next) break;
#pragma unroll
        for (int a = 0; a < 2; ++a)
#pragma unroll
            for (int b = 0; b < 2; ++b)
#pragma unroll
                for (int m = 0; m < 4; ++m)
#pragma unroll
                    for (int n = 0; n < 2; ++n) acc[a][b][m][n] = (f32x4){0.f, 0.f, 0.f, 0.f};
        cur = nxt; cA = nA; cB = nB; ++ui;
        if constexpr (ALIGN_EPI) { if (wr == 1) PG8_BAR; }
    }
    PG8_WAIT_V(0);
    if constexpr (!ALIGN_EPI) { if (wr == 0) PG8_BAR; }
    PG8_BAR;
    if constexpr (Epi::AFTER_DRAIN) { E.fused(acc, cur, wr, wc, fr, fq, lds, wid, lane); S.done(cur); }
#undef PG8_SA
#undef PG8_SB
#undef PG8_STAGE
#undef PG8_LDA
#undef PG8_LDB
#undef PG8_MMA
#undef PG8_WAIT_V
#undef PG8_WAIT_L
#undef PG8_BAR
#undef PG8_SCHED
}
}

#define XB_TMO      128
#define XB_XCNT(j)  (256  + 64 * (j))
#define XB_XSUB(j)  (1280 + 64 * (j))
#define XB_XGEN(j)  (2304 + 64 * (j))
#define XB_TOP      3328
#define XB_TOPGEN   3392
#define XCD_BAR_WORDS 3456
#define XB_SPIN_CAP (1u << 18)

__device__ __forceinline__ unsigned xb_ld(unsigned* p)              { return __hip_atomic_load(p, __ATOMIC_RELAXED, __HIP_MEMORY_SCOPE_AGENT); }
__device__ __forceinline__ unsigned xb_add(unsigned* p, unsigned v) { return __hip_atomic_fetch_add(p, v, __ATOMIC_RELAXED, __HIP_MEMORY_SCOPE_AGENT); }
__device__ __forceinline__ unsigned xb_xcc_id() { return (unsigned)__builtin_amdgcn_s_getreg((3 << 11) | 20) & 0xFu; }
#define XB_SPIN(cond, bar) do { unsigned _sp = 0; while (cond) { __builtin_amdgcn_s_sleep(1); \
    if ((++_sp & 255u) == 0u) { if (xb_ld(&(bar)[XB_TMO])) break; if (_sp > XB_SPIN_CAP) { atomicAdd(&(bar)[XB_TMO], 1u); break; } } } } while (0)

struct XcdBarrier {
    unsigned* bar; unsigned x;
    volatile LAS unsigned* st;
};

__device__ __forceinline__ XcdBarrier xcd_barrier_post(unsigned* bar, volatile LAS unsigned* st) {
    XcdBarrier b; b.bar = bar; b.x = xb_xcc_id(); b.st = st;
    if (threadIdx.x == 0) (void)xb_add(&bar[XB_XCNT(b.x)], 1u);
    return b;
}
__device__ __forceinline__ void xcd_barrier_complete(unsigned* bar, unsigned x, unsigned& nloc, unsigned& nx) {
    const unsigned G = gridDim.x * gridDim.y * gridDim.z;
    unsigned sum, cnt, mine, sp = 0u;
    for (;;) {
        sum = 0u; cnt = 0u; mine = 0u;
#pragma unroll
        for (unsigned j = 0; j < 16; ++j) { const unsigned c = xb_ld(&bar[XB_XCNT(j)]); sum += c; cnt += (c > 0u) ? 1u : 0u; mine = (j == x) ? c : mine; }
        if (sum == G) break;
        __builtin_amdgcn_s_sleep(1);
        if ((++sp & 255u) == 0u) { if (xb_ld(&bar[XB_TMO])) break; if (sp > XB_SPIN_CAP) { atomicAdd(&bar[XB_TMO], 1u); break; } }
    }
    nloc = mine > 0u ? mine : 1u; nx = cnt > 0u ? cnt : 1u;
}

__device__ __forceinline__ void xcd_barrier(const XcdBarrier& b) {
    asm volatile("s_waitcnt vmcnt(0)" ::: "memory");
    __syncthreads();
    if (threadIdx.x == 0) {
        unsigned* bar = b.bar;
        __builtin_amdgcn_s_waitcnt(0);
        unsigned nloc = b.st[0], nx = b.st[1];
        if (nloc == 0u) { xcd_barrier_complete(bar, b.x, nloc, nx); b.st[0] = nloc; b.st[1] = nx; }
        const unsigned old = xb_add(&bar[XB_XSUB(b.x)], 1u);
        const unsigned gen = old / nloc;
        if (old + 1u == (gen + 1u) * nloc) {
            __builtin_amdgcn_fence(__ATOMIC_RELEASE, "agent");
            asm volatile("s_waitcnt vmcnt(0)" ::: "memory");
            const unsigned og = xb_add(&bar[XB_TOP], 1u);
            const unsigned tg = og / nx;
            if (og + 1u == (tg + 1u) * nx) xb_add(&bar[XB_TOPGEN], 1u);
            else XB_SPIN(xb_ld(&bar[XB_TOPGEN]) == tg, bar);
            __builtin_amdgcn_fence(__ATOMIC_ACQUIRE, "agent");
            xb_add(&bar[XB_XGEN(b.x)], 1u);
            asm volatile("s_waitcnt vmcnt(0)" ::: "memory");
        } else {
            XB_SPIN(xb_ld(&bar[XB_XGEN(b.x)]) == gen, bar);
            __builtin_amdgcn_fence(__ATOMIC_ACQUIRE, "agent");
            asm volatile("s_waitcnt vmcnt(0)" ::: "memory");
        }
    }
    __syncthreads();
}

typedef unsigned short bf16_t;
typedef short bf16x8 __attribute__((ext_vector_type(8)));
typedef float f32x4 __attribute__((ext_vector_type(4)));
typedef unsigned u32x4 __attribute__((ext_vector_type(4)));
typedef unsigned u32x2 __attribute__((ext_vector_type(2)));

struct Ctx {
    const float* x; const int* positions; const float *ln_mix, *ln_ffn, *ln_final, *w_in_ab, *w_pool, *pool_scale, *idx_k_norm, *w_out_ab, *w_in_c, *hgrn_lb, *hgrn_out_norm, *w_out_c, *w_gate_up, *w_down;
    float* out;
    unsigned* ctl; float* rope; float* part; float* lbv;
    bf16_t *W_inab, *W_pool, *W_outab, *W_inc, *W_outc, *W_gu0, *W_gu1, *W_dn0, *W_dn1;
    bf16_t *XB, *Y, *P, *ACT, *L1Q, *L1K, *L1I, *L1G, *ORAW;
    int G, bid;
};

__device__ __forceinline__ float bf_lo(unsigned w) { return __uint_as_float(w << 16); }
__device__ __forceinline__ float bf_hi(unsigned w) { return __uint_as_float(w & 0xffff0000u); }
__device__ __forceinline__ float bf2f(bf16_t b) { return __uint_as_float(((unsigned)b) << 16); }
__device__ __forceinline__ unsigned pk2(float lo, float hi) { return pg8::cvt_pk_bf16(lo, hi); }
__device__ __forceinline__ float wave_sum(float v) {
#pragma unroll
    for (int o = 1; o < 64; o <<= 1) v += __shfl_xor(v, o);
    return v;
}

__device__ __forceinline__ unsigned pk4_fp8(float a, float b, float c, float d) { int w = 0; w = __builtin_amdgcn_cvt_pk_fp8_f32(a, b, w, false); w = __builtin_amdgcn_cvt_pk_fp8_f32(c, d, w, true); return (unsigned)w; }
__device__ __forceinline__ u32x2 bf8_to_fp8(u32x4 w) { u32x2 o; o.x = pk4_fp8(bf_lo(w.x), bf_hi(w.x), bf_lo(w.y), bf_hi(w.y)); o.y = pk4_fp8(bf_lo(w.z), bf_hi(w.z), bf_lo(w.w), bf_hi(w.w)); return o; }

struct RowMapId { __device__ __forceinline__ int operator()(int n) const { return n; } };
struct RowMapAB { __device__ __forceinline__ int operator()(int n) const {
    if (n < PC_Q || (n >= PC_V && n < PC_QI) || n >= PC_WI) return n;
    const int d = n & 63; if (d >= 16) return n;
    return n - d + ((d < 8) ? 2 * d : 2 * (d - 8) + 1); } };
struct RowMapGU { __device__ __forceinline__ int operator()(int n) const {
    if (n < DFF) return 256 * (n >> 7) + (n & 127);
    const int f = n - DFF; return 256 * (f >> 7) + 128 + (f & 127); } };

template <class RowMap>
__device__ __forceinline__ void transpose_item(const float* W, int K, int N, const float* kgain, const float* nscale, bf16_t* WT, RowMap map, LAS float* scr, int item, int lane) {
    const int nblk = (N + 31) >> 5, kb = item / nblk, nb = item - kb * nblk, k0 = 64 * kb, n0 = 32 * nb;
    const int nr = n0 + (lane & 31); const float ns = (nr < N && nscale) ? nscale[nr] : 1.0f;
    float wv[32];
    const int nrc = (nr < N) ? nr : N - 1;
#pragma unroll
    for (int i = 0; i < 32; ++i) wv[i] = W[(size_t)(k0 + 2 * i + (lane >> 5)) * N + nrc];
    float kg[32];
#pragma unroll
    for (int i = 0; i < 32; ++i) kg[i] = kgain ? kgain[k0 + 2 * i + (lane >> 5)] : 1.0f;
#pragma unroll
    for (int i = 0; i < 32; ++i) { const int kk = 2 * i + (lane >> 5); scr[kk * 33 + (lane & 31)] = (nr < N) ? wv[i] * kg[i] * ns : 0.f; }
    asm volatile("s_waitcnt lgkmcnt(0)" ::: "memory");
    const int c = lane & 7;
#pragma unroll
    for (int j = 0; j < 4; ++j) { const int nl = (lane >> 3) + 8 * j; const LAS float* s = scr + (8 * c) * 33 + nl;
        u32x4 o; o.x = pk2(s[0 * 33], s[1 * 33]); o.y = pk2(s[2 * 33], s[3 * 33]); o.z = pk2(s[4 * 33], s[5 * 33]); o.w = pk2(s[6 * 33], s[7 * 33]);
        if (n0 + nl < N) *(u32x4*)(WT + (size_t)map(n0 + nl) * K + k0 + 8 * c) = o; }
    asm volatile("s_waitcnt lgkmcnt(0)" ::: "memory");
}

__device__ __forceinline__ void rope_cs(int pos, int i, float& c, float& s) {
    const double inv = (i == 0) ? 1.0 : (i == 1) ? 0.19392274474868576 : (i == 2) ? 0.03760603093086393 : (i == 3) ? 0.007292664737217109 : (i == 4) ? 0.001414213562373095
                     : (i == 5) ? 0.0002742481756762073 : (i == 6) ? 5.318295896944988e-05 : 1.031338537721246e-05;
    const double a = (double)pos * inv;
    const double kq = rint(a * 0.63661977236758134308);
    double r = fma(-kq, 1.57079632679489655800e+00, a); r = fma(-kq, 6.12323399573676603587e-17, r);
    const double r2 = r * r;
    double sp = -7.6471637318198164759e-13; sp = fma(sp, r2, 1.6059043836821614599e-10); sp = fma(sp, r2, -2.5052108385441718775e-08); sp = fma(sp, r2, 2.7557319223985890653e-06);
    sp = fma(sp, r2, -1.9841269841269841270e-04); sp = fma(sp, r2, 8.3333333333333333333e-03); sp = fma(sp, r2, -1.6666666666666666667e-01); const double sn = fma(sp * r2, r, r);
    double cp = 4.7794773323873852974e-14; cp = fma(cp, r2, -1.1470745597729724714e-11); cp = fma(cp, r2, 2.0876756987868098979e-09); cp = fma(cp, r2, -2.7557319223985890653e-07);
    cp = fma(cp, r2, 2.4801587301587301587e-05); cp = fma(cp, r2, -1.3888888888888888889e-03); cp = fma(cp, r2, 4.1666666666666666667e-02); cp = fma(cp, r2, -0.5); const double cn = fma(cp, r2, 1.0);
    const int q = ((int)kq) & 3;
    const double cc = (q == 0) ? cn : (q == 1) ? -sn : (q == 2) ? -cn : sn;
    const double ss = (q == 0) ? sn : (q == 1) ? cn : (q == 2) ? -sn : -cn;
    c = (float)cc; s = (float)ss;
}

__device__ __forceinline__ void phase_prologue(const Ctx& C, LAS unsigned char* lds) {
    const int tid = threadIdx.x, lane = tid & 63, wave = __builtin_amdgcn_readfirstlane(tid >> 6);
    LAS float* scr = (LAS float*)(lds + wave * 16384);
    const int gw = C.bid * 8 + wave, NGW = C.G * 8;
    constexpr int I_AB = 16 * 51, I_PL = 2 * 4, I_SQ = 16 * 32, I_INC = 16 * 128, I_GU = 16 * 176, I_DN = 44 * 32;
    constexpr int NITEMS = I_AB + 4 * I_PL + I_SQ + I_INC + I_SQ + 2 * I_GU + I_DN;
    for (int it = gw; it < NITEMS; it += NGW) {
        int r = it;
        if (r < I_AB) { transpose_item(C.w_in_ab, 1024, NAB_REAL, C.ln_mix, nullptr, C.W_inab, RowMapAB(), scr, r, lane); continue; } r -= I_AB;
        if (r < 4 * I_PL) { const int g = r / I_PL; transpose_item(C.w_pool + g * 16384, 128, 128, nullptr, C.pool_scale + g * 128, C.W_pool + g * 16384, RowMapId(), scr, r - g * I_PL, lane); continue; } r -= 4 * I_PL;
        if (r < I_SQ) { transpose_item(C.w_out_ab, 1024, 1024, nullptr, nullptr, C.W_outab, RowMapId(), scr, r, lane); continue; } r -= I_SQ;
        if (r < I_INC) { transpose_item(C.w_in_c, 1024, NINC, C.ln_mix + 1024, nullptr, C.W_inc, RowMapId(), scr, r, lane); continue; } r -= I_INC;
        if (r < I_SQ) { transpose_item(C.w_out_c, 1024, 1024, nullptr, nullptr, C.W_outc, RowMapId(), scr, r, lane); continue; } r -= I_SQ;
        if (r < I_GU) { transpose_item(C.w_gate_up, 1024, 2 * DFF, C.ln_ffn, nullptr, C.W_gu0, RowMapGU(), scr, r, lane); continue; } r -= I_GU;
        if (r < I_GU) { transpose_item(C.w_gate_up + (size_t)1024 * 2 * DFF, 1024, 2 * DFF, C.ln_ffn + 1024, nullptr, C.W_gu1, RowMapGU(), scr, r, lane); continue; } r -= I_GU;
        transpose_item(C.w_down, DFF, 1024, nullptr, nullptr, C.W_dn0, RowMapId(), scr, r, lane);
    }
    const int gt = C.bid * 512 + tid, NGT = C.G * 512;
    for (int i = gt; i < (NAB - NAB_REAL) * 1024 / 8; i += NGT) ((u32x4*)(C.W_inab + (size_t)NAB_REAL * 1024))[i] = (u32x4){0u, 0u, 0u, 0u};
    for (int i = gt; i < NTOK * 8; i += NGT) { const int tok = i >> 3, f = i & 7; float c, s; rope_cs(C.positions[tok], f, c, s); C.rope[(size_t)tok * 16 + f] = c; C.rope[(size_t)tok * 16 + 8 + f] = s; }
    for (int i = gt; i < 1024; i += NGT) C.lbv[i] = 1.0f / (1.0f + expf(C.hgrn_lb[i] - C.hgrn_lb[1024 + i]));
    for (int row0 = 4 * gw; row0 < NTOK; row0 += 4 * NGW) {
        f32x4 v[4][4];
#pragma unroll
        for (int rr = 0; rr < 4; ++rr)
#pragma unroll
            for (int j = 0; j < 4; ++j) v[rr][j] = ((const f32x4*)(C.x + (size_t)(row0 + rr) * 1024) + lane)[64 * j];
#pragma unroll
        for (int rr = 0; rr < 4; ++rr) { const int row = row0 + rr; u32x2* o8 = (u32x2*)(C.XB + (size_t)row * 1024) + lane; float s = 0.f;
#pragma unroll
            for (int j = 0; j < 4; ++j) { const f32x4 x4 = v[rr][j]; s += (x4[0] * x4[0] + x4[1] * x4[1]) + (x4[2] * x4[2] + x4[3] * x4[3]); u32x2 w; w.x = pk2(x4[0], x4[1]); w.y = pk2(x4[2], x4[3]); o8[64 * j] = w; }
            s = wave_sum(s);
            if (lane < 16) C.part[(size_t)row * 16 + lane] = (lane == 0) ? s : 0.f; }
    }
}

__device__ __forceinline__ void phase_prologue_late(const Ctx& C, LAS unsigned char* lds) {
    const int tid = threadIdx.x, lane = tid & 63, wave = __builtin_amdgcn_readfirstlane(tid >> 6);
    LAS float* scr = (LAS float*)(lds + wave * 16384);
    const int half = C.G >> 1; if (C.bid < half) return;
    const int gw = (C.bid - half) * 8 + wave, NGW = (C.G - half) * 8;
    for (int it = gw; it < 44 * 32; it += NGW) transpose_item(C.w_down + (size_t)DFF * 1024, DFF, 1024, nullptr, nullptr, C.W_dn1, RowMapId(), scr, it, lane);
}

__device__ __forceinline__ void phase_fixup_pool(const Ctx& C, LAS unsigned char* lds) {
    const int tid = threadIdx.x, lane = tid & 63, wid = __builtin_amdgcn_readfirstlane(tid >> 6);
    for (int tile = C.bid; tile < NTOK / 128; tile += C.G) {
        const int tok0 = tile * 128;
        for (int it = tid; it < 128 * 16; it += 512) {
            const int tl = it >> 4, slot = it & 15;
            const int tok = tok0 + tl;
            unsigned char* kv8 = (unsigned char*)C.ctl + WS_KV8 + (size_t)tok * 256;
            if (slot == 15) {
                const bf16_t* vp = C.P + (size_t)tok * NAB + PC_V;
#pragma unroll
                for (int q2 = 0; q2 < 8; ++q2) { const u32x2 a = bf8_to_fp8(*(const u32x4*)(vp + 16 * q2)), b = bf8_to_fp8(*(const u32x4*)(vp + 16 * q2 + 8)); *(u32x4*)(kv8 + 128 + 16 * q2) = (u32x4){a.x, a.y, b.x, b.y}; }
                continue; }
            const f32x4* rp = (const f32x4*)(C.rope + (size_t)tok * 16);
            const f32x4 c0 = rp[0], c1 = rp[1], s0 = rp[2], s1 = rp[3];
            const float cs[8] = {c0[0], c0[1], c0[2], c0[3], c1[0], c1[1], c1[2], c1[3]}, sn[8] = {s0[0], s0[1], s0[2], s0[3], s1[0], s1[1], s1[2], s1[3]};
            bf16_t* rowp = C.P + (size_t)tok * NAB;
            if (slot < 14) {
                const int col = (slot < 8) ? PC_Q + 64 * slot : (slot < 10) ? PC_K + 64 * (slot - 8) : PC_QI + 64 * (slot - 10);
                u32x4 w0 = *(u32x4*)(rowp + col), w1 = *(u32x4*)(rowp + col + 8);
                unsigned w[8] = {w0.x, w0.y, w0.z, w0.w, w1.x, w1.y, w1.z, w1.w};
#pragma unroll
                for (int i = 0; i < 8; ++i) { const float x1 = bf_lo(w[i]), x2 = bf_hi(w[i]); w[i] = pk2(x1 * cs[i] - x2 * sn[i], x2 * cs[i] + x1 * sn[i]); }
                *(u32x4*)(rowp + col) = (u32x4){w[0], w[1], w[2], w[3]}; *(u32x4*)(rowp + col + 8) = (u32x4){w[4], w[5], w[6], w[7]};
                if (slot == 8 || slot == 9) {
                    unsigned char* kd = kv8 + 64 * (slot - 8);
                    { const u32x2 a = bf8_to_fp8((u32x4){w[0], w[1], w[2], w[3]}), b = bf8_to_fp8((u32x4){w[4], w[5], w[6], w[7]}); *(u32x4*)kd = (u32x4){a.x, a.y, b.x, b.y}; }
#pragma unroll
                    for (int q2 = 1; q2 < 4; ++q2) { const u32x2 a = bf8_to_fp8(*(const u32x4*)(rowp + col + 16 * q2)), b = bf8_to_fp8(*(const u32x4*)(rowp + col + 16 * q2 + 8)); *(u32x4*)(kd + 16 * q2) = (u32x4){a.x, a.y, b.x, b.y}; } }
            } else {
                unsigned w[32];
#pragma unroll
                for (int q = 0; q < 8; ++q) { const u32x4 t = *(u32x4*)(rowp + PC_KI + 8 * q); w[4 * q] = t.x; w[4 * q + 1] = t.y; w[4 * q + 2] = t.z; w[4 * q + 3] = t.w; }
                float ss = 0.f;
#pragma unroll
                for (int i = 0; i < 32; ++i) { const float a = bf_lo(w[i]), b = bf_hi(w[i]); ss += a * a + b * b; }
                const float r = 1.0f / sqrtf(ss * (1.0f / 64.0f) + EPS);
#pragma unroll
                for (int i = 0; i < 32; ++i) {
                    const int d0 = (i < 8) ? i : 2 * i, d1 = (i < 8) ? i + 8 : 2 * i + 1;
                    float a = bf_lo(w[i]) * r * C.idx_k_norm[d0], b = bf_hi(w[i]) * r * C.idx_k_norm[d1];
                    if (i < 8) { const float x1 = a, x2 = b; a = x1 * cs[i] - x2 * sn[i]; b = x2 * cs[i] + x1 * sn[i]; }
                    w[i] = pk2(a, b); }
#pragma unroll
                for (int q = 0; q < 8; ++q) *(u32x4*)(rowp + PC_KI + 8 * q) = (u32x4){w[4 * q], w[4 * q + 1], w[4 * q + 2], w[4 * q + 3]};
            }
        }
        const int fr = lane & 15, fq = lane >> 4;
        const int tl0 = wid * 16 + fr, tok = tok0 + tl0, t = tok & (SEQ - 1);
        const bool hist = (tok0 & (SEQ - 1)) != 0;
        LAS unsigned char* ubuf = lds; LAS unsigned char* wbuf = lds + 39424;
        u32x4 ur[5], wv[4];
#define POOL_LOAD(gx) { _Pragma("unroll") for (int i = 0; i < 5; ++i) { int p = tid + 512 * i; p = p < 2288 ? p : 2287; const int r = p >> 4, pc = p & 15; const int trow = (r < 15 && !hist) ? tok0 : tok0 - 15 + r; \
            ur[i] = *(const u32x4*)(C.P + (size_t)trow * NAB + PC_U + (gx) * 128 + pc * 8); } \
        _Pragma("unroll") for (int i = 0; i < 4; ++i) wv[i] = *(const u32x4*)(C.W_pool + (gx) * 16384 + (tid + 512 * i) * 8); }
        POOL_LOAD(0)
#pragma unroll 1
        for (int g = 0; g < 4; ++g) {
            __syncthreads();
#pragma unroll
            for (int i = 0; i < 5; ++i) { const int p = tid + 512 * i; if (p < 2288) *(LAS u32x4*)(ubuf + (p >> 4) * 272 + (p & 15) * 16) = ur[i]; }
#pragma unroll
            for (int i = 0; i < 4; ++i) { const int p = tid + 512 * i, d = p >> 4; const int slot = (d & ~31) + 16 * ((d >> 2) & 1) + 4 * ((d >> 3) & 3) + (d & 3); *(LAS u32x4*)(wbuf + slot * 272 + (p & 15) * 16) = wv[i]; }
            __syncthreads();
            if (g < 3) POOL_LOAD(g + 1)
            const int win = 2 << g;
            const int cnt = (t + 1 < win) ? t + 1 : win; const float rc = 1.0f / (float)cnt;
            f32x4 acc[4][2];
#pragma unroll
            for (int a = 0; a < 4; ++a) { acc[a][0] = (f32x4){0.f, 0.f, 0.f, 0.f}; acc[a][1] = (f32x4){0.f, 0.f, 0.f, 0.f}; }
#pragma unroll
            for (int kk = 0; kk < 4; ++kk) {
                const LAS unsigned char* up = ubuf + (15 + tl0) * 272 + kk * 64 + fq * 16;
                float s[8], cur[8];
                { const u32x4 wx = *(const LAS u32x4*)up; cur[0] = bf_lo(wx.x); cur[1] = bf_hi(wx.x); cur[2] = bf_lo(wx.y); cur[3] = bf_hi(wx.y); cur[4] = bf_lo(wx.z); cur[5] = bf_hi(wx.z); cur[6] = bf_lo(wx.w); cur[7] = bf_hi(wx.w); }
#pragma unroll
                for (int i = 0; i < 8; ++i) s[i] = cur[i];
                for (int j = 1; j < win; ++j) {
                    const u32x4 wx = *(const LAS u32x4*)(up - j * 272); const float m = (j <= t) ? 1.0f : 0.0f;
                    s[0] += m * bf_lo(wx.x); s[1] += m * bf_hi(wx.x); s[2] += m * bf_lo(wx.y); s[3] += m * bf_hi(wx.y); s[4] += m * bf_lo(wx.z); s[5] += m * bf_hi(wx.z); s[6] += m * bf_lo(wx.w); s[7] += m * bf_hi(wx.w); }
                u32x4 af; af.x = pk2(s[0] * rc - cur[0], s[1] * rc - cur[1]); af.y = pk2(s[2] * rc - cur[2], s[3] * rc - cur[3]); af.z = pk2(s[4] * rc - cur[4], s[5] * rc - cur[5]); af.w = pk2(s[6] * rc - cur[6], s[7] * rc - cur[7]);
                const bf16x8 a = __builtin_bit_cast(bf16x8, af);
#pragma unroll
                for (int nn = 0; nn < 4; ++nn)
#pragma unroll
                    for (int n = 0; n < 2; ++n) {
                        const bf16x8 bfr = *(const LAS bf16x8*)(wbuf + (32 * nn + 16 * n + fr) * 272 + kk * 64 + fq * 16);
                        acc[nn][n] = __builtin_amdgcn_mfma_f32_16x16x32_bf16(bfr, a, acc[nn][n], 0, 0, 0); }
            }
#pragma unroll
            for (int nn = 0; nn < 4; ++nn) { u32x4 w; w.x = pk2(acc[nn][0][0], acc[nn][0][1]); w.y = pk2(acc[nn][0][2], acc[nn][0][3]); w.z = pk2(acc[nn][1][0], acc[nn][1][1]); w.w = pk2(acc[nn][1][2], acc[nn][1][3]);
                *(u32x4*)(C.Y + (size_t)tok * 1024 + g * 128 + 32 * nn + 8 * fq) = w; }
        }
#undef POOL_LOAD
    }
}

__device__ __forceinline__ unsigned fkey(float f) { const unsigned u = __float_as_uint(f); return u ^ ((unsigned)((int)u >> 31) | 0x80000000u); }

__device__ __forceinline__ void phase_attn_simple(const Ctx& C, LAS unsigned char* lds) {
    const int tid = threadIdx.x, lane = tid & 63, wid = tid >> 6;
    LAS unsigned* sc = (LAS unsigned*)lds;
    LAS float* qif = (LAS float*)(lds + 32768);
    LAS float* qf = (LAS float*)(lds + 32768 + 1024);
    LAS unsigned* hist = (LAS unsigned*)(lds + 32768 + 1024 + 2048);
    LAS unsigned* wsum = hist + 256;
    LAS unsigned* ctl = wsum + 16;
    LAS unsigned short* sel = (LAS unsigned short*)(ctl + 8);
    LAS float* pr = (LAS float*)(sel + 256);
    LAS float* red = pr + 2048;
    LAS float* red2 = red + 64;
    for (int qx = C.bid; qx < NTOK; qx += C.G) {
        const int tok = qx, b = tok >> 13, t = tok & (SEQ - 1), n = t + 1;
        const bf16_t* prow = C.P + (size_t)tok * NAB;
        const bf16_t* pb = C.P + (size_t)(b << 13) * NAB;
        __syncthreads();
        if (tid < 256) qif[tid] = bf2f(prow[PC_QI + tid]);
        qf[tid] = bf2f(prow[PC_Q + tid]);
        if (tid == 0) { ctl[0] = 0u; ctl[1] = TOPK; ctl[2] = 0u; }
        float wi[4];
#pragma unroll
        for (int h = 0; h < 4; ++h) wi[h] = bf2f(prow[PC_WI + h]) * 0.0625f;
        __syncthreads();
        for (int s = tid; s < n; s += 512) {
            asm volatile("" ::: "memory");
            const u32x4* kr = (const u32x4*)(pb + (size_t)s * NAB + PC_KI);
            float d0 = 0.f, d1 = 0.f, d2 = 0.f, d3 = 0.f;
#pragma unroll
            for (int q = 0; q < 8; ++q) { const u32x4 w = kr[q]; const float kv[8] = {bf_lo(w.x), bf_hi(w.x), bf_lo(w.y), bf_hi(w.y), bf_lo(w.z), bf_hi(w.z), bf_lo(w.w), bf_hi(w.w)};
#pragma unroll
                for (int j = 0; j < 8; ++j) { const int d = 8 * q + j; d0 += qif[d] * kv[j]; d1 += qif[64 + d] * kv[j]; d2 += qif[128 + d] * kv[j]; d3 += qif[192 + d] * kv[j]; } }
            float scv = 0.0f;
            scv = fmaf(wi[0], fmaxf(d0, 0.f), scv); scv = fmaf(wi[1], fmaxf(d1, 0.f), scv); scv = fmaf(wi[2], fmaxf(d2, 0.f), scv); scv = fmaf(wi[3], fmaxf(d3, 0.f), scv);
            sc[s] = fkey(scv);
        }
        __syncthreads();
        int nsel;
        if (n <= TOPK) { if (tid < n) sel[tid] = (unsigned short)tid; nsel = n; }
        else {
            nsel = TOPK;
            for (int pass = 0; pass < 4; ++pass) {
                const int shift = 24 - 8 * pass;
                if (tid < 256) hist[tid] = 0u;
                __syncthreads();
                const unsigned prefix = ctl[0]; const unsigned himask = (pass == 0) ? 0u : (0xffffffffu << (shift + 8));
                for (int s = tid; s < n; s += 512) { const unsigned k = sc[s]; if ((k & himask) == prefix) __hip_atomic_fetch_add(&hist[(k >> shift) & 255u], 1u, __ATOMIC_RELAXED, __HIP_MEMORY_SCOPE_WORKGROUP); }
                __syncthreads();
                if (wid == 0) {
                    const unsigned need = ctl[1];
                    const unsigned c0 = hist[255 - 4 * lane], c1 = hist[254 - 4 * lane], c2 = hist[253 - 4 * lane], c3 = hist[252 - 4 * lane];
                    const unsigned tot = c0 + c1 + c2 + c3; unsigned incl = tot;
#pragma unroll
                    for (int o = 1; o < 64; o <<= 1) { const unsigned v = __shfl_up(incl, o); if (lane >= o) incl += v; }
                    const unsigned excl = incl - tot;
                    if (excl < need && need <= incl) {
                        const unsigned r = need - excl; unsigned bin, above;
                        if (r <= c0) { bin = 255 - 4 * lane; above = excl; }
                        else if (r <= c0 + c1) { bin = 254 - 4 * lane; above = excl + c0; }
                        else if (r <= c0 + c1 + c2) { bin = 253 - 4 * lane; above = excl + c0 + c1; }
                        else { bin = 252 - 4 * lane; above = excl + c0 + c1 + c2; }
                        ctl[0] = prefix | (bin << shift); ctl[1] = need - above;
                    }
                }
                __syncthreads();
            }
            const unsigned T = ctl[0], mneed = ctl[1];
            unsigned ceq = 0;
#pragma unroll
            for (int j = 0; j < 16; ++j) { const int s = tid * 16 + j; if (s < n && sc[s] == T) ++ceq; }
            unsigned incl = ceq;
#pragma unroll
            for (int o = 1; o < 64; o <<= 1) { const unsigned v = __shfl_up(incl, o); if (lane >= o) incl += v; }
            if (lane == 63) wsum[wid] = incl;
            __syncthreads();
            unsigned base = 0;
            for (int w = 0; w < wid; ++w) base += wsum[w];
            unsigned rank = base + incl - ceq;
            for (int j = 0; j < 16; ++j) { const int s = tid * 16 + j;
                if (s < n) { const unsigned k = sc[s]; bool take = k > T; if (k == T) { take = rank < mneed; ++rank; }
                    if (take) { const unsigned slot = __hip_atomic_fetch_add(&ctl[2], 1u, __ATOMIC_RELAXED, __HIP_MEMORY_SCOPE_WORKGROUP); if (slot < TOPK) sel[slot] = (unsigned short)s; } } }
        }
        __syncthreads();
        {
            const int j = tid & 255, hh = tid >> 8;
            float sv[4] = {-INFINITY, -INFINITY, -INFINITY, -INFINITY};
            if (j < nsel) {
                const u32x4* kr = (const u32x4*)(pb + (size_t)sel[j] * NAB + PC_K + 64 * hh);
                float d[4] = {0.f, 0.f, 0.f, 0.f};
#pragma unroll
                for (int q = 0; q < 8; ++q) { const u32x4 w = kr[q]; const float kv[8] = {bf_lo(w.x), bf_hi(w.x), bf_lo(w.y), bf_hi(w.y), bf_lo(w.z), bf_hi(w.z), bf_lo(w.w), bf_hi(w.w)};
#pragma unroll
                    for (int e = 0; e < 8; ++e)
#pragma unroll
                        for (int r = 0; r < 4; ++r) d[r] += qf[(4 * hh + r) * 64 + 8 * q + e] * kv[e]; }
#pragma unroll
                for (int r = 0; r < 4; ++r) sv[r] = d[r] * 0.125f;
            }
#pragma unroll
            for (int r = 0; r < 4; ++r) { float m = sv[r];
#pragma unroll
                for (int o = 1; o < 64; o <<= 1) m = fmaxf(m, __shfl_xor(m, o));
                if (lane == 0) red[(4 * hh + r) * 8 + (wid & 3)] = m; }
            __syncthreads();
            float ev[4];
#pragma unroll
            for (int r = 0; r < 4; ++r) { const int h = 4 * hh + r; const float m = fmaxf(fmaxf(red[h * 8], red[h * 8 + 1]), fmaxf(red[h * 8 + 2], red[h * 8 + 3]));
                ev[r] = (j < nsel) ? __expf(sv[r] - m) : 0.f; float sm = ev[r];
#pragma unroll
                for (int o = 1; o < 64; o <<= 1) sm += __shfl_xor(sm, o);
                if (lane == 0) red2[h * 8 + (wid & 3)] = sm; }
            __syncthreads();
#pragma unroll
            for (int r = 0; r < 4; ++r) { const int h = 4 * hh + r; const float sm = (red2[h * 8] + red2[h * 8 + 1]) + (red2[h * 8 + 2] + red2[h * 8 + 3]);
                pr[h * 256 + j] = ev[r] / sm; }
        }
        __syncthreads();
        {
            const int h = tid >> 6, g = h >> 2; float o = 0.f;
            const bf16_t* vb = pb + PC_V + 64 * g + lane;
            for (int j = 0; j < nsel; ++j) o += pr[h * 256 + j] * bf2f(vb[(size_t)sel[j] * NAB]);
            C.Y[(size_t)tok * 1024 + 512 + tid] = (bf16_t)(pk2(o, 0.f) & 0xffffu);
        }
    }
}

__device__ __forceinline__ void phase_hgrn_simple(const Ctx& C) {
    const int tid = threadIdx.x, lane = tid & 63, wid = tid >> 6;
    for (int unit = C.bid; unit < BATCH * 8 * 8; unit += C.G) {
        const int b = unit >> 6, h = (unit >> 3) & 7, sl = unit & 7;
        const int e = sl * 16 + 2 * wid + (lane >> 5), dg = lane & 31;
        const size_t cq = (size_t)h * 128 + 4 * dg, cv = (size_t)h * 128 + e;
        float S0 = 0.f, S1 = 0.f, S2 = 0.f, S3 = 0.f;
        const size_t tok0 = (size_t)b * SEQ;
        for (int t0 = 0; t0 < SEQ; t0 += 8) {
            u32x2 qv[8], kv[8]; bf16_t vv[8];
#pragma unroll
            for (int u = 0; u < 8; ++u) { const size_t ro = (tok0 + t0 + u) * 1024; qv[u] = *(const u32x2*)(C.L1Q + ro + cq); kv[u] = *(const u32x2*)(C.L1K + ro + cq); vv[u] = C.L1I[ro + cv]; }
#pragma unroll
            for (int u = 0; u < 8; ++u) {
                const float k0 = bf_lo(kv[u].x), k1 = bf_hi(kv[u].x), k2 = bf_lo(kv[u].y), k3 = bf_hi(kv[u].y), v = bf2f(vv[u]);
                S0 = (1.0f - k0) * S0 + k0 * v; S1 = (1.0f - k1) * S1 + k1 * v; S2 = (1.0f - k2) * S2 + k2 * v; S3 = (1.0f - k3) * S3 + k3 * v;
                float o = (bf_lo(qv[u].x) * S0 + bf_hi(qv[u].x) * S1) + (bf_lo(qv[u].y) * S2 + bf_hi(qv[u].y) * S3);
#pragma unroll
                for (int off = 1; off < 32; off <<= 1) o += __shfl_xor(o, off);
                if (dg == 0) C.ORAW[(tok0 + t0 + u) * 1024 + cv] = (bf16_t)(pk2(o, 0.f) & 0xffffu);
            }
        }
    }
}
__device__ __forceinline__ void phase_hgrn_post(const Ctx& C) {
    const int tid = threadIdx.x, lane = tid & 63, wave = tid >> 6;
    const int gw = C.bid * 8 + wave, NGW = C.G * 8;
    for (int tok = gw; tok < NTOK; tok += NGW) {
        const size_t ro = (size_t)tok * 1024 + 16 * lane;
        const u32x4 a0 = *(const u32x4*)(C.ORAW + ro), a1 = *(const u32x4*)(C.ORAW + ro + 8), g0 = *(const u32x4*)(C.L1G + ro), g1 = *(const u32x4*)(C.L1G + ro + 8);
        const unsigned aw[8] = {a0.x, a0.y, a0.z, a0.w, a1.x, a1.y, a1.z, a1.w}, gwd[8] = {g0.x, g0.y, g0.z, g0.w, g1.x, g1.y, g1.z, g1.w};
        float ss = 0.f;
#pragma unroll
        for (int i = 0; i < 8; ++i) { const float x = bf_lo(aw[i]), y = bf_hi(aw[i]); ss += x * x + y * y; }
        ss += __shfl_xor(ss, 1); ss += __shfl_xor(ss, 2); ss += __shfl_xor(ss, 4);
        const float r = 1.0f / sqrtf(ss * (1.0f / 128.0f) + EPS);
        const float* nw = C.hgrn_out_norm + 16 * (lane & 7);
        unsigned ow[8];
#pragma unroll
        for (int i = 0; i < 8; ++i) ow[i] = pk2(bf_lo(aw[i]) * r * nw[2 * i] * bf_lo(gwd[i]), bf_hi(aw[i]) * r * nw[2 * i + 1] * bf_hi(gwd[i]));
        *(u32x4*)(C.Y + ro) = (u32x4){ow[0], ow[1], ow[2], ow[3]}; *(u32x4*)(C.Y + ro + 8) = (u32x4){ow[4], ow[5], ow[6], ow[7]};
    }
}
__device__ __forceinline__ void phase_final_norm(const Ctx& C) {
    const bool grp = C.G == 256;
    const int gt = grp ? (C.bid >> 3) * 512 + (int)threadIdx.x : C.bid * 512 + (int)threadIdx.x, NGT = grp ? 32 * 512 : C.G * 512, NEL = grp ? 4096 * 128 : NTOK * 128, rbase = grp ? 4096 * (C.bid & 7) : 0;
    for (int i = gt; i < NEL; i += NGT) { const int row = rbase + (i >> 7), c8 = (i & 127) * 8;
        const float r = pg8::row_rinv(C.part, row);
        const u32x4 b = *(const u32x4*)(C.XB + (size_t)row * 1024 + c8); const f32x4 g0 = *(const f32x4*)(C.ln_final + c8), g1 = *(const f32x4*)(C.ln_final + c8 + 4);
        f32x4 o0, o1; o0[0] = bf_lo(b.x) * r * g0[0]; o0[1] = bf_hi(b.x) * r * g0[1]; o0[2] = bf_lo(b.y) * r * g0[2]; o0[3] = bf_hi(b.y) * r * g0[3];
        o1[0] = bf_lo(b.z) * r * g1[0]; o1[1] = bf_hi(b.z) * r * g1[1]; o1[2] = bf_lo(b.w) * r * g1[2]; o1[3] = bf_hi(b.w) * r * g1[3];
        *(f32x4*)(C.out + (size_t)row * 1024 + c8) = o0; *(f32x4*)(C.out + (size_t)row * 1024 + c8 + 4) = o1; }
}

typedef float f32x16 __attribute__((ext_vector_type(16)));
typedef float f32x2 __attribute__((ext_vector_type(2)));
constexpr int AQ = 32;
constexpr int A_SEL = 131072;
constexpr int A_QS = A_SEL + AQ * 256 * 2;
constexpr int VROW = 144;

__device__ __forceinline__ float relu_f(float x) { const int b = __float_as_int(x); return __int_as_float(b > 0 ? b : 0); }
__device__ __forceinline__ void idx_tile16(const bf16x8 k0, const bf16x8 k1, const bf16x8 (&qb)[4][2], const float (&wq)[4], float (&sc)[4]) {
#pragma unroll
    for (int r = 0; r < 4; ++r) sc[r] = 0.0f;
#pragma unroll
    for (int h = 0; h < 4; ++h) { f32x4 a = (f32x4){0.f, 0.f, 0.f, 0.f};
        a = __builtin_amdgcn_mfma_f32_16x16x32_bf16(k0, qb[h][0], a, 0, 0, 0); a = __builtin_amdgcn_mfma_f32_16x16x32_bf16(k1, qb[h][1], a, 0, 0, 0);
#pragma unroll
        for (int r = 0; r < 4; ++r) sc[r] = fmaf(wq[h], relu_f(a[r]), sc[r]); }
}


__device__ __forceinline__ unsigned wave_incl_scan(unsigned v, int lane) {
    v += (unsigned)__builtin_amdgcn_update_dpp(0, (int)v, 0x111, 0xf, 0xf, false);
    v += (unsigned)__builtin_amdgcn_update_dpp(0, (int)v, 0x112, 0xf, 0xf, false);
    v += (unsigned)__builtin_amdgcn_update_dpp(0, (int)v, 0x114, 0xf, 0xf, false);
    v += (unsigned)__builtin_amdgcn_update_dpp(0, (int)v, 0x118, 0xf, 0xf, false);
    const unsigned r0 = (unsigned)__builtin_amdgcn_readlane((int)v, 15), r1 = (unsigned)__builtin_amdgcn_readlane((int)v, 31), r2 = (unsigned)__builtin_amdgcn_readlane((int)v, 47);
    const int row = lane >> 4;
    return v + (row >= 1 ? r0 : 0u) + (row >= 2 ? r1 : 0u) + (row >= 3 ? r2 : 0u);
}

__device__ __forceinline__ void phase_attn(const Ctx& C, LAS unsigned char* lds) {
    const int tid = threadIdx.x, lane0 = tid & 63, wid = __builtin_amdgcn_readfirstlane(tid >> 6);
    LAS unsigned* hist = (LAS unsigned*)lds;
    LAS unsigned short* sel = (LAS unsigned short*)(lds + A_SEL);
    LAS unsigned* tpool = (LAS unsigned*)(lds + 65536); constexpr int TCAP = 16384;
    LAS unsigned* dummy = (LAS unsigned*)(lds + A_QS + 1024) + tid;
    LAS unsigned* bmp = (LAS unsigned*)(lds + 32768);
    LAS int* q_bin = (LAS int*)(lds + A_QS); LAS int* q_need = q_bin + 32; LAS int* q_cnt = q_bin + 64; LAS int* q_off = q_bin + 96; LAS int* q_selc = q_bin + 128; LAS int* q_tiec = q_bin + 160;
    unsigned* pool = (unsigned*)((unsigned char*)C.ctl + (C.bid < 64 ? WS_XB + (size_t)C.bid * MiB : 296 * MiB + (size_t)(C.bid - 64) * MiB));
    const int nbw = C.G >> 2, ntile = SEQ / AQ, jb = C.bid >> 2;
    for (int ui = 0; ui * nbw < ntile; ++ui) {
        const int rank = ui * nbw + ((ui & 1) ? (nbw - 1 - jb) : jb);
        if (jb >= nbw || rank >= ntile) continue;
        const int tile = (ntile - 1) - rank, b = C.bid & 3, t0 = tile * AQ, tok0 = b * SEQ + t0;
        const bf16_t* pb = C.P + (size_t)(b * SEQ) * NAB;
        const unsigned char* kv8b = (const unsigned char*)C.ctl + WS_KV8 + (size_t)(b * SEQ) * 256;
        __syncthreads();
        int ln = lane0; asm volatile("" : "+v"(ln)); const int lane = ln;
        if (t0 < TOPK) {
            int tf = tid; asm volatile("" : "+v"(tf));
            for (int i = tf; i < AQ * 256; i += 512) { const int q = i >> 8, j = i & 255; sel[i] = (unsigned short)((j <= t0 + q) ? j : 0); }
        } else {
            for (int i = tid; i < AQ * 1024 / 4; i += 512) ((LAS u32x4*)hist)[i] = (u32x4){0u, 0u, 0u, 0u};
            const int qc = ln & 15, fq = ln >> 4;
            bf16x8 qb[2][4][2]; float wq[2][4];
#pragma unroll
            for (int hf = 0; hf < 2; ++hf) { const bf16_t* qrow = C.P + (size_t)(tok0 + 16 * hf + qc) * NAB;
#pragma unroll
              for (int h = 0; h < 4; ++h) { wq[hf][h] = bf2f(qrow[PC_WI + h]) * 0.0625f;
#pragma unroll
                  for (int ks = 0; ks < 2; ++ks) qb[hf][h][ks] = *(const bf16x8*)(qrow + PC_QI + h * 64 + ks * 32 + 8 * fq); } }
            const int kdiag0 = 2 * tile;
            const bf16_t* kbase = pb + (size_t)qc * NAB + PC_KI + 8 * fq;
            __syncthreads();
            bf16x8 kr[4][2]; const int kmaxt = kdiag0 + 1;
#define IDX_RING_LOAD(j, ktx) { const int ktc_ = ((ktx) <= kmaxt) ? (ktx) : kmaxt; const bf16_t* kp_ = kbase + (size_t)(ktc_ * 16) * NAB; kr[j][0] = *(const bf16x8*)kp_; kr[j][1] = *(const bf16x8*)(kp_ + 32); }
#pragma unroll
            for (int j = 0; j < 4; ++j) IDX_RING_LOAD(j, wid + 8 * j)
            for (int kt0 = wid; kt0 <= kmaxt; kt0 += 32) {
#pragma unroll
                for (int j = 0; j < 4; ++j) { const int kt = kt0 + 8 * j;
                    if (kt <= kmaxt) {
#pragma unroll
                        for (int hf = 0; hf < 2; ++hf) if (kt <= kdiag0 + hf) {
                            float sc[4]; idx_tile16(kr[j][0], kr[j][1], qb[hf], wq[hf], sc);
                            const int qn = 16 * hf + qc; LAS unsigned* hrow = hist + qn * 1024;
                            if (kt != kdiag0 + hf) {
#pragma unroll
                                for (int r = 0; r < 4; ++r) { const unsigned bin = fkey(sc[r]) >> 21;
                                    __hip_atomic_fetch_add(&hrow[(bin >> 1) ^ (unsigned)qn], (bin & 1u) ? 65536u : 1u, __ATOMIC_RELAXED, __HIP_MEMORY_SCOPE_WORKGROUP); }
                            } else {
#pragma unroll
                                for (int r = 0; r < 4; ++r) { const unsigned bin = fkey(sc[r]) >> 21;
                                    __hip_atomic_fetch_add(&hrow[(bin >> 1) ^ (unsigned)qn], (4 * fq + r <= qc) ? ((bin & 1u) ? 65536u : 1u) : 0u, __ATOMIC_RELAXED, __HIP_MEMORY_SCOPE_WORKGROUP); } } } }
                    IDX_RING_LOAD(j, kt + 32) }
            }
            __syncthreads();
#if defined(DBG_REPEAT) && DBG_REPEAT == 35
#pragma unroll 1
            for (int i8 = 0; i8 < 8; ++i8) { const int i = i8 & 3; const int q = 4 * wid + i;
#else
#pragma unroll 1
            for (int i = 0; i < 4; ++i) { const int q = 4 * wid + i;
#endif
                unsigned hw[16]; unsigned tot = 0;
#pragma unroll
                for (int j = 0; j < 16; ++j) { hw[j] = hist[q * 1024 + ((1023 - 16 * lane - j) ^ q)]; tot += (hw[j] & 0xffffu) + (hw[j] >> 16); }
                const unsigned incl = wave_incl_scan(tot, lane);
                const unsigned excl = incl - tot;
                if (excl < TOPK && TOPK <= incl) {
                    unsigned run = excl; int fbin = -1; unsigned fabove = 0, fcnt = 0;
#pragma unroll
                    for (int j = 0; j < 16; ++j) {
                        const unsigned chi = hw[j] >> 16, clo = hw[j] & 0xffffu; const int wbin = 2 * (1023 - 16 * lane - j);
                        if (fbin < 0 && run + chi >= TOPK) { fbin = wbin + 1; fabove = run; fcnt = chi; } run += chi;
                        if (fbin < 0 && run + clo >= TOPK) { fbin = wbin; fabove = run; fcnt = clo; } run += clo; }
                    q_bin[q] = fbin; q_need[q] = TOPK - (int)fabove; q_cnt[q] = (int)fcnt; q_selc[q] = 0; q_tiec[q] = 0;
                } }
            __syncthreads();
            for (int i = tid; i < AQ * 256 / 4; i += 512) ((LAS u32x4*)bmp)[i] = (u32x4){0u, 0u, 0u, 0u};
            if (tid < 32) { int tq = tid; asm volatile("" : "+v"(tq));
                int c = q_cnt[tq], incl = c;
#pragma unroll
                for (int o = 1; o < 32; o <<= 1) { const int v = __shfl_up(incl, o); if (tq >= o) incl += v; }
                q_off[tq] = incl - c; }
            __syncthreads();
            unsigned mybin[2]; int myoff[2];
#pragma unroll
            for (int hf = 0; hf < 2; ++hf) { mybin[hf] = (unsigned)q_bin[16 * hf + qc]; myoff[hf] = q_off[16 * hf + qc]; }
#if defined(DBG_REPEAT) && (DBG_REPEAT == 34 || DBG_REPEAT == 36)
#pragma unroll 1
            for (int rep34 = 0; rep34 < 2; ++rep34) {
            if (rep34 && DBG_REPEAT == 34) { __syncthreads(); if (tid < 32) q_tiec[tid] = 0; __syncthreads(); }
#endif
#pragma unroll
            for (int j = 0; j < 4; ++j) IDX_RING_LOAD(j, wid + 8 * j)
            for (int kt0 = wid; kt0 <= kmaxt; kt0 += 32) {
#pragma unroll
                for (int j = 0; j < 4; ++j) { const int kt = kt0 + 8 * j;
                    if (kt <= kmaxt) {
#pragma unroll
                for (int hf = 0; hf < 2; ++hf) if (kt <= kdiag0 + hf) {
                    float sc[4]; idx_tile16(kr[j][0], kr[j][1], qb[hf], wq[hf], sc);
                    const bool diag = kt == kdiag0 + hf; const int qn = 16 * hf + qc; const int s0 = kt * 16 + 4 * fq;
                    unsigned amask = 0u, ent[4]; int nt = 0; bool ist[4];
#pragma unroll
                    for (int r = 0; r < 4; ++r) { const unsigned key = fkey(sc[r]); const unsigned bin = key >> 21;
                        amask |= (bin > mybin[hf]) ? (1u << r) : 0u; ist[r] = bin == mybin[hf];
                        ent[r] = (((key >> 2) & 0x7ffffu) << 13) | (unsigned)(8191 - (s0 + r)); }
                    if (diag) {
#pragma unroll
                        for (int r = 0; r < 4; ++r) { const bool v = 4 * fq + r <= qc; amask &= v ? ~0u : ~(1u << r); ist[r] = ist[r] && v; } }
#pragma unroll
                    for (int r = 0; r < 4; ++r) nt += ist[r] ? 1 : 0;
                    __hip_atomic_fetch_or(&bmp[qn * 256 + (s0 >> 5)], amask << (s0 & 31), __ATOMIC_RELAXED, __HIP_MEMORY_SCOPE_WORKGROUP);
#if defined(DBG_REPEAT) && DBG_REPEAT == 36
                    int vi = myoff[hf]; if (rep34 == 0) vi += __hip_atomic_fetch_add(&q_tiec[qn], nt, __ATOMIC_RELAXED, __HIP_MEMORY_SCOPE_WORKGROUP);
                    if (rep34) { for (int r = 0; r < 4; ++r) ist[r] = false; nt = 0; }
#else
                    int vi = myoff[hf] + __hip_atomic_fetch_add(&q_tiec[qn], nt, __ATOMIC_RELAXED, __HIP_MEMORY_SCOPE_WORKGROUP);
#endif
                    if (__ballot(nt > 0 && vi + nt > TCAP) == 0ull) {
#pragma unroll
                        for (int r = 0; r < 4; ++r) { LAS unsigned* dst = ist[r] ? (tpool + vi) : dummy; *dst = ent[r]; vi += ist[r] ? 1 : 0; }
                    } else {
#pragma unroll
                        for (int r = 0; r < 4; ++r) if (ist[r]) { if (vi < TCAP) tpool[vi] = ent[r]; else pool[vi] = ent[r]; ++vi; } } }
                    }
                    IDX_RING_LOAD(j, kt + 32) }
            }
#if defined(DBG_REPEAT) && (DBG_REPEAT == 34 || DBG_REPEAT == 36)
            }
#endif
#undef IDX_RING_LOAD
            __syncthreads();
#if defined(DBG_REPEAT) && DBG_REPEAT == 33
#pragma unroll 1
            for (int rep33 = 0; rep33 < 2; ++rep33)
#endif
            {
                int cq[4], offq[4], Rq[4]; unsigned needq[4], thrq[4], actq[4], validq[4]; constexpr int NR = 10; unsigned ev[4][NR]; bool slowq[4];
#pragma unroll
                for (int i = 0; i < 4; ++i) { const int q = 4 * wid + i; cq[i] = q_cnt[q]; offq[i] = q_off[q]; const int m = q_need[q];
                    needq[i] = (unsigned)(m < cq[i] ? m : cq[i]);
                    slowq[i] = cq[i] > 64 * NR; Rq[i] = slowq[i] ? 0 : (cq[i] + 63) >> 6; thrq[i] = 0u; actq[i] = 0u; }
#pragma unroll
                for (int i = 0; i < 4; ++i)
#pragma unroll
                    for (int r = 0; r < NR; ++r) { const int e = lane + 64 * r; const bool in = e < cq[i] && !slowq[i]; const int vi = offq[i] + (e < cq[i] ? e : cq[i] - 1); const unsigned v = (vi < TCAP) ? tpool[vi] : pool[vi]; ev[i][r] = in ? v : 0u; actq[i] |= in ? (1u << r) : 0u; }
#pragma unroll
                for (int i = 0; i < 4; ++i) validq[i] = actq[i];
                const int Rmax = max(max(Rq[0], Rq[1]), max(Rq[2], Rq[3]));
#pragma unroll 1
                for (int p = 3; p >= 0; --p) { const int shift = 8 * p;
#pragma unroll
                    for (int i = 0; i < 4; ++i) *(LAS u32x4*)(lds + (wid * 4 + i) * 1024 + 16 * lane) = (u32x4){0u, 0u, 0u, 0u};
#pragma unroll
                    for (int r = 0; r < NR; ++r) if (r < Rmax) {
#pragma unroll
                        for (int i = 0; i < 4; ++i) { LAS unsigned* wh = (LAS unsigned*)(lds + (wid * 4 + i) * 1024); if ((actq[i] >> r) & 1u) __hip_atomic_fetch_add(&wh[(ev[i][r] >> shift) & 255u], 1u, __ATOMIC_RELAXED, __HIP_MEMORY_SCOPE_WORKGROUP); } }
                    u32x4 hv[4]; unsigned tot[4], incl[4];
#pragma unroll
                    for (int i = 0; i < 4; ++i) { hv[i] = *(const LAS u32x4*)(lds + (wid * 4 + i) * 1024 + 16 * (63 - lane)); tot[i] = (hv[i].x + hv[i].y) + (hv[i].z + hv[i].w); }
#pragma unroll
                    for (int i = 0; i < 4; ++i) incl[i] = wave_incl_scan(tot[i], lane);
#pragma unroll
                    for (int i = 0; i < 4; ++i) { const unsigned excl = incl[i] - tot[i], need = needq[i]; const bool cross = excl < need && need <= incl[i];
                        unsigned dig = 252u - 4u * (unsigned)lane, ab = excl + hv[i].w + hv[i].z + hv[i].y;
                        if (excl + hv[i].w >= need) { dig += 3u; ab = excl; } else if (excl + hv[i].w + hv[i].z >= need) { dig += 2u; ab = excl + hv[i].w; } else if (excl + hv[i].w + hv[i].z + hv[i].y >= need) { dig += 1u; ab = excl + hv[i].w + hv[i].z; }
                        const unsigned long long bm = __ballot(cross);
                        if (bm) { const int src = __ffsll(bm) - 1; dig = (unsigned)__shfl((int)dig, src); ab = (unsigned)__shfl((int)ab, src);
                            thrq[i] |= dig << shift; needq[i] = need - ab;
                            unsigned keep = 0u;
#pragma unroll
                            for (int r = 0; r < NR; ++r) keep |= (((ev[i][r] >> shift) & 255u) == dig) ? (1u << r) : 0u;
                            actq[i] &= keep; } }
                }
#pragma unroll
                for (int i = 0; i < 4; ++i) { LAS unsigned* bq = bmp + (4 * wid + i) * 256;
#pragma unroll
                    for (int r = 0; r < NR; ++r) if (r < Rmax) { if (((validq[i] >> r) & 1u) && ev[i][r] >= thrq[i]) { const unsigned ix = 8191u - (ev[i][r] & 8191u); __hip_atomic_fetch_or(&bq[ix >> 5], 1u << (ix & 31u), __ATOMIC_RELAXED, __HIP_MEMORY_SCOPE_WORKGROUP); } } }
#pragma unroll 1
                for (int i = 0; i < 4; ++i) if (slowq[i]) { const int c = cq[i], off = offq[i]; LAS unsigned* bq = bmp + (4 * wid + i) * 256;
                    unsigned need = needq[i], thr = 0u;
#pragma unroll 1
                    for (int bit = 31; bit >= 0; --bit) { unsigned cnt1 = 0; const unsigned hm = (bit == 31) ? 0u : (0xffffffffu << (bit + 1));
                        for (int e = lane; e < c; e += 64) { const int vi = off + e; const unsigned v = (vi < TCAP) ? tpool[vi] : pool[vi]; if ((v & hm) == thr && ((v >> bit) & 1u)) ++cnt1; }
#pragma unroll
                        for (int o = 1; o < 64; o <<= 1) cnt1 += __shfl_xor(cnt1, o);
                        if (cnt1 >= need) thr |= 1u << bit; else need -= cnt1; }
                    for (int e = lane; e < c; e += 64) { const int vi = off + e; const unsigned v = (vi < TCAP) ? tpool[vi] : pool[vi]; if (v >= thr) { const unsigned ix = 8191u - (v & 8191u); __hip_atomic_fetch_or(&bq[ix >> 5], 1u << (ix & 31u), __ATOMIC_RELAXED, __HIP_MEMORY_SCOPE_WORKGROUP); } } }
                u32x4 bw[4]; unsigned cntb[4], inb[4];
#pragma unroll
                for (int i = 0; i < 4; ++i) { bw[i] = *(const LAS u32x4*)(bmp + (4 * wid + i) * 256 + 4 * lane); cntb[i] = (unsigned)((__popc(bw[i].x) + __popc(bw[i].y)) + (__popc(bw[i].z) + __popc(bw[i].w))); }
#pragma unroll
                for (int i = 0; i < 4; ++i) inb[i] = wave_incl_scan(cntb[i], lane);
#pragma unroll
                for (int i = 0; i < 4; ++i) { LAS unsigned short* sq = sel + (4 * wid + i) * 256; int pos = (int)(inb[i] - cntb[i]); const unsigned w4[4] = {bw[i].x, bw[i].y, bw[i].z, bw[i].w};
#pragma unroll
                    for (int wi = 0; wi < 4; ++wi) { unsigned w = w4[wi]; while (w) { const int bp = __ffs((int)w) - 1; if (pos < 256) sq[pos] = (unsigned short)((4 * lane + wi) * 32 + bp); ++pos; w &= w - 1u; } } }
            }
        }
        __syncthreads();
#ifndef A_EXP2
        LAS unsigned char* pbuf = lds + wid * 16384;
        LAS unsigned char* vbuf = pbuf + 4096;
        int ln2 = lane0; asm volatile("" : "+v"(ln2));
        const int hh = ln2 & 15, fq = ln2 >> 4;
        typedef int i32x2 __attribute__((ext_vector_type(2)));
        const unsigned char* kgb = kv8b + (ln2 & 7) * 16;
        LAS unsigned char* kstw = vbuf + (ln2 >> 3) * 144 + (ln2 & 7) * 16; const LAS unsigned char* kstr = vbuf + hh * 144 + 8 * fq;
        const unsigned char* vgb = kv8b + 128 + (ln2 & 3) * 16;
#define ATT_LOADK(kk, sqx, b4) { _Pragma("unroll") for (int i8 = 0; i8 < 8; ++i8) { const int kidx = (sqx)[64 * (b4) + 8 * i8 + (ln2 >> 3)]; kk[i8] = *(const u32x4*)(kgb + (size_t)kidx * 256); } }
#define ATT_MMAK(kk, b4) { _Pragma("unroll") for (int i8 = 0; i8 < 8; ++i8) *(LAS u32x4*)(kstw + i8 * (8 * 144)) = kk[i8]; \
    _Pragma("unroll") for (int j4 = 0; j4 < 4; ++j4) { f32x4 a = (f32x4){0.f, 0.f, 0.f, 0.f}; _Pragma("unroll") for (int k4 = 0; k4 < 4; ++k4) a = __builtin_amdgcn_mfma_f32_16x16x32_fp8_fp8(*(const LAS long*)(kstr + j4 * (16 * 144) + 32 * k4), qf[k4], a, 0, 0, 0); S[4 * (b4) + j4] = a; } }
#define ATT_LOADV(slot, sqx, chx) { _Pragma("unroll") for (int p2 = 0; p2 < 2; ++p2) { const unsigned char* vp = vgb + (size_t)(sqx)[32 * (chx) + (ln2 >> 2) + 16 * p2] * 256; vr[slot][0][p2] = *(const u32x4*)vp; vr[slot][1][p2] = *(const u32x4*)(vp + 64); } }
#define ATT_LOADQ(tokx) { _Pragma("unroll") for (int kk = 0; kk < 4; ++kk) { u32x4 w = (u32x4){0u, 0u, 0u, 0u}; if (hh < 8 && (hh >> 2) == (kk >> 1)) w = *(const u32x4*)(C.P + (size_t)(tokx) * NAB + PC_Q + hh * 64 + (kk & 1) * 32 + 8 * fq); qraw[kk] = w; } }
#if defined(DBG_REPEAT) && DBG_REPEAT == 31
#pragma unroll 1
        for (int rep31 = 0; rep31 < 2; ++rep31)
#endif
        {
        u32x4 kA[8], kB[8]; u32x4 qraw[4]; u32x4 vr[3][2][2];
        { const LAS unsigned short* sq0 = sel + (4 * wid) * 256; ATT_LOADQ(tok0 + 4 * wid) ATT_LOADK(kA, sq0, 0) ATT_LOADK(kB, sq0, 1) }
#pragma unroll 1
        for (int iq = 0; iq < 4; ++iq) {
            const int q = 4 * wid + iq, tok = tok0 + q, t = t0 + q, nsel = (t + 1 < TOPK) ? t + 1 : TOPK;
            const LAS unsigned short* sq = sel + q * 256;
            {
                long qf[4];
#pragma unroll
                for (int kk = 0; kk < 4; ++kk) { const u32x2 f8 = bf8_to_fp8(qraw[kk]); qf[kk] = (long)(((unsigned long long)f8.y << 32) | f8.x); }
                f32x4 S[16];
                ATT_MMAK(kA, 0) ATT_LOADK(kA, sq, 2)
                ATT_MMAK(kB, 1) ATT_LOADK(kB, sq, 3)
                ATT_MMAK(kA, 2) ATT_MMAK(kB, 3)
                ATT_LOADV(0, sq, 0) ATT_LOADV(1, sq, 1) ATT_LOADV(2, sq, 2)
                float mx = -INFINITY;
                if (nsel < TOPK) {
                    const int nrel = nsel - 4 * fq;
#pragma unroll
                    for (int tl = 0; tl < 16; ++tl)
#pragma unroll
                        for (int r = 0; r < 4; ++r) S[tl][r] = ((16 * tl + r) < nrel) ? S[tl][r] : -INFINITY; }
#pragma unroll
                for (int tl = 0; tl < 16; ++tl)
#pragma unroll
                    for (int r = 0; r < 4; ++r) mx = fmaxf(mx, S[tl][r]);
                mx = fmaxf(mx, __shfl_xor(mx, 16)); mx = fmaxf(mx, __shfl_xor(mx, 32));
                const float cexp = 0.125f * 1.44269504088896f, moff = -mx * cexp;
                float sm = 0.f;
#pragma unroll
                for (int tl = 0; tl < 16; ++tl)
#pragma unroll
                    for (int r = 0; r < 4; ++r) { const float e = __builtin_amdgcn_exp2f(fmaf(S[tl][r], cexp, moff)); S[tl][r] = e; sm += e; }
                sm += __shfl_xor(sm, 16); sm += __shfl_xor(sm, 32);
                const float inv = 1.0f / sm;
#pragma unroll
                for (int ch = 0; ch < 8; ++ch) { u32x2 w; w.x = pk4_fp8(S[2 * ch][0] * inv, S[2 * ch][1] * inv, S[2 * ch][2] * inv, S[2 * ch][3] * inv);
                    w.y = pk4_fp8(S[2 * ch + 1][0] * inv, S[2 * ch + 1][1] * inv, S[2 * ch + 1][2] * inv, S[2 * ch + 1][3] * inv); *(LAS u32x2*)(pbuf + ch * 512 + lane * 8) = w; }
            }
            if (iq < 3) { const LAS unsigned short* sqn = sq + 256; ATT_LOADK(kA, sqn, 0) ATT_LOADK(kB, sqn, 1) }
            f32x4 O[2][4];
#pragma unroll
            for (int g = 0; g < 2; ++g)
#pragma unroll
                for (int dt = 0; dt < 4; ++dt) O[g][dt] = (f32x4){0.f, 0.f, 0.f, 0.f};
            const int tq8 = hh >> 1, tp8 = hh & 1;
            const LAS unsigned char* vtr = vbuf + ((tq8 < 4) ? (4 * fq + tq8) : (16 + 4 * fq + tq8 - 4)) * 80 + tp8 * 8;
#pragma unroll
            for (int ch = 0; ch < 8; ++ch) {
                const long pf = *(const LAS long*)(pbuf + ch * 512 + lane * 8);
#pragma unroll
                for (int g = 0; g < 2; ++g) {
#pragma unroll
                    for (int p2 = 0; p2 < 2; ++p2) *(LAS u32x4*)(vbuf + ((ln2 >> 2) + 16 * p2) * 80 + (ln2 & 3) * 16) = vr[ch % 3][g][p2];
#pragma unroll
                    for (int dt = 0; dt < 4; ++dt) {
                        const i32x2 t8 = __builtin_amdgcn_ds_read_tr8_b64_v2i32((LAS i32x2*)(vtr + dt * 16));
                        const long vb = (long)(((unsigned long long)(unsigned)t8[1] << 32) | (unsigned)t8[0]);
                        O[g][dt] = __builtin_amdgcn_mfma_f32_16x16x32_fp8_fp8(pf, vb, O[g][dt], 0, 0, 0); }
                }
                if (ch + 3 < 8) ATT_LOADV(ch % 3, sq, ch + 3)
                if (ch == 5 && iq < 3) ATT_LOADQ(tok + 1)
            }
            if (fq < 2) {
#pragma unroll
                for (int dt = 0; dt < 4; ++dt)
#pragma unroll
                    for (int r = 0; r < 4; ++r) { const float ov = (fq == 0) ? O[0][dt][r] : O[1][dt][r];
                        *(LAS bf16_t*)(pbuf + ((4 * fq + r) * 64 + dt * 16 + hh) * 2) = (bf16_t)(pk2(ov, 0.f) & 0xffffu); }
            }
            asm volatile("" ::: "memory");
            { const u32x4 ow = *(const LAS u32x4*)(pbuf + ln2 * 16); *(u32x4*)(C.Y + (size_t)tok * 1024 + 512 + ln2 * 8) = ow; }
        }
        }
#undef ATT_LOADK
#undef ATT_MMAK
#undef ATT_LOADV
#undef ATT_LOADQ
#endif
    }
}


constexpr int H_QE = 0, H_KD = 17408, H_KET = 34816, H_VT = 53248, H_AL = 71680, H_ST = 80896, H_QTOT = 115712, H_BL = 117760, H_SSQ = 118272;
constexpr int PQ = 272, PT = 144;
constexpr size_t WS_HU = 440 * MiB, WS_HLB = 460 * MiB;

__device__ __forceinline__ bf16x8 ldsfrag(const LAS unsigned char* p) { return *(const LAS bf16x8*)p; }

constexpr int H_VRAW = 118784;
__device__ __forceinline__ int hgrn_item_of(int c, int G) {
    if (G != 256) return c;
    const int x = c & 7, j = c >> 3; const int b = x >> 1, seg = 4 * (x & 1) + (j >> 3), h = j & 7;
    return (b << 6) | (h << 3) | seg;
}
template <bool WITH_Q>
__device__ __forceinline__ void hgrn_load(const Ctx& C, size_t tokc, int h, int tid, u32x4 (&kr)[2], u32x4 (&vr)[2], u32x4 (&qr)[2]) {
#pragma unroll
    for (int j = 0; j < 2; ++j) { const int p = tid + 512 * j; const size_t off = (tokc + (size_t)(p >> 4)) * 1024 + (size_t)h * 128 + (p & 15) * 8;
        kr[j] = *(const u32x4*)(C.L1K + off); vr[j] = *(const u32x4*)(C.L1I + off); if (WITH_Q) qr[j] = *(const u32x4*)(C.L1Q + off); }
}
template <bool WITH_Q>
__device__ __forceinline__ float hgrn_stage(LAS unsigned char* lds, int tid, const u32x4 (&kr)[2], const u32x4 (&vr)[2], const u32x4 (&qr)[2]) {
    const int d = tid & 127, tq = tid >> 7;
#pragma unroll
    for (int j = 0; j < 2; ++j) { const int p = tid + 512 * j; const int ro = (p >> 4) * PQ + (p & 15) * 16;
        *(LAS u32x4*)(lds + H_KD + ro) = kr[j]; *(LAS u32x4*)(lds + H_VRAW + ro) = vr[j]; if (WITH_Q) *(LAS u32x4*)(lds + H_QE + ro) = qr[j]; }
    __syncthreads();
    float kf[16], vf[16], c[16];
#pragma unroll
    for (int i = 0; i < 16; ++i) { kf[i] = bf2f(*(const LAS bf16_t*)(lds + H_KD + (tq * 16 + i) * PQ + d * 2)); vf[i] = bf2f(*(const LAS bf16_t*)(lds + H_VRAW + (tq * 16 + i) * PQ + d * 2)); }
    float run = 0.f;
#pragma unroll
    for (int i = 0; i < 16; ++i) { run += __logf(1.0f - kf[i]); c[i] = run; }
    LAS float* qtot = (LAS float*)(lds + H_QTOT);
    qtot[tq * 128 + d] = run;
    { u32x4 w0, w1; w0.x = pk2(vf[0], vf[1]); w0.y = pk2(vf[2], vf[3]); w0.z = pk2(vf[4], vf[5]); w0.w = pk2(vf[6], vf[7]); w1.x = pk2(vf[8], vf[9]); w1.y = pk2(vf[10], vf[11]); w1.z = pk2(vf[12], vf[13]); w1.w = pk2(vf[14], vf[15]);
      *(LAS u32x4*)(lds + H_VT + d * PT + tq * 32) = w0; *(LAS u32x4*)(lds + H_VT + d * PT + tq * 32 + 16) = w1; }
    __syncthreads();
    float pre = 0.f, tot = 0.f;
#pragma unroll
    for (int q4 = 0; q4 < 4; ++q4) { const float x = qtot[q4 * 128 + d]; if (q4 < tq) pre += x; tot += x; }
    if (tq == 0) ((LAS float*)(lds + H_BL))[d] = tot;
    { float ke[16];
#pragma unroll
      for (int i = 0; i < 16; ++i) ke[i] = kf[i] * __expf(tot - (pre + c[i]));
      u32x4 w0, w1; w0.x = pk2(ke[0], ke[1]); w0.y = pk2(ke[2], ke[3]); w0.z = pk2(ke[4], ke[5]); w0.w = pk2(ke[6], ke[7]); w1.x = pk2(ke[8], ke[9]); w1.y = pk2(ke[10], ke[11]); w1.z = pk2(ke[12], ke[13]); w1.w = pk2(ke[14], ke[15]);
      *(LAS u32x4*)(lds + H_KET + d * PT + tq * 32) = w0; *(LAS u32x4*)(lds + H_KET + d * PT + tq * 32 + 16) = w1; }
    if (WITH_Q) {
#pragma unroll
        for (int i = 0; i < 16; ++i) { const float b = pre + c[i]; const float qv = bf2f(*(const LAS bf16_t*)(lds + H_QE + (tq * 16 + i) * PQ + d * 2));
            *(LAS bf16_t*)(lds + H_QE + (tq * 16 + i) * PQ + d * 2) = (bf16_t)(pk2(qv * __expf(b), 0.f) & 0xffffu);
            *(LAS bf16_t*)(lds + H_KD + (tq * 16 + i) * PQ + d * 2) = (bf16_t)(pk2(kf[i] * __expf(-b), 0.f) & 0xffffu); }
    }
    return tot;
}
__device__ __forceinline__ void hgrn_state_update(LAS unsigned char* lds, f32x4 (&S)[8], int wid, int l15, int fq) {
    const LAS float* bl = (const LAS float*)(lds + H_BL);
    float dec[4];
#pragma unroll
    for (int r = 0; r < 4; ++r) dec[r] = __expf(bl[16 * wid + 4 * fq + r]);
    const bf16x8 ka0 = ldsfrag(lds + H_KET + (16 * wid + l15) * PT + 16 * fq), ka1 = ldsfrag(lds + H_KET + (16 * wid + l15) * PT + 64 + 16 * fq);
#pragma unroll
    for (int et = 0; et < 8; ++et) {
#pragma unroll
        for (int r = 0; r < 4; ++r) S[et][r] *= dec[r];
        S[et] = __builtin_amdgcn_mfma_f32_16x16x32_bf16(ka0, ldsfrag(lds + H_VT + (et * 16 + l15) * PT + 16 * fq), S[et], 0, 0, 0);
        S[et] = __builtin_amdgcn_mfma_f32_16x16x32_bf16(ka1, ldsfrag(lds + H_VT + (et * 16 + l15) * PT + 64 + 16 * fq), S[et], 0, 0, 0); }
}

__device__ __forceinline__ void phase_hgrn_local(const Ctx& C, LAS unsigned char* lds) {
    const int tid = threadIdx.x, lane = tid & 63, wid = __builtin_amdgcn_readfirstlane(tid >> 6), l15 = lane & 15, fq = lane >> 4;
    float* Ug = (float*)((unsigned char*)C.ctl + WS_HU); float* LBg = (float*)((unsigned char*)C.ctl + WS_HLB);
    for (int it0 = C.bid; it0 < 256; it0 += C.G) {
        const int item = hgrn_item_of(it0, C.G); const int seg = item & 7, h = (item >> 3) & 7, b = item >> 6;
        if (seg == 7) continue;
        f32x4 S[8];
#pragma unroll
        for (int et = 0; et < 8; ++et) S[et] = (f32x4){0.f, 0.f, 0.f, 0.f};
        float lbacc = 0.f;
        u32x4 kr[2], vr[2], qr[2];
        hgrn_load<false>(C, (size_t)b * SEQ + (size_t)seg * 1024, h, tid, kr, vr, qr);
#pragma unroll 1
        for (int ch = 0; ch < 16; ++ch) {
            const size_t tokc = (size_t)b * SEQ + (size_t)seg * 1024 + (size_t)ch * 64;
            __syncthreads();
            lbacc += hgrn_stage<false>(lds, tid, kr, vr, qr);
            if (ch < 15) hgrn_load<false>(C, tokc + 64, h, tid, kr, vr, qr);
            __syncthreads();
            hgrn_state_update(lds, S, wid, l15, fq);
        }
#pragma unroll
        for (int et = 0; et < 8; ++et) *(f32x4*)(Ug + ((size_t)(item * 8 + wid) * 8 + et) * 256 + lane * 4) = S[et];
        if (tid < 128) LBg[item * 128 + tid] = lbacc;
    }
}

__device__ __forceinline__ void phase_hgrn_chunks(const Ctx& C, LAS unsigned char* lds) {
    const int tid = threadIdx.x, lane = tid & 63, wid = __builtin_amdgcn_readfirstlane(tid >> 6), l15 = lane & 15, fq = lane >> 4;
    const float* Ug = (const float*)((unsigned char*)C.ctl + WS_HU); const float* LBg = (const float*)((unsigned char*)C.ctl + WS_HLB);
    LAS float* ssq = (LAS float*)(lds + H_SSQ);
    for (int it0 = C.bid; it0 < 256; it0 += C.G) {
        const int item = hgrn_item_of(it0, C.G); const int seg = item & 7, h = (item >> 3) & 7, b = item >> 6;
        f32x4 S[8];
#pragma unroll
        for (int et = 0; et < 8; ++et) S[et] = (f32x4){0.f, 0.f, 0.f, 0.f};
#pragma unroll 1
        for (int j = 0; j < seg; ++j) { const int it = item - seg + j; float dec[4];
#pragma unroll
            for (int r = 0; r < 4; ++r) dec[r] = __expf(LBg[it * 128 + 16 * wid + 4 * fq + r]);
#pragma unroll
            for (int et = 0; et < 8; ++et) { const f32x4 u = *(const f32x4*)(Ug + ((size_t)(it * 8 + wid) * 8 + et) * 256 + lane * 4);
#pragma unroll
                for (int r = 0; r < 4; ++r) S[et][r] = S[et][r] * dec[r] + u[r]; } }
        __syncthreads();
        u32x4 kr[2], vr[2], qr[2];
        hgrn_load<true>(C, (size_t)b * SEQ + (size_t)seg * 1024, h, tid, kr, vr, qr);
#pragma unroll 1
        for (int ch = 0; ch < 16; ++ch) {
            const size_t tokc = (size_t)b * SEQ + (size_t)seg * 1024 + (size_t)ch * 64;
#pragma unroll
            for (int et = 0; et < 8; ++et) { u32x2 w; w.x = pk2(S[et][0], S[et][1]); w.y = pk2(S[et][2], S[et][3]); *(LAS u32x2*)(lds + H_ST + (et * 16 + l15) * PQ + (16 * wid + 4 * fq) * 2) = w; }
            (void)hgrn_stage<true>(lds, tid, kr, vr, qr);
            if (ch < 15) hgrn_load<true>(C, tokc + 64, h, tid, kr, vr, qr);
            u32x2 gw[4];
            { const size_t ro = (tokc + (wid & 3) * 16 + l15) * 1024 + (size_t)h * 128;
#pragma unroll
              for (int j = 0; j < 4; ++j) gw[j] = *(const u32x2*)(C.L1G + ro + (4 * (wid >> 2) + j) * 16 + 4 * fq); }
            __syncthreads();
            { const int ti = wid >> 1;
#pragma unroll
              for (int u = 0; u < 2; ++u) { const int si = 2 * (wid & 1) + u; u32x2 w = (u32x2){0u, 0u};
                  if (si <= ti) { f32x4 a = (f32x4){0.f, 0.f, 0.f, 0.f};
#pragma unroll
                      for (int kk = 0; kk < 4; ++kk) a = __builtin_amdgcn_mfma_f32_16x16x32_bf16(ldsfrag(lds + H_KD + (si * 16 + l15) * PQ + kk * 64 + 16 * fq), ldsfrag(lds + H_QE + (ti * 16 + l15) * PQ + kk * 64 + 16 * fq), a, 0, 0, 0);
                      if (si == ti) {
#pragma unroll
                          for (int r = 0; r < 4; ++r) if (4 * fq + r > l15) a[r] = 0.f; }
                      w.x = pk2(a[0], a[1]); w.y = pk2(a[2], a[3]); }
                  *(LAS u32x2*)(lds + H_AL + (ti * 16 + l15) * PT + (si * 16 + 4 * fq) * 2) = w; } }
            hgrn_state_update(lds, S, wid, l15, fq);
            __syncthreads();
            const int ti = wid & 3, eh = wid >> 2;
            f32x4 o[4];
            { const bf16x8 ab0 = ldsfrag(lds + H_AL + (ti * 16 + l15) * PT + 16 * fq), ab1 = ldsfrag(lds + H_AL + (ti * 16 + l15) * PT + 64 + 16 * fq);
              bf16x8 qb[4];
#pragma unroll
              for (int kk = 0; kk < 4; ++kk) qb[kk] = ldsfrag(lds + H_QE + (ti * 16 + l15) * PQ + kk * 64 + 16 * fq);
#pragma unroll
              for (int j = 0; j < 4; ++j) { const int et = 4 * eh + j; f32x4 a = (f32x4){0.f, 0.f, 0.f, 0.f};
                  a = __builtin_amdgcn_mfma_f32_16x16x32_bf16(ldsfrag(lds + H_VT + (et * 16 + l15) * PT + 16 * fq), ab0, a, 0, 0, 0);
                  a = __builtin_amdgcn_mfma_f32_16x16x32_bf16(ldsfrag(lds + H_VT + (et * 16 + l15) * PT + 64 + 16 * fq), ab1, a, 0, 0, 0);
#pragma unroll
                  for (int kk = 0; kk < 4; ++kk) a = __builtin_amdgcn_mfma_f32_16x16x32_bf16(ldsfrag(lds + H_ST + (et * 16 + l15) * PQ + kk * 64 + 16 * fq), qb[kk], a, 0, 0, 0);
                  o[j] = a; } }
            float sq = 0.f;
#pragma unroll
            for (int j = 0; j < 4; ++j) sq += (o[j][0] * o[j][0] + o[j][1] * o[j][1]) + (o[j][2] * o[j][2] + o[j][3] * o[j][3]);
            sq += __shfl_xor(sq, 16); sq += __shfl_xor(sq, 32);
            if (fq == 0) ssq[eh * 64 + ti * 16 + l15] = sq;
            __syncthreads();
            { const float tot = ssq[ti * 16 + l15] + ssq[64 + ti * 16 + l15]; const float rinv = 1.0f / sqrtf(tot * (1.0f / 128.0f) + EPS);
              const size_t ro = (tokc + ti * 16 + l15) * 1024 + (size_t)h * 128;
#pragma unroll
              for (int j = 0; j < 4; ++j) { const int e0 = (4 * eh + j) * 16 + 4 * fq; const f32x4 nw = *(const f32x4*)(C.hgrn_out_norm + e0);
                  u32x2 w; w.x = pk2(o[j][0] * rinv * nw[0] * bf_lo(gw[j].x), o[j][1] * rinv * nw[1] * bf_hi(gw[j].x)); w.y = pk2(o[j][2] * rinv * nw[2] * bf_lo(gw[j].y), o[j][3] * rinv * nw[3] * bf_hi(gw[j].y));
                  *(u32x2*)(C.Y + ro + e0) = w; } }
        }
    }
}

constexpr int NPHASES = 14;
struct Args { const void* in[16]; float* out; unsigned char* ws; int ph_lo, ph_hi; };


typedef const __attribute__((address_space(4))) Args* KArgP;
__device__ __forceinline__ void make_ctx(Ctx& C) {
    KArgP ka = (KArgP)__builtin_amdgcn_kernarg_segment_ptr(); asm volatile("" : "+s"(ka));
    C.x = (const float*)ka->in[0]; C.positions = (const int*)ka->in[1]; C.ln_mix = (const float*)ka->in[2]; C.ln_ffn = (const float*)ka->in[3]; C.ln_final = (const float*)ka->in[4];
    C.w_in_ab = (const float*)ka->in[5]; C.w_pool = (const float*)ka->in[6]; C.pool_scale = (const float*)ka->in[7]; C.idx_k_norm = (const float*)ka->in[8]; C.w_out_ab = (const float*)ka->in[9];
    C.w_in_c = (const float*)ka->in[10]; C.hgrn_lb = (const float*)ka->in[11]; C.hgrn_out_norm = (const float*)ka->in[12]; C.w_out_c = (const float*)ka->in[13]; C.w_gate_up = (const float*)ka->in[14]; C.w_down = (const float*)ka->in[15];
    C.out = ka->out;
    unsigned char* ws = ka->ws;
    C.ctl = (unsigned*)(ws + WS_CTL); C.rope = (float*)(ws + WS_ROPE); C.part = (float*)(ws + WS_PART); C.lbv = (float*)(ws + WS_LB);
    C.W_inab = (bf16_t*)(ws + WS_W_INAB); C.W_pool = (bf16_t*)(ws + WS_W_POOL); C.W_outab = (bf16_t*)(ws + WS_W_OUTAB); C.W_inc = (bf16_t*)(ws + WS_W_INC); C.W_outc = (bf16_t*)(ws + WS_W_OUTC);
    C.W_gu0 = (bf16_t*)(ws + WS_W_GU0); C.W_gu1 = (bf16_t*)(ws + WS_W_GU1); C.W_dn0 = (bf16_t*)(ws + WS_W_DN0); C.W_dn1 = (bf16_t*)(ws + WS_W_DN1);
    C.XB = (bf16_t*)(ws + WS_XB); C.Y = (bf16_t*)(ws + WS_Y); C.P = (bf16_t*)(ws + WS_P); C.ACT = (bf16_t*)(ws + WS_ACT);
    C.L1Q = (bf16_t*)(ws + WS_L1Q); C.L1K = (bf16_t*)(ws + WS_L1K); C.L1I = (bf16_t*)(ws + WS_L1I); C.L1G = (bf16_t*)(ws + WS_L1G); C.ORAW = (bf16_t*)(ws + WS_ORAW);
    C.G = gridDim.x; C.bid = blockIdx.x;
}

#if USE_SIMPLE_GEMM
#define RUN_GEMM(EpiT, gg, EE) pg8::gemm_simple<EpiT>(gg, C.G, C.bid, EE)
#else
#define RUN_GEMM(EpiT, gg, EE) do { if (threadIdx.x == 0) *(LAS int*)(lds + 131072 + 1024) = -1; __syncthreads(); pg8::StaticOrder S_; S_.init((gg).M, (gg).N, C.G, C.bid); pg8::gemm_phase<EpiT, pg8::StaticOrder, true, true>(lds, gg, S_, EE); } while (0)
#endif

__device__ __forceinline__ void xcd_barrier_local(const XcdBarrier& b) {
    asm volatile("s_waitcnt vmcnt(0)" ::: "memory");
    __syncthreads();
    if (threadIdx.x == 0) {
        unsigned* bar = b.bar;
        __builtin_amdgcn_s_waitcnt(0);
        const unsigned nloc = b.st[0];
        const unsigned old = xb_add(&bar[XB_XSUB(b.x)], 1u);
        const unsigned gen = old / nloc;
        if (old + 1u == (gen + 1u) * nloc) xb_add(&bar[XB_XGEN(b.x)], 1u);
        else XB_SPIN(xb_ld(&bar[XB_XGEN(b.x)]) == gen, bar);
        __builtin_amdgcn_fence(__ATOMIC_ACQUIRE, "agent");
        asm volatile("s_waitcnt vmcnt(0)" ::: "memory");
    }
    __syncthreads();
}
constexpr int CW_TAB = 8192;

__global__ void __launch_bounds__(512, 2) mega_fwd(Args a) {
    extern __shared__ __attribute__((aligned(16))) unsigned char lds_raw[];
    LAS unsigned char* lds = (LAS unsigned char*)lds_raw;
    unsigned* const ctl0 = (unsigned*)(a.ws + WS_CTL);

    volatile LAS unsigned* MISC = (volatile LAS unsigned*)(lds + LDS_MISC);
    if (threadIdx.x < 64) MISC[threadIdx.x] = 0u;
    __syncthreads();
    XcdBarrier bar; bar.bar = ctl0 + CW_BAR; bar.x = 0; bar.st = nullptr;
    if (N_LAUNCH_MODE == 1) bar = xcd_barrier_post(ctl0 + CW_BAR, MISC + 8);
    if (N_LAUNCH_MODE == 1 && threadIdx.x == 0) __hip_atomic_store(&ctl0[CW_TAB + blockIdx.x], xb_xcc_id() + 1u, __ATOMIC_RELAXED, __HIP_MEMORY_SCOPE_AGENT);

    const int lo = a.ph_lo, hi = a.ph_hi;
#ifndef ONLY_PHASE
#define ONLY_PHASE -1
#endif
#define IN(k) (lo <= (k) && (k) < hi && (ONLY_PHASE < 0 || ONLY_PHASE == (k)))
#if defined(DBG_REPEAT) && DBG_REPEAT == 90
#define SEAM(k) do { if (N_LAUNCH_MODE == 1 && IN((k) + 1)) { xcd_barrier(bar); if ((k) == 5) for (int rr_ = 0; rr_ < 20; ++rr_) xcd_barrier(bar); } } while (0)
#else
#define SEAM(k) do { if (N_LAUNCH_MODE == 1 && IN((k) + 1)) xcd_barrier(bar); } while (0)
#endif

#if USE_SIMPLE_GEMM || USE_SIMPLE_ATTN || USE_SIMPLE_HGRN
#define SEAM_L(k) SEAM(k)
#else
#define SEAM_L(k) do { if (N_LAUNCH_MODE == 1 && IN((k) + 1)) { if (MISC[10]) xcd_barrier_local(bar); else xcd_barrier(bar); } } while (0)
#endif
    if (IN(0)) { Ctx C; make_ctx(C); phase_prologue(C, lds); __syncthreads();
#if defined(DBG_REPEAT) && DBG_REPEAT == 0
        phase_prologue(C, lds); __syncthreads();
#endif
        SEAM(0);
        if (N_LAUNCH_MODE == 1 && lo == 0) {
            if (threadIdx.x < 64) { bool ok = (gridDim.x == 256u);
                for (unsigned t = threadIdx.x; t < gridDim.x && t < 256u; t += 64u) { const unsigned v = xb_ld(&ctl0[CW_TAB + t]), r = xb_ld(&ctl0[CW_TAB + (t & 7u)]); ok = ok && v != 0u && v == r; }
                unsigned m = 0u;
                for (unsigned i = 0; i < 8u; ++i) m |= 1u << (xb_ld(&ctl0[CW_TAB + i]) & 31u);
                ok = ok && __popc(m) == 8;
                const bool all = __ballot(ok) == ~0ull;
                if (threadIdx.x == 0) MISC[10] = all ? 1u : 0u; }
            __syncthreads(); } }
    if (IN(1)) { Ctx C; make_ctx(C); pg8::Gemm g{C.XB, C.W_inab, NTOK, NAB, 1024}; pg8::EpiScaleBf16 E{C.P, NAB, pg8::RinvTab{C.part, lds}}; RUN_GEMM(pg8::EpiScaleBf16, g, E);
        __syncthreads(); phase_prologue_late(C, lds); __syncthreads();
#if defined(DBG_REPEAT) && DBG_REPEAT == 1
        RUN_GEMM(pg8::EpiScaleBf16, g, E);
#endif
        SEAM(1); }
    if (IN(2)) { Ctx C; make_ctx(C); phase_fixup_pool(C, lds);
#if defined(DBG_REPEAT) && DBG_REPEAT == 2
        phase_fixup_pool(C, lds);
#endif
        SEAM(2); }
#ifdef DBG_ZERO_ATTN
    if (IN(3)) { Ctx C; make_ctx(C); for (int i = C.bid * 512 + threadIdx.x; i < NTOK * 64; i += C.G * 512) { const int tok = i >> 6, c = i & 63; *(u32x4*)(C.Y + (size_t)tok * 1024 + 512 + 8 * c) = (u32x4){0u, 0u, 0u, 0u}; } SEAM(3); }
#else
#if USE_SIMPLE_ATTN
    if (IN(3)) { Ctx C; make_ctx(C); phase_attn_simple(C, lds); __syncthreads(); SEAM(3); }
#else
    if (IN(3)) { Ctx C; make_ctx(C); phase_attn(C, lds); __syncthreads();
#if defined(DBG_REPEAT) && DBG_REPEAT == 3
        phase_attn(C, lds); __syncthreads();
#endif
        SEAM(3); }
#endif
#endif
    if (IN(4)) { Ctx C; make_ctx(C); pg8::Gemm g{C.Y, C.W_outab, NTOK, 1024, 1024}; pg8::EpiResidual<true> E{C.XB, C.part, C.x}; RUN_GEMM(pg8::EpiResidual<true>, g, E); SEAM_L(4); }
    if (IN(5)) { Ctx C; make_ctx(C); pg8::Gemm g{C.XB, C.W_gu0, NTOK, 2 * DFF, 1024}; pg8::EpiSwiGLU E{C.ACT, pg8::RinvTab{C.part, lds}}; RUN_GEMM(pg8::EpiSwiGLU, g, E);
#if defined(DBG_REPEAT) && DBG_REPEAT == 5
        RUN_GEMM(pg8::EpiSwiGLU, g, E);
#endif
        SEAM_L(5); }
    if (IN(6)) { Ctx C; make_ctx(C); pg8::Gemm g{C.ACT, C.W_dn0, NTOK, 1024, DFF}; pg8::EpiResidual<false> E{C.XB, C.part, C.x}; RUN_GEMM(pg8::EpiResidual<false>, g, E); SEAM_L(6); }
    if (IN(7)) { Ctx C; make_ctx(C); pg8::Gemm g{C.XB, C.W_inc, NTOK, NINC, 1024}; pg8::EpiHgrnIn E{C.L1Q, C.L1K, C.L1I, C.L1G, pg8::RinvTab{C.part, lds}, C.lbv}; RUN_GEMM(pg8::EpiHgrnIn, g, E); SEAM_L(7); }
#if USE_SIMPLE_HGRN
    if (IN(8)) { Ctx C; make_ctx(C); phase_hgrn_simple(C); SEAM(8); }
    if (IN(9)) { Ctx C; make_ctx(C); phase_hgrn_post(C); SEAM_L(9); }
#else
    if (IN(8)) { Ctx C; make_ctx(C); phase_hgrn_local(C, lds); __syncthreads();
#if defined(DBG_REPEAT) && DBG_REPEAT == 8
        phase_hgrn_local(C, lds); __syncthreads();
#endif
        SEAM(8); }
    if (IN(9)) { Ctx C; make_ctx(C); phase_hgrn_chunks(C, lds); __syncthreads();
#if defined(DBG_REPEAT) && DBG_REPEAT == 9
        phase_hgrn_chunks(C, lds); __syncthreads();
#endif
        SEAM_L(9); }
#endif
    if (IN(10)) { Ctx C; make_ctx(C); pg8::Gemm g{C.Y, C.W_outc, NTOK, 1024, 1024}; pg8::EpiResidual<false> E{C.XB, C.part, C.x}; RUN_GEMM(pg8::EpiResidual<false>, g, E); SEAM_L(10); }
    if (IN(11)) { Ctx C; make_ctx(C); pg8::Gemm g{C.XB, C.W_gu1, NTOK, 2 * DFF, 1024}; pg8::EpiSwiGLU E{C.ACT, pg8::RinvTab{C.part, lds}}; RUN_GEMM(pg8::EpiSwiGLU, g, E); SEAM_L(11); }
    if (IN(12)) { Ctx C; make_ctx(C); pg8::Gemm g{C.ACT, C.W_dn1, NTOK, 1024, DFF}; pg8::EpiResidual<false> E{C.XB, C.part, C.x}; RUN_GEMM(pg8::EpiResidual<false>, g, E); SEAM_L(12); }
    if (IN(13)) { Ctx C; make_ctx(C); phase_final_norm(C); }
#ifdef DBG_STOP_AFTER
    if (IN(14)) { Ctx C; make_ctx(C); for (int i = C.bid * 512 + threadIdx.x; i < NTOK * 1024; i += C.G * 512) { const int tok = i >> 10, c = i & 1023; float v;
        if (DBG_STOP_AFTER <= 3) v = bf2f(C.P[(size_t)tok * NAB + c]) + bf2f(C.P[(size_t)tok * NAB + 768 + c]) + bf2f(C.Y[(size_t)tok * 1024 + (c & 511)]);
        else if (DBG_STOP_AFTER == 7 || DBG_STOP_AFTER == 8) v = bf2f(C.L1Q[i]) + bf2f(C.L1K[i]) + bf2f(C.L1I[i]) + bf2f(C.L1G[i]) + (DBG_STOP_AFTER == 8 ? bf2f(C.ORAW[i]) : 0.f);
        else if (DBG_STOP_AFTER == 9) v = bf2f(C.Y[i]);
        else if (DBG_STOP_AFTER == 5 || DBG_STOP_AFTER == 11) v = bf2f(C.ACT[(size_t)tok * DFF + c]) + bf2f(C.ACT[(size_t)tok * DFF + 1024 + c]) + bf2f(C.ACT[(size_t)tok * DFF + 1792 + c]);
        else v = C.out[i] + bf2f(C.XB[i]);
        C.out[i] = v; } }
#endif
#undef IN
#undef SEAM
#undef SEAM_L
}

extern "C" void kernel_launch(void* const* d_in, const int* in_sizes, int n_in, void* d_out, int out_size, void* d_ws, size_t ws_size, hipStream_t stream) {
    static int grid = 0;
    if (grid == 0) {
        if (n_in != 16 || in_sizes[0] != NTOK * DM || out_size != NTOK * DM || ws_size < WS_END) {
            fprintf(stderr, "kernel_launch: built for 16 inputs, x/out of %d floats, >= %zu bytes of workspace; got n_in %d, in0 %d, out %d, ws %zu; nothing launched\n", NTOK * DM, (size_t)WS_END, n_in, n_in > 0 ? in_sizes[0] : -1, out_size, ws_size);
            grid = -1; return; }
        int dev = 0, cus = 0, per_cu = 0;
        if (hipGetDevice(&dev) != hipSuccess || hipDeviceGetAttribute(&cus, hipDeviceAttributeMultiprocessorCount, dev) != hipSuccess) { fprintf(stderr, "kernel_launch: device query failed\n"); grid = -1; return; }
        if (hipFuncSetAttribute((const void*)mega_fwd, hipFuncAttributeMaxDynamicSharedMemorySize, LDS_BYTES) != hipSuccess) { fprintf(stderr, "kernel_launch: hipFuncSetAttribute failed\n"); grid = -1; return; }
        if (hipOccupancyMaxActiveBlocksPerMultiprocessor(&per_cu, (const void*)mega_fwd, 512, LDS_BYTES) != hipSuccess || per_cu < 1)
            fprintf(stderr, "kernel_launch: note: occupancy query reports %d workgroups per CU\n", per_cu);
        (void)hipGetLastError();
        grid = cus;
    }
    if (grid < 0) return;
    if (hipMemsetAsync((char*)d_ws + WS_CTL, 0, CTL_ZERO_BYTES, stream) != hipSuccess) { fprintf(stderr, "kernel_launch: hipMemsetAsync failed\n"); return; }
    Args a{};
    for (int i = 0; i < 16; ++i) a.in[i] = d_in[i];
    a.out = (float*)d_out; a.ws = (unsigned char*)d_ws;
    if (N_LAUNCH_MODE == 1) {
        a.ph_lo = 0; a.ph_hi = NPHASES;
        hipLaunchKernelGGL(mega_fwd, dim3(grid), dim3(512), LDS_BYTES, stream, a);
    } else {
#ifdef DBG_STOP_AFTER
        for (int p = 0; p <= DBG_STOP_AFTER; ++p) { a.ph_lo = p; a.ph_hi = p + 1; hipLaunchKernelGGL(mega_fwd, dim3(grid), dim3(512), LDS_BYTES, stream, a); }
        a.ph_lo = 14; a.ph_hi = 15; hipLaunchKernelGGL(mega_fwd, dim3(grid), dim3(512), LDS_BYTES, stream, a);
#else
        for (int p = 0; p < NPHASES; ++p) { a.ph_lo = p; a.ph_hi = p + 1; hipLaunchKernelGGL(mega_fwd, dim3(grid), dim3(512), LDS_BYTES, stream, a); }
#endif
    }
    const hipError_t le = hipPeekAtLastError();
    if (le != hipSuccess) fprintf(stderr, "kernel_launch: launch failed: %s\n", hipGetErrorName(le));
}
```

```cpp
#include <hip/hip_runtime.h>
#include <cstdio>
#include <cstdint>

#ifndef N_LAUNCH_MODE
#define N_LAUNCH_MODE 1
#endif
#ifndef USE_SIMPLE_HGRN
#define USE_SIMPLE_HGRN 0
#endif
#ifndef USE_SIMPLE_ATTN
#define USE_SIMPLE_ATTN 0
#endif
#ifndef USE_SIMPLE_GEMM
#define USE_SIMPLE_GEMM 0
#endif

#define LAS __attribute__((address_space(3)))

constexpr int BATCH = 4, SEQ = 8192, DM = 1024, NTOK = BATCH * SEQ;
constexpr int NAB_REAL = 1604, NAB = 1792;
constexpr int DFF = 2816;
constexpr int NINC = 4096;
constexpr int PC_U = 0, PC_Q = 512, PC_K = 1024, PC_V = 1152, PC_QI = 1280, PC_KI = 1536, PC_WI = 1600;
constexpr float EPS = 1e-6f;
constexpr int TOPK = 256;

constexpr size_t MiB = 1u << 20;
constexpr size_t WS_CTL = 0, CTL_ZERO_BYTES = 1 * MiB;
constexpr size_t WS_ROPE = 1 * MiB;
constexpr size_t WS_PART = 3 * MiB;
constexpr size_t WS_LB = 5 * MiB;
constexpr size_t WS_W_INAB = 6 * MiB;
constexpr size_t WS_W_POOL = WS_W_INAB + (size_t)NAB * DM * 2;
constexpr size_t WS_W_OUTAB = 10 * MiB;
constexpr size_t WS_W_INC = 12 * MiB;
constexpr size_t WS_W_OUTC = 20 * MiB;
constexpr size_t WS_W_GU0 = 22 * MiB, WS_W_GU1 = 33 * MiB;
constexpr size_t WS_W_DN0 = 44 * MiB, WS_W_DN1 = WS_W_DN0 + (size_t)DM * DFF * 2;
constexpr size_t WS_XB = 56 * MiB;
constexpr size_t WS_Y = 120 * MiB;
constexpr size_t WS_P = 184 * MiB;
constexpr size_t WS_ACT = 184 * MiB;
constexpr size_t WS_L1Q = 184 * MiB, WS_L1K = 248 * MiB, WS_L1I = 312 * MiB, WS_L1G = 376 * MiB;
constexpr size_t WS_ORAW = 440 * MiB;
constexpr size_t WS_KV8 = 488 * MiB;
constexpr size_t WS_END = 512 * MiB;
static_assert(WS_W_POOL + 4 * 128 * 128 * 2 <= WS_W_OUTAB && WS_W_DN1 + (size_t)DM * DFF * 2 <= WS_XB && WS_P + (size_t)NTOK * NAB * 2 <= 360 * MiB && WS_ACT + (size_t)NTOK * DFF * 2 <= WS_L1G + 64 * MiB, "ws map");
constexpr int CW_BAR = 4096;

constexpr int LDS_BYTES = 163840;
constexpr int LDS_MISC = 163840 - 256;
namespace pg8 {
#define PG8_LAS __attribute__((address_space(3)))
typedef unsigned short bf16_t;
typedef short bf16x8 __attribute__((ext_vector_type(8)));
typedef float f32x4 __attribute__((ext_vector_type(4)));
typedef unsigned u32x4 __attribute__((ext_vector_type(4)));
constexpr int BM = 256, BK = 64, HALF = 128, HTB = HALF * BK * 2  , STAGE_BYTES = 8 * HTB, NXCD = 8, WGM = 8;

__host__ __device__ __forceinline__ int lds_byte(int r, int c) { const int st = (r >> 4) * 2 + (c >> 5), rr = r & 15, cc = c & 31, ob = rr * 64 + cc * 2; return st * 1024 + (ob ^ (((ob >> 9) & 1) << 5)); }
__host__ __device__ __forceinline__ void stage_rc(int b, int& R, int& C) { const int st = b / 1024, sb = b % 1024, swz = sb ^ (((sb >> 9) & 1) << 5); R = (st >> 1) * 16 + swz / 64; C = (st & 1) * 32 + (swz % 64) / 2; }
__host__ __device__ __forceinline__ int perm32(int rho) { const int n = rho >> 4, i = rho & 15; return 8 * (i >> 2) + 4 * n + (i & 3); }

struct Unit { int pm, pn; };
struct Gemm { const bf16_t* A; const bf16_t* Bt; int M, N, K; };

struct StaticOrder {
    int nM, nN, nwg, G, c;
    __host__ __device__ void init(int M, int N, int G_, int c_) { nM = M / BM; nN = N / BM; nwg = nM * nN; G = G_; c = c_; }
    __host__ __device__ bool next(int i, Unit& u) const {
        const long L = (long)i * G + c; if (L >= nwg) return false;
        int wgid = (int)L; { const int q = nwg / NXCD, r = nwg % NXCD, xcd = wgid % NXCD, off = wgid / NXCD; wgid = (xcd < r ? xcd * (q + 1) : r * (q + 1) + (xcd - r) * q) + off; }
        const int nig = WGM * nN, gid = wgid / nig, fm = gid * WGM, gsz = (nM - fm) < WGM ? (nM - fm) : WGM;
        u.pm = fm + ((wgid % nig) % gsz); u.pn = (wgid % nig) / gsz; return true;
    }
    __device__ __forceinline__ void a_ready(const Unit&) const {}
    __device__ __forceinline__ void done(const Unit&) const {}
};
typedef __bf16 bf16x2_t __attribute__((ext_vector_type(2)));
__device__ __forceinline__ unsigned cvt_pk_bf16(float lo, float hi) { const bf16x2_t v = {(__bf16)lo, (__bf16)hi}; return __builtin_bit_cast(unsigned, v); }

typedef float f32x2 __attribute__((ext_vector_type(2)));
typedef unsigned u32x2 __attribute__((ext_vector_type(2)));

__device__ __forceinline__ float row_rinv(const float* part, int row) {
    const f32x4* p = (const f32x4*)(part + (size_t)row * 16);
    const f32x4 a = p[0], b = p[1], c = p[2], d = p[3];
    const float s = (((a[0] + a[1]) + (a[2] + a[3])) + ((b[0] + b[1]) + (b[2] + b[3]))) + (((c[0] + c[1]) + (c[2] + c[3])) + ((d[0] + d[1]) + (d[2] + d[3])));
    return 1.0f / sqrtf(s * (1.0f / 1024.0f) + 1e-6f);
}
struct RinvTab {
    const float* part; PG8_LAS unsigned char* ldsb;
    __device__ __forceinline__ void prepare(int pm) const {
        PG8_LAS int* cpm = (PG8_LAS int*)(ldsb + 131072 + 1024); PG8_LAS float* rtab = (PG8_LAS float*)(ldsb + 131072);
        if (*cpm != pm) {
            asm volatile("s_waitcnt lgkmcnt(0)" ::: "memory"); __builtin_amdgcn_s_barrier(); asm volatile("" ::: "memory");
            if (threadIdx.x < 256) rtab[threadIdx.x] = row_rinv(part, pm * BM + (int)threadIdx.x);
            if (threadIdx.x == 0) *cpm = pm;
            asm volatile("s_waitcnt vmcnt(0) lgkmcnt(0)" ::: "memory"); __builtin_amdgcn_s_barrier(); asm volatile("" ::: "memory");
        }
    }
    __device__ __forceinline__ float get(int row_in_panel) const { return ((const PG8_LAS float*)(ldsb + 131072))[row_in_panel]; }
};
__device__ __forceinline__ float sigmoid_neg(float x) { return __builtin_amdgcn_rcpf(1.0f + __expf(x)); }
__device__ __forceinline__ float silu_f(float x) { return x * __builtin_amdgcn_rcpf(1.0f + __expf(-x)); }

struct EpiScaleBf16 {
    static constexpr bool PERM = true, AFTER_DRAIN = false;
    bf16_t* O; int ldc; RinvTab rt;
    __device__ __forceinline__ void operator()(const f32x4 (&acc)[2][2][4][2], const Unit& u, int wr, int wc, int fr, int fq) const {
        rt.prepare(u.pm);
        const int row0 = u.pm * BM + wr * 64 + fr, col0 = u.pn * BM + wc * 32 + 8 * fq;
#pragma unroll
        for (int ai = 0; ai < 2; ++ai)
#pragma unroll
            for (int m = 0; m < 4; ++m) { const int row = row0 + ai * HALF + m * 16; const float r = rt.get(row - u.pm * BM); bf16_t* rowp = O + (size_t)row * ldc + col0;
#pragma unroll
                for (int bj = 0; bj < 2; ++bj) { const f32x4 v0 = acc[ai][bj][m][0] * r, v1 = acc[ai][bj][m][1] * r;
                    u32x4 w; w.x = cvt_pk_bf16(v0[0], v0[1]); w.y = cvt_pk_bf16(v0[2], v0[3]); w.z = cvt_pk_bf16(v1[0], v1[1]); w.w = cvt_pk_bf16(v1[2], v1[3]);
                    *(u32x4*)(rowp + bj * HALF) = w; } }
    }
};
template <bool BASE_F32> struct EpiResidual {
    static constexpr bool PERM = true, AFTER_DRAIN = false;
    bf16_t* xb; float* part; const float* xin;
    __device__ __forceinline__ void operator()(const f32x4 (&acc)[2][2][4][2], const Unit& u, int wr, int wc, int fr, int fq) const {
        const int row0 = u.pm * BM + wr * 64 + fr, col0 = u.pn * BM + wc * 32 + 8 * fq;
#pragma unroll
        for (int ai = 0; ai < 2; ++ai)
#pragma unroll
            for (int m = 0; m < 4; ++m) { const int row = row0 + ai * HALF + m * 16; const size_t off = (size_t)row * 1024 + col0; float ss = 0.f;
#pragma unroll
                for (int bj = 0; bj < 2; ++bj) {
                    f32x4 x0, x1;
                    if (BASE_F32) { x0 = *(const f32x4*)(xin + off + bj * HALF) + acc[ai][bj][m][0]; x1 = *(const f32x4*)(xin + off + bj * HALF + 4) + acc[ai][bj][m][1]; }
                    else { const u32x4 b = *(const u32x4*)(xb + off + bj * HALF);
                    x0[0] = __uint_as_float(b.x << 16) + acc[ai][bj][m][0][0]; x0[1] = __uint_as_float(b.x & 0xffff0000u) + acc[ai][bj][m][0][1];
                    x0[2] = __uint_as_float(b.y << 16) + acc[ai][bj][m][0][2]; x0[3] = __uint_as_float(b.y & 0xffff0000u) + acc[ai][bj][m][0][3];
                    x1[0] = __uint_as_float(b.z << 16) + acc[ai][bj][m][1][0]; x1[1] = __uint_as_float(b.z & 0xffff0000u) + acc[ai][bj][m][1][1];
                    x1[2] = __uint_as_float(b.w << 16) + acc[ai][bj][m][1][2]; x1[3] = __uint_as_float(b.w & 0xffff0000u) + acc[ai][bj][m][1][3]; }
                    ss += ((x0[0] * x0[0] + x0[1] * x0[1]) + (x0[2] * x0[2] + x0[3] * x0[3])) + ((x1[0] * x1[0] + x1[1] * x1[1]) + (x1[2] * x1[2] + x1[3] * x1[3]));
                    u32x4 w; w.x = cvt_pk_bf16(x0[0], x0[1]); w.y = cvt_pk_bf16(x0[2], x0[3]); w.z = cvt_pk_bf16(x1[0], x1[1]); w.w = cvt_pk_bf16(x1[2], x1[3]);
                    *(u32x4*)(xb + off + bj * HALF) = w; }
                ss += __shfl_xor(ss, 16); ss += __shfl_xor(ss, 32);
                if (fq == 0) part[(size_t)row * 16 + u.pn * 4 + wc] = ss; }
    }
};
struct EpiSwiGLU {
    static constexpr bool PERM = true, AFTER_DRAIN = false;
    bf16_t* O; RinvTab rt;
    __device__ __forceinline__ void operator()(const f32x4 (&acc)[2][2][4][2], const Unit& u, int wr, int wc, int fr, int fq) const {
        rt.prepare(u.pm);
        const int row0 = u.pm * BM + wr * 64 + fr, f0 = u.pn * HALF + wc * 32 + 8 * fq;
#pragma unroll
        for (int ai = 0; ai < 2; ++ai)
#pragma unroll
            for (int m = 0; m < 4; ++m) { const int row = row0 + ai * HALF + m * 16; const float r = rt.get(row - u.pm * BM);
                float a[8];
#pragma unroll
                for (int n = 0; n < 2; ++n)
#pragma unroll
                    for (int j = 0; j < 4; ++j) { const float g = acc[ai][0][m][n][j] * r, up = acc[ai][1][m][n][j] * r; a[4 * n + j] = silu_f(g) * up; }
                u32x4 w; w.x = cvt_pk_bf16(a[0], a[1]); w.y = cvt_pk_bf16(a[2], a[3]); w.z = cvt_pk_bf16(a[4], a[5]); w.w = cvt_pk_bf16(a[6], a[7]);
                *(u32x4*)(O + (size_t)row * 2816 + f0) = w; }
    }
};
struct EpiHgrnIn {
    static constexpr bool PERM = true, AFTER_DRAIN = false;
    bf16_t *Q1, *K1, *I1, *G1; RinvTab rt; const float* lb;
    __device__ __forceinline__ void operator()(const f32x4 (&acc)[2][2][4][2], const Unit& u, int wr, int wc, int fr, int fq) const {
        rt.prepare(u.pm);
        const int sec = u.pn >> 2; const int row0 = u.pm * BM + wr * 64 + fr, col0 = (u.pn & 3) * BM + wc * 32 + 8 * fq;
        bf16_t* O = sec == 0 ? Q1 : sec == 1 ? K1 : sec == 2 ? I1 : G1;
        float lbc[2][8];
#pragma unroll
        for (int bj = 0; bj < 2; ++bj)
#pragma unroll
            for (int j = 0; j < 8; ++j) lbc[bj][j] = (sec == 1) ? (1.0f - lb[col0 + bj * HALF + j]) : 0.f;
#pragma unroll
        for (int ai = 0; ai < 2; ++ai)
#pragma unroll
            for (int m = 0; m < 4; ++m) { const int row = row0 + ai * HALF + m * 16; const float r = rt.get(row - u.pm * BM); bf16_t* rowp = O + (size_t)row * 1024 + col0;
#pragma unroll
                for (int bj = 0; bj < 2; ++bj) { float a[8];
#pragma unroll
                    for (int n = 0; n < 2; ++n)
#pragma unroll
                        for (int j = 0; j < 4; ++j) { const float v = acc[ai][bj][m][n][j] * r; float o;
                            if (sec == 0) o = v * 0.08838834764831845f; else if (sec == 1) o = lbc[bj][4 * n + j] * sigmoid_neg(v); else if (sec == 2) o = v; else o = silu_f(v);
                            a[4 * n + j] = o; }
                    u32x4 w; w.x = cvt_pk_bf16(a[0], a[1]); w.y = cvt_pk_bf16(a[2], a[3]); w.z = cvt_pk_bf16(a[4], a[5]); w.w = cvt_pk_bf16(a[6], a[7]);
                    *(u32x4*)(rowp + bj * HALF) = w; } }
    }
};

template <class Epi>
__device__ __forceinline__ void gemm_simple(const Gemm g, int G, int c, const Epi& E) {
    const int tid = threadIdx.x, wid = __builtin_amdgcn_readfirstlane(tid >> 6), lane = tid & 63, wr = wid >> 2, wc = wid & 3, fr = lane & 15, fq = lane >> 4;
    const int nN = g.N / BM, nunits = (g.M / BM) * nN, K = g.K;
    for (int ui = c; ui < nunits; ui += G) {
        Unit u; u.pm = ui / nN; u.pn = ui % nN;
        f32x4 acc[2][2][4][2];
#pragma unroll
        for (int a = 0; a < 2; ++a)
#pragma unroll
            for (int b = 0; b < 2; ++b)
#pragma unroll
                for (int m = 0; m < 4; ++m)
#pragma unroll
                    for (int n = 0; n < 2; ++n) acc[a][b][m][n] = (f32x4){0.f, 0.f, 0.f, 0.f};
        const bf16_t* Ab = g.A + (size_t)(u.pm * BM + wr * 64 + fr) * K + fq * 8;
        const bf16_t* Bb = g.Bt + (size_t)(u.pn * BM + wc * 32 + 8 * (fr >> 2) + (fr & 3)) * K + fq * 8;
        for (int kk = 0; kk < K; kk += 32) {
            bf16x8 a[2][4], b[2][2];
#pragma unroll
            for (int ai = 0; ai < 2; ++ai)
#pragma unroll
                for (int m = 0; m < 4; ++m) a[ai][m] = *(const bf16x8*)(Ab + (size_t)(ai * HALF + m * 16) * K + kk);
#pragma unroll
            for (int bj = 0; bj < 2; ++bj)
#pragma unroll
                for (int n = 0; n < 2; ++n) b[bj][n] = *(const bf16x8*)(Bb + (size_t)(bj * HALF + 4 * n) * K + kk);
#pragma unroll
            for (int ai = 0; ai < 2; ++ai)
#pragma unroll
                for (int bj = 0; bj < 2; ++bj)
#pragma unroll
                    for (int m = 0; m < 4; ++m)
#pragma unroll
                        for (int n = 0; n < 2; ++n) acc[ai][bj][m][n] = __builtin_amdgcn_mfma_f32_16x16x32_bf16(b[bj][n], a[ai][m], acc[ai][bj][m][n], 0, 0, 0);
        }
        E(acc, u, wr, wc, fr, fq);
    }
}
template <class Epi, class Sched, bool ALIGN_EPI = false, bool SP2 = false>
__device__ __forceinline__ void gemm_phase(PG8_LAS unsigned char* lds, const Gemm g, const Sched& S, const Epi& E) {
    const int tid = threadIdx.x, wid = __builtin_amdgcn_readfirstlane(tid >> 6), lane = tid & 63, wr = wid >> 2, wc = wid & 3, fr = lane & 15, fq = lane >> 4;
    const int K = g.K, nt = K / BK;
    unsigned voffA[2], voffB[2];
#pragma unroll
    for (int i = 0; i < 2; ++i) { int R, C; stage_rc(tid * 16 + i * 8192, R, C); const int Rb = Epi::PERM ? ((R & ~31) + perm32(R & 31)) : R;
        voffA[i] = (unsigned)(R * K + C) * 2u; voffB[i] = (unsigned)(Rb * K + C) * 2u; }
    const size_t kstep = (size_t)(BK * 2);
    const size_t hstep = (size_t)HALF * K * 2;
    const size_t tstep = 2 * hstep;
    const unsigned ldsw = (unsigned)wid * 1024u;
    const int aoff = lds_byte(wr * 64 + fr, fq * 8), boff = lds_byte(wc * 32 + fr, fq * 8);
#define PG8_SA(b, h) (((b) * 2 + (h)) * HTB)
#define PG8_SB(b, h) ((4 + (b) * 2 + (h)) * HTB)
#define PG8_STAGE(bufoff, gbase, voff) do { _Pragma("unroll") for (int _i = 0; _i < 2; ++_i) \
        __builtin_amdgcn_global_load_lds((const unsigned*)((const char*)(gbase) + (voff)[_i]), (PG8_LAS unsigned*)(lds + (bufoff) + ldsw + _i * 8192), 16, 0, 0); } while (0)
#define PG8_LDA(dst, b, h) do { _Pragma("unroll") for (int m = 0; m < 4; ++m) _Pragma("unroll") for (int k = 0; k < 2; ++k) dst[m][k] = *(const PG8_LAS bf16x8*)(lds + PG8_SA(b, h) + aoff + m * 2048 + k * 1024); } while (0)
#define PG8_LDB(dst, b, h) do { _Pragma("unroll") for (int n = 0; n < 2; ++n) _Pragma("unroll") for (int k = 0; k < 2; ++k) dst[n][k] = *(const PG8_LAS bf16x8*)(lds + PG8_SB(b, h) + boff + n * 2048 + k * 1024); } while (0)
#define PG8_MMA(ai, bj, At, Bt) do { __builtin_amdgcn_s_setprio(1); _Pragma("unroll") for (int m = 0; m < 4; ++m) _Pragma("unroll") for (int n = 0; n < 2; ++n) _Pragma("unroll") for (int k = 0; k < 2; ++k) \
        acc[ai][bj][m][n] = __builtin_amdgcn_mfma_f32_16x16x32_bf16(Bt[n][k], At[m][k], acc[ai][bj][m][n], 0, 0, 0); __builtin_amdgcn_s_setprio(0); } while (0)
#define PG8_WAIT_V(n) asm volatile("s_waitcnt vmcnt(" #n ")" ::: "memory")
#define PG8_WAIT_L(n) asm volatile("s_waitcnt lgkmcnt(" #n ")" ::: "memory")
#define PG8_BAR __builtin_amdgcn_s_barrier()
#define PG8_SCHED __builtin_amdgcn_sched_barrier(0)
    Unit cur, nxt; int ui = 0;
    if (!S.next(0, cur)) return;
    f32x4 acc[2][2][4][2];
#pragma unroll
    for (int a = 0; a < 2; ++a)
#pragma unroll
        for (int b = 0; b < 2; ++b)
#pragma unroll
            for (int m = 0; m < 4; ++m)
#pragma unroll
                for (int n = 0; n < 2; ++n) acc[a][b][m][n] = (f32x4){0.f, 0.f, 0.f, 0.f};
    bf16x8 At[4][2], B0[2][2], B1[2][2];
    const char* cA = (const char*)g.A + (size_t)cur.pm * tstep; const char* cB = (const char*)g.Bt + (size_t)cur.pn * tstep;
    S.a_ready(cur);
    if constexpr (SP2) {
        PG8_STAGE(PG8_SB(0, 0), cB, voffB); PG8_STAGE(PG8_SB(0, 1), cB + hstep, voffB); PG8_STAGE(PG8_SA(0, 0), cA, voffA); PG8_STAGE(PG8_SA(0, 1), cA + hstep, voffA);
        if (wr == 1) PG8_BAR;
        PG8_WAIT_V(2); PG8_BAR;
        PG8_STAGE(PG8_SB(1, 0), cB + kstep, voffB); PG8_STAGE(PG8_SA(1, 0), cA + kstep, voffA); PG8_STAGE(PG8_SB(1, 1), cB + hstep + kstep, voffB);
        PG8_WAIT_V(6); PG8_BAR;
    } else {
        PG8_STAGE(PG8_SB(0, 0), cB, voffB); PG8_STAGE(PG8_SA(0, 0), cA, voffA); PG8_STAGE(PG8_SB(0, 1), cB + hstep, voffB); PG8_STAGE(PG8_SA(0, 1), cA + hstep, voffA);
        if (wr == 1) PG8_BAR;
        PG8_WAIT_V(4); PG8_BAR;
        PG8_STAGE(PG8_SB(1, 0), cB + kstep, voffB); PG8_STAGE(PG8_SA(1, 0), cA + kstep, voffA); PG8_STAGE(PG8_SB(1, 1), cB + hstep + kstep, voffB);
        PG8_WAIT_V(6); PG8_BAR;
    }
    for (;;) {
        const bool has_next = S.next(ui + 1, nxt);
        const char* nA = has_next ? (const char*)g.A + (size_t)nxt.pm * tstep : cA; const char* nB = has_next ? (const char*)g.Bt + (size_t)nxt.pn * tstep : cB;
        for (int t = 0; t < nt; t += 2) {
            const bool last = (t == nt - 2);
            const char* a1 = cA + (size_t)(t + 1) * kstep;
            const char* a2 = last ? nA : cA + (size_t)(t + 2) * kstep; const char* b2 = last ? nB : cB + (size_t)(t + 2) * kstep;
            const char* a3 = a2 + kstep; const char* b3 = b2 + kstep;
            if (last && has_next) S.a_ready(nxt);
            if constexpr (SP2) {
            PG8_LDB(B0, 0, 0); PG8_LDB(B1, 0, 1); PG8_SCHED; PG8_LDA(At, 0, 0); PG8_STAGE(PG8_SA(1, 1), a1 + hstep, voffA);
            PG8_WAIT_V(8); PG8_WAIT_L(0); PG8_BAR; PG8_MMA(0, 0, At, B0); PG8_MMA(0, 1, At, B1); PG8_BAR; PG8_SCHED;
            PG8_LDA(At, 0, 1); PG8_STAGE(PG8_SB(0, 0), b2, voffB); PG8_STAGE(PG8_SB(0, 1), b2 + hstep, voffB); PG8_STAGE(PG8_SA(0, 0), a2, voffA);
            PG8_WAIT_V(8); PG8_WAIT_L(0); PG8_BAR; PG8_MMA(1, 0, At, B0); PG8_MMA(1, 1, At, B1); PG8_BAR; PG8_SCHED;
            PG8_LDB(B0, 1, 0); PG8_LDB(B1, 1, 1); PG8_SCHED; PG8_LDA(At, 1, 0); PG8_STAGE(PG8_SA(0, 1), a2 + hstep, voffA);
            PG8_WAIT_V(8); PG8_WAIT_L(0); PG8_BAR; PG8_MMA(0, 0, At, B0); PG8_MMA(0, 1, At, B1); PG8_BAR; PG8_SCHED;
            PG8_LDA(At, 1, 1); PG8_STAGE(PG8_SB(1, 0), b3, voffB); PG8_STAGE(PG8_SB(1, 1), b3 + hstep, voffB); PG8_STAGE(PG8_SA(1, 0), a3, voffA);
            PG8_WAIT_V(8); PG8_WAIT_L(0); PG8_BAR; PG8_MMA(1, 0, At, B0); PG8_MMA(1, 1, At, B1); PG8_BAR; PG8_SCHED;
            } else {
            PG8_LDB(B0, 0, 0); PG8_SCHED; PG8_LDA(At, 0, 0); PG8_STAGE(PG8_SA(1, 1), a1 + hstep, voffA);
            PG8_WAIT_L(8); PG8_BAR; PG8_WAIT_L(0); PG8_MMA(0, 0, At, B0); PG8_BAR; PG8_SCHED;
            PG8_LDB(B1, 0, 1); PG8_STAGE(PG8_SB(0, 0), b2, voffB);
            PG8_BAR; PG8_WAIT_L(0); PG8_MMA(0, 1, At, B1); PG8_BAR;
            PG8_LDA(At, 0, 1); PG8_STAGE(PG8_SA(0, 0), a2, voffA);
            PG8_BAR; PG8_WAIT_L(0); PG8_MMA(1, 0, At, B0); PG8_BAR; PG8_SCHED;
            PG8_STAGE(PG8_SB(0, 1), b2 + hstep, voffB);
            PG8_WAIT_V(6); PG8_BAR; PG8_MMA(1, 1, At, B1); PG8_BAR;
            PG8_LDB(B0, 1, 0); PG8_SCHED; PG8_LDA(At, 1, 0); PG8_STAGE(PG8_SA(0, 1), a2 + hstep, voffA);
            PG8_WAIT_L(8); PG8_BAR; PG8_WAIT_L(0); PG8_MMA(0, 0, At, B0); PG8_BAR; PG8_SCHED;
            PG8_LDB(B1, 1, 1); PG8_STAGE(PG8_SB(1, 0), b3, voffB);
            PG8_BAR; PG8_WAIT_L(0); PG8_MMA(0, 1, At, B1); PG8_BAR;
            PG8_LDA(At, 1, 1); PG8_STAGE(PG8_SA(1, 0), a3, voffA);
            PG8_BAR; PG8_WAIT_L(0); PG8_MMA(1, 0, At, B0); PG8_BAR; PG8_SCHED;
            PG8_STAGE(PG8_SB(1, 1), b3 + hstep, voffB);
            PG8_WAIT_V(6); PG8_BAR; PG8_MMA(1, 1, At, B1); PG8_BAR;
            }
        }
        if constexpr (ALIGN_EPI) { if (wr == 0) PG8_BAR; }
        if constexpr (!Epi::AFTER_DRAIN) { E(acc, cur, wr, wc, fr, fq); S.done(cur); }
        if (!has_next) break;
#pragma unroll
        for (int a = 0; a < 2; ++a)
#pragma unroll
            for (int b = 0; b < 2; ++b)
#pragma unroll
                for (int m = 0; m < 4; ++m)
#pragma unroll
                    for (int n = 0; n < 2; ++n) acc[a][b][m][n] = (f32x4){0.f, 0.f, 0.f, 0.f};
        cur = nxt; cA = nA; cB = nB; ++ui;
        if constexpr (ALIGN_EPI) { if (wr == 1) PG8_BAR; }
    }
    PG8_WAIT_V(0);
    if constexpr (!ALIGN_EPI) { if (wr == 0) PG8_BAR; }
    PG8_BAR;
    if constexpr (Epi::AFTER_DRAIN) { E.fused(acc, cur, wr, wc, fr, fq, lds, wid, lane); S.done(cur); }
#undef PG8_SA
#undef PG8_SB
#undef PG8_STAGE
#undef PG8_LDA
#undef PG8_LDB
#undef PG8_MMA
#undef PG8_WAIT_V
#undef PG8_WAIT_L
#undef PG8_BAR
#undef PG8_SCHED
}
}

#define XB_TMO      128
#define XB_XCNT(j)  (256  + 64 * (j))
#define XB_XSUB(j)  (1280 + 64 * (j))
#define XB_XGEN(j)  (2304 + 64 * (j))
#define XB_TOP      3328
#define XB_TOPGEN   3392
#define XCD_BAR_WORDS 3456
#define XB_SPIN_CAP (1u << 18)

__device__ __forceinline__ unsigned xb_ld(unsigned* p)              { return __hip_atomic_load(p, __ATOMIC_RELAXED, __HIP_MEMORY_SCOPE_AGENT); }
__device__ __forceinline__ unsigned xb_add(unsigned* p, unsigned v) { return __hip_atomic_fetch_add(p, v, __ATOMIC_RELAXED, __HIP_MEMORY_SCOPE_AGENT); }
__device__ __forceinline__ unsigned xb_xcc_id() { return (unsigned)__builtin_amdgcn_s_getreg((3 << 11) | 20) & 0xFu; }
#define XB_SPIN(cond, bar) do { unsigned _sp = 0; while (cond) { __builtin_amdgcn_s_sleep(1); \
    if ((++_sp & 255u) == 0u) { if (xb_ld(&(bar)[XB_TMO])) break; if (_sp > XB_SPIN_CAP) { atomicAdd(&(bar)[XB_TMO], 1u); break; } } } } while (0)

struct XcdBarrier {
    unsigned* bar; unsigned x;
    volatile LAS unsigned* st;
};

__device__ __forceinline__ XcdBarrier xcd_barrier_post(unsigned* bar, volatile LAS unsigned* st) {
    XcdBarrier b; b.bar = bar; b.x = xb_xcc_id(); b.st = st;
    if (threadIdx.x == 0) (void)xb_add(&bar[XB_XCNT(b.x)], 1u);
    return b;
}
__device__ __forceinline__ void xcd_barrier_complete(unsigned* bar, unsigned x, unsigned& nloc, unsigned& nx) {
    const unsigned G = gridDim.x * gridDim.y * gridDim.z;
    unsigned sum, cnt, mine, sp = 0u;
    for (;;) {
        sum = 0u; cnt = 0u; mine = 0u;
#pragma unroll
        for (unsigned j = 0; j < 16; ++j) { const unsigned c = xb_ld(&bar[XB_XCNT(j)]); sum += c; cnt += (c > 0u) ? 1u : 0u; mine = (j == x) ? c : mine; }
        if (sum == G) break;
        __builtin_amdgcn_s_sleep(1);
        if ((++sp & 255u) == 0u) { if (xb_ld(&bar[XB_TMO])) break; if (sp > XB_SPIN_CAP) { atomicAdd(&bar[XB_TMO], 1u); break; } }
    }
    nloc = mine > 0u ? mine : 1u; nx = cnt > 0u ? cnt : 1u;
}

__device__ __forceinline__ void xcd_barrier(const XcdBarrier& b) {
    asm volatile("s_waitcnt vmcnt(0)" ::: "memory");
    __syncthreads();
    if (threadIdx.x == 0) {
        unsigned* bar = b.bar;
        __builtin_amdgcn_s_waitcnt(0);
        unsigned nloc = b.st[0], nx = b.st[1];
        if (nloc == 0u) { xcd_barrier_complete(bar, b.x, nloc, nx); b.st[0] = nloc; b.st[1] = nx; }
        const unsigned old = xb_add(&bar[XB_XSUB(b.x)], 1u);
        const unsigned gen = old / nloc;
        if (old + 1u == (gen + 1u) * nloc) {
            __builtin_amdgcn_fence(__ATOMIC_RELEASE, "agent");
            asm volatile("s_waitcnt vmcnt(0)" ::: "memory");
            const unsigned og = xb_add(&bar[XB_TOP], 1u);
            const unsigned tg = og / nx;
            if (og + 1u == (tg + 1u) * nx) xb_add(&bar[XB_TOPGEN], 1u);
            else XB_SPIN(xb_ld(&bar[XB_TOPGEN]) == tg, bar);
            __builtin_amdgcn_fence(__ATOMIC_ACQUIRE, "agent");
            xb_add(&bar[XB_XGEN(b.x)], 1u);
            asm volatile("s_waitcnt vmcnt(0)" ::: "memory");
        } else {
            XB_SPIN(xb_ld(&bar[XB_XGEN(b.x)]) == gen, bar);
            __builtin_amdgcn_fence(__ATOMIC_ACQUIRE, "agent");
            asm volatile("s_waitcnt vmcnt(0)" ::: "memory");
        }
    }
    __syncthreads();
}

typedef unsigned short bf16_t;
typedef short bf16x8 __attribute__((ext_vector_type(8)));
typedef float f32x4 __attribute__((ext_vector_type(4)));
typedef unsigned u32x4 __attribute__((ext_vector_type(4)));
typedef unsigned u32x2 __attribute__((ext_vector_type(2)));

struct Ctx {
    const float* x; const int* positions; const float *ln_mix, *ln_ffn, *ln_final, *w_in_ab, *w_pool, *pool_scale, *idx_k_norm, *w_out_ab, *w_in_c, *hgrn_lb, *hgrn_out_norm, *w_out_c, *w_gate_up, *w_down;
    float* out;
    unsigned* ctl; float* rope; float* part; float* lbv;
    bf16_t *W_inab, *W_pool, *W_outab, *W_inc, *W_outc, *W_gu0, *W_gu1, *W_dn0, *W_dn1;
    bf16_t *XB, *Y, *P, *ACT, *L1Q, *L1K, *L1I, *L1G, *ORAW;
    int G, bid;
};

__device__ __forceinline__ float bf_lo(unsigned w) { return __uint_as_float(w << 16); }
__device__ __forceinline__ float bf_hi(unsigned w) { return __uint_as_float(w & 0xffff0000u); }
__device__ __forceinline__ float bf2f(bf16_t b) { return __uint_as_float(((unsigned)b) << 16); }
__device__ __forceinline__ unsigned pk2(float lo, float hi) { return pg8::cvt_pk_bf16(lo, hi); }
__device__ __forceinline__ float wave_sum(float v) {
#pragma unroll
    for (int o = 1; o < 64; o <<= 1) v += __shfl_xor(v, o);
    return v;
}

__device__ __forceinline__ unsigned pk4_fp8(float a, float b, float c, float d) { int w = 0; w = __builtin_amdgcn_cvt_pk_fp8_f32(a, b, w, false); w = __builtin_amdgcn_cvt_pk_fp8_f32(c, d, w, true); return (unsigned)w; }
__device__ __forceinline__ u32x2 bf8_to_fp8(u32x4 w) { u32x2 o; o.x = pk4_fp8(bf_lo(w.x), bf_hi(w.x), bf_lo(w.y), bf_hi(w.y)); o.y = pk4_fp8(bf_lo(w.z), bf_hi(w.z), bf_lo(w.w), bf_hi(w.w)); return o; }

struct RowMapId { __device__ __forceinline__ int operator()(int n) const { return n; } };
struct RowMapAB { __device__ __forceinline__ int operator()(int n) const {
    if (n < PC_Q || (n >= PC_V && n < PC_QI) || n >= PC_WI) return n;
    const int d = n & 63; if (d >= 16) return n;
    return n - d + ((d < 8) ? 2 * d : 2 * (d - 8) + 1); } };
struct RowMapGU { __device__ __forceinline__ int operator()(int n) const {
    if (n < DFF) return 256 * (n >> 7) + (n & 127);
    const int f = n - DFF; return 256 * (f >> 7) + 128 + (f & 127); } };

template <class RowMap>
__device__ __forceinline__ void transpose_item(const float* W, int K, int N, const float* kgain, const float* nscale, bf16_t* WT, RowMap map, LAS float* scr, int item, int lane) {
    const int nblk = (N + 31) >> 5, kb = item / nblk, nb = item - kb * nblk, k0 = 64 * kb, n0 = 32 * nb;
    const int nr = n0 + (lane & 31); const float ns = (nr < N && nscale) ? nscale[nr] : 1.0f;
    float wv[32];
    const int nrc = (nr < N) ? nr : N - 1;
#pragma unroll
    for (int i = 0; i < 32; ++i) wv[i] = W[(size_t)(k0 + 2 * i + (lane >> 5)) * N + nrc];
    float kg[32];
#pragma unroll
    for (int i = 0; i < 32; ++i) kg[i] = kgain ? kgain[k0 + 2 * i + (lane >> 5)] : 1.0f;
#pragma unroll
    for (int i = 0; i < 32; ++i) { const int kk = 2 * i + (lane >> 5); scr[kk * 33 + (lane & 31)] = (nr < N) ? wv[i] * kg[i] * ns : 0.f; }
    asm volatile("s_waitcnt lgkmcnt(0)" ::: "memory");
    const int c = lane & 7;
#pragma unroll
    for (int j = 0; j < 4; ++j) { const int nl = (lane >> 3) + 8 * j; const LAS float* s = scr + (8 * c) * 33 + nl;
        u32x4 o; o.x = pk2(s[0 * 33], s[1 * 33]); o.y = pk2(s[2 * 33], s[3 * 33]); o.z = pk2(s[4 * 33], s[5 * 33]); o.w = pk2(s[6 * 33], s[7 * 33]);
        if (n0 + nl < N) *(u32x4*)(WT + (size_t)map(n0 + nl) * K + k0 + 8 * c) = o; }
    asm volatile("s_waitcnt lgkmcnt(0)" ::: "memory");
}

__device__ __forceinline__ void rope_cs(int pos, int i, float& c, float& s) {
    const double inv = (i == 0) ? 1.0 : (i == 1) ? 0.19392274474868576 : (i == 2) ? 0.03760603093086393 : (i == 3) ? 0.007292664737217109 : (i == 4) ? 0.001414213562373095
                     : (i == 5) ? 0.0002742481756762073 : (i == 6) ? 5.318295896944988e-05 : 1.031338537721246e-05;
    const double a = (double)pos * inv;
    const double kq = rint(a * 0.63661977236758134308);
    double r = fma(-kq, 1.57079632679489655800e+00, a); r = fma(-kq, 6.12323399573676603587e-17, r);
    const double r2 = r * r;
    double sp = -7.6471637318198164759e-13; sp = fma(sp, r2, 1.6059043836821614599e-10); sp = fma(sp, r2, -2.5052108385441718775e-08); sp = fma(sp, r2, 2.7557319223985890653e-06);
    sp = fma(sp, r2, -1.9841269841269841270e-04); sp = fma(sp, r2, 8.3333333333333333333e-03); sp = fma(sp, r2, -1.6666666666666666667e-01); const double sn = fma(sp * r2, r, r);
    double cp = 4.7794773323873852974e-14; cp = fma(cp, r2, -1.1470745597729724714e-11); cp = fma(cp, r2, 2.0876756987868098979e-09); cp = fma(cp, r2, -2.7557319223985890653e-07);
    cp = fma(cp, r2, 2.4801587301587301587e-05); cp = fma(cp, r2, -1.3888888888888888889e-03); cp = fma(cp, r2, 4.1666666666666666667e-02); cp = fma(cp, r2, -0.5); const double cn = fma(cp, r2, 1.0);
    const int q = ((int)kq) & 3;
    const double cc = (q == 0) ? cn : (q == 1) ? -sn : (q == 2) ? -cn : sn;
    const double ss = (q == 0) ? sn : (q == 1) ? cn : (q == 2) ? -sn : -cn;
    c = (float)cc; s = (float)ss;
}

__device__ __forceinline__ void phase_prologue(const Ctx& C, LAS unsigned char* lds) {
    const int tid = threadIdx.x, lane = tid & 63, wave = __builtin_amdgcn_readfirstlane(tid >> 6);
    LAS float* scr = (LAS float*)(lds + wave * 16384);
    const int gw = C.bid * 8 + wave, NGW = C.G * 8;
    constexpr int I_AB = 16 * 51, I_PL = 2 * 4, I_SQ = 16 * 32, I_INC = 16 * 128, I_GU = 16 * 176, I_DN = 44 * 32;
    constexpr int NITEMS = I_AB + 4 * I_PL + I_SQ + I_INC + I_SQ + 2 * I_GU + I_DN;
    for (int it = gw; it < NITEMS; it += NGW) {
        int r = it;
        if (r < I_AB) { transpose_item(C.w_in_ab, 1024, NAB_REAL, C.ln_mix, nullptr, C.W_inab, RowMapAB(), scr, r, lane); continue; } r -= I_AB;
        if (r < 4 * I_PL) { const int g = r / I_PL; transpose_item(C.w_pool + g * 16384, 128, 128, nullptr, C.pool_scale + g * 128, C.W_pool + g * 16384, RowMapId(), scr, r - g * I_PL, lane); continue; } r -= 4 * I_PL;
        if (r < I_SQ) { transpose_item(C.w_out_ab, 1024, 1024, nullptr, nullptr, C.W_outab, RowMapId(), scr, r, lane); continue; } r -= I_SQ;
        if (r < I_INC) { transpose_item(C.w_in_c, 1024, NINC, C.ln_mix + 1024, nullptr, C.W_inc, RowMapId(), scr, r, lane); continue; } r -= I_INC;
        if (r < I_SQ) { transpose_item(C.w_out_c, 1024, 1024, nullptr, nullptr, C.W_outc, RowMapId(), scr, r, lane); continue; } r -= I_SQ;
        if (r < I_GU) { transpose_item(C.w_gate_up, 1024, 2 * DFF, C.ln_ffn, nullptr, C.W_gu0, RowMapGU(), scr, r, lane); continue; } r -= I_GU;
        if (r < I_GU) { transpose_item(C.w_gate_up + (size_t)1024 * 2 * DFF, 1024, 2 * DFF, C.ln_ffn + 1024, nullptr, C.W_gu1, RowMapGU(), scr, r, lane); continue; } r -= I_GU;
        transpose_item(C.w_down, DFF, 1024, nullptr, nullptr, C.W_dn0, RowMapId(), scr, r, lane);
    }
    const int gt = C.bid * 512 + tid, NGT = C.G * 512;
    for (int i = gt; i < (NAB - NAB_REAL) * 1024 / 8; i += NGT) ((u32x4*)(C.W_inab + (size_t)NAB_REAL * 1024))[i] = (u32x4){0u, 0u, 0u, 0u};
    for (int i = gt; i < NTOK * 8; i += NGT) { const int tok = i >> 3, f = i & 7; float c, s; rope_cs(C.positions[tok], f, c, s); C.rope[(size_t)tok * 16 + f] = c; C.rope[(size_t)tok * 16 + 8 + f] = s; }
    for (int i = gt; i < 1024; i += NGT) C.lbv[i] = 1.0f / (1.0f + expf(C.hgrn_lb[i] - C.hgrn_lb[1024 + i]));
    for (int row0 = 4 * gw; row0 < NTOK; row0 += 4 * NGW) {
        f32x4 v[4][4];
#pragma unroll
        for (int rr = 0; rr < 4; ++rr)
#pragma unroll
            for (int j = 0; j < 4; ++j) v[rr][j] = ((const f32x4*)(C.x + (size_t)(row0 + rr) * 1024) + lane)[64 * j];
#pragma unroll
        for (int rr = 0; rr < 4; ++rr) { const int row = row0 + rr; u32x2* o8 = (u32x2*)(C.XB + (size_t)row * 1024) + lane; float s = 0.f;
#pragma unroll
            for (int j = 0; j < 4; ++j) { const f32x4 x4 = v[rr][j]; s += (x4[0] * x4[0] + x4[1] * x4[1]) + (x4[2] * x4[2] + x4[3] * x4[3]); u32x2 w; w.x = pk2(x4[0], x4[1]); w.y = pk2(x4[2], x4[3]); o8[64 * j] = w; }
            s = wave_sum(s);
            if (lane < 16) C.part[(size_t)row * 16 + lane] = (lane == 0) ? s : 0.f; }
    }
}

__device__ __forceinline__ void phase_prologue_late(const Ctx& C, LAS unsigned char* lds) {
    const int tid = threadIdx.x, lane = tid & 63, wave = __builtin_amdgcn_readfirstlane(tid >> 6);
    LAS float* scr = (LAS float*)(lds + wave * 16384);
    const int half = C.G >> 1; if (C.bid < half) return;
    const int gw = (C.bid - half) * 8 + wave, NGW = (C.G - half) * 8;
    for (int it = gw; it < 44 * 32; it += NGW) transpose_item(C.w_down + (size_t)DFF * 1024, DFF, 1024, nullptr, nullptr, C.W_dn1, RowMapId(), scr, it, lane);
}

__device__ __forceinline__ void phase_fixup_pool(const Ctx& C, LAS unsigned char* lds) {
    const int tid = threadIdx.x, lane = tid & 63, wid = __builtin_amdgcn_readfirstlane(tid >> 6);
    for (int tile = C.bid; tile < NTOK / 128; tile += C.G) {
        const int tok0 = tile * 128;
        for (int it = tid; it < 128 * 16; it += 512) {
            const int tl = it >> 4, slot = it & 15;
            const int tok = tok0 + tl;
            unsigned char* kv8 = (unsigned char*)C.ctl + WS_KV8 + (size_t)tok * 256;
            if (slot == 15) {
                const bf16_t* vp = C.P + (size_t)tok * NAB + PC_V;
#pragma unroll
                for (int q2 = 0; q2 < 8; ++q2) { const u32x2 a = bf8_to_fp8(*(const u32x4*)(vp + 16 * q2)), b = bf8_to_fp8(*(const u32x4*)(vp + 16 * q2 + 8)); *(u32x4*)(kv8 + 128 + 16 * q2) = (u32x4){a.x, a.y, b.x, b.y}; }
                continue; }
            const f32x4* rp = (const f32x4*)(C.rope + (size_t)tok * 16);
            const f32x4 c0 = rp[0], c1 = rp[1], s0 = rp[2], s1 = rp[3];
            const float cs[8] = {c0[0], c0[1], c0[2], c0[3], c1[0], c1[1], c1[2], c1[3]}, sn[8] = {s0[0], s0[1], s0[2], s0[3], s1[0], s1[1], s1[2], s1[3]};
            bf16_t* rowp = C.P + (size_t)tok * NAB;
            if (slot < 14) {
                const int col = (slot < 8) ? PC_Q + 64 * slot : (slot < 10) ? PC_K + 64 * (slot - 8) : PC_QI + 64 * (slot - 10);
                u32x4 w0 = *(u32x4*)(rowp + col), w1 = *(u32x4*)(rowp + col + 8);
                unsigned w[8] = {w0.x, w0.y, w0.z, w0.w, w1.x, w1.y, w1.z, w1.w};
#pragma unroll
                for (int i = 0; i < 8; ++i) { const float x1 = bf_lo(w[i]), x2 = bf_hi(w[i]); w[i] = pk2(x1 * cs[i] - x2 * sn[i], x2 * cs[i] + x1 * sn[i]); }
                *(u32x4*)(rowp + col) = (u32x4){w[0], w[1], w[2], w[3]}; *(u32x4*)(rowp + col + 8) = (u32x4){w[4], w[5], w[6], w[7]};
                if (slot == 8 || slot == 9) {
                    unsigned char* kd = kv8 + 64 * (slot - 8);
                    { const u32x2 a = bf8_to_fp8((u32x4){w[0], w[1], w[2], w[3]}), b = bf8_to_fp8((u32x4){w[4], w[5], w[6], w[7]}); *(u32x4*)kd = (u32x4){a.x, a.y, b.x, b.y}; }
#pragma unroll
                    for (int q2 = 1; q2 < 4; ++q2) { const u32x2 a = bf8_to_fp8(*(const u32x4*)(rowp + col + 16 * q2)), b = bf8_to_fp8(*(const u32x4*)(rowp + col + 16 * q2 + 8)); *(u32x4*)(kd + 16 * q2) = (u32x4){a.x, a.y, b.x, b.y}; } }
            } else {
                unsigned w[32];
#pragma unroll
                for (int q = 0; q < 8; ++q) { const u32x4 t = *(u32x4*)(rowp + PC_KI + 8 * q); w[4 * q] = t.x; w[4 * q + 1] = t.y; w[4 * q + 2] = t.z; w[4 * q + 3] = t.w; }
                float ss = 0.f;
#pragma unroll
                for (int i = 0; i < 32; ++i) { const float a = bf_lo(w[i]), b = bf_hi(w[i]); ss += a * a + b * b; }
                const float r = 1.0f / sqrtf(ss * (1.0f / 64.0f) + EPS);
#pragma unroll
                for (int i = 0; i < 32; ++i) {
                    const int d0 = (i < 8) ? i : 2 * i, d1 = (i < 8) ? i + 8 : 2 * i + 1;
                    float a = bf_lo(w[i]) * r * C.idx_k_norm[d0], b = bf_hi(w[i]) * r * C.idx_k_norm[d1];
                    if (i < 8) { const float x1 = a, x2 = b; a = x1 * cs[i] - x2 * sn[i]; b = x2 * cs[i] + x1 * sn[i]; }
                    w[i] = pk2(a, b); }
#pragma unroll
                for (int q = 0; q < 8; ++q) *(u32x4*)(rowp + PC_KI + 8 * q) = (u32x4){w[4 * q], w[4 * q + 1], w[4 * q + 2], w[4 * q + 3]};
            }
        }
        const int fr = lane & 15, fq = lane >> 4;
        const int tl0 = wid * 16 + fr, tok = tok0 + tl0, t = tok & (SEQ - 1);
        const bool hist = (tok0 & (SEQ - 1)) != 0;
        LAS unsigned char* ubuf = lds; LAS unsigned char* wbuf = lds + 39424;
        u32x4 ur[5], wv[4];
#define POOL_LOAD(gx) { _Pragma("unroll") for (int i = 0; i < 5; ++i) { int p = tid + 512 * i; p = p < 2288 ? p : 2287; const int r = p >> 4, pc = p & 15; const int trow = (r < 15 && !hist) ? tok0 : tok0 - 15 + r; \
            ur[i] = *(const u32x4*)(C.P + (size_t)trow * NAB + PC_U + (gx) * 128 + pc * 8); } \
        _Pragma("unroll") for (int i = 0; i < 4; ++i) wv[i] = *(const u32x4*)(C.W_pool + (gx) * 16384 + (tid + 512 * i) * 8); }
        POOL_LOAD(0)
#pragma unroll 1
        for (int g = 0; g < 4; ++g) {
            __syncthreads();
#pragma unroll
            for (int i = 0; i < 5; ++i) { const int p = tid + 512 * i; if (p < 2288) *(LAS u32x4*)(ubuf + (p >> 4) * 272 + (p & 15) * 16) = ur[i]; }
#pragma unroll
            for (int i = 0; i < 4; ++i) { const int p = tid + 512 * i, d = p >> 4; const int slot = (d & ~31) + 16 * ((d >> 2) & 1) + 4 * ((d >> 3) & 3) + (d & 3); *(LAS u32x4*)(wbuf + slot * 272 + (p & 15) * 16) = wv[i]; }
            __syncthreads();
            if (g < 3) POOL_LOAD(g + 1)
            const int win = 2 << g;
            const int cnt = (t + 1 < win) ? t + 1 : win; const float rc = 1.0f / (float)cnt;
            f32x4 acc[4][2];
#pragma unroll
            for (int a = 0; a < 4; ++a) { acc[a][0] = (f32x4){0.f, 0.f, 0.f, 0.f}; acc[a][1] = (f32x4){0.f, 0.f, 0.f, 0.f}; }
#pragma unroll
            for (int kk = 0; kk < 4; ++kk) {
                const LAS unsigned char* up = ubuf + (15 + tl0) * 272 + kk * 64 + fq * 16;
                float s[8], cur[8];
                { const u32x4 wx = *(const LAS u32x4*)up; cur[0] = bf_lo(wx.x); cur[1] = bf_hi(wx.x); cur[2] = bf_lo(wx.y); cur[3] = bf_hi(wx.y); cur[4] = bf_lo(wx.z); cur[5] = bf_hi(wx.z); cur[6] = bf_lo(wx.w); cur[7] = bf_hi(wx.w); }
#pragma unroll
                for (int i = 0; i < 8; ++i) s[i] = cur[i];
                for (int j = 1; j < win; ++j) {
                    const u32x4 wx = *(const LAS u32x4*)(up - j * 272); const float m = (j <= t) ? 1.0f : 0.0f;
                    s[0] += m * bf_lo(wx.x); s[1] += m * bf_hi(wx.x); s[2] += m * bf_lo(wx.y); s[3] += m * bf_hi(wx.y); s[4] += m * bf_lo(wx.z); s[5] += m * bf_hi(wx.z); s[6] += m * bf_lo(wx.w); s[7] += m * bf_hi(wx.w); }
                u32x4 af; af.x = pk2(s[0] * rc - cur[0], s[1] * rc - cur[1]); af.y = pk2(s[2] * rc - cur[2], s[3] * rc - cur[3]); af.z = pk2(s[4] * rc - cur[4], s[5] * rc - cur[5]); af.w = pk2(s[6] * rc - cur[6], s[7] * rc - cur[7]);
                const bf16x8 a = __builtin_bit_cast(bf16x8, af);
#pragma unroll
                for (int nn = 0; nn < 4; ++nn)
#pragma unroll
                    for (int n = 0; n < 2; ++n) {
                        const bf16x8 bfr = *(const LAS bf16x8*)(wbuf + (32 * nn + 16 * n + fr) * 272 + kk * 64 + fq * 16);
                        acc[nn][n] = __builtin_amdgcn_mfma_f32_16x16x32_bf16(bfr, a, acc[nn][n], 0, 0, 0); }
            }
#pragma unroll
            for (int nn = 0; nn < 4; ++nn) { u32x4 w; w.x = pk2(acc[nn][0][0], acc[nn][0][1]); w.y = pk2(acc[nn][0][2], acc[nn][0][3]); w.z = pk2(acc[nn][1][0], acc[nn][1][1]); w.w = pk2(acc[nn][1][2], acc[nn][1][3]);
                *(u32x4*)(C.Y + (size_t)tok * 1024 + g * 128 + 32 * nn + 8 * fq) = w; }
        }
#undef POOL_LOAD
    }
}

__device__ __forceinline__ unsigned fkey(float f) { const unsigned u = __float_as_uint(f); return u ^ ((unsigned)((int)u >> 31) | 0x80000000u); }

__device__ __forceinline__ void phase_attn_simple(const Ctx& C, LAS unsigned char* lds) {
    const int tid = threadIdx.x, lane = tid & 63, wid = tid >> 6;
    LAS unsigned* sc = (LAS unsigned*)lds;
    LAS float* qif = (LAS float*)(lds + 32768);
    LAS float* qf = (LAS float*)(lds + 32768 + 1024);
    LAS unsigned* hist = (LAS unsigned*)(lds + 32768 + 1024 + 2048);
    LAS unsigned* wsum = hist + 256;
    LAS unsigned* ctl = wsum + 16;
    LAS unsigned short* sel = (LAS unsigned short*)(ctl + 8);
    LAS float* pr = (LAS float*)(sel + 256);
    LAS float* red = pr + 2048;
    LAS float* red2 = red + 64;
    for (int qx = C.bid; qx < NTOK; qx += C.G) {
        const int tok = qx, b = tok >> 13, t = tok & (SEQ - 1), n = t + 1;
        const bf16_t* prow = C.P + (size_t)tok * NAB;
        const bf16_t* pb = C.P + (size_t)(b << 13) * NAB;
        __syncthreads();
        if (tid < 256) qif[tid] = bf2f(prow[PC_QI + tid]);
        qf[tid] = bf2f(prow[PC_Q + tid]);
        if (tid == 0) { ctl[0] = 0u; ctl[1] = TOPK; ctl[2] = 0u; }
        float wi[4];
#pragma unroll
        for (int h = 0; h < 4; ++h) wi[h] = bf2f(prow[PC_WI + h]) * 0.0625f;
        __syncthreads();
        for (int s = tid; s < n; s += 512) {
            asm volatile("" ::: "memory");
            const u32x4* kr = (const u32x4*)(pb + (size_t)s * NAB + PC_KI);
            float d0 = 0.f, d1 = 0.f, d2 = 0.f, d3 = 0.f;
#pragma unroll
            for (int q = 0; q < 8; ++q) { const u32x4 w = kr[q]; const float kv[8] = {bf_lo(w.x), bf_hi(w.x), bf_lo(w.y), bf_hi(w.y), bf_lo(w.z), bf_hi(w.z), bf_lo(w.w), bf_hi(w.w)};
#pragma unroll
                for (int j = 0; j < 8; ++j) { const int d = 8 * q + j; d0 += qif[d] * kv[j]; d1 += qif[64 + d] * kv[j]; d2 += qif[128 + d] * kv[j]; d3 += qif[192 + d] * kv[j]; } }
            float scv = 0.0f;
            scv = fmaf(wi[0], fmaxf(d0, 0.f), scv); scv = fmaf(wi[1], fmaxf(d1, 0.f), scv); scv = fmaf(wi[2], fmaxf(d2, 0.f), scv); scv = fmaf(wi[3], fmaxf(d3, 0.f), scv);
            sc[s] = fkey(scv);
        }
        __syncthreads();
        int nsel;
        if (n <= TOPK) { if (tid < n) sel[tid] = (unsigned short)tid; nsel = n; }
        else {
            nsel = TOPK;
            for (int pass = 0; pass < 4; ++pass) {
                const int shift = 24 - 8 * pass;
                if (tid < 256) hist[tid] = 0u;
                __syncthreads();
                const unsigned prefix = ctl[0]; const unsigned himask = (pass == 0) ? 0u : (0xffffffffu << (shift + 8));
                for (int s = tid; s < n; s += 512) { const unsigned k = sc[s]; if ((k & himask) == prefix) __hip_atomic_fetch_add(&hist[(k >> shift) & 255u], 1u, __ATOMIC_RELAXED, __HIP_MEMORY_SCOPE_WORKGROUP); }
                __syncthreads();
                if (wid == 0) {
                    const unsigned need = ctl[1];
                    const unsigned c0 = hist[255 - 4 * lane], c1 = hist[254 - 4 * lane], c2 = hist[253 - 4 * lane], c3 = hist[252 - 4 * lane];
                    const unsigned tot = c0 + c1 + c2 + c3; unsigned incl = tot;
#pragma unroll
                    for (int o = 1; o < 64; o <<= 1) { const unsigned v = __shfl_up(incl, o); if (lane >= o) incl += v; }
                    const unsigned excl = incl - tot;
                    if (excl < need && need <= incl) {
                        const unsigned r = need - excl; unsigned bin, above;
                        if (r <= c0) { bin = 255 - 4 * lane; above = excl; }
                        else if (r <= c0 + c1) { bin = 254 - 4 * lane; above = excl + c0; }
                        else if (r <= c0 + c1 + c2) { bin = 253 - 4 * lane; above = excl + c0 + c1; }
                        else { bin = 252 - 4 * lane; above = excl + c0 + c1 + c2; }
                        ctl[0] = prefix | (bin << shift); ctl[1] = need - above;
                    }
                }
                __syncthreads();
            }
            const unsigned T = ctl[0], mneed = ctl[1];
            unsigned ceq = 0;
#pragma unroll
            for (int j = 0; j < 16; ++j) { const int s = tid * 16 + j; if (s < n && sc[s] == T) ++ceq; }
            unsigned incl = ceq;
#pragma unroll
            for (int o = 1; o < 64; o <<= 1) { const unsigned v = __shfl_up(incl, o); if (lane >= o) incl += v; }
            if (lane == 63) wsum[wid] = incl;
            __syncthreads();
            unsigned base = 0;
            for (int w = 0; w < wid; ++w) base += wsum[w];
            unsigned rank = base + incl - ceq;
            for (int j = 0; j < 16; ++j) { const int s = tid * 16 + j;
                if (s < n) { const unsigned k = sc[s]; bool take = k > T; if (k == T) { take = rank < mneed; ++rank; }
                    if (take) { const unsigned slot = __hip_atomic_fetch_add(&ctl[2], 1u, __ATOMIC_RELAXED, __HIP_MEMORY_SCOPE_WORKGROUP); if (slot < TOPK) sel[slot] = (unsigned short)s; } } }
        }
        __syncthreads();
        {
            const int j = tid & 255, hh = tid >> 8;
            float sv[4] = {-INFINITY, -INFINITY, -INFINITY, -INFINITY};
            if (j < nsel) {
                const u32x4* kr = (const u32x4*)(pb + (size_t)sel[j] * NAB + PC_K + 64 * hh);
                float d[4] = {0.f, 0.f, 0.f, 0.f};
#pragma unroll
                for (int q = 0; q < 8; ++q) { const u32x4 w = kr[q]; const float kv[8] = {bf_lo(w.x), bf_hi(w.x), bf_lo(w.y), bf_hi(w.y), bf_lo(w.z), bf_hi(w.z), bf_lo(w.w), bf_hi(w.w)};
#pragma unroll
                    for (int e = 0; e < 8; ++e)
#pragma unroll
                        for (int r = 0; r < 4; ++r) d[r] += qf[(4 * hh + r) * 64 + 8 * q + e] * kv[e]; }
#pragma unroll
                for (int r = 0; r < 4; ++r) sv[r] = d[r] * 0.125f;
            }
#pragma unroll
            for (int r = 0; r < 4; ++r) { float m = sv[r];
#pragma unroll
                for (int o = 1; o < 64; o <<= 1) m = fmaxf(m, __shfl_xor(m, o));
                if (lane == 0) red[(4 * hh + r) * 8 + (wid & 3)] = m; }
            __syncthreads();
            float ev[4];
#pragma unroll
            for (int r = 0; r < 4; ++r) { const int h = 4 * hh + r; const float m = fmaxf(fmaxf(red[h * 8], red[h * 8 + 1]), fmaxf(red[h * 8 + 2], red[h * 8 + 3]));
                ev[r] = (j < nsel) ? __expf(sv[r] - m) : 0.f; float sm = ev[r];
#pragma unroll
                for (int o = 1; o < 64; o <<= 1) sm += __shfl_xor(sm, o);
                if (lane == 0) red2[h * 8 + (wid & 3)] = sm; }
            __syncthreads();
#pragma unroll
            for (int r = 0; r < 4; ++r) { const int h = 4 * hh + r; const float sm = (red2[h * 8] + red2[h * 8 + 1]) + (red2[h * 8 + 2] + red2[h * 8 + 3]);
                pr[h * 256 + j] = ev[r] / sm; }
        }
        __syncthreads();
        {
            const int h = tid >> 6, g = h >> 2; float o = 0.f;
            const bf16_t* vb = pb + PC_V + 64 * g + lane;
            for (int j = 0; j < nsel; ++j) o += pr[h * 256 + j] * bf2f(vb[(size_t)sel[j] * NAB]);
            C.Y[(size_t)tok * 1024 + 512 + tid] = (bf16_t)(pk2(o, 0.f) & 0xffffu);
        }
    }
}

__device__ __forceinline__ void phase_hgrn_simple(const Ctx& C) {
    const int tid = threadIdx.x, lane = tid & 63, wid = tid >> 6;
    for (int unit = C.bid; unit < BATCH * 8 * 8; unit += C.G) {
        const int b = unit >> 6, h = (unit >> 3) & 7, sl = unit & 7;
        const int e = sl * 16 + 2 * wid + (lane >> 5), dg = lane & 31;
        const size_t cq = (size_t)h * 128 + 4 * dg, cv = (size_t)h * 128 + e;
        float S0 = 0.f, S1 = 0.f, S2 = 0.f, S3 = 0.f;
        const size_t tok0 = (size_t)b * SEQ;
        for (int t0 = 0; t0 < SEQ; t0 += 8) {
            u32x2 qv[8], kv[8]; bf16_t vv[8];
#pragma unroll
            for (int u = 0; u < 8; ++u) { const size_t ro = (tok0 + t0 + u) * 1024; qv[u] = *(const u32x2*)(C.L1Q + ro + cq); kv[u] = *(const u32x2*)(C.L1K + ro + cq); vv[u] = C.L1I[ro + cv]; }
#pragma unroll
            for (int u = 0; u < 8; ++u) {
                const float k0 = bf_lo(kv[u].x), k1 = bf_hi(kv[u].x), k2 = bf_lo(kv[u].y), k3 = bf_hi(kv[u].y), v = bf2f(vv[u]);
                S0 = (1.0f - k0) * S0 + k0 * v; S1 = (1.0f - k1) * S1 + k1 * v; S2 = (1.0f - k2) * S2 + k2 * v; S3 = (1.0f - k3) * S3 + k3 * v;
                float o = (bf_lo(qv[u].x) * S0 + bf_hi(qv[u].x) * S1) + (bf_lo(qv[u].y) * S2 + bf_hi(qv[u].y) * S3);
#pragma unroll
                for (int off = 1; off < 32; off <<= 1) o += __shfl_xor(o, off);
                if (dg == 0) C.ORAW[(tok0 + t0 + u) * 1024 + cv] = (bf16_t)(pk2(o, 0.f) & 0xffffu);
            }
        }
    }
}
__device__ __forceinline__ void phase_hgrn_post(const Ctx& C) {
    const int tid = threadIdx.x, lane = tid & 63, wave = tid >> 6;
    const int gw = C.bid * 8 + wave, NGW = C.G * 8;
    for (int tok = gw; tok < NTOK; tok += NGW) {
        const size_t ro = (size_t)tok * 1024 + 16 * lane;
        const u32x4 a0 = *(const u32x4*)(C.ORAW + ro), a1 = *(const u32x4*)(C.ORAW + ro + 8), g0 = *(const u32x4*)(C.L1G + ro), g1 = *(const u32x4*)(C.L1G + ro + 8);
        const unsigned aw[8] = {a0.x, a0.y, a0.z, a0.w, a1.x, a1.y, a1.z, a1.w}, gwd[8] = {g0.x, g0.y, g0.z, g0.w, g1.x, g1.y, g1.z, g1.w};
        float ss = 0.f;
#pragma unroll
        for (int i = 0; i < 8; ++i) { const float x = bf_lo(aw[i]), y = bf_hi(aw[i]); ss += x * x + y * y; }
        ss += __shfl_xor(ss, 1); ss += __shfl_xor(ss, 2); ss += __shfl_xor(ss, 4);
        const float r = 1.0f / sqrtf(ss * (1.0f / 128.0f) + EPS);
        const float* nw = C.hgrn_out_norm + 16 * (lane & 7);
        unsigned ow[8];
#pragma unroll
        for (int i = 0; i < 8; ++i) ow[i] = pk2(bf_lo(aw[i]) * r * nw[2 * i] * bf_lo(gwd[i]), bf_hi(aw[i]) * r * nw[2 * i + 1] * bf_hi(gwd[i]));
        *(u32x4*)(C.Y + ro) = (u32x4){ow[0], ow[1], ow[2], ow[3]}; *(u32x4*)(C.Y + ro + 8) = (u32x4){ow[4], ow[5], ow[6], ow[7]};
    }
}
__device__ __forceinline__ void phase_final_norm(const Ctx& C) {
    const bool grp = C.G == 256;
    const int gt = grp ? (C.bid >> 3) * 512 + (int)threadIdx.x : C.bid * 512 + (int)threadIdx.x, NGT = grp ? 32 * 512 : C.G * 512, NEL = grp ? 4096 * 128 : NTOK * 128, rbase = grp ? 4096 * (C.bid & 7) : 0;
    for (int i = gt; i < NEL; i += NGT) { const int row = rbase + (i >> 7), c8 = (i & 127) * 8;
        const float r = pg8::row_rinv(C.part, row);
        const u32x4 b = *(const u32x4*)(C.XB + (size_t)row * 1024 + c8); const f32x4 g0 = *(const f32x4*)(C.ln_final + c8), g1 = *(const f32x4*)(C.ln_final + c8 + 4);
        f32x4 o0, o1; o0[0] = bf_lo(b.x) * r * g0[0]; o0[1] = bf_hi(b.x) * r * g0[1]; o0[2] = bf_lo(b.y) * r * g0[2]; o0[3] = bf_hi(b.y) * r * g0[3];
        o1[0] = bf_lo(b.z) * r * g1[0]; o1[1] = bf_hi(b.z) * r * g1[1]; o1[2] = bf_lo(b.w) * r * g1[2]; o1[3] = bf_hi(b.w) * r * g1[3];
        *(f32x4*)(C.out + (size_t)row * 1024 + c8) = o0; *(f32x4*)(C.out + (size_t)row * 1024 + c8 + 4) = o1; }
}

typedef float f32x16 __attribute__((ext_vector_type(16)));
typedef float f32x2 __attribute__((ext_vector_type(2)));
constexpr int AQ = 32;
constexpr int A_SEL = 131072;
constexpr int A_QS = A_SEL + AQ * 256 * 2;
constexpr int VROW = 144;

__device__ __forceinline__ float relu_f(float x) { const int b = __float_as_int(x); return __int_as_float(b > 0 ? b : 0); }
__device__ __forceinline__ void idx_tile16(const bf16x8 k0, const bf16x8 k1, const bf16x8 (&qb)[4][2], const float (&wq)[4], float (&sc)[4]) {
#pragma unroll
    for (int r = 0; r < 4; ++r) sc[r] = 0.0f;
#pragma unroll
    for (int h = 0; h < 4; ++h) { f32x4 a = (f32x4){0.f, 0.f, 0.f, 0.f};
        a = __builtin_amdgcn_mfma_f32_16x16x32_bf16(k0, qb[h][0], a, 0, 0, 0); a = __builtin_amdgcn_mfma_f32_16x16x32_bf16(k1, qb[h][1], a, 0, 0, 0);
#pragma unroll
        for (int r = 0; r < 4; ++r) sc[r] = fmaf(wq[h], relu_f(a[r]), sc[r]); }
}


__device__ __forceinline__ unsigned wave_incl_scan(unsigned v, int lane) {
    v += (unsigned)__builtin_amdgcn_update_dpp(0, (int)v, 0x111, 0xf, 0xf, false);
    v += (unsigned)__builtin_amdgcn_update_dpp(0, (int)v, 0x112, 0xf, 0xf, false);
    v += (unsigned)__builtin_amdgcn_update_dpp(0, (int)v, 0x114, 0xf, 0xf, false);
    v += (unsigned)__builtin_amdgcn_update_dpp(0, (int)v, 0x118, 0xf, 0xf, false);
    const unsigned r0 = (unsigned)__builtin_amdgcn_readlane((int)v, 15), r1 = (unsigned)__builtin_amdgcn_readlane((int)v, 31), r2 = (unsigned)__builtin_amdgcn_readlane((int)v, 47);
    const int row = lane >> 4;
    return v + (row >= 1 ? r0 : 0u) + (row >= 2 ? r1 : 0u) + (row >= 3 ? r2 : 0u);
}

__device__ __forceinline__ void phase_attn(const Ctx& C, LAS unsigned char* lds) {
    const int tid = threadIdx.x, lane0 = tid & 63, wid = __builtin_amdgcn_readfirstlane(tid >> 6);
    LAS unsigned* hist = (LAS unsigned*)lds;
    LAS unsigned short* sel = (LAS unsigned short*)(lds + A_SEL);
    LAS unsigned* tpool = (LAS unsigned*)(lds + 65536); constexpr int TCAP = 16384;
    LAS unsigned* dummy = (LAS unsigned*)(lds + A_QS + 1024) + tid;
    LAS unsigned* bmp = (LAS unsigned*)(lds + 32768);
    LAS int* q_bin = (LAS int*)(lds + A_QS); LAS int* q_need = q_bin + 32; LAS int* q_cnt = q_bin + 64; LAS int* q_off = q_bin + 96; LAS int* q_selc = q_bin + 128; LAS int* q_tiec = q_bin + 160;
    unsigned* pool = (unsigned*)((unsigned char*)C.ctl + (C.bid < 64 ? WS_XB + (size_t)C.bid * MiB : 296 * MiB + (size_t)(C.bid - 64) * MiB));
    const int nbw = C.G >> 2, ntile = SEQ / AQ, jb = C.bid >> 2;
    for (int ui = 0; ui * nbw < ntile; ++ui) {
        const int rank = ui * nbw + ((ui & 1) ? (nbw - 1 - jb) : jb);
        if (jb >= nbw || rank >= ntile) continue;
        const int tile = (ntile - 1) - rank, b = C.bid & 3, t0 = tile * AQ, tok0 = b * SEQ + t0;
        const bf16_t* pb = C.P + (size_t)(b * SEQ) * NAB;
        const unsigned char* kv8b = (const unsigned char*)C.ctl + WS_KV8 + (size_t)(b * SEQ) * 256;
        __syncthreads();
        int ln = lane0; asm volatile("" : "+v"(ln)); const int lane = ln;
        if (t0 < TOPK) {
            int tf = tid; asm volatile("" : "+v"(tf));
            for (int i = tf; i < AQ * 256; i += 512) { const int q = i >> 8, j = i & 255; sel[i] = (unsigned short)((j <= t0 + q) ? j : 0); }
        } else {
            for (int i = tid; i < AQ * 1024 / 4; i += 512) ((LAS u32x4*)hist)[i] = (u32x4){0u, 0u, 0u, 0u};
            const int qc = ln & 15, fq = ln >> 4;
            bf16x8 qb[2][4][2]; float wq[2][4];
#pragma unroll
            for (int hf = 0; hf < 2; ++hf) { const bf16_t* qrow = C.P + (size_t)(tok0 + 16 * hf + qc) * NAB;
#pragma unroll
              for (int h = 0; h < 4; ++h) { wq[hf][h] = bf2f(qrow[PC_WI + h]) * 0.0625f;
#pragma unroll
                  for (int ks = 0; ks < 2; ++ks) qb[hf][h][ks] = *(const bf16x8*)(qrow + PC_QI + h * 64 + ks * 32 + 8 * fq); } }
            const int kdiag0 = 2 * tile;
            const bf16_t* kbase = pb + (size_t)qc * NAB + PC_KI + 8 * fq;
            __syncthreads();
            bf16x8 kr[4][2]; const int kmaxt = kdiag0 + 1;
#define IDX_RING_LOAD(j, ktx) { const int ktc_ = ((ktx) <= kmaxt) ? (ktx) : kmaxt; const bf16_t* kp_ = kbase + (size_t)(ktc_ * 16) * NAB; kr[j][0] = *(const bf16x8*)kp_; kr[j][1] = *(const bf16x8*)(kp_ + 32); }
#pragma unroll
            for (int j = 0; j < 4; ++j) IDX_RING_LOAD(j, wid + 8 * j)
            for (int kt0 = wid; kt0 <= kmaxt; kt0 += 32) {
#pragma unroll
                for (int j = 0; j < 4; ++j) { const int kt = kt0 + 8 * j;
                    if (kt <= kmaxt) {
#pragma unroll
                        for (int hf = 0; hf < 2; ++hf) if (kt <= kdiag0 + hf) {
                            float sc[4]; idx_tile16(kr[j][0], kr[j][1], qb[hf], wq[hf], sc);
                            const int qn = 16 * hf + qc; LAS unsigned* hrow = hist + qn * 1024;
                            if (kt != kdiag0 + hf) {
#pragma unroll
                                for (int r = 0; r < 4; ++r) { const unsigned bin = fkey(sc[r]) >> 21;
                                    __hip_atomic_fetch_add(&hrow[(bin >> 1) ^ (unsigned)qn], (bin & 1u) ? 65536u : 1u, __ATOMIC_RELAXED, __HIP_MEMORY_SCOPE_WORKGROUP); }
                            } else {
#pragma unroll
                                for (int r = 0; r < 4; ++r) { const unsigned bin = fkey(sc[r]) >> 21;
                                    __hip_atomic_fetch_add(&hrow[(bin >> 1) ^ (unsigned)qn], (4 * fq + r <= qc) ? ((bin & 1u) ? 65536u : 1u) : 0u, __ATOMIC_RELAXED, __HIP_MEMORY_SCOPE_WORKGROUP); } } } }
                    IDX_RING_LOAD(j, kt + 32) }
            }
            __syncthreads();
#if defined(DBG_REPEAT) && DBG_REPEAT == 35
#pragma unroll 1
            for (int i8 = 0; i8 < 8; ++i8) { const int i = i8 & 3; const int q = 4 * wid + i;
#else
#pragma unroll 1
            for (int i = 0; i < 4; ++i) { const int q = 4 * wid + i;
#endif
                unsigned tot = 0;
#pragma unroll
                for (int j = 0; j < 16; ++j) { const unsigned w = hist[q * 1024 + ((1023 - 16 * lane - ((j + lane + (lane >> 4)) & 15)) ^ q)]; tot += (w & 0xffffu) + (w >> 16); }
                const unsigned incl = wave_incl_scan(tot, lane);
                const unsigned excl = incl - tot;
                if (excl < TOPK && TOPK <= incl) {
                    unsigned hw[16];
#pragma unroll
                    for (int j = 0; j < 16; ++j) hw[j] = hist[q * 1024 + ((1023 - 16 * lane - j) ^ q)];
                    unsigned run = excl; int fbin = -1; unsigned fabove = 0, fcnt = 0;
#pragma unroll
                    for (int j = 0; j < 16; ++j) {
                        const unsigned chi = hw[j] >> 16, clo = hw[j] & 0xffffu; const int wbin = 2 * (1023 - 16 * lane - j);
                        if (fbin < 0 && run + chi >= TOPK) { fbin = wbin + 1; fabove = run; fcnt = chi; } run += chi;
                        if (fbin < 0 && run + clo >= TOPK) { fbin = wbin; fabove = run; fcnt = clo; } run += clo; }
                    q_bin[q] = fbin; q_need[q] = TOPK - (int)fabove; q_cnt[q] = (int)fcnt; q_selc[q] = 0; q_tiec[q] = 0;
                } }
            __syncthreads();
            for (int i = tid; i < AQ * 256 / 4; i += 512) ((LAS u32x4*)bmp)[i] = (u32x4){0u, 0u, 0u, 0u};
            if (tid < 32) { int tq = tid; asm volatile("" : "+v"(tq));
                int c = q_cnt[tq], incl = c;
#pragma unroll
                for (int o = 1; o < 32; o <<= 1) { const int v = __shfl_up(incl, o); if (tq >= o) incl += v; }
                q_off[tq] = incl - c; }
            __syncthreads();
            unsigned mybin[2]; int myoff[2];
#pragma unroll
            for (int hf = 0; hf < 2; ++hf) { mybin[hf] = (unsigned)q_bin[16 * hf + qc]; myoff[hf] = q_off[16 * hf + qc]; }
#if defined(DBG_REPEAT) && (DBG_REPEAT == 34 || DBG_REPEAT == 36)
#pragma unroll 1
            for (int rep34 = 0; rep34 < 2; ++rep34) {
            if (rep34 && DBG_REPEAT == 34) { __syncthreads(); if (tid < 32) q_tiec[tid] = 0; __syncthreads(); }
#endif
#pragma unroll
            for (int j = 0; j < 4; ++j) IDX_RING_LOAD(j, wid + 8 * j)
            for (int kt0 = wid; kt0 <= kmaxt; kt0 += 32) {
#pragma unroll
                for (int j = 0; j < 4; ++j) { const int kt = kt0 + 8 * j;
                    if (kt <= kmaxt) {
#pragma unroll
                for (int hf = 0; hf < 2; ++hf) if (kt <= kdiag0 + hf) {
                    float sc[4]; idx_tile16(kr[j][0], kr[j][1], qb[hf], wq[hf], sc);
                    const bool diag = kt == kdiag0 + hf; const int qn = 16 * hf + qc; const int s0 = kt * 16 + 4 * fq;
                    unsigned amask = 0u, ent[4]; int nt = 0; bool ist[4];
#pragma unroll
                    for (int r = 0; r < 4; ++r) { const unsigned key = fkey(sc[r]); const unsigned bin = key >> 21;
                        amask |= (bin > mybin[hf]) ? (1u << r) : 0u; ist[r] = bin == mybin[hf];
                        ent[r] = (((key >> 2) & 0x7ffffu) << 13) | (unsigned)(8191 - (s0 + r)); }
                    if (diag) {
#pragma unroll
                        for (int r = 0; r < 4; ++r) { const bool v = 4 * fq + r <= qc; amask &= v ? ~0u : ~(1u << r); ist[r] = ist[r] && v; } }
#pragma unroll
                    for (int r = 0; r < 4; ++r) nt += ist[r] ? 1 : 0;
                    __hip_atomic_fetch_or(&bmp[qn * 256 + (s0 >> 5)], amask << (s0 & 31), __ATOMIC_RELAXED, __HIP_MEMORY_SCOPE_WORKGROUP);
#if defined(DBG_REPEAT) && DBG_REPEAT == 36
                    int vi = myoff[hf]; if (rep34 == 0) vi += __hip_atomic_fetch_add(&q_tiec[qn], nt, __ATOMIC_RELAXED, __HIP_MEMORY_SCOPE_WORKGROUP);
                    if (rep34) { for (int r = 0; r < 4; ++r) ist[r] = false; nt = 0; }
#else
                    int vi = myoff[hf] + __hip_atomic_fetch_add(&q_tiec[qn], nt, __ATOMIC_RELAXED, __HIP_MEMORY_SCOPE_WORKGROUP);
#endif
                    if (__ballot(nt > 0 && vi + nt > TCAP) == 0ull) {
#pragma unroll
                        for (int r = 0; r < 4; ++r) { LAS unsigned* dst = ist[r] ? (tpool + vi) : dummy; *dst = ent[r]; vi += ist[r] ? 1 : 0; }
                    } else {
#pragma unroll
                        for (int r = 0; r < 4; ++r) if (ist[r]) { if (vi < TCAP) tpool[vi] = ent[r]; else pool[vi] = ent[r]; ++vi; } } }
                    }
                    IDX_RING_LOAD(j, kt + 32) }
            }
#if defined(DBG_REPEAT) && (DBG_REPEAT == 34 || DBG_REPEAT == 36)
            }
#endif
#undef IDX_RING_LOAD
            __syncthreads();
#if defined(DBG_REPEAT) && DBG_REPEAT == 33
#pragma unroll 1
            for (int rep33 = 0; rep33 < 2; ++rep33)
#endif
            {
                int cq[4], offq[4], Rq[4]; unsigned needq[4], thrq[4], actq[4], validq[4]; constexpr int NR = 10; unsigned ev[4][NR]; bool slowq[4];
#pragma unroll
                for (int i = 0; i < 4; ++i) { const int q = 4 * wid + i; cq[i] = q_cnt[q]; offq[i] = q_off[q]; const int m = q_need[q];
                    needq[i] = (unsigned)(m < cq[i] ? m : cq[i]);
                    slowq[i] = cq[i] > 64 * NR; Rq[i] = slowq[i] ? 0 : (cq[i] + 63) >> 6; thrq[i] = 0u; actq[i] = 0u; }
#pragma unroll
                for (int i = 0; i < 4; ++i)
#pragma unroll
                    for (int r = 0; r < NR; ++r) { const int e = lane + 64 * r; const bool in = e < cq[i] && !slowq[i]; const int vi = offq[i] + (e < cq[i] ? e : cq[i] - 1); const unsigned v = (vi < TCAP) ? tpool[vi] : pool[vi]; ev[i][r] = in ? v : 0u; actq[i] |= in ? (1u << r) : 0u; }
#pragma unroll
                for (int i = 0; i < 4; ++i) validq[i] = actq[i];
                const int Rmax = max(max(Rq[0], Rq[1]), max(Rq[2], Rq[3]));
#pragma unroll 1
                for (int p = 3; p >= 0; --p) { const int shift = 8 * p;
#pragma unroll
                    for (int i = 0; i < 4; ++i) *(LAS u32x4*)(lds + (wid * 4 + i) * 1024 + 16 * lane) = (u32x4){0u, 0u, 0u, 0u};
#pragma unroll
                    for (int r = 0; r < NR; ++r) if (r < Rmax) {
#pragma unroll
                        for (int i = 0; i < 4; ++i) { LAS unsigned* wh = (LAS unsigned*)(lds + (wid * 4 + i) * 1024); if ((actq[i] >> r) & 1u) __hip_atomic_fetch_add(&wh[(ev[i][r] >> shift) & 255u], 1u, __ATOMIC_RELAXED, __HIP_MEMORY_SCOPE_WORKGROUP); } }
                    u32x4 hv[4]; unsigned tot[4], incl[4];
#pragma unroll
                    for (int i = 0; i < 4; ++i) { hv[i] = *(const LAS u32x4*)(lds + (wid * 4 + i) * 1024 + 16 * (63 - lane)); tot[i] = (hv[i].x + hv[i].y) + (hv[i].z + hv[i].w); }
#pragma unroll
                    for (int i = 0; i < 4; ++i) incl[i] = wave_incl_scan(tot[i], lane);
#pragma unroll
                    for (int i = 0; i < 4; ++i) { const unsigned excl = incl[i] - tot[i], need = needq[i]; const bool cross = excl < need && need <= incl[i];
                        unsigned dig = 252u - 4u * (unsigned)lane, ab = excl + hv[i].w + hv[i].z + hv[i].y;
                        if (excl + hv[i].w >= need) { dig += 3u; ab = excl; } else if (excl + hv[i].w + hv[i].z >= need) { dig += 2u; ab = excl + hv[i].w; } else if (excl + hv[i].w + hv[i].z + hv[i].y >= need) { dig += 1u; ab = excl + hv[i].w + hv[i].z; }
                        const unsigned long long bm = __ballot(cross);
                        if (bm) { const int src = __ffsll(bm) - 1; dig = (unsigned)__shfl((int)dig, src); ab = (unsigned)__shfl((int)ab, src);
                            thrq[i] |= dig << shift; needq[i] = need - ab;
                            unsigned keep = 0u;
#pragma unroll
                            for (int r = 0; r < NR; ++r) keep |= (((ev[i][r] >> shift) & 255u) == dig) ? (1u << r) : 0u;
                            actq[i] &= keep; } }
                }
#pragma unroll
                for (int i = 0; i < 4; ++i) { LAS unsigned* bq = bmp + (4 * wid + i) * 256;
#pragma unroll
                    for (int r = 0; r < NR; ++r) if (r < Rmax) { if (((validq[i] >> r) & 1u) && ev[i][r] >= thrq[i]) { const unsigned ix = 8191u - (ev[i][r] & 8191u); __hip_atomic_fetch_or(&bq[ix >> 5], 1u << (ix & 31u), __ATOMIC_RELAXED, __HIP_MEMORY_SCOPE_WORKGROUP); } } }
#pragma unroll 1
                for (int i = 0; i < 4; ++i) if (slowq[i]) { const int c = cq[i], off = offq[i]; LAS unsigned* bq = bmp + (4 * wid + i) * 256;
                    unsigned need = needq[i], thr = 0u;
#pragma unroll 1
                    for (int bit = 31; bit >= 0; --bit) { unsigned cnt1 = 0; const unsigned hm = (bit == 31) ? 0u : (0xffffffffu << (bit + 1));
                        for (int e = lane; e < c; e += 64) { const int vi = off + e; const unsigned v = (vi < TCAP) ? tpool[vi] : pool[vi]; if ((v & hm) == thr && ((v >> bit) & 1u)) ++cnt1; }
#pragma unroll
                        for (int o = 1; o < 64; o <<= 1) cnt1 += __shfl_xor(cnt1, o);
                        if (cnt1 >= need) thr |= 1u << bit; else need -= cnt1; }
                    for (int e = lane; e < c; e += 64) { const int vi = off + e; const unsigned v = (vi < TCAP) ? tpool[vi] : pool[vi]; if (v >= thr) { const unsigned ix = 8191u - (v & 8191u); __hip_atomic_fetch_or(&bq[ix >> 5], 1u << (ix & 31u), __ATOMIC_RELAXED, __HIP_MEMORY_SCOPE_WORKGROUP); } } }
                u32x4 bw[4]; unsigned cntb[4], inb[4];
#pragma unroll
                for (int i = 0; i < 4; ++i) { bw[i] = *(const LAS u32x4*)(bmp + (4 * wid + i) * 256 + 4 * lane); cntb[i] = (unsigned)((__popc(bw[i].x) + __popc(bw[i].y)) + (__popc(bw[i].z) + __popc(bw[i].w))); }
#pragma unroll
                for (int i = 0; i < 4; ++i) inb[i] = wave_incl_scan(cntb[i], lane);
#pragma unroll
                for (int i = 0; i < 4; ++i) { LAS unsigned short* sq = sel + (4 * wid + i) * 256; int pos = (int)(inb[i] - cntb[i]); const unsigned w4[4] = {bw[i].x, bw[i].y, bw[i].z, bw[i].w};
#pragma unroll
                    for (int wi = 0; wi < 4; ++wi) { unsigned w = w4[wi]; while (w) { const int bp = __ffs((int)w) - 1; if (pos < 256) sq[pos] = (unsigned short)((4 * lane + wi) * 32 + bp); ++pos; w &= w - 1u; } } }
            }
        }
        __syncthreads();
#ifndef A_EXP2
        LAS unsigned char* pbuf = lds + wid * 16384;
        LAS unsigned char* vbuf = pbuf + 4096;
        int ln2 = lane0; asm volatile("" : "+v"(ln2));
        const int hh = ln2 & 15, fq = ln2 >> 4;
        typedef int i32x2 __attribute__((ext_vector_type(2)));
        const unsigned char* kgb = kv8b + (ln2 & 7) * 16;
        LAS unsigned char* kstw = vbuf + (ln2 >> 3) * 144 + (ln2 & 7) * 16; const LAS unsigned char* kstr = vbuf + hh * 144 + 8 * fq;
        const unsigned char* vgb = kv8b + 128 + (ln2 & 3) * 16;
#define ATT_LOADK(kk, sqx, b4) { _Pragma("unroll") for (int i8 = 0; i8 < 8; ++i8) { const int kidx = (sqx)[64 * (b4) + 8 * i8 + (ln2 >> 3)]; kk[i8] = *(const u32x4*)(kgb + (size_t)kidx * 256); } }
#define ATT_MMAK(kk, b4) { _Pragma("unroll") for (int i8 = 0; i8 < 8; ++i8) *(LAS u32x4*)(kstw + i8 * (8 * 144)) = kk[i8]; \
    _Pragma("unroll") for (int j4 = 0; j4 < 4; ++j4) { f32x4 a = (f32x4){0.f, 0.f, 0.f, 0.f}; _Pragma("unroll") for (int k4 = 0; k4 < 4; ++k4) a = __builtin_amdgcn_mfma_f32_16x16x32_fp8_fp8(*(const LAS long*)(kstr + j4 * (16 * 144) + 32 * k4), qf[k4], a, 0, 0, 0); S[4 * (b4) + j4] = a; } }
#define ATT_LOADV(slot, sqx, chx) { _Pragma("unroll") for (int p2 = 0; p2 < 2; ++p2) { const unsigned char* vp = vgb + (size_t)(sqx)[32 * (chx) + (ln2 >> 2) + 16 * p2] * 256; vr[slot][0][p2] = *(const u32x4*)vp; vr[slot][1][p2] = *(const u32x4*)(vp + 64); } }
#define ATT_LOADQ(tokx) { _Pragma("unroll") for (int kk = 0; kk < 4; ++kk) { u32x4 w = (u32x4){0u, 0u, 0u, 0u}; if (hh < 8 && (hh >> 2) == (kk >> 1)) w = *(const u32x4*)(C.P + (size_t)(tokx) * NAB + PC_Q + hh * 64 + (kk & 1) * 32 + 8 * fq); qraw[kk] = w; } }
#if defined(DBG_REPEAT) && DBG_REPEAT == 31
#pragma unroll 1
        for (int rep31 = 0; rep31 < 2; ++rep31)
#endif
        {
        u32x4 kA[8], kB[8]; u32x4 qraw[4]; u32x4 vr[3][2][2];
        { const LAS unsigned short* sq0 = sel + (4 * wid) * 256; ATT_LOADQ(tok0 + 4 * wid) ATT_LOADK(kA, sq0, 0) ATT_LOADK(kB, sq0, 1) }
#pragma unroll 1
        for (int iq = 0; iq < 4; ++iq) {
            const int q = 4 * wid + iq, tok = tok0 + q, t = t0 + q, nsel = (t + 1 < TOPK) ? t + 1 : TOPK;
            const LAS unsigned short* sq = sel + q * 256;
            {
                long qf[4];
#pragma unroll
                for (int kk = 0; kk < 4; ++kk) { const u32x2 f8 = bf8_to_fp8(qraw[kk]); qf[kk] = (long)(((unsigned long long)f8.y << 32) | f8.x); }
                f32x4 S[16];
                ATT_MMAK(kA, 0) ATT_LOADK(kA, sq, 2)
                ATT_MMAK(kB, 1) ATT_LOADK(kB, sq, 3)
                ATT_MMAK(kA, 2) ATT_MMAK(kB, 3)
                ATT_LOADV(0, sq, 0) ATT_LOADV(1, sq, 1) ATT_LOADV(2, sq, 2)
                float mx = -INFINITY;
                if (nsel < TOPK) {
                    const int nrel = nsel - 4 * fq;
#pragma unroll
                    for (int tl = 0; tl < 16; ++tl)
#pragma unroll
                        for (int r = 0; r < 4; ++r) S[tl][r] = ((16 * tl + r) < nrel) ? S[tl][r] : -INFINITY; }
#pragma unroll
                for (int tl = 0; tl < 16; ++tl)
#pragma unroll
                    for (int r = 0; r < 4; ++r) mx = fmaxf(mx, S[tl][r]);
                mx = fmaxf(mx, __shfl_xor(mx, 16)); mx = fmaxf(mx, __shfl_xor(mx, 32));
                const float cexp = 0.125f * 1.44269504088896f, moff = -mx * cexp;
                float sm = 0.f;
#pragma unroll
                for (int tl = 0; tl < 16; ++tl)
#pragma unroll
                    for (int r = 0; r < 4; ++r) { const float e = __builtin_amdgcn_exp2f(fmaf(S[tl][r], cexp, moff)); S[tl][r] = e; sm += e; }
                sm += __shfl_xor(sm, 16); sm += __shfl_xor(sm, 32);
                const float inv = 1.0f / sm;
#pragma unroll
                for (int ch = 0; ch < 8; ++ch) { u32x2 w; w.x = pk4_fp8(S[2 * ch][0] * inv, S[2 * ch][1] * inv, S[2 * ch][2] * inv, S[2 * ch][3] * inv);
                    w.y = pk4_fp8(S[2 * ch + 1][0] * inv, S[2 * ch + 1][1] * inv, S[2 * ch + 1][2] * inv, S[2 * ch + 1][3] * inv); *(LAS u32x2*)(pbuf + ch * 512 + lane * 8) = w; }
            }
            if (iq < 3) { const LAS unsigned short* sqn = sq + 256; ATT_LOADK(kA, sqn, 0) ATT_LOADK(kB, sqn, 1) }
            f32x4 O[2][4];
#pragma unroll
            for (int g = 0; g < 2; ++g)
#pragma unroll
                for (int dt = 0; dt < 4; ++dt) O[g][dt] = (f32x4){0.f, 0.f, 0.f, 0.f};
            const int tq8 = hh >> 1, tp8 = hh & 1;
            const LAS unsigned char* vtr = vbuf + ((tq8 < 4) ? (4 * fq + tq8) : (16 + 4 * fq + tq8 - 4)) * 80 + tp8 * 8;
#pragma unroll
            for (int ch = 0; ch < 8; ++ch) {
                const long pf = *(const LAS long*)(pbuf + ch * 512 + lane * 8);
#pragma unroll
                for (int g = 0; g < 2; ++g) {
#pragma unroll
                    for (int p2 = 0; p2 < 2; ++p2) *(LAS u32x4*)(vbuf + ((ln2 >> 2) + 16 * p2) * 80 + (ln2 & 3) * 16) = vr[ch % 3][g][p2];
#pragma unroll
                    for (int dt = 0; dt < 4; ++dt) {
                        const i32x2 t8 = __builtin_amdgcn_ds_read_tr8_b64_v2i32((LAS i32x2*)(vtr + dt * 16));
                        const long vb = (long)(((unsigned long long)(unsigned)t8[1] << 32) | (unsigned)t8[0]);
                        O[g][dt] = __builtin_amdgcn_mfma_f32_16x16x32_fp8_fp8(pf, vb, O[g][dt], 0, 0, 0); }
                }
                if (ch + 3 < 8) ATT_LOADV(ch % 3, sq, ch + 3)
                if (ch == 5 && iq < 3) ATT_LOADQ(tok + 1)
            }
            if (fq < 2) {
#pragma unroll
                for (int dt = 0; dt < 4; ++dt)
#pragma unroll
                    for (int r = 0; r < 4; ++r) { const float ov = (fq == 0) ? O[0][dt][r] : O[1][dt][r];
                        *(LAS bf16_t*)(pbuf + ((4 * fq + r) * 64 + dt * 16 + hh) * 2) = (bf16_t)(pk2(ov, 0.f) & 0xffffu); }
            }
            asm volatile("" ::: "memory");
            { const u32x4 ow = *(const LAS u32x4*)(pbuf + ln2 * 16); *(u32x4*)(C.Y + (size_t)tok * 1024 + 512 + ln2 * 8) = ow; }
        }
        }
#undef ATT_LOADK
#undef ATT_MMAK
#undef ATT_LOADV
#undef ATT_LOADQ
#endif
    }
}


constexpr int H_QE = 0, H_KD = 17408, H_KET = 34816, H_VT = 53248, H_AL = 71680, H_ST = 80896, H_QTOT = 115712, H_BL = 117760, H_SSQ = 118272;
constexpr int PQ = 272, PT = 144;
constexpr size_t WS_HU = 440 * MiB, WS_HLB = 460 * MiB;

__device__ __forceinline__ bf16x8 ldsfrag(const LAS unsigned char* p) { return *(const LAS bf16x8*)p; }

constexpr int H_VRAW = 118784;
__device__ __forceinline__ int hgrn_item_of(int c, int G) {
    if (G != 256) return c;
    const int x = c & 7, j = c >> 3; const int b = x >> 1, seg = 4 * (x & 1) + (j >> 3), h = j & 7;
    return (b << 6) | (h << 3) | seg;
}
template <bool WITH_Q>
__device__ __forceinline__ void hgrn_load(const Ctx& C, size_t tokc, int h, int tid, u32x4 (&kr)[2], u32x4 (&vr)[2], u32x4 (&qr)[2]) {
#pragma unroll
    for (int j = 0; j < 2; ++j) { const int p = tid + 512 * j; const size_t off = (tokc + (size_t)(p >> 4)) * 1024 + (size_t)h * 128 + (p & 15) * 8;
        kr[j] = *(const u32x4*)(C.L1K + off); vr[j] = *(const u32x4*)(C.L1I + off); if (WITH_Q) qr[j] = *(const u32x4*)(C.L1Q + off); }
}
template <bool WITH_Q>
__device__ __forceinline__ float hgrn_stage(LAS unsigned char* lds, int tid, const u32x4 (&kr)[2], const u32x4 (&vr)[2], const u32x4 (&qr)[2]) {
    const int d = tid & 127, tq = tid >> 7;
#pragma unroll
    for (int j = 0; j < 2; ++j) { const int p = tid + 512 * j; const int ro = (p >> 4) * PQ + (p & 15) * 16;
        *(LAS u32x4*)(lds + H_KD + ro) = kr[j]; *(LAS u32x4*)(lds + H_VRAW + ro) = vr[j]; if (WITH_Q) *(LAS u32x4*)(lds + H_QE + ro) = qr[j]; }
    __syncthreads();
    float kf[16], vf[16], c[16];
#pragma unroll
    for (int i = 0; i < 16; ++i) { kf[i] = bf2f(*(const LAS bf16_t*)(lds + H_KD + (tq * 16 + i) * PQ + d * 2)); vf[i] = bf2f(*(const LAS bf16_t*)(lds + H_VRAW + (tq * 16 + i) * PQ + d * 2)); }
    float run = 0.f;
#pragma unroll
    for (int i = 0; i < 16; ++i) { run += __logf(1.0f - kf[i]); c[i] = run; }
    LAS float* qtot = (LAS float*)(lds + H_QTOT);
    qtot[tq * 128 + d] = run;
    { u32x4 w0, w1; w0.x = pk2(vf[0], vf[1]); w0.y = pk2(vf[2], vf[3]); w0.z = pk2(vf[4], vf[5]); w0.w = pk2(vf[6], vf[7]); w1.x = pk2(vf[8], vf[9]); w1.y = pk2(vf[10], vf[11]); w1.z = pk2(vf[12], vf[13]); w1.w = pk2(vf[14], vf[15]);
      *(LAS u32x4*)(lds + H_VT + d * PT + tq * 32) = w0; *(LAS u32x4*)(lds + H_VT + d * PT + tq * 32 + 16) = w1; }
    __syncthreads();
    float pre = 0.f, tot = 0.f;
#pragma unroll
    for (int q4 = 0; q4 < 4; ++q4) { const float x = qtot[q4 * 128 + d]; if (q4 < tq) pre += x; tot += x; }
    if (tq == 0) ((LAS float*)(lds + H_BL))[d] = tot;
    { float ke[16];
#pragma unroll
      for (int i = 0; i < 16; ++i) ke[i] = kf[i] * __expf(tot - (pre + c[i]));
      u32x4 w0, w1; w0.x = pk2(ke[0], ke[1]); w0.y = pk2(ke[2], ke[3]); w0.z = pk2(ke[4], ke[5]); w0.w = pk2(ke[6], ke[7]); w1.x = pk2(ke[8], ke[9]); w1.y = pk2(ke[10], ke[11]); w1.z = pk2(ke[12], ke[13]); w1.w = pk2(ke[14], ke[15]);
      *(LAS u32x4*)(lds + H_KET + d * PT + tq * 32) = w0; *(LAS u32x4*)(lds + H_KET + d * PT + tq * 32 + 16) = w1; }
    if (WITH_Q) {
#pragma unroll
        for (int i = 0; i < 16; ++i) { const float b = pre + c[i]; const float qv = bf2f(*(const LAS bf16_t*)(lds + H_QE + (tq * 16 + i) * PQ + d * 2));
            *(LAS bf16_t*)(lds + H_QE + (tq * 16 + i) * PQ + d * 2) = (bf16_t)(pk2(qv * __expf(b), 0.f) & 0xffffu);
            *(LAS bf16_t*)(lds + H_KD + (tq * 16 + i) * PQ + d * 2) = (bf16_t)(pk2(kf[i] * __expf(-b), 0.f) & 0xffffu); }
    }
    return tot;
}
__device__ __forceinline__ void hgrn_state_update(LAS unsigned char* lds, f32x4 (&S)[8], int wid, int l15, int fq) {
    const LAS float* bl = (const LAS float*)(lds + H_BL);
    float dec[4];
#pragma unroll
    for (int r = 0; r < 4; ++r) dec[r] = __expf(bl[16 * wid + 4 * fq + r]);
    const bf16x8 ka0 = ldsfrag(lds + H_KET + (16 * wid + l15) * PT + 16 * fq), ka1 = ldsfrag(lds + H_KET + (16 * wid + l15) * PT + 64 + 16 * fq);
#pragma unroll
    for (int et = 0; et < 8; ++et) {
#pragma unroll
        for (int r = 0; r < 4; ++r) S[et][r] *= dec[r];
        S[et] = __builtin_amdgcn_mfma_f32_16x16x32_bf16(ka0, ldsfrag(lds + H_VT + (et * 16 + l15) * PT + 16 * fq), S[et], 0, 0, 0);
        S[et] = __builtin_amdgcn_mfma_f32_16x16x32_bf16(ka1, ldsfrag(lds + H_VT + (et * 16 + l15) * PT + 64 + 16 * fq), S[et], 0, 0, 0); }
}

__device__ __forceinline__ void phase_hgrn_local(const Ctx& C, LAS unsigned char* lds) {
    const int tid = threadIdx.x, lane = tid & 63, wid = __builtin_amdgcn_readfirstlane(tid >> 6), l15 = lane & 15, fq = lane >> 4;
    float* Ug = (float*)((unsigned char*)C.ctl + WS_HU); float* LBg = (float*)((unsigned char*)C.ctl + WS_HLB);
    for (int it0 = C.bid; it0 < 256; it0 += C.G) {
        const int item = hgrn_item_of(it0, C.G); const int seg = item & 7, h = (item >> 3) & 7, b = item >> 6;
        if (seg == 7) continue;
        f32x4 S[8];
#pragma unroll
        for (int et = 0; et < 8; ++et) S[et] = (f32x4){0.f, 0.f, 0.f, 0.f};
        float lbacc = 0.f;
        u32x4 kr[2], vr[2], qr[2];
        hgrn_load<false>(C, (size_t)b * SEQ + (size_t)seg * 1024, h, tid, kr, vr, qr);
#pragma unroll 1
        for (int ch = 0; ch < 16; ++ch) {
            const size_t tokc = (size_t)b * SEQ + (size_t)seg * 1024 + (size_t)ch * 64;
            __syncthreads();
            lbacc += hgrn_stage<false>(lds, tid, kr, vr, qr);
            if (ch < 15) hgrn_load<false>(C, tokc + 64, h, tid, kr, vr, qr);
            __syncthreads();
            hgrn_state_update(lds, S, wid, l15, fq);
        }
#pragma unroll
        for (int et = 0; et < 8; ++et) *(f32x4*)(Ug + ((size_t)(item * 8 + wid) * 8 + et) * 256 + lane * 4) = S[et];
        if (tid < 128) LBg[item * 128 + tid] = lbacc;
    }
}

__device__ __forceinline__ void phase_hgrn_chunks(const Ctx& C, LAS unsigned char* lds) {
    const int tid = threadIdx.x, lane = tid & 63, wid = __builtin_amdgcn_readfirstlane(tid >> 6), l15 = lane & 15, fq = lane >> 4;
    const float* Ug = (const float*)((unsigned char*)C.ctl + WS_HU); const float* LBg = (const float*)((unsigned char*)C.ctl + WS_HLB);
    LAS float* ssq = (LAS float*)(lds + H_SSQ);
    for (int it0 = C.bid; it0 < 256; it0 += C.G) {
        const int item = hgrn_item_of(it0, C.G); const int seg = item & 7, h = (item >> 3) & 7, b = item >> 6;
        f32x4 S[8];
#pragma unroll
        for (int et = 0; et < 8; ++et) S[et] = (f32x4){0.f, 0.f, 0.f, 0.f};
#pragma unroll 1
        for (int j = 0; j < seg; ++j) { const int it = item - seg + j; float dec[4];
#pragma unroll
            for (int r = 0; r < 4; ++r) dec[r] = __expf(LBg[it * 128 + 16 * wid + 4 * fq + r]);
#pragma unroll
            for (int et = 0; et < 8; ++et) { const f32x4 u = *(const f32x4*)(Ug + ((size_t)(it * 8 + wid) * 8 + et) * 256 + lane * 4);
#pragma unroll
                for (int r = 0; r < 4; ++r) S[et][r] = S[et][r] * dec[r] + u[r]; } }
        __syncthreads();
        u32x4 kr[2], vr[2], qr[2];
        hgrn_load<true>(C, (size_t)b * SEQ + (size_t)seg * 1024, h, tid, kr, vr, qr);
#pragma unroll 1
        for (int ch = 0; ch < 16; ++ch) {
            const size_t tokc = (size_t)b * SEQ + (size_t)seg * 1024 + (size_t)ch * 64;
#pragma unroll
            for (int et = 0; et < 8; ++et) { u32x2 w; w.x = pk2(S[et][0], S[et][1]); w.y = pk2(S[et][2], S[et][3]); *(LAS u32x2*)(lds + H_ST + (et * 16 + l15) * PQ + (16 * wid + 4 * fq) * 2) = w; }
            (void)hgrn_stage<true>(lds, tid, kr, vr, qr);
            if (ch < 15) hgrn_load<true>(C, tokc + 64, h, tid, kr, vr, qr);
            u32x2 gw[4];
            { const size_t ro = (tokc + (wid & 3) * 16 + l15) * 1024 + (size_t)h * 128;
#pragma unroll
              for (int j = 0; j < 4; ++j) gw[j] = *(const u32x2*)(C.L1G + ro + (4 * (wid >> 2) + j) * 16 + 4 * fq); }
            __syncthreads();
            { const int ti = wid >> 1;
#pragma unroll
              for (int u = 0; u < 2; ++u) { const int si = 2 * (wid & 1) + u; u32x2 w = (u32x2){0u, 0u};
                  if (si <= ti) { f32x4 a = (f32x4){0.f, 0.f, 0.f, 0.f};
#pragma unroll
                      for (int kk = 0; kk < 4; ++kk) a = __builtin_amdgcn_mfma_f32_16x16x32_bf16(ldsfrag(lds + H_KD + (si * 16 + l15) * PQ + kk * 64 + 16 * fq), ldsfrag(lds + H_QE + (ti * 16 + l15) * PQ + kk * 64 + 16 * fq), a, 0, 0, 0);
                      if (si == ti) {
#pragma unroll
                          for (int r = 0; r < 4; ++r) if (4 * fq + r > l15) a[r] = 0.f; }
                      w.x = pk2(a[0], a[1]); w.y = pk2(a[2], a[3]); }
                  *(LAS u32x2*)(lds + H_AL + (ti * 16 + l15) * PT + (si * 16 + 4 * fq) * 2) = w; } }
            hgrn_state_update(lds, S, wid, l15, fq);
            __syncthreads();
            const int ti = wid & 3, eh = wid >> 2;
            f32x4 o[4];
            { const bf16x8 ab0 = ldsfrag(lds + H_AL + (ti * 16 + l15) * PT + 16 * fq), ab1 = ldsfrag(lds + H_AL + (ti * 16 + l15) * PT + 64 + 16 * fq);
              bf16x8 qb[4];
#pragma unroll
              for (int kk = 0; kk < 4; ++kk) qb[kk] = ldsfrag(lds + H_QE + (ti * 16 + l15) * PQ + kk * 64 + 16 * fq);
#pragma unroll
              for (int j = 0; j < 4; ++j) { const int et = 4 * eh + j; f32x4 a = (f32x4){0.f, 0.f, 0.f, 0.f};
                  a = __builtin_amdgcn_mfma_f32_16x16x32_bf16(ldsfrag(lds + H_VT + (et * 16 + l15) * PT + 16 * fq), ab0, a, 0, 0, 0);
                  a = __builtin_amdgcn_mfma_f32_16x16x32_bf16(ldsfrag(lds + H_VT + (et * 16 + l15) * PT + 64 + 16 * fq), ab1, a, 0, 0, 0);
#pragma unroll
                  for (int kk = 0; kk < 4; ++kk) a = __builtin_amdgcn_mfma_f32_16x16x32_bf16(ldsfrag(lds + H_ST + (et * 16 + l15) * PQ + kk * 64 + 16 * fq), qb[kk], a, 0, 0, 0);
                  o[j] = a; } }
            float sq = 0.f;
#pragma unroll
            for (int j = 0; j < 4; ++j) sq += (o[j][0] * o[j][0] + o[j][1] * o[j][1]) + (o[j][2] * o[j][2] + o[j][3] * o[j][3]);
            sq += __shfl_xor(sq, 16); sq += __shfl_xor(sq, 32);
            if (fq == 0) ssq[eh * 64 + ti * 16 + l15] = sq;
            __syncthreads();
            { const float tot = ssq[ti * 16 + l15] + ssq[64 + ti * 16 + l15]; const float rinv = 1.0f / sqrtf(tot * (1.0f / 128.0f) + EPS);
              const size_t ro = (tokc + ti * 16 + l15) * 1024 + (size_t)h * 128;
#pragma unroll
              for (int j = 0; j < 4; ++j) { const int e0 = (4 * eh + j) * 16 + 4 * fq; const f32x4 nw = *(const f32x4*)(C.hgrn_out_norm + e0);
                  u32x2 w; w.x = pk2(o[j][0] * rinv * nw[0] * bf_lo(gw[j].x), o[j][1] * rinv * nw[1] * bf_hi(gw[j].x)); w.y = pk2(o[j][2] * rinv * nw[2] * bf_lo(gw[j].y), o[j][3] * rinv * nw[3] * bf_hi(gw[j].y));
                  *(u32x2*)(C.Y + ro + e0) = w; } }
        }
    }
}

constexpr int NPHASES = 14;
struct Args { const void* in[16]; float* out; unsigned char* ws; int ph_lo, ph_hi; };


typedef const __attribute__((address_space(4))) Args* KArgP;
__device__ __forceinline__ void make_ctx(Ctx& C) {
    KArgP ka = (KArgP)__builtin_amdgcn_kernarg_segment_ptr(); asm volatile("" : "+s"(ka));
    C.x = (const float*)ka->in[0]; C.positions = (const int*)ka->in[1]; C.ln_mix = (const float*)ka->in[2]; C.ln_ffn = (const float*)ka->in[3]; C.ln_final = (const float*)ka->in[4];
    C.w_in_ab = (const float*)ka->in[5]; C.w_pool = (const float*)ka->in[6]; C.pool_scale = (const float*)ka->in[7]; C.idx_k_norm = (const float*)ka->in[8]; C.w_out_ab = (const float*)ka->in[9];
    C.w_in_c = (const float*)ka->in[10]; C.hgrn_lb = (const float*)ka->in[11]; C.hgrn_out_norm = (const float*)ka->in[12]; C.w_out_c = (const float*)ka->in[13]; C.w_gate_up = (const float*)ka->in[14]; C.w_down = (const float*)ka->in[15];
    C.out = ka->out;
    unsigned char* ws = ka->ws;
    C.ctl = (unsigned*)(ws + WS_CTL); C.rope = (float*)(ws + WS_ROPE); C.part = (float*)(ws + WS_PART); C.lbv = (float*)(ws + WS_LB);
    C.W_inab = (bf16_t*)(ws + WS_W_INAB); C.W_pool = (bf16_t*)(ws + WS_W_POOL); C.W_outab = (bf16_t*)(ws + WS_W_OUTAB); C.W_inc = (bf16_t*)(ws + WS_W_INC); C.W_outc = (bf16_t*)(ws + WS_W_OUTC);
    C.W_gu0 = (bf16_t*)(ws + WS_W_GU0); C.W_gu1 = (bf16_t*)(ws + WS_W_GU1); C.W_dn0 = (bf16_t*)(ws + WS_W_DN0); C.W_dn1 = (bf16_t*)(ws + WS_W_DN1);
    C.XB = (bf16_t*)(ws + WS_XB); C.Y = (bf16_t*)(ws + WS_Y); C.P = (bf16_t*)(ws + WS_P); C.ACT = (bf16_t*)(ws + WS_ACT);
    C.L1Q = (bf16_t*)(ws + WS_L1Q); C.L1K = (bf16_t*)(ws + WS_L1K); C.L1I = (bf16_t*)(ws + WS_L1I); C.L1G = (bf16_t*)(ws + WS_L1G); C.ORAW = (bf16_t*)(ws + WS_ORAW);
    C.G = gridDim.x; C.bid = blockIdx.x;
}

#if USE_SIMPLE_GEMM
#define RUN_GEMM(EpiT, gg, EE) pg8::gemm_simple<EpiT>(gg, C.G, C.bid, EE)
#else
#define RUN_GEMM(EpiT, gg, EE) do { if (threadIdx.x == 0) *(LAS int*)(lds + 131072 + 1024) = -1; __syncthreads(); pg8::StaticOrder S_; S_.init((gg).M, (gg).N, C.G, C.bid); pg8::gemm_phase<EpiT, pg8::StaticOrder, true, true>(lds, gg, S_, EE); } while (0)
#endif

__device__ __forceinline__ void xcd_barrier_local(const XcdBarrier& b) {
    asm volatile("s_waitcnt vmcnt(0)" ::: "memory");
    __syncthreads();
    if (threadIdx.x == 0) {
        unsigned* bar = b.bar;
        __builtin_amdgcn_s_waitcnt(0);
        const unsigned nloc = b.st[0];
        const unsigned old = xb_add(&bar[XB_XSUB(b.x)], 1u);
        const unsigned gen = old / nloc;
        if (old + 1u == (gen + 1u) * nloc) xb_add(&bar[XB_XGEN(b.x)], 1u);
        else XB_SPIN(xb_ld(&bar[XB_XGEN(b.x)]) == gen, bar);
        __builtin_amdgcn_fence(__ATOMIC_ACQUIRE, "agent");
        asm volatile("s_waitcnt vmcnt(0)" ::: "memory");
    }
    __syncthreads();
}
constexpr int CW_TAB = 8192;

__global__ void __launch_bounds__(512, 2) mega_fwd(Args a) {
    extern __shared__ __attribute__((aligned(16))) unsigned char lds_raw[];
    LAS unsigned char* lds = (LAS unsigned char*)lds_raw;
    unsigned* const ctl0 = (unsigned*)(a.ws + WS_CTL);

    volatile LAS unsigned* MISC = (volatile LAS unsigned*)(lds + LDS_MISC);
    if (threadIdx.x < 64) MISC[threadIdx.x] = 0u;
    __syncthreads();
    XcdBarrier bar; bar.bar = ctl0 + CW_BAR; bar.x = 0; bar.st = nullptr;
    if (N_LAUNCH_MODE == 1) bar = xcd_barrier_post(ctl0 + CW_BAR, MISC + 8);
    if (N_LAUNCH_MODE == 1 && threadIdx.x == 0) __hip_atomic_store(&ctl0[CW_TAB + blockIdx.x], xb_xcc_id() + 1u, __ATOMIC_RELAXED, __HIP_MEMORY_SCOPE_AGENT);

    const int lo = a.ph_lo, hi = a.ph_hi;
#ifndef ONLY_PHASE
#define ONLY_PHASE -1
#endif
#define IN(k) (lo <= (k) && (k) < hi && (ONLY_PHASE < 0 || ONLY_PHASE == (k)))
#if defined(DBG_REPEAT) && DBG_REPEAT == 90
#define SEAM(k) do { if (N_LAUNCH_MODE == 1 && IN((k) + 1)) { xcd_barrier(bar); if ((k) == 5) for (int rr_ = 0; rr_ < 20; ++rr_) xcd_barrier(bar); } } while (0)
#else
#define SEAM(k) do { if (N_LAUNCH_MODE == 1 && IN((k) + 1)) xcd_barrier(bar); } while (0)
#endif

#if USE_SIMPLE_GEMM || USE_SIMPLE_ATTN || USE_SIMPLE_HGRN
#define SEAM_L(k) SEAM(k)
#else
#define SEAM_L(k) do { if (N_LAUNCH_MODE == 1 && IN((k) + 1)) { if (MISC[10]) xcd_barrier_local(bar); else xcd_barrier(bar); } } while (0)
#endif
    if (IN(0)) { Ctx C; make_ctx(C); phase_prologue(C, lds); __syncthreads();
#if defined(DBG_REPEAT) && DBG_REPEAT == 0
        phase_prologue(C, lds); __syncthreads();
#endif
        SEAM(0);
        if (N_LAUNCH_MODE == 1 && lo == 0) {
            if (threadIdx.x < 64) { bool ok = (gridDim.x == 256u);
                for (unsigned t = threadIdx.x; t < gridDim.x && t < 256u; t += 64u) { const unsigned v = xb_ld(&ctl0[CW_TAB + t]), r = xb_ld(&ctl0[CW_TAB + (t & 7u)]); ok = ok && v != 0u && v == r; }
                unsigned m = 0u;
                for (unsigned i = 0; i < 8u; ++i) m |= 1u << (xb_ld(&ctl0[CW_TAB + i]) & 31u);
                ok = ok && __popc(m) == 8;
                const bool all = __ballot(ok) == ~0ull;
                if (threadIdx.x == 0) MISC[10] = all ? 1u : 0u; }
            __syncthreads(); } }
    if (IN(1)) { Ctx C; make_ctx(C); pg8::Gemm g{C.XB, C.W_inab, NTOK, NAB, 1024}; pg8::EpiScaleBf16 E{C.P, NAB, pg8::RinvTab{C.part, lds}}; RUN_GEMM(pg8::EpiScaleBf16, g, E);
        __syncthreads(); phase_prologue_late(C, lds); __syncthreads();
#if defined(DBG_REPEAT) && DBG_REPEAT == 1
        RUN_GEMM(pg8::EpiScaleBf16, g, E);
#endif
        SEAM(1); }
    if (IN(2)) { Ctx C; make_ctx(C); phase_fixup_pool(C, lds);
#if defined(DBG_REPEAT) && DBG_REPEAT == 2
        phase_fixup_pool(C, lds);
#endif
        SEAM(2); }
#ifdef DBG_ZERO_ATTN
    if (IN(3)) { Ctx C; make_ctx(C); for (int i = C.bid * 512 + threadIdx.x; i < NTOK * 64; i += C.G * 512) { const int tok = i >> 6, c = i & 63; *(u32x4*)(C.Y + (size_t)tok * 1024 + 512 + 8 * c) = (u32x4){0u, 0u, 0u, 0u}; } SEAM(3); }
#else
#if USE_SIMPLE_ATTN
    if (IN(3)) { Ctx C; make_ctx(C); phase_attn_simple(C, lds); __syncthreads(); SEAM(3); }
#else
    if (IN(3)) { Ctx C; make_ctx(C); phase_attn(C, lds); __syncthreads();
#if defined(DBG_REPEAT) && DBG_REPEAT == 3
        phase_attn(C, lds); __syncthreads();
#endif
        SEAM(3); }
#endif
#endif
    if (IN(4)) { Ctx C; make_ctx(C); pg8::Gemm g{C.Y, C.W_outab, NTOK, 1024, 1024}; pg8::EpiResidual<true> E{C.XB, C.part, C.x}; RUN_GEMM(pg8::EpiResidual<true>, g, E); SEAM_L(4); }
    if (IN(5)) { Ctx C; make_ctx(C); pg8::Gemm g{C.XB, C.W_gu0, NTOK, 2 * DFF, 1024}; pg8::EpiSwiGLU E{C.ACT, pg8::RinvTab{C.part, lds}}; RUN_GEMM(pg8::EpiSwiGLU, g, E);
#if defined(DBG_REPEAT) && DBG_REPEAT == 5
        RUN_GEMM(pg8::EpiSwiGLU, g, E);
#endif
        SEAM_L(5); }
    if (IN(6)) { Ctx C; make_ctx(C); pg8::Gemm g{C.ACT, C.W_dn0, NTOK, 1024, DFF}; pg8::EpiResidual<false> E{C.XB, C.part, C.x}; RUN_GEMM(pg8::EpiResidual<false>, g, E); SEAM_L(6); }
    if (IN(7)) { Ctx C; make_ctx(C); pg8::Gemm g{C.XB, C.W_inc, NTOK, NINC, 1024}; pg8::EpiHgrnIn E{C.L1Q, C.L1K, C.L1I, C.L1G, pg8::RinvTab{C.part, lds}, C.lbv}; RUN_GEMM(pg8::EpiHgrnIn, g, E); SEAM_L(7); }
#if USE_SIMPLE_HGRN
    if (IN(8)) { Ctx C; make_ctx(C); phase_hgrn_simple(C); SEAM(8); }
    if (IN(9)) { Ctx C; make_ctx(C); phase_hgrn_post(C); SEAM_L(9); }
#else
    if (IN(8)) { Ctx C; make_ctx(C); phase_hgrn_local(C, lds); __syncthreads();
#if defined(DBG_REPEAT) && DBG_REPEAT == 8
        phase_hgrn_local(C, lds); __syncthreads();
#endif
        SEAM(8); }
    if (IN(9)) { Ctx C; make_ctx(C); phase_hgrn_chunks(C, lds); __syncthreads();
#if defined(DBG_REPEAT) && DBG_REPEAT == 9
        phase_hgrn_chunks(C, lds); __syncthreads();
#endif
        SEAM_L(9); }
#endif
    if (IN(10)) { Ctx C; make_ctx(C); pg8::Gemm g{C.Y, C.W_outc, NTOK, 1024, 1024}; pg8::EpiResidual<false> E{C.XB, C.part, C.x}; RUN_GEMM(pg8::EpiResidual<false>, g, E); SEAM_L(10); }
    if (IN(11)) { Ctx C; make_ctx(C); pg8::Gemm g{C.XB, C.W_gu1, NTOK, 2 * DFF, 1024}; pg8::EpiSwiGLU E{C.ACT, pg8::RinvTab{C.part, lds}}; RUN_GEMM(pg8::EpiSwiGLU, g, E); SEAM_L(11); }
    if (IN(12)) { Ctx C; make_ctx(C); pg8::Gemm g{C.ACT, C.W_dn1, NTOK, 1024, DFF}; pg8::EpiResidual<false> E{C.XB, C.part, C.x}; RUN_GEMM(pg8::EpiResidual<false>, g, E); SEAM_L(12); }
    if (IN(13)) { Ctx C; make_ctx(C); phase_final_norm(C); }
#ifdef DBG_STOP_AFTER
    if (IN(14)) { Ctx C; make_ctx(C); for (int i = C.bid * 512 + threadIdx.x; i < NTOK * 1024; i += C.G * 512) { const int tok = i >> 10, c = i & 1023; float v;
        if (DBG_STOP_AFTER <= 3) v = bf2f(C.P[(size_t)tok * NAB + c]) + bf2f(C.P[(size_t)tok * NAB + 768 + c]) + bf2f(C.Y[(size_t)tok * 1024 + (c & 511)]);
        else if (DBG_STOP_AFTER == 7 || DBG_STOP_AFTER == 8) v = bf2f(C.L1Q[i]) + bf2f(C.L1K[i]) + bf2f(C.L1I[i]) + bf2f(C.L1G[i]) + (DBG_STOP_AFTER == 8 ? bf2f(C.ORAW[i]) : 0.f);
        else if (DBG_STOP_AFTER == 9) v = bf2f(C.Y[i]);
        else if (DBG_STOP_AFTER == 5 || DBG_STOP_AFTER == 11) v = bf2f(C.ACT[(size_t)tok * DFF + c]) + bf2f(C.ACT[(size_t)tok * DFF + 1024 + c]) + bf2f(C.ACT[(size_t)tok * DFF + 1792 + c]);
        else v = C.out[i] + bf2f(C.XB[i]);
        C.out[i] = v; } }
#endif
#undef IN
#undef SEAM
#undef SEAM_L
}

extern "C" void kernel_launch(void* const* d_in, const int* in_sizes, int n_in, void* d_out, int out_size, void* d_ws, size_t ws_size, hipStream_t stream) {
    static int grid = 0;
    if (grid == 0) {
        if (n_in != 16 || in_sizes[0] != NTOK * DM || out_size != NTOK * DM || ws_size < WS_END) {
            fprintf(stderr, "kernel_launch: built for 16 inputs, x/out of %d floats, >= %zu bytes of workspace; got n_in %d, in0 %d, out %d, ws %zu; nothing launched\n", NTOK * DM, (size_t)WS_END, n_in, n_in > 0 ? in_sizes[0] : -1, out_size, ws_size);
            grid = -1; return; }
        int dev = 0, cus = 0, per_cu = 0;
        if (hipGetDevice(&dev) != hipSuccess || hipDeviceGetAttribute(&cus, hipDeviceAttributeMultiprocessorCount, dev) != hipSuccess) { fprintf(stderr, "kernel_launch: device query failed\n"); grid = -1; return; }
        if (hipFuncSetAttribute((const void*)mega_fwd, hipFuncAttributeMaxDynamicSharedMemorySize, LDS_BYTES) != hipSuccess) { fprintf(stderr, "kernel_launch: hipFuncSetAttribute failed\n"); grid = -1; return; }
        if (hipOccupancyMaxActiveBlocksPerMultiprocessor(&per_cu, (const void*)mega_fwd, 512, LDS_BYTES) != hipSuccess || per_cu < 1)
            fprintf(stderr, "kernel_launch: note: occupancy query reports %d workgroups per CU\n", per_cu);
        (void)hipGetLastError();
        grid = cus;
    }
    if (grid < 0) return;
    if (hipMemsetAsync((char*)d_ws + WS_CTL, 0, CTL_ZERO_BYTES, stream) != hipSuccess) { fprintf(stderr, "kernel_launch: hipMemsetAsync failed\n"); return; }
    Args a{};
    for (int i = 0; i < 16; ++i) a.in[i] = d_in[i];
    a.out = (float*)d_out; a.ws = (unsigned char*)d_ws;
    if (N_LAUNCH_MODE == 1) {
        a.ph_lo = 0; a.ph_hi = NPHASES;
        hipLaunchKernelGGL(mega_fwd, dim3(grid), dim3(512), LDS_BYTES, stream, a);
    } else {
#ifdef DBG_STOP_AFTER
        for (int p = 0; p <= DBG_STOP_AFTER; ++p) { a.ph_lo = p; a.ph_hi = p + 1; hipLaunchKernelGGL(mega_fwd, dim3(grid), dim3(512), LDS_BYTES, stream, a); }
        a.ph_lo = 14; a.ph_hi = 15; hipLaunchKernelGGL(mega_fwd, dim3(grid), dim3(512), LDS_BYTES, stream, a);
#else
        for (int p = 0; p < NPHASES; ++p) { a.ph_lo = p; a.ph_hi = p + 1; hipLaunchKernelGGL(mega_fwd, dim3(grid), dim3(512), LDS_BYTES, stream, a); }
#endif
    }
    const hipError_t le = hipPeekAtLastError();
    if (le != hipSuccess) fprintf(stderr, "kernel_launch: launch failed: %s\n", hipGetErrorName(le));
}
```

```cpp
#include <hip/hip_runtime.h>
#include <cstdio>
#include <cstdint>

#ifndef N_LAUNCH_MODE
#define N_LAUNCH_MODE 1
#endif
#ifndef USE_SIMPLE_HGRN
#define USE_SIMPLE_HGRN 0
#endif
#ifndef USE_SIMPLE_ATTN
#define USE_SIMPLE_ATTN 0
#endif
#ifndef USE_SIMPLE_GEMM
#define USE_SIMPLE_GEMM 0
#endif

#define LAS __attribute__((address_space(3)))

constexpr int BATCH = 4, SEQ = 8192, DM = 1024, NTOK = BATCH * SEQ;
constexpr int NAB_REAL = 1604, NAB = 1792;
constexpr int DFF = 2816;
constexpr int NINC = 4096;
constexpr int PC_U = 0, PC_Q = 512, PC_K = 1024, PC_V = 1152, PC_QI = 1280, PC_KI = 1536, PC_WI = 1600;
constexpr float EPS = 1e-6f;
constexpr int TOPK = 256;

constexpr size_t MiB = 1u << 20;
constexpr size_t WS_CTL = 0, CTL_ZERO_BYTES = 1 * MiB;
constexpr size_t WS_ROPE = 1 * MiB;
constexpr size_t WS_PART = 3 * MiB;
constexpr size_t WS_LB = 5 * MiB;
constexpr size_t WS_W_INAB = 6 * MiB;
constexpr size_t WS_W_POOL = WS_W_INAB + (size_t)NAB * DM * 2;
constexpr size_t WS_W_OUTAB = 10 * MiB;
constexpr size_t WS_W_INC = 12 * MiB;
constexpr size_t WS_W_OUTC = 20 * MiB;
constexpr size_t WS_W_GU0 = 22 * MiB, WS_W_GU1 = 33 * MiB;
constexpr size_t WS_W_DN0 = 44 * MiB, WS_W_DN1 = WS_W_DN0 + (size_t)DM * DFF * 2;
constexpr size_t WS_XB = 56 * MiB;
constexpr size_t WS_Y = 120 * MiB;
constexpr size_t WS_P = 184 * MiB;
constexpr size_t WS_ACT = 184 * MiB;
constexpr size_t WS_L1Q = 184 * MiB, WS_L1K = 248 * MiB, WS_L1I = 312 * MiB, WS_L1G = 376 * MiB;
constexpr size_t WS_ORAW = 440 * MiB;
constexpr size_t WS_KV8 = 488 * MiB;
constexpr size_t WS_END = 512 * MiB;
static_assert(WS_W_POOL + 4 * 128 * 128 * 2 <= WS_W_OUTAB && WS_W_DN1 + (size_t)DM * DFF * 2 <= WS_XB && WS_P + (size_t)NTOK * NAB * 2 <= 360 * MiB && WS_ACT + (size_t)NTOK * DFF * 2 <= WS_L1G + 64 * MiB, "ws map");
constexpr int CW_BAR = 4096;

constexpr int LDS_BYTES = 163840;
constexpr int LDS_MISC = 163840 - 256;
namespace pg8 {
#define PG8_LAS __attribute__((address_space(3)))
typedef unsigned short bf16_t;
typedef short bf16x8 __attribute__((ext_vector_type(8)));
typedef float f32x4 __attribute__((ext_vector_type(4)));
typedef unsigned u32x4 __attribute__((ext_vector_type(4)));
constexpr int BM = 256, BK = 64, HALF = 128, HTB = HALF * BK * 2  , STAGE_BYTES = 8 * HTB, NXCD = 8, WGM = 8;

__host__ __device__ __forceinline__ int lds_byte(int r, int c) { const int st = (r >> 4) * 2 + (c >> 5), rr = r & 15, cc = c & 31, ob = rr * 64 + cc * 2; return st * 1024 + (ob ^ (((ob >> 9) & 1) << 5)); }
__host__ __device__ __forceinline__ void stage_rc(int b, int& R, int& C) { const int st = b / 1024, sb = b % 1024, swz = sb ^ (((sb >> 9) & 1) << 5); R = (st >> 1) * 16 + swz / 64; C = (st & 1) * 32 + (swz % 64) / 2; }
__host__ __device__ __forceinline__ int perm32(int rho) { const int n = rho >> 4, i = rho & 15; return 8 * (i >> 2) + 4 * n + (i & 3); }

struct Unit { int pm, pn; };
struct Gemm { const bf16_t* A; const bf16_t* Bt; int M, N, K; };

struct StaticOrder {
    int nM, nN, nwg, G, c;
    __host__ __device__ void init(int M, int N, int G_, int c_) { nM = M / BM; nN = N / BM; nwg = nM * nN; G = G_; c = c_; }
    __host__ __device__ bool next(int i, Unit& u) const {
        const long L = (long)i * G + c; if (L >= nwg) return false;
        int wgid = (int)L; { const int q = nwg / NXCD, r = nwg % NXCD, xcd = wgid % NXCD, off = wgid / NXCD; wgid = (xcd < r ? xcd * (q + 1) : r * (q + 1) + (xcd - r) * q) + off; }
        const int nig = WGM * nN, gid = wgid / nig, fm = gid * WGM, gsz = (nM - fm) < WGM ? (nM - fm) : WGM;
        u.pm = fm + ((wgid % nig) % gsz); u.pn = (wgid % nig) / gsz; return true;
    }
    __device__ __forceinline__ void a_ready(const Unit&) const {}
    __device__ __forceinline__ void done(const Unit&) const {}
};
typedef __bf16 bf16x2_t __attribute__((ext_vector_type(2)));
__device__ __forceinline__ unsigned cvt_pk_bf16(float lo, float hi) { const bf16x2_t v = {(__bf16)lo, (__bf16)hi}; return __builtin_bit_cast(unsigned, v); }

typedef float f32x2 __attribute__((ext_vector_type(2)));
typedef unsigned u32x2 __attribute__((ext_vector_type(2)));

__device__ __forceinline__ float row_rinv(const float* part, int row) {
    const f32x4* p = (const f32x4*)(part + (size_t)row * 16);
    const f32x4 a = p[0], b = p[1], c = p[2], d = p[3];
    const float s = (((a[0] + a[1]) + (a[2] + a[3])) + ((b[0] + b[1]) + (b[2] + b[3]))) + (((c[0] + c[1]) + (c[2] + c[3])) + ((d[0] + d[1]) + (d[2] + d[3])));
    return 1.0f / sqrtf(s * (1.0f / 1024.0f) + 1e-6f);
}
struct RinvTab {
    const float* part; PG8_LAS unsigned char* ldsb;
    __device__ __forceinline__ void prepare(int pm) const {
        PG8_LAS int* cpm = (PG8_LAS int*)(ldsb + 131072 + 1024); PG8_LAS float* rtab = (PG8_LAS float*)(ldsb + 131072);
        if (*cpm != pm) {
            asm volatile("s_waitcnt lgkmcnt(0)" ::: "memory"); __builtin_amdgcn_s_barrier(); asm volatile("" ::: "memory");
            if (threadIdx.x < 256) rtab[threadIdx.x] = row_rinv(part, pm * BM + (int)threadIdx.x);
            if (threadIdx.x == 0) *cpm = pm;
            asm volatile("s_waitcnt vmcnt(0) lgkmcnt(0)" ::: "memory"); __builtin_amdgcn_s_barrier(); asm volatile("" ::: "memory");
        }
    }
    __device__ __forceinline__ float get(int row_in_panel) const { return ((const PG8_LAS float*)(ldsb + 131072))[row_in_panel]; }
};
__device__ __forceinline__ float sigmoid_neg(float x) { return __builtin_amdgcn_rcpf(1.0f + __expf(x)); }
__device__ __forceinline__ float silu_f(float x) { return x * __builtin_amdgcn_rcpf(1.0f + __expf(-x)); }

struct EpiScaleBf16 {
    static constexpr bool PERM = true, AFTER_DRAIN = false;
    bf16_t* O; int ldc; RinvTab rt;
    __device__ __forceinline__ void operator()(const f32x4 (&acc)[2][2][4][2], const Unit& u, int wr, int wc, int fr, int fq) const {
        rt.prepare(u.pm);
        const int row0 = u.pm * BM + wr * 64 + fr, col0 = u.pn * BM + wc * 32 + 8 * fq;
#pragma unroll
        for (int ai = 0; ai < 2; ++ai)
#pragma unroll
            for (int m = 0; m < 4; ++m) { const int row = row0 + ai * HALF + m * 16; const float r = rt.get(row - u.pm * BM); bf16_t* rowp = O + (size_t)row * ldc + col0;
#pragma unroll
                for (int bj = 0; bj < 2; ++bj) { const f32x4 v0 = acc[ai][bj][m][0] * r, v1 = acc[ai][bj][m][1] * r;
                    u32x4 w; w.x = cvt_pk_bf16(v0[0], v0[1]); w.y = cvt_pk_bf16(v0[2], v0[3]); w.z = cvt_pk_bf16(v1[0], v1[1]); w.w = cvt_pk_bf16(v1[2], v1[3]);
                    *(u32x4*)(rowp + bj * HALF) = w; } }
    }
};
template <bool BASE_F32> struct EpiResidual {
    static constexpr bool PERM = true, AFTER_DRAIN = false;
    bf16_t* xb; float* part; const float* xin;
    __device__ __forceinline__ void operator()(const f32x4 (&acc)[2][2][4][2], const Unit& u, int wr, int wc, int fr, int fq) const {
        const int row0 = u.pm * BM + wr * 64 + fr, col0 = u.pn * BM + wc * 32 + 8 * fq;
#pragma unroll
        for (int ai = 0; ai < 2; ++ai)
#pragma unroll
            for (int m = 0; m < 4; ++m) { const int row = row0 + ai * HALF + m * 16; const size_t off = (size_t)row * 1024 + col0; float ss = 0.f;
#pragma unroll
                for (int bj = 0; bj < 2; ++bj) {
                    f32x4 x0, x1;
                    if (BASE_F32) { x0 = *(const f32x4*)(xin + off + bj * HALF) + acc[ai][bj][m][0]; x1 = *(const f32x4*)(xin + off + bj * HALF + 4) + acc[ai][bj][m][1]; }
                    else { const u32x4 b = *(const u32x4*)(xb + off + bj * HALF);
                    x0[0] = __uint_as_float(b.x << 16) + acc[ai][bj][m][0][0]; x0[1] = __uint_as_float(b.x & 0xffff0000u) + acc[ai][bj][m][0][1];
                    x0[2] = __uint_as_float(b.y << 16) + acc[ai][bj][m][0][2]; x0[3] = __uint_as_float(b.y & 0xffff0000u) + acc[ai][bj][m][0][3];
                    x1[0] = __uint_as_float(b.z << 16) + acc[ai][bj][m][1][0]; x1[1] = __uint_as_float(b.z & 0xffff0000u) + acc[ai][bj][m][1][1];
                    x1[2] = __uint_as_float(b.w << 16) + acc[ai][bj][m][1][2]; x1[3] = __uint_as_float(b.w & 0xffff0000u) + acc[ai][bj][m][1][3]; }
                    ss += ((x0[0] * x0[0] + x0[1] * x0[1]) + (x0[2] * x0[2] + x0[3] * x0[3])) + ((x1[0] * x1[0] + x1[1] * x1[1]) + (x1[2] * x1[2] + x1[3] * x1[3]));
                    u32x4 w; w.x = cvt_pk_bf16(x0[0], x0[1]); w.y = cvt_pk_bf16(x0[2], x0[3]); w.z = cvt_pk_bf16(x1[0], x1[1]); w.w = cvt_pk_bf16(x1[2], x1[3]);
                    *(u32x4*)(xb + off + bj * HALF) = w; }
                ss += __shfl_xor(ss, 16); ss += __shfl_xor(ss, 32);
                if (fq == 0) part[(size_t)row * 16 + u.pn * 4 + wc] = ss; }
    }
};
struct EpiSwiGLU {
    static constexpr bool PERM = true, AFTER_DRAIN = false;
    bf16_t* O; RinvTab rt;
    __device__ __forceinline__ void operator()(const f32x4 (&acc)[2][2][4][2], const Unit& u, int wr, int wc, int fr, int fq) const {
        rt.prepare(u.pm);
        const int row0 = u.pm * BM + wr * 64 + fr, f0 = u.pn * HALF + wc * 32 + 8 * fq;
#pragma unroll
        for (int ai = 0; ai < 2; ++ai)
#pragma unroll
            for (int m = 0; m < 4; ++m) { const int row = row0 + ai * HALF + m * 16; const float r = rt.get(row - u.pm * BM);
                float a[8];
#pragma unroll
                for (int n = 0; n < 2; ++n)
#pragma unroll
                    for (int j = 0; j < 4; ++j) { const float g = acc[ai][0][m][n][j] * r, up = acc[ai][1][m][n][j] * r; a[4 * n + j] = silu_f(g) * up; }
                u32x4 w; w.x = cvt_pk_bf16(a[0], a[1]); w.y = cvt_pk_bf16(a[2], a[3]); w.z = cvt_pk_bf16(a[4], a[5]); w.w = cvt_pk_bf16(a[6], a[7]);
                *(u32x4*)(O + (size_t)row * 2816 + f0) = w; }
    }
};
struct EpiHgrnIn {
    static constexpr bool PERM = true, AFTER_DRAIN = false;
    bf16_t *Q1, *K1, *I1, *G1; RinvTab rt; const float* lb;
    __device__ __forceinline__ void operator()(const f32x4 (&acc)[2][2][4][2], const Unit& u, int wr, int wc, int fr, int fq) const {
        rt.prepare(u.pm);
        const int sec = u.pn >> 2; const int row0 = u.pm * BM + wr * 64 + fr, col0 = (u.pn & 3) * BM + wc * 32 + 8 * fq;
        bf16_t* O = sec == 0 ? Q1 : sec == 1 ? K1 : sec == 2 ? I1 : G1;
        float lbc[2][8];
#pragma unroll
        for (int bj = 0; bj < 2; ++bj)
#pragma unroll
            for (int j = 0; j < 8; ++j) lbc[bj][j] = (sec == 1) ? (1.0f - lb[col0 + bj * HALF + j]) : 0.f;
#pragma unroll
        for (int ai = 0; ai < 2; ++ai)
#pragma unroll
            for (int m = 0; m < 4; ++m) { const int row = row0 + ai * HALF + m * 16; const float r = rt.get(row - u.pm * BM); bf16_t* rowp = O + (size_t)row * 1024 + col0;
#pragma unroll
                for (int bj = 0; bj < 2; ++bj) { float a[8];
#pragma unroll
                    for (int n = 0; n < 2; ++n)
#pragma unroll
                        for (int j = 0; j < 4; ++j) { const float v = acc[ai][bj][m][n][j] * r; float o;
                            if (sec == 0) o = v * 0.08838834764831845f; else if (sec == 1) o = lbc[bj][4 * n + j] * sigmoid_neg(v); else if (sec == 2) o = v; else o = silu_f(v);
                            a[4 * n + j] = o; }
                    u32x4 w; w.x = cvt_pk_bf16(a[0], a[1]); w.y = cvt_pk_bf16(a[2], a[3]); w.z = cvt_pk_bf16(a[4], a[5]); w.w = cvt_pk_bf16(a[6], a[7]);
                    *(u32x4*)(rowp + bj * HALF) = w; } }
    }
};

template <class Epi>
__device__ __forceinline__ void gemm_simple(const Gemm g, int G, int c, const Epi& E) {
    const int tid = threadIdx.x, wid = __builtin_amdgcn_readfirstlane(tid >> 6), lane = tid & 63, wr = wid >> 2, wc = wid & 3, fr = lane & 15, fq = lane >> 4;
    const int nN = g.N / BM, nunits = (g.M / BM) * nN, K = g.K;
    for (int ui = c; ui < nunits; ui += G) {
        Unit u; u.pm = ui / nN; u.pn = ui % nN;
        f32x4 acc[2][2][4][2];
#pragma unroll
        for (int a = 0; a < 2; ++a)
#pragma unroll
            for (int b = 0; b < 2; ++b)
#pragma unroll
                for (int m = 0; m < 4; ++m)
#pragma unroll
                    for (int n = 0; n < 2; ++n) acc[a][b][m][n] = (f32x4){0.f, 0.f, 0.f, 0.f};
        const bf16_t* Ab = g.A + (size_t)(u.pm * BM + wr * 64 + fr) * K + fq * 8;
        const bf16_t* Bb = g.Bt + (size_t)(u.pn * BM + wc * 32 + 8 * (fr >> 2) + (fr & 3)) * K + fq * 8;
        for (int kk = 0; kk < K; kk += 32) {
            bf16x8 a[2][4], b[2][2];
#pragma unroll
            for (int ai = 0; ai < 2; ++ai)
#pragma unroll
                for (int m = 0; m < 4; ++m) a[ai][m] = *(const bf16x8*)(Ab + (size_t)(ai * HALF + m * 16) * K + kk);
#pragma unroll
            for (int bj = 0; bj < 2; ++bj)
#pragma unroll
                for (int n = 0; n < 2; ++n) b[bj][n] = *(const bf16x8*)(Bb + (size_t)(bj * HALF + 4 * n) * K + kk);
#pragma unroll
            for (int ai = 0; ai < 2; ++ai)
#pragma unroll
                for (int bj = 0; bj < 2; ++bj)
#pragma unroll
                    for (int m = 0; m < 4; ++m)
#pragma unroll
                        for (int n = 0; n < 2; ++n) acc[ai][bj][m][n] = __builtin_amdgcn_mfma_f32_16x16x32_bf16(b[bj][n], a[ai][m], acc[ai][bj][m][n], 0, 0, 0);
        }
        E(acc, u, wr, wc, fr, fq);
    }
}
template <class Epi, class Sched, bool ALIGN_EPI = false, bool SP2 = false>
__device__ __forceinline__ void gemm_phase(PG8_LAS unsigned char* lds, const Gemm g, const Sched& S, const Epi& E) {
    const int tid = threadIdx.x, wid = __builtin_amdgcn_readfirstlane(tid >> 6), lane = tid & 63, wr = wid >> 2, wc = wid & 3, fr = lane & 15, fq = lane >> 4;
    const int K = g.K, nt = K / BK;
    unsigned voffA[2], voffB[2];
#pragma unroll
    for (int i = 0; i < 2; ++i) { int R, C; stage_rc(tid * 16 + i * 8192, R, C); const int Rb = Epi::PERM ? ((R & ~31) + perm32(R & 31)) : R;
        voffA[i] = (unsigned)(R * K + C) * 2u; voffB[i] = (unsigned)(Rb * K + C) * 2u; }
    const size_t kstep = (size_t)(BK * 2);
    const size_t hstep = (size_t)HALF * K * 2;
    const size_t tstep = 2 * hstep;
    const unsigned ldsw = (unsigned)wid * 1024u;
    const int aoff = lds_byte(wr * 64 + fr, fq * 8), boff = lds_byte(wc * 32 + fr, fq * 8);
#define PG8_SA(b, h) (((b) * 2 + (h)) * HTB)
#define PG8_SB(b, h) ((4 + (b) * 2 + (h)) * HTB)
#define PG8_STAGE(bufoff, gbase, voff) do { _Pragma("unroll") for (int _i = 0; _i < 2; ++_i) \
        __builtin_amdgcn_global_load_lds((const unsigned*)((const char*)(gbase) + (voff)[_i]), (PG8_LAS unsigned*)(lds + (bufoff) + ldsw + _i * 8192), 16, 0, 0); } while (0)
#define PG8_LDA(dst, b, h) do { _Pragma("unroll") for (int m = 0; m < 4; ++m) _Pragma("unroll") for (int k = 0; k < 2; ++k) dst[m][k] = *(const PG8_LAS bf16x8*)(lds + PG8_SA(b, h) + aoff + m * 2048 + k * 1024); } while (0)
#define PG8_LDB(dst, b, h) do { _Pragma("unroll") for (int n = 0; n < 2; ++n) _Pragma("unroll") for (int k = 0; k < 2; ++k) dst[n][k] = *(const PG8_LAS bf16x8*)(lds + PG8_SB(b, h) + boff + n * 2048 + k * 1024); } while (0)
#define PG8_MMA(ai, bj, At, Bt) do { __builtin_amdgcn_s_setprio(1); _Pragma("unroll") for (int m = 0; m < 4; ++m) _Pragma("unroll") for (int n = 0; n < 2; ++n) _Pragma("unroll") for (int k = 0; k < 2; ++k) \
        acc[ai][bj][m][n] = __builtin_amdgcn_mfma_f32_16x16x32_bf16(Bt[n][k], At[m][k], acc[ai][bj][m][n], 0, 0, 0); __builtin_amdgcn_s_setprio(0); } while (0)
#define PG8_WAIT_V(n) asm volatile("s_waitcnt vmcnt(" #n ")" ::: "memory")
#define PG8_WAIT_L(n) asm volatile("s_waitcnt lgkmcnt(" #n ")" ::: "memory")
#define PG8_BAR __builtin_amdgcn_s_barrier()
#define PG8_SCHED __builtin_amdgcn_sched_barrier(0)
    Unit cur, nxt; int ui = 0;
    if (!S.next(0, cur)) return;
    f32x4 acc[2][2][4][2];
#pragma unroll
    for (int a = 0; a < 2; ++a)
#pragma unroll
        for (int b = 0; b < 2; ++b)
#pragma unroll
            for (int m = 0; m < 4; ++m)
#pragma unroll
                for (int n = 0; n < 2; ++n) acc[a][b][m][n] = (f32x4){0.f, 0.f, 0.f, 0.f};
    bf16x8 At[4][2], B0[2][2], B1[2][2];
    const char* cA = (const char*)g.A + (size_t)cur.pm * tstep; const char* cB = (const char*)g.Bt + (size_t)cur.pn * tstep;
    S.a_ready(cur);
    if constexpr (SP2) {
        PG8_STAGE(PG8_SB(0, 0), cB, voffB); PG8_STAGE(PG8_SB(0, 1), cB + hstep, voffB); PG8_STAGE(PG8_SA(0, 0), cA, voffA); PG8_STAGE(PG8_SA(0, 1), cA + hstep, voffA);
        if (wr == 1) PG8_BAR;
        PG8_WAIT_V(2); PG8_BAR;
        PG8_STAGE(PG8_SB(1, 0), cB + kstep, voffB); PG8_STAGE(PG8_SA(1, 0), cA + kstep, voffA); PG8_STAGE(PG8_SB(1, 1), cB + hstep + kstep, voffB);
        PG8_WAIT_V(6); PG8_BAR;
    } else {
        PG8_STAGE(PG8_SB(0, 0), cB, voffB); PG8_STAGE(PG8_SA(0, 0), cA, voffA); PG8_STAGE(PG8_SB(0, 1), cB + hstep, voffB); PG8_STAGE(PG8_SA(0, 1), cA + hstep, voffA);
        if (wr == 1) PG8_BAR;
        PG8_WAIT_V(4); PG8_BAR;
        PG8_STAGE(PG8_SB(1, 0), cB + kstep, voffB); PG8_STAGE(PG8_SA(1, 0), cA + kstep, voffA); PG8_STAGE(PG8_SB(1, 1), cB + hstep + kstep, voffB);
        PG8_WAIT_V(6); PG8_BAR;
    }
    for (;;) {
        const bool has_next = S.next(ui + 1, nxt);
        const char* nA = has_next ? (const char*)g.A + (size_t)nxt.pm * tstep : cA; const char* nB = has_next ? (const char*)g.Bt + (size_t)nxt.pn * tstep : cB;
        for (int t = 0; t < nt; t += 2) {
            const bool last = (t == nt - 2);
            const char* a1 = cA + (size_t)(t + 1) * kstep;
            const char* a2 = last ? nA : cA + (size_t)(t + 2) * kstep; const char* b2 = last ? nB : cB + (size_t)(t + 2) * kstep;
            const char* a3 = a2 + kstep; const char* b3 = b2 + kstep;
            if (last && has_next) S.a_ready(nxt);
            if constexpr (SP2) {
            PG8_LDB(B0, 0, 0); PG8_LDB(B1, 0, 1); PG8_SCHED; PG8_LDA(At, 0, 0); PG8_STAGE(PG8_SA(1, 1), a1 + hstep, voffA);
            PG8_WAIT_V(8); PG8_WAIT_L(0); PG8_BAR; PG8_MMA(0, 0, At, B0); PG8_MMA(0, 1, At, B1); PG8_BAR; PG8_SCHED;
            PG8_LDA(At, 0, 1); PG8_STAGE(PG8_SB(0, 0), b2, voffB); PG8_STAGE(PG8_SB(0, 1), b2 + hstep, voffB); PG8_STAGE(PG8_SA(0, 0), a2, voffA);
            PG8_WAIT_V(8); PG8_WAIT_L(0); PG8_BAR; PG8_MMA(1, 0, At, B0); PG8_MMA(1, 1, At, B1); PG8_BAR; PG8_SCHED;
            PG8_LDB(B0, 1, 0); PG8_LDB(B1, 1, 1); PG8_SCHED; PG8_LDA(At, 1, 0); PG8_STAGE(PG8_SA(0, 1), a2 + hstep, voffA);
            PG8_WAIT_V(8); PG8_WAIT_L(0); PG8_BAR; PG8_MMA(0, 0, At, B0); PG8_MMA(0, 1, At, B1); PG8_BAR; PG8_SCHED;
            PG8_LDA(At, 1, 1); PG8_STAGE(PG8_SB(1, 0), b3, voffB); PG8_STAGE(PG8_SB(1, 1), b3 + hstep, voffB); PG8_STAGE(PG8_SA(1, 0), a3, voffA);
            PG8_WAIT_V(8); PG8_WAIT_L(0); PG8_BAR; PG8_MMA(1, 0, At, B0); PG8_MMA(1, 1, At, B1); PG8_BAR; PG8_SCHED;
            } else {
            PG8_LDB(B0, 0, 0); PG8_SCHED; PG8_LDA(At, 0, 0); PG8_STAGE(PG8_SA(1, 1), a1 + hstep, voffA);
            PG8_WAIT_L(8); PG8_BAR; PG8_WAIT_L(0); PG8_MMA(0, 0, At, B0); PG8_BAR; PG8_SCHED;
            PG8_LDB(B1, 0, 1); PG8_STAGE(PG8_SB(0, 0), b2, voffB);
            PG8_BAR; PG8_WAIT_L(0); PG8_MMA(0, 1, At, B1); PG8_BAR;
            PG8_LDA(At, 0, 1); PG8_STAGE(PG8_SA(0, 0), a2, voffA);
            PG8_BAR; PG8_WAIT_L(0); PG8_MMA(1, 0, At, B0); PG8_BAR; PG8_SCHED;
            PG8_STAGE(PG8_SB(0, 1), b2 + hstep, voffB);
            PG8_WAIT_V(6); PG8_BAR; PG8_MMA(1, 1, At, B1); PG8_BAR;
            PG8_LDB(B0, 1, 0); PG8_SCHED; PG8_LDA(At, 1, 0); PG8_STAGE(PG8_SA(0, 1), a2 + hstep, voffA);
            PG8_WAIT_L(8); PG8_BAR; PG8_WAIT_L(0); PG8_MMA(0, 0, At, B0); PG8_BAR; PG8_SCHED;
            PG8_LDB(B1, 1, 1); PG8_STAGE(PG8_SB(1, 0), b3, voffB);
            PG8_BAR; PG8_WAIT_L(0); PG8_MMA(0, 1, At, B1); PG8_BAR;
            PG8_LDA(At, 1, 1); PG8_STAGE(PG8_SA(1, 0), a3, voffA);
            PG8_BAR; PG8_WAIT_L(0); PG8_MMA(1, 0, At, B0); PG8_BAR; PG8_SCHED;
            PG8_STAGE(PG8_SB(1, 1), b3 + hstep, voffB);
            PG8_WAIT_V(6); PG8_BAR; PG8_MMA(1, 1, At, B1); PG8_BAR;
            }
        }
        if constexpr (ALIGN_EPI) { if (wr == 0) PG8_BAR; }
        if constexpr (!Epi::AFTER_DRAIN) { E(acc, cur, wr, wc, fr, fq); S.done(cur); }
        if (!has_next) break;
#pragma unroll
        for (int a = 0; a < 2; ++a)
#pragma unroll
            for (int b = 0; b < 2; ++b)
#pragma unroll
                for (int m = 0; m < 4; ++m)
#pragma unroll
                    for (int n = 0; n < 2; ++n) acc[a][b][m][n] = (f32x4){0.f, 0.f, 0.f, 0.f};
        cur = nxt; cA = nA; cB = nB; ++ui;
        if constexpr (ALIGN_EPI) { if (wr == 1) PG8_BAR; }
    }
    PG8_WAIT_V(0);
    if constexpr (!ALIGN_EPI) { if (wr == 0) PG8_BAR; }
    PG8_BAR;
    if constexpr (Epi::AFTER_DRAIN) { E.fused(acc, cur, wr, wc, fr, fq, lds, wid, lane); S.done(cur); }
#undef PG8_SA
#undef PG8_SB
#undef PG8_STAGE
#undef PG8_LDA
#undef PG8_LDB
#undef PG8_MMA
#undef PG8_WAIT_V
#undef PG8_WAIT_L
#undef PG8_BAR
#undef PG8_SCHED
}
}

#define XB_TMO      128
#define XB_XCNT(j)  (256  + 64 * (j))
#define XB_XSUB(j)  (1280 + 64 * (j))
#define XB_XGEN(j)  (2304 + 64 * (j))
#define XB_TOP      3328
#define XB_TOPGEN   3392
#define XCD_BAR_WORDS 3456
#define XB_SPIN_CAP (1u << 18)

__device__ __forceinline__ unsigned xb_ld(unsigned* p)              { return __hip_atomic_load(p, __ATOMIC_RELAXED, __HIP_MEMORY_SCOPE_AGENT); }
__device__ __forceinline__ unsigned xb_add(unsigned* p, unsigned v) { return __hip_atomic_fetch_add(p, v, __ATOMIC_RELAXED, __HIP_MEMORY_SCOPE_AGENT); }
__device__ __forceinline__ unsigned xb_xcc_id() { return (unsigned)__builtin_amdgcn_s_getreg((3 << 11) | 20) & 0xFu; }
#define XB_SPIN(cond, bar) do { unsigned _sp = 0; while (cond) { __builtin_amdgcn_s_sleep(1); \
    if ((++_sp & 255u) == 0u) { if (xb_ld(&(bar)[XB_TMO])) break; if (_sp > XB_SPIN_CAP) { atomicAdd(&(bar)[XB_TMO], 1u); break; } } } } while (0)

struct XcdBarrier {
    unsigned* bar; unsigned x;
    volatile LAS unsigned* st;
};

__device__ __forceinline__ XcdBarrier xcd_barrier_post(unsigned* bar, volatile LAS unsigned* st) {
    XcdBarrier b; b.bar = bar; b.x = xb_xcc_id(); b.st = st;
    if (threadIdx.x == 0) (void)xb_add(&bar[XB_XCNT(b.x)], 1u);
    return b;
}
__device__ __forceinline__ void xcd_barrier_complete(unsigned* bar, unsigned x, unsigned& nloc, unsigned& nx) {
    const unsigned G = gridDim.x * gridDim.y * gridDim.z;
    unsigned sum, cnt, mine, sp = 0u;
    for (;;) {
        sum = 0u; cnt = 0u; mine = 0u;
#pragma unroll
        for (unsigned j = 0; j < 16; ++j) { const unsigned c = xb_ld(&bar[XB_XCNT(j)]); sum += c; cnt += (c > 0u) ? 1u : 0u; mine = (j == x) ? c : mine; }
        if (sum == G) break;
        __builtin_amdgcn_s_sleep(1);
        if ((++sp & 255u) == 0u) { if (xb_ld(&bar[XB_TMO])) break; if (sp > XB_SPIN_CAP) { atomicAdd(&bar[XB_TMO], 1u); break; } }
    }
    nloc = mine > 0u ? mine : 1u; nx = cnt > 0u ? cnt : 1u;
}

__device__ __forceinline__ void xcd_barrier(const XcdBarrier& b) {
    asm volatile("s_waitcnt vmcnt(0)" ::: "memory");
    __syncthreads();
    if (threadIdx.x == 0) {
        unsigned* bar = b.bar;
        __builtin_amdgcn_s_waitcnt(0);
        unsigned nloc = b.st[0], nx = b.st[1];
        if (nloc == 0u) { xcd_barrier_complete(bar, b.x, nloc, nx); b.st[0] = nloc; b.st[1] = nx; }
        const unsigned old = xb_add(&bar[XB_XSUB(b.x)], 1u);
        const unsigned gen = old / nloc;
        if (old + 1u == (gen + 1u) * nloc) {
            __builtin_amdgcn_fence(__ATOMIC_RELEASE, "agent");
            asm volatile("s_waitcnt vmcnt(0)" ::: "memory");
            const unsigned og = xb_add(&bar[XB_TOP], 1u);
            const unsigned tg = og / nx;
            if (og + 1u == (tg + 1u) * nx) xb_add(&bar[XB_TOPGEN], 1u);
            else XB_SPIN(xb_ld(&bar[XB_TOPGEN]) == tg, bar);
            __builtin_amdgcn_fence(__ATOMIC_ACQUIRE, "agent");
            xb_add(&bar[XB_XGEN(b.x)], 1u);
            asm volatile("s_waitcnt vmcnt(0)" ::: "memory");
        } else {
            XB_SPIN(xb_ld(&bar[XB_XGEN(b.x)]) == gen, bar);
            __builtin_amdgcn_fence(__ATOMIC_ACQUIRE, "agent");
            asm volatile("s_waitcnt vmcnt(0)" ::: "memory");
        }
    }
    __syncthreads();
}

typedef unsigned short bf16_t;
typedef short bf16x8 __attribute__((ext_vector_type(8)));
typedef float f32x4 __attribute__((ext_vector_type(4)));
typedef unsigned u32x4 __attribute__((ext_vector_type(4)));
typedef unsigned u32x2 __attribute__((ext_vector_type(2)));

struct Ctx {
    const float* x; const int* positions; const float *ln_mix, *ln_ffn, *ln_final, *w_in_ab, *w_pool, *pool_scale, *idx_k_norm, *w_out_ab, *w_in_c, *hgrn_lb, *hgrn_out_norm, *w_out_c, *w_gate_up, *w_down;
    float* out;
    unsigned* ctl; float* rope; float* part; float* lbv;
    bf16_t *W_inab, *W_pool, *W_outab, *W_inc, *W_outc, *W_gu0, *W_gu1, *W_dn0, *W_dn1;
    bf16_t *XB, *Y, *P, *ACT, *L1Q, *L1K, *L1I, *L1G, *ORAW;
    int G, bid;
};

__device__ __forceinline__ float bf_lo(unsigned w) { return __uint_as_float(w << 16); }
__device__ __forceinline__ float bf_hi(unsigned w) { return __uint_as_float(w & 0xffff0000u); }
__device__ __forceinline__ float bf2f(bf16_t b) { return __uint_as_float(((unsigned)b) << 16); }
__device__ __forceinline__ unsigned pk2(float lo, float hi) { return pg8::cvt_pk_bf16(lo, hi); }
__device__ __forceinline__ float wave_sum(float v) {
#pragma unroll
    for (int o = 1; o < 64; o <<= 1) v += __shfl_xor(v, o);
    return v;
}

__device__ __forceinline__ unsigned pk4_fp8(float a, float b, float c, float d) { int w = 0; w = __builtin_amdgcn_cvt_pk_fp8_f32(a, b, w, false); w = __builtin_amdgcn_cvt_pk_fp8_f32(c, d, w, true); return (unsigned)w; }
__device__ __forceinline__ u32x2 bf8_to_fp8(u32x4 w) { u32x2 o; o.x = pk4_fp8(bf_lo(w.x), bf_hi(w.x), bf_lo(w.y), bf_hi(w.y)); o.y = pk4_fp8(bf_lo(w.z), bf_hi(w.z), bf_lo(w.w), bf_hi(w.w)); return o; }

struct RowMapId { __device__ __forceinline__ int operator()(int n) const { return n; } };
struct RowMapAB { __device__ __forceinline__ int operator()(int n) const {
    if (n < PC_Q || (n >= PC_V && n < PC_QI) || n >= PC_WI) return n;
    const int d = n & 63; if (d >= 16) return n;
    return n - d + ((d < 8) ? 2 * d : 2 * (d - 8) + 1); } };
struct RowMapGU { __device__ __forceinline__ int operator()(int n) const {
    if (n < DFF) return 256 * (n >> 7) + (n & 127);
    const int f = n - DFF; return 256 * (f >> 7) + 128 + (f & 127); } };

template <class RowMap>
__device__ __forceinline__ void transpose_item(const float* W, int K, int N, const float* kgain, const float* nscale, bf16_t* WT, RowMap map, LAS float* scr, int item, int lane) {
    const int nblk = (N + 31) >> 5, kb = item / nblk, nb = item - kb * nblk, k0 = 64 * kb, n0 = 32 * nb;
    const int nr = n0 + (lane & 31); const float ns = (nr < N && nscale) ? nscale[nr] : 1.0f;
    float wv[32];
    const int nrc = (nr < N) ? nr : N - 1;
#pragma unroll
    for (int i = 0; i < 32; ++i) wv[i] = W[(size_t)(k0 + 2 * i + (lane >> 5)) * N + nrc];
    float kg[32];
#pragma unroll
    for (int i = 0; i < 32; ++i) kg[i] = kgain ? kgain[k0 + 2 * i + (lane >> 5)] : 1.0f;
#pragma unroll
    for (int i = 0; i < 32; ++i) { const int kk = 2 * i + (lane >> 5); scr[kk * 33 + (lane & 31)] = (nr < N) ? wv[i] * kg[i] * ns : 0.f; }
    asm volatile("s_waitcnt lgkmcnt(0)" ::: "memory");
    const int c = lane & 7;
#pragma unroll
    for (int j = 0; j < 4; ++j) { const int nl = (lane >> 3) + 8 * j; const LAS float* s = scr + (8 * c) * 33 + nl;
        u32x4 o; o.x = pk2(s[0 * 33], s[1 * 33]); o.y = pk2(s[2 * 33], s[3 * 33]); o.z = pk2(s[4 * 33], s[5 * 33]); o.w = pk2(s[6 * 33], s[7 * 33]);
        if (n0 + nl < N) *(u32x4*)(WT + (size_t)map(n0 + nl) * K + k0 + 8 * c) = o; }
    asm volatile("s_waitcnt lgkmcnt(0)" ::: "memory");
}

__device__ __forceinline__ void rope_cs(int pos, int i, float& c, float& s) {
    const double inv = (i == 0) ? 1.0 : (i == 1) ? 0.19392274474868576 : (i == 2) ? 0.03760603093086393 : (i == 3) ? 0.007292664737217109 : (i == 4) ? 0.001414213562373095
                     : (i == 5) ? 0.0002742481756762073 : (i == 6) ? 5.318295896944988e-05 : 1.031338537721246e-05;
    const double a = (double)pos * inv;
    const double kq = rint(a * 0.63661977236758134308);
    double r = fma(-kq, 1.57079632679489655800e+00, a); r = fma(-kq, 6.12323399573676603587e-17, r);
    const double r2 = r * r;
    double sp = -7.6471637318198164759e-13; sp = fma(sp, r2, 1.6059043836821614599e-10); sp = fma(sp, r2, -2.5052108385441718775e-08); sp = fma(sp, r2, 2.7557319223985890653e-06);
    sp = fma(sp, r2, -1.9841269841269841270e-04); sp = fma(sp, r2, 8.3333333333333333333e-03); sp = fma(sp, r2, -1.6666666666666666667e-01); const double sn = fma(sp * r2, r, r);
    double cp = 4.7794773323873852974e-14; cp = fma(cp, r2, -1.1470745597729724714e-11); cp = fma(cp, r2, 2.0876756987868098979e-09); cp = fma(cp, r2, -2.7557319223985890653e-07);
    cp = fma(cp, r2, 2.4801587301587301587e-05); cp = fma(cp, r2, -1.3888888888888888889e-03); cp = fma(cp, r2, 4.1666666666666666667e-02); cp = fma(cp, r2, -0.5); const double cn = fma(cp, r2, 1.0);
    const int q = ((int)kq) & 3;
    const double cc = (q == 0) ? cn : (q == 1) ? -sn : (q == 2) ? -cn : sn;
    const double ss = (q == 0) ? sn : (q == 1) ? cn : (q == 2) ? -sn : -cn;
    c = (float)cc; s = (float)ss;
}

__device__ __forceinline__ void phase_prologue(const Ctx& C, LAS unsigned char* lds) {
    const int tid = threadIdx.x, lane = tid & 63, wave = __builtin_amdgcn_readfirstlane(tid >> 6);
    LAS float* scr = (LAS float*)(lds + wave * 16384);
    const int gw = C.bid * 8 + wave, NGW = C.G * 8;
    constexpr int I_AB = 16 * 51, I_PL = 2 * 4, I_SQ = 16 * 32, I_INC = 16 * 128, I_GU = 16 * 176, I_DN = 44 * 32;
    constexpr int NITEMS = I_AB + 4 * I_PL + I_SQ + I_INC + I_SQ + 2 * I_GU + I_DN;
    for (int it = gw; it < NITEMS; it += NGW) {
        int r = it;
        if (r < I_AB) { transpose_item(C.w_in_ab, 1024, NAB_REAL, C.ln_mix, nullptr, C.W_inab, RowMapAB(), scr, r, lane); continue; } r -= I_AB;
        if (r < 4 * I_PL) { const int g = r / I_PL; transpose_item(C.w_pool + g * 16384, 128, 128, nullptr, C.pool_scale + g * 128, C.W_pool + g * 16384, RowMapId(), scr, r - g * I_PL, lane); continue; } r -= 4 * I_PL;
        if (r < I_SQ) { transpose_item(C.w_out_ab, 1024, 1024, nullptr, nullptr, C.W_outab, RowMapId(), scr, r, lane); continue; } r -= I_SQ;
        if (r < I_INC) { transpose_item(C.w_in_c, 1024, NINC, C.ln_mix + 1024, nullptr, C.W_inc, RowMapId(), scr, r, lane); continue; } r -= I_INC;
        if (r < I_SQ) { transpose_item(C.w_out_c, 1024, 1024, nullptr, nullptr, C.W_outc, RowMapId(), scr, r, lane); continue; } r -= I_SQ;
        if (r < I_GU) { transpose_item(C.w_gate_up, 1024, 2 * DFF, C.ln_ffn, nullptr, C.W_gu0, RowMapGU(), scr, r, lane); continue; } r -= I_GU;
        if (r < I_GU) { transpose_item(C.w_gate_up + (size_t)1024 * 2 * DFF, 1024, 2 * DFF, C.ln_ffn + 1024, nullptr, C.W_gu1, RowMapGU(), scr, r, lane); continue; } r -= I_GU;
        transpose_item(C.w_down, DFF, 1024, nullptr, nullptr, C.W_dn0, RowMapId(), scr, r, lane);
    }
    const int gt = C.bid * 512 + tid, NGT = C.G * 512;
    for (int i = gt; i < (NAB - NAB_REAL) * 1024 / 8; i += NGT) ((u32x4*)(C.W_inab + (size_t)NAB_REAL * 1024))[i] = (u32x4){0u, 0u, 0u, 0u};
    for (int i = gt; i < 1024; i += NGT) C.lbv[i] = 1.0f / (1.0f + expf(C.hgrn_lb[i] - C.hgrn_lb[1024 + i]));
    for (int row0 = 4 * gw; row0 < NTOK; row0 += 4 * NGW) {
        f32x4 v[4][4];
#pragma unroll
        for (int rr = 0; rr < 4; ++rr)
#pragma unroll
            for (int j = 0; j < 4; ++j) v[rr][j] = ((const f32x4*)(C.x + (size_t)(row0 + rr) * 1024) + lane)[64 * j];
#pragma unroll
        for (int rr = 0; rr < 4; ++rr) { const int row = row0 + rr; u32x2* o8 = (u32x2*)(C.XB + (size_t)row * 1024) + lane; float s = 0.f;
#pragma unroll
            for (int j = 0; j < 4; ++j) { const f32x4 x4 = v[rr][j]; s += (x4[0] * x4[0] + x4[1] * x4[1]) + (x4[2] * x4[2] + x4[3] * x4[3]); u32x2 w; w.x = pk2(x4[0], x4[1]); w.y = pk2(x4[2], x4[3]); o8[64 * j] = w; }
            s = wave_sum(s);
            if (lane < 16) C.part[(size_t)row * 16 + lane] = (lane == 0) ? s : 0.f; }
    }
}

__device__ __forceinline__ void phase_prologue_late(const Ctx& C, LAS unsigned char* lds) {
    const int tid = threadIdx.x, lane = tid & 63, wave = __builtin_amdgcn_readfirstlane(tid >> 6);
    LAS float* scr = (LAS float*)(lds + wave * 16384);
    const int half = C.G >> 1; if (C.bid < half) return;
    const int gw = (C.bid - half) * 8 + wave, NGW = (C.G - half) * 8;
    for (int it = gw; it < 44 * 32; it += NGW) transpose_item(C.w_down + (size_t)DFF * 1024, DFF, 1024, nullptr, nullptr, C.W_dn1, RowMapId(), scr, it, lane);
    { const int gt = (C.bid - half) * 512 + tid, NGT = (C.G - half) * 512;
      for (int i = gt; i < NTOK * 8; i += NGT) { const int tok = i >> 3, f = i & 7; float c, s; rope_cs(C.positions[tok], f, c, s); C.rope[(size_t)tok * 16 + f] = c; C.rope[(size_t)tok * 16 + 8 + f] = s; } }
}

__device__ __forceinline__ void phase_fixup_pool(const Ctx& C, LAS unsigned char* lds) {
    const int tid = threadIdx.x, lane = tid & 63, wid = __builtin_amdgcn_readfirstlane(tid >> 6);
    for (int tile = C.bid; tile < NTOK / 128; tile += C.G) {
        const int tok0 = tile * 128;
        for (int it = tid; it < 128 * 16; it += 512) {
            const int tl = it >> 4, slot = it & 15;
            const int tok = tok0 + tl;
            unsigned char* kv8 = (unsigned char*)C.ctl + WS_KV8 + (size_t)tok * 256;
            if (slot == 15) {
                const bf16_t* vp = C.P + (size_t)tok * NAB + PC_V;
#pragma unroll
                for (int q2 = 0; q2 < 8; ++q2) { const u32x2 a = bf8_to_fp8(*(const u32x4*)(vp + 16 * q2)), b = bf8_to_fp8(*(const u32x4*)(vp + 16 * q2 + 8)); *(u32x4*)(kv8 + 128 + 16 * q2) = (u32x4){a.x, a.y, b.x, b.y}; }
                continue; }
            const f32x4* rp = (const f32x4*)(C.rope + (size_t)tok * 16);
            const f32x4 c0 = rp[0], c1 = rp[1], s0 = rp[2], s1 = rp[3];
            const float cs[8] = {c0[0], c0[1], c0[2], c0[3], c1[0], c1[1], c1[2], c1[3]}, sn[8] = {s0[0], s0[1], s0[2], s0[3], s1[0], s1[1], s1[2], s1[3]};
            bf16_t* rowp = C.P + (size_t)tok * NAB;
            if (slot < 14) {
                const int col = (slot < 8) ? PC_Q + 64 * slot : (slot < 10) ? PC_K + 64 * (slot - 8) : PC_QI + 64 * (slot - 10);
                u32x4 w0 = *(u32x4*)(rowp + col), w1 = *(u32x4*)(rowp + col + 8);
                unsigned w[8] = {w0.x, w0.y, w0.z, w0.w, w1.x, w1.y, w1.z, w1.w};
#pragma unroll
                for (int i = 0; i < 8; ++i) { const float x1 = bf_lo(w[i]), x2 = bf_hi(w[i]); w[i] = pk2(x1 * cs[i] - x2 * sn[i], x2 * cs[i] + x1 * sn[i]); }
                *(u32x4*)(rowp + col) = (u32x4){w[0], w[1], w[2], w[3]}; *(u32x4*)(rowp + col + 8) = (u32x4){w[4], w[5], w[6], w[7]};
                if (slot == 8 || slot == 9) {
                    unsigned char* kd = kv8 + 64 * (slot - 8);
                    { const u32x2 a = bf8_to_fp8((u32x4){w[0], w[1], w[2], w[3]}), b = bf8_to_fp8((u32x4){w[4], w[5], w[6], w[7]}); *(u32x4*)kd = (u32x4){a.x, a.y, b.x, b.y}; }
#pragma unroll
                    for (int q2 = 1; q2 < 4; ++q2) { const u32x2 a = bf8_to_fp8(*(const u32x4*)(rowp + col + 16 * q2)), b = bf8_to_fp8(*(const u32x4*)(rowp + col + 16 * q2 + 8)); *(u32x4*)(kd + 16 * q2) = (u32x4){a.x, a.y, b.x, b.y}; } }
            } else {
                unsigned w[32];
#pragma unroll
                for (int q = 0; q < 8; ++q) { const u32x4 t = *(u32x4*)(rowp + PC_KI + 8 * q); w[4 * q] = t.x; w[4 * q + 1] = t.y; w[4 * q + 2] = t.z; w[4 * q + 3] = t.w; }
                float ss = 0.f;
#pragma unroll
                for (int i = 0; i < 32; ++i) { const float a = bf_lo(w[i]), b = bf_hi(w[i]); ss += a * a + b * b; }
                const float r = 1.0f / sqrtf(ss * (1.0f / 64.0f) + EPS);
#pragma unroll
                for (int i = 0; i < 32; ++i) {
                    const int d0 = (i < 8) ? i : 2 * i, d1 = (i < 8) ? i + 8 : 2 * i + 1;
                    float a = bf_lo(w[i]) * r * C.idx_k_norm[d0], b = bf_hi(w[i]) * r * C.idx_k_norm[d1];
                    if (i < 8) { const float x1 = a, x2 = b; a = x1 * cs[i] - x2 * sn[i]; b = x2 * cs[i] + x1 * sn[i]; }
                    w[i] = pk2(a, b); }
#pragma unroll
                for (int q = 0; q < 8; ++q) *(u32x4*)(rowp + PC_KI + 8 * q) = (u32x4){w[4 * q], w[4 * q + 1], w[4 * q + 2], w[4 * q + 3]};
            }
        }
        const int fr = lane & 15, fq = lane >> 4;
        const int tl0 = wid * 16 + fr, tok = tok0 + tl0, t = tok & (SEQ - 1);
        const bool hist = (tok0 & (SEQ - 1)) != 0;
        LAS unsigned char* ubuf = lds; LAS unsigned char* wbuf = lds + 39424;
        u32x4 ur[5], wv[4];
#define POOL_LOAD(gx) { _Pragma("unroll") for (int i = 0; i < 5; ++i) { int p = tid + 512 * i; p = p < 2288 ? p : 2287; const int r = p >> 4, pc = p & 15; const int trow = (r < 15 && !hist) ? tok0 : tok0 - 15 + r; \
            ur[i] = *(const u32x4*)(C.P + (size_t)trow * NAB + PC_U + (gx) * 128 + pc * 8); } \
        _Pragma("unroll") for (int i = 0; i < 4; ++i) wv[i] = *(const u32x4*)(C.W_pool + (gx) * 16384 + (tid + 512 * i) * 8); }
        POOL_LOAD(0)
#pragma unroll 1
        for (int g = 0; g < 4; ++g) {
            __syncthreads();
#pragma unroll
            for (int i = 0; i < 5; ++i) { const int p = tid + 512 * i; if (p < 2288) *(LAS u32x4*)(ubuf + (p >> 4) * 272 + (p & 15) * 16) = ur[i]; }
#pragma unroll
            for (int i = 0; i < 4; ++i) { const int p = tid + 512 * i, d = p >> 4; const int slot = (d & ~31) + 16 * ((d >> 2) & 1) + 4 * ((d >> 3) & 3) + (d & 3); *(LAS u32x4*)(wbuf + slot * 272 + (p & 15) * 16) = wv[i]; }
            __syncthreads();
            if (g < 3) POOL_LOAD(g + 1)
            const int win = 2 << g;
            const int cnt = (t + 1 < win) ? t + 1 : win; const float rc = 1.0f / (float)cnt;
            f32x4 acc[4][2];
#pragma unroll
            for (int a = 0; a < 4; ++a) { acc[a][0] = (f32x4){0.f, 0.f, 0.f, 0.f}; acc[a][1] = (f32x4){0.f, 0.f, 0.f, 0.f}; }
#pragma unroll
            for (int kk = 0; kk < 4; ++kk) {
                const LAS unsigned char* up = ubuf + (15 + tl0) * 272 + kk * 64 + fq * 16;
                float s[8], cur[8];
                { const u32x4 wx = *(const LAS u32x4*)up; cur[0] = bf_lo(wx.x); cur[1] = bf_hi(wx.x); cur[2] = bf_lo(wx.y); cur[3] = bf_hi(wx.y); cur[4] = bf_lo(wx.z); cur[5] = bf_hi(wx.z); cur[6] = bf_lo(wx.w); cur[7] = bf_hi(wx.w); }
#pragma unroll
                for (int i = 0; i < 8; ++i) s[i] = cur[i];
                for (int j = 1; j < win; ++j) {
                    const u32x4 wx = *(const LAS u32x4*)(up - j * 272); const float m = (j <= t) ? 1.0f : 0.0f;
                    s[0] += m * bf_lo(wx.x); s[1] += m * bf_hi(wx.x); s[2] += m * bf_lo(wx.y); s[3] += m * bf_hi(wx.y); s[4] += m * bf_lo(wx.z); s[5] += m * bf_hi(wx.z); s[6] += m * bf_lo(wx.w); s[7] += m * bf_hi(wx.w); }
                u32x4 af; af.x = pk2(s[0] * rc - cur[0], s[1] * rc - cur[1]); af.y = pk2(s[2] * rc - cur[2], s[3] * rc - cur[3]); af.z = pk2(s[4] * rc - cur[4], s[5] * rc - cur[5]); af.w = pk2(s[6] * rc - cur[6], s[7] * rc - cur[7]);
                const bf16x8 a = __builtin_bit_cast(bf16x8, af);
#pragma unroll
                for (int nn = 0; nn < 4; ++nn)
#pragma unroll
                    for (int n = 0; n < 2; ++n) {
                        const bf16x8 bfr = *(const LAS bf16x8*)(wbuf + (32 * nn + 16 * n + fr) * 272 + kk * 64 + fq * 16);
                        acc[nn][n] = __builtin_amdgcn_mfma_f32_16x16x32_bf16(bfr, a, acc[nn][n], 0, 0, 0); }
            }
#pragma unroll
            for (int nn = 0; nn < 4; ++nn) { u32x4 w; w.x = pk2(acc[nn][0][0], acc[nn][0][1]); w.y = pk2(acc[nn][0][2], acc[nn][0][3]); w.z = pk2(acc[nn][1][0], acc[nn][1][1]); w.w = pk2(acc[nn][1][2], acc[nn][1][3]);
                *(u32x4*)(C.Y + (size_t)tok * 1024 + g * 128 + 32 * nn + 8 * fq) = w; }
        }
#undef POOL_LOAD
    }
}

__device__ __forceinline__ unsigned fkey(float f) { const unsigned u = __float_as_uint(f); return u ^ ((unsigned)((int)u >> 31) | 0x80000000u); }

__device__ __forceinline__ void phase_attn_simple(const Ctx& C, LAS unsigned char* lds) {
    const int tid = threadIdx.x, lane = tid & 63, wid = tid >> 6;
    LAS unsigned* sc = (LAS unsigned*)lds;
    LAS float* qif = (LAS float*)(lds + 32768);
    LAS float* qf = (LAS float*)(lds + 32768 + 1024);
    LAS unsigned* hist = (LAS unsigned*)(lds + 32768 + 1024 + 2048);
    LAS unsigned* wsum = hist + 256;
    LAS unsigned* ctl = wsum + 16;
    LAS unsigned short* sel = (LAS unsigned short*)(ctl + 8);
    LAS float* pr = (LAS float*)(sel + 256);
    LAS float* red = pr + 2048;
    LAS float* red2 = red + 64;
    for (int qx = C.bid; qx < NTOK; qx += C.G) {
        const int tok = qx, b = tok >> 13, t = tok & (SEQ - 1), n = t + 1;
        const bf16_t* prow = C.P + (size_t)tok * NAB;
        const bf16_t* pb = C.P + (size_t)(b << 13) * NAB;
        __syncthreads();
        if (tid < 256) qif[tid] = bf2f(prow[PC_QI + tid]);
        qf[tid] = bf2f(prow[PC_Q + tid]);
        if (tid == 0) { ctl[0] = 0u; ctl[1] = TOPK; ctl[2] = 0u; }
        float wi[4];
#pragma unroll
        for (int h = 0; h < 4; ++h) wi[h] = bf2f(prow[PC_WI + h]) * 0.0625f;
        __syncthreads();
        for (int s = tid; s < n; s += 512) {
            asm volatile("" ::: "memory");
            const u32x4* kr = (const u32x4*)(pb + (size_t)s * NAB + PC_KI);
            float d0 = 0.f, d1 = 0.f, d2 = 0.f, d3 = 0.f;
#pragma unroll
            for (int q = 0; q < 8; ++q) { const u32x4 w = kr[q]; const float kv[8] = {bf_lo(w.x), bf_hi(w.x), bf_lo(w.y), bf_hi(w.y), bf_lo(w.z), bf_hi(w.z), bf_lo(w.w), bf_hi(w.w)};
#pragma unroll
                for (int j = 0; j < 8; ++j) { const int d = 8 * q + j; d0 += qif[d] * kv[j]; d1 += qif[64 + d] * kv[j]; d2 += qif[128 + d] * kv[j]; d3 += qif[192 + d] * kv[j]; } }
            float scv = 0.0f;
            scv = fmaf(wi[0], fmaxf(d0, 0.f), scv); scv = fmaf(wi[1], fmaxf(d1, 0.f), scv); scv = fmaf(wi[2], fmaxf(d2, 0.f), scv); scv = fmaf(wi[3], fmaxf(d3, 0.f), scv);
            sc[s] = fkey(scv);
        }
        __syncthreads();
        int nsel;
        if (n <= TOPK) { if (tid < n) sel[tid] = (unsigned short)tid; nsel = n; }
        else {
            nsel = TOPK;
            for (int pass = 0; pass < 4; ++pass) {
                const int shift = 24 - 8 * pass;
                if (tid < 256) hist[tid] = 0u;
                __syncthreads();
                const unsigned prefix = ctl[0]; const unsigned himask = (pass == 0) ? 0u : (0xffffffffu << (shift + 8));
                for (int s = tid; s < n; s += 512) { const unsigned k = sc[s]; if ((k & himask) == prefix) __hip_atomic_fetch_add(&hist[(k >> shift) & 255u], 1u, __ATOMIC_RELAXED, __HIP_MEMORY_SCOPE_WORKGROUP); }
                __syncthreads();
                if (wid == 0) {
                    const unsigned need = ctl[1];
                    const unsigned c0 = hist[255 - 4 * lane], c1 = hist[254 - 4 * lane], c2 = hist[253 - 4 * lane], c3 = hist[252 - 4 * lane];
                    const unsigned tot = c0 + c1 + c2 + c3; unsigned incl = tot;
#pragma unroll
                    for (int o = 1; o < 64; o <<= 1) { const unsigned v = __shfl_up(incl, o); if (lane >= o) incl += v; }
                    const unsigned excl = incl - tot;
                    if (excl < need && need <= incl) {
                        const unsigned r = need - excl; unsigned bin, above;
                        if (r <= c0) { bin = 255 - 4 * lane; above = excl; }
                        else if (r <= c0 + c1) { bin = 254 - 4 * lane; above = excl + c0; }
                        else if (r <= c0 + c1 + c2) { bin = 253 - 4 * lane; above = excl + c0 + c1; }
                        else { bin = 252 - 4 * lane; above = excl + c0 + c1 + c2; }
                        ctl[0] = prefix | (bin << shift); ctl[1] = need - above;
                    }
                }
                __syncthreads();
            }
            const unsigned T = ctl[0], mneed = ctl[1];
            unsigned ceq = 0;
#pragma unroll
            for (int j = 0; j < 16; ++j) { const int s = tid * 16 + j; if (s < n && sc[s] == T) ++ceq; }
            unsigned incl = ceq;
#pragma unroll
            for (int o = 1; o < 64; o <<= 1) { const unsigned v = __shfl_up(incl, o); if (lane >= o) incl += v; }
            if (lane == 63) wsum[wid] = incl;
            __syncthreads();
            unsigned base = 0;
            for (int w = 0; w < wid; ++w) base += wsum[w];
            unsigned rank = base + incl - ceq;
            for (int j = 0; j < 16; ++j) { const int s = tid * 16 + j;
                if (s < n) { const unsigned k = sc[s]; bool take = k > T; if (k == T) { take = rank < mneed; ++rank; }
                    if (take) { const unsigned slot = __hip_atomic_fetch_add(&ctl[2], 1u, __ATOMIC_RELAXED, __HIP_MEMORY_SCOPE_WORKGROUP); if (slot < TOPK) sel[slot] = (unsigned short)s; } } }
        }
        __syncthreads();
        {
            const int j = tid & 255, hh = tid >> 8;
            float sv[4] = {-INFINITY, -INFINITY, -INFINITY, -INFINITY};
            if (j < nsel) {
                const u32x4* kr = (const u32x4*)(pb + (size_t)sel[j] * NAB + PC_K + 64 * hh);
                float d[4] = {0.f, 0.f, 0.f, 0.f};
#pragma unroll
                for (int q = 0; q < 8; ++q) { const u32x4 w = kr[q]; const float kv[8] = {bf_lo(w.x), bf_hi(w.x), bf_lo(w.y), bf_hi(w.y), bf_lo(w.z), bf_hi(w.z), bf_lo(w.w), bf_hi(w.w)};
#pragma unroll
                    for (int e = 0; e < 8; ++e)
#pragma unroll
                        for (int r = 0; r < 4; ++r) d[r] += qf[(4 * hh + r) * 64 + 8 * q + e] * kv[e]; }
#pragma unroll
                for (int r = 0; r < 4; ++r) sv[r] = d[r] * 0.125f;
            }
#pragma unroll
            for (int r = 0; r < 4; ++r) { float m = sv[r];
#pragma unroll
                for (int o = 1; o < 64; o <<= 1) m = fmaxf(m, __shfl_xor(m, o));
                if (lane == 0) red[(4 * hh + r) * 8 + (wid & 3)] = m; }
            __syncthreads();
            float ev[4];
#pragma unroll
            for (int r = 0; r < 4; ++r) { const int h = 4 * hh + r; const float m = fmaxf(fmaxf(red[h * 8], red[h * 8 + 1]), fmaxf(red[h * 8 + 2], red[h * 8 + 3]));
                ev[r] = (j < nsel) ? __expf(sv[r] - m) : 0.f; float sm = ev[r];
#pragma unroll
                for (int o = 1; o < 64; o <<= 1) sm += __shfl_xor(sm, o);
                if (lane == 0) red2[h * 8 + (wid & 3)] = sm; }
            __syncthreads();
#pragma unroll
            for (int r = 0; r < 4; ++r) { const int h = 4 * hh + r; const float sm = (red2[h * 8] + red2[h * 8 + 1]) + (red2[h * 8 + 2] + red2[h * 8 + 3]);
                pr[h * 256 + j] = ev[r] / sm; }
        }
        __syncthreads();
        {
            const int h = tid >> 6, g = h >> 2; float o = 0.f;
            const bf16_t* vb = pb + PC_V + 64 * g + lane;
            for (int j = 0; j < nsel; ++j) o += pr[h * 256 + j] * bf2f(vb[(size_t)sel[j] * NAB]);
            C.Y[(size_t)tok * 1024 + 512 + tid] = (bf16_t)(pk2(o, 0.f) & 0xffffu);
        }
    }
}

__device__ __forceinline__ void phase_hgrn_simple(const Ctx& C) {
    const int tid = threadIdx.x, lane = tid & 63, wid = tid >> 6;
    for (int unit = C.bid; unit < BATCH * 8 * 8; unit += C.G) {
        const int b = unit >> 6, h = (unit >> 3) & 7, sl = unit & 7;
        const int e = sl * 16 + 2 * wid + (lane >> 5), dg = lane & 31;
        const size_t cq = (size_t)h * 128 + 4 * dg, cv = (size_t)h * 128 + e;
        float S0 = 0.f, S1 = 0.f, S2 = 0.f, S3 = 0.f;
        const size_t tok0 = (size_t)b * SEQ;
        for (int t0 = 0; t0 < SEQ; t0 += 8) {
            u32x2 qv[8], kv[8]; bf16_t vv[8];
#pragma unroll
            for (int u = 0; u < 8; ++u) { const size_t ro = (tok0 + t0 + u) * 1024; qv[u] = *(const u32x2*)(C.L1Q + ro + cq); kv[u] = *(const u32x2*)(C.L1K + ro + cq); vv[u] = C.L1I[ro + cv]; }
#pragma unroll
            for (int u = 0; u < 8; ++u) {
                const float k0 = bf_lo(kv[u].x), k1 = bf_hi(kv[u].x), k2 = bf_lo(kv[u].y), k3 = bf_hi(kv[u].y), v = bf2f(vv[u]);
                S0 = (1.0f - k0) * S0 + k0 * v; S1 = (1.0f - k1) * S1 + k1 * v; S2 = (1.0f - k2) * S2 + k2 * v; S3 = (1.0f - k3) * S3 + k3 * v;
                float o = (bf_lo(qv[u].x) * S0 + bf_hi(qv[u].x) * S1) + (bf_lo(qv[u].y) * S2 + bf_hi(qv[u].y) * S3);
#pragma unroll
                for (int off = 1; off < 32; off <<= 1) o += __shfl_xor(o, off);
                if (dg == 0) C.ORAW[(tok0 + t0 + u) * 1024 + cv] = (bf16_t)(pk2(o, 0.f) & 0xffffu);
            }
        }
    }
}
__device__ __forceinline__ void phase_hgrn_post(const Ctx& C) {
    const int tid = threadIdx.x, lane = tid & 63, wave = tid >> 6;
    const int gw = C.bid * 8 + wave, NGW = C.G * 8;
    for (int tok = gw; tok < NTOK; tok += NGW) {
        const size_t ro = (size_t)tok * 1024 + 16 * lane;
        const u32x4 a0 = *(const u32x4*)(C.ORAW + ro), a1 = *(const u32x4*)(C.ORAW + ro + 8), g0 = *(const u32x4*)(C.L1G + ro), g1 = *(const u32x4*)(C.L1G + ro + 8);
        const unsigned aw[8] = {a0.x, a0.y, a0.z, a0.w, a1.x, a1.y, a1.z, a1.w}, gwd[8] = {g0.x, g0.y, g0.z, g0.w, g1.x, g1.y, g1.z, g1.w};
        float ss = 0.f;
#pragma unroll
        for (int i = 0; i < 8; ++i) { const float x = bf_lo(aw[i]), y = bf_hi(aw[i]); ss += x * x + y * y; }
        ss += __shfl_xor(ss, 1); ss += __shfl_xor(ss, 2); ss += __shfl_xor(ss, 4);
        const float r = 1.0f / sqrtf(ss * (1.0f / 128.0f) + EPS);
        const float* nw = C.hgrn_out_norm + 16 * (lane & 7);
        unsigned ow[8];
#pragma unroll
        for (int i = 0; i < 8; ++i) ow[i] = pk2(bf_lo(aw[i]) * r * nw[2 * i] * bf_lo(gwd[i]), bf_hi(aw[i]) * r * nw[2 * i + 1] * bf_hi(gwd[i]));
        *(u32x4*)(C.Y + ro) = (u32x4){ow[0], ow[1], ow[2], ow[3]}; *(u32x4*)(C.Y + ro + 8) = (u32x4){ow[4], ow[5], ow[6], ow[7]};
    }
}
__device__ __forceinline__ void phase_final_norm(const Ctx& C) {
    const bool grp = C.G == 256;
    const int gt = grp ? (C.bid >> 3) * 512 + (int)threadIdx.x : C.bid * 512 + (int)threadIdx.x, NGT = grp ? 32 * 512 : C.G * 512, NEL = grp ? 4096 * 128 : NTOK * 128, rbase = grp ? 4096 * (C.bid & 7) : 0;
    for (int i = gt; i < NEL; i += NGT) { const int row = rbase + (i >> 7), c8 = (i & 127) * 8;
        const float r = pg8::row_rinv(C.part, row);
        const u32x4 b = *(const u32x4*)(C.XB + (size_t)row * 1024 + c8); const f32x4 g0 = *(const f32x4*)(C.ln_final + c8), g1 = *(const f32x4*)(C.ln_final + c8 + 4);
        f32x4 o0, o1; o0[0] = bf_lo(b.x) * r * g0[0]; o0[1] = bf_hi(b.x) * r * g0[1]; o0[2] = bf_lo(b.y) * r * g0[2]; o0[3] = bf_hi(b.y) * r * g0[3];
        o1[0] = bf_lo(b.z) * r * g1[0]; o1[1] = bf_hi(b.z) * r * g1[1]; o1[2] = bf_lo(b.w) * r * g1[2]; o1[3] = bf_hi(b.w) * r * g1[3];
        *(f32x4*)(C.out + (size_t)row * 1024 + c8) = o0; *(f32x4*)(C.out + (size_t)row * 1024 + c8 + 4) = o1; }
}

typedef float f32x16 __attribute__((ext_vector_type(16)));
typedef float f32x2 __attribute__((ext_vector_type(2)));
constexpr int AQ = 32;
constexpr int A_SEL = 131072;
constexpr int A_QS = A_SEL + AQ * 256 * 2;
constexpr int VROW = 144;

__device__ __forceinline__ float relu_f(float x) { const int b = __float_as_int(x); return __int_as_float(b > 0 ? b : 0); }
__device__ __forceinline__ void idx_tile16(const bf16x8 k0, const bf16x8 k1, const bf16x8 (&qb)[4][2], const float (&wq)[4], float (&sc)[4]) {
#pragma unroll
    for (int r = 0; r < 4; ++r) sc[r] = 0.0f;
#pragma unroll
    for (int h = 0; h < 4; ++h) { f32x4 a = (f32x4){0.f, 0.f, 0.f, 0.f};
        a = __builtin_amdgcn_mfma_f32_16x16x32_bf16(k0, qb[h][0], a, 0, 0, 0); a = __builtin_amdgcn_mfma_f32_16x16x32_bf16(k1, qb[h][1], a, 0, 0, 0);
#pragma unroll
        for (int r = 0; r < 4; ++r) sc[r] = fmaf(wq[h], relu_f(a[r]), sc[r]); }
}


__device__ __forceinline__ unsigned wave_incl_scan(unsigned v, int lane) {
    v += (unsigned)__builtin_amdgcn_update_dpp(0, (int)v, 0x111, 0xf, 0xf, false);
    v += (unsigned)__builtin_amdgcn_update_dpp(0, (int)v, 0x112, 0xf, 0xf, false);
    v += (unsigned)__builtin_amdgcn_update_dpp(0, (int)v, 0x114, 0xf, 0xf, false);
    v += (unsigned)__builtin_amdgcn_update_dpp(0, (int)v, 0x118, 0xf, 0xf, false);
    const unsigned r0 = (unsigned)__builtin_amdgcn_readlane((int)v, 15), r1 = (unsigned)__builtin_amdgcn_readlane((int)v, 31), r2 = (unsigned)__builtin_amdgcn_readlane((int)v, 47);
    const int row = lane >> 4;
    return v + (row >= 1 ? r0 : 0u) + (row >= 2 ? r1 : 0u) + (row >= 3 ? r2 : 0u);
}

__device__ __forceinline__ void phase_attn(const Ctx& C, LAS unsigned char* lds) {
    const int tid = threadIdx.x, lane0 = tid & 63, wid = __builtin_amdgcn_readfirstlane(tid >> 6);
    LAS unsigned* hist = (LAS unsigned*)lds;
    LAS unsigned short* sel = (LAS unsigned short*)(lds + A_SEL);
    LAS unsigned* tpool = (LAS unsigned*)(lds + 65536); constexpr int TCAP = 16384;
    LAS unsigned* dummy = (LAS unsigned*)(lds + A_QS + 1024) + tid;
    LAS unsigned* bmp = (LAS unsigned*)(lds + 32768);
    LAS int* q_bin = (LAS int*)(lds + A_QS); LAS int* q_need = q_bin + 32; LAS int* q_cnt = q_bin + 64; LAS int* q_off = q_bin + 96; LAS int* q_selc = q_bin + 128; LAS int* q_tiec = q_bin + 160;
    unsigned* pool = (unsigned*)((unsigned char*)C.ctl + (C.bid < 64 ? WS_XB + (size_t)C.bid * MiB : 296 * MiB + (size_t)(C.bid - 64) * MiB));
    const int nbw = C.G >> 2, ntile = SEQ / AQ, jb = C.bid >> 2;
    for (int ui = 0; ui * nbw < ntile; ++ui) {
        const int rank = ui * nbw + ((ui & 1) ? (nbw - 1 - jb) : jb);
        if (jb >= nbw || rank >= ntile) continue;
        const int tile = (ntile - 1) - rank, b = C.bid & 3, t0 = tile * AQ, tok0 = b * SEQ + t0;
        const bf16_t* pb = C.P + (size_t)(b * SEQ) * NAB;
        const unsigned char* kv8b = (const unsigned char*)C.ctl + WS_KV8 + (size_t)(b * SEQ) * 256;
        __syncthreads();
        int ln = lane0; asm volatile("" : "+v"(ln)); const int lane = ln;
        if (t0 < TOPK) {
            int tf = tid; asm volatile("" : "+v"(tf));
            for (int i = tf; i < AQ * 256; i += 512) { const int q = i >> 8, j = i & 255; sel[i] = (unsigned short)((j <= t0 + q) ? j : 0); }
        } else {
            for (int i = tid; i < AQ * 1024 / 4; i += 512) ((LAS u32x4*)hist)[i] = (u32x4){0u, 0u, 0u, 0u};
            const int qc = ln & 15, fq = ln >> 4;
            bf16x8 qb[2][4][2]; float wq[2][4];
#pragma unroll
            for (int hf = 0; hf < 2; ++hf) { const bf16_t* qrow = C.P + (size_t)(tok0 + 16 * hf + qc) * NAB;
#pragma unroll
              for (int h = 0; h < 4; ++h) { wq[hf][h] = bf2f(qrow[PC_WI + h]) * 0.0625f;
#pragma unroll
                  for (int ks = 0; ks < 2; ++ks) qb[hf][h][ks] = *(const bf16x8*)(qrow + PC_QI + h * 64 + ks * 32 + 8 * fq); } }
            const int kdiag0 = 2 * tile;
            const bf16_t* kbase = pb + (size_t)qc * NAB + PC_KI + 8 * fq;
            __syncthreads();
            bf16x8 kr[4][2]; const int kmaxt = kdiag0 + 1;
#define IDX_RING_LOAD(j, ktx) { const int ktc_ = ((ktx) <= kmaxt) ? (ktx) : kmaxt; const bf16_t* kp_ = kbase + (size_t)(ktc_ * 16) * NAB; kr[j][0] = *(const bf16x8*)kp_; kr[j][1] = *(const bf16x8*)(kp_ + 32); }
#pragma unroll
            for (int j = 0; j < 4; ++j) IDX_RING_LOAD(j, wid + 8 * j)
            for (int kt0 = wid; kt0 <= kmaxt; kt0 += 32) {
#pragma unroll
                for (int j = 0; j < 4; ++j) { const int kt = kt0 + 8 * j;
                    if (kt <= kmaxt) {
#pragma unroll
                        for (int hf = 0; hf < 2; ++hf) if (kt <= kdiag0 + hf) {
                            float sc[4]; idx_tile16(kr[j][0], kr[j][1], qb[hf], wq[hf], sc);
                            const int qn = 16 * hf + qc; LAS unsigned* hrow = hist + qn * 1024;
                            if (kt != kdiag0 + hf) {
#pragma unroll
                                for (int r = 0; r < 4; ++r) { const unsigned bin = fkey(sc[r]) >> 21;
                                    __hip_atomic_fetch_add(&hrow[(bin >> 1) ^ (unsigned)qn], (bin & 1u) ? 65536u : 1u, __ATOMIC_RELAXED, __HIP_MEMORY_SCOPE_WORKGROUP); }
                            } else {
#pragma unroll
                                for (int r = 0; r < 4; ++r) { const unsigned bin = fkey(sc[r]) >> 21;
                                    __hip_atomic_fetch_add(&hrow[(bin >> 1) ^ (unsigned)qn], (4 * fq + r <= qc) ? ((bin & 1u) ? 65536u : 1u) : 0u, __ATOMIC_RELAXED, __HIP_MEMORY_SCOPE_WORKGROUP); } } } }
                    IDX_RING_LOAD(j, kt + 32) }
            }
            __syncthreads();
#if defined(DBG_REPEAT) && DBG_REPEAT == 35
#pragma unroll 1
            for (int i8 = 0; i8 < 8; ++i8) { const int i = i8 & 3; const int q = 4 * wid + i;
#else
#pragma unroll 1
            for (int i = 0; i < 4; ++i) { const int q = 4 * wid + i;
#endif
                unsigned tot = 0;
#pragma unroll
                for (int j = 0; j < 16; ++j) { const unsigned w = hist[q * 1024 + ((1023 - 16 * lane - ((j + lane + (lane >> 4)) & 15)) ^ q)]; tot += (w & 0xffffu) + (w >> 16); }
                const unsigned incl = wave_incl_scan(tot, lane);
                const unsigned excl = incl - tot;
                if (excl < TOPK && TOPK <= incl) {
                    unsigned hw[16];
#pragma unroll
                    for (int j = 0; j < 16; ++j) hw[j] = hist[q * 1024 + ((1023 - 16 * lane - j) ^ q)];
                    unsigned run = excl; int fbin = -1; unsigned fabove = 0, fcnt = 0;
#pragma unroll
                    for (int j = 0; j < 16; ++j) {
                        const unsigned chi = hw[j] >> 16, clo = hw[j] & 0xffffu; const int wbin = 2 * (1023 - 16 * lane - j);
                        if (fbin < 0 && run + chi >= TOPK) { fbin = wbin + 1; fabove = run; fcnt = chi; } run += chi;
                        if (fbin < 0 && run + clo >= TOPK) { fbin = wbin; fabove = run; fcnt = clo; } run += clo; }
                    q_bin[q] = fbin; q_need[q] = TOPK - (int)fabove; q_cnt[q] = (int)fcnt; q_selc[q] = 0; q_tiec[q] = 0;
                } }
            __syncthreads();
            for (int i = tid; i < AQ * 256 / 4; i += 512) ((LAS u32x4*)bmp)[i] = (u32x4){0u, 0u, 0u, 0u};
            if (tid < 32) { int tq = tid; asm volatile("" : "+v"(tq));
                int c = q_cnt[tq], incl = c;
#pragma unroll
                for (int o = 1; o < 32; o <<= 1) { const int v = __shfl_up(incl, o); if (tq >= o) incl += v; }
                q_off[tq] = incl - c; }
            __syncthreads();
            unsigned mybin[2]; int myoff[2];
#pragma unroll
            for (int hf = 0; hf < 2; ++hf) { mybin[hf] = (unsigned)q_bin[16 * hf + qc]; myoff[hf] = q_off[16 * hf + qc]; }
#if defined(DBG_REPEAT) && (DBG_REPEAT == 34 || DBG_REPEAT == 36)
#pragma unroll 1
            for (int rep34 = 0; rep34 < 2; ++rep34) {
            if (rep34 && DBG_REPEAT == 34) { __syncthreads(); if (tid < 32) q_tiec[tid] = 0; __syncthreads(); }
#endif
#pragma unroll
            for (int j = 0; j < 4; ++j) IDX_RING_LOAD(j, wid + 8 * j)
            for (int kt0 = wid; kt0 <= kmaxt; kt0 += 32) {
#pragma unroll
                for (int j = 0; j < 4; ++j) { const int kt = kt0 + 8 * j;
                    if (kt <= kmaxt) {
#pragma unroll
                for (int hf = 0; hf < 2; ++hf) if (kt <= kdiag0 + hf) {
                    float sc[4]; idx_tile16(kr[j][0], kr[j][1], qb[hf], wq[hf], sc);
                    const bool diag = kt == kdiag0 + hf; const int qn = 16 * hf + qc; const int s0 = kt * 16 + 4 * fq;
                    unsigned amask = 0u, ent[4]; int nt = 0; bool ist[4];
#pragma unroll
                    for (int r = 0; r < 4; ++r) { const unsigned key = fkey(sc[r]); const unsigned bin = key >> 21;
                        amask |= (bin > mybin[hf]) ? (1u << r) : 0u; ist[r] = bin == mybin[hf];
                        ent[r] = (((key >> 2) & 0x7ffffu) << 13) | (unsigned)(8191 - (s0 + r)); }
                    if (diag) {
#pragma unroll
                        for (int r = 0; r < 4; ++r) { const bool v = 4 * fq + r <= qc; amask &= v ? ~0u : ~(1u << r); ist[r] = ist[r] && v; } }
#pragma unroll
                    for (int r = 0; r < 4; ++r) nt += ist[r] ? 1 : 0;
                    __hip_atomic_fetch_or(&bmp[qn * 256 + (s0 >> 5)], amask << (s0 & 31), __ATOMIC_RELAXED, __HIP_MEMORY_SCOPE_WORKGROUP);
#if defined(DBG_REPEAT) && DBG_REPEAT == 36
                    int vi = myoff[hf]; if (rep34 == 0) vi += __hip_atomic_fetch_add(&q_tiec[qn], nt, __ATOMIC_RELAXED, __HIP_MEMORY_SCOPE_WORKGROUP);
                    if (rep34) { for (int r = 0; r < 4; ++r) ist[r] = false; nt = 0; }
#else
                    int vi = myoff[hf] + __hip_atomic_fetch_add(&q_tiec[qn], nt, __ATOMIC_RELAXED, __HIP_MEMORY_SCOPE_WORKGROUP);
#endif
                    if (__ballot(nt > 0 && vi + nt > TCAP) == 0ull) {
#pragma unroll
                        for (int r = 0; r < 4; ++r) { LAS unsigned* dst = ist[r] ? (tpool + vi) : dummy; *dst = ent[r]; vi += ist[r] ? 1 : 0; }
                    } else {
#pragma unroll
                        for (int r = 0; r < 4; ++r) if (ist[r]) { if (vi < TCAP) tpool[vi] = ent[r]; else pool[vi] = ent[r]; ++vi; } } }
                    }
                    IDX_RING_LOAD(j, kt + 32) }
            }
#if defined(DBG_REPEAT) && (DBG_REPEAT == 34 || DBG_REPEAT == 36)
            }
#endif
#undef IDX_RING_LOAD
            __syncthreads();
#if defined(DBG_REPEAT) && DBG_REPEAT == 33
#pragma unroll 1
            for (int rep33 = 0; rep33 < 2; ++rep33)
#endif
            {
                int cq[4], offq[4], Rq[4]; unsigned needq[4], thrq[4], actq[4], validq[4]; constexpr int NR = 10; unsigned ev[4][NR]; bool slowq[4];
#pragma unroll
                for (int i = 0; i < 4; ++i) { const int q = 4 * wid + i; cq[i] = q_cnt[q]; offq[i] = q_off[q]; const int m = q_need[q];
                    needq[i] = (unsigned)(m < cq[i] ? m : cq[i]);
                    slowq[i] = cq[i] > 64 * NR; Rq[i] = slowq[i] ? 0 : (cq[i] + 63) >> 6; thrq[i] = 0u; actq[i] = 0u; }
#pragma unroll
                for (int i = 0; i < 4; ++i)
#pragma unroll
                    for (int r = 0; r < NR; ++r) { const int e = lane + 64 * r; const bool in = e < cq[i] && !slowq[i]; const int vi = offq[i] + (e < cq[i] ? e : cq[i] - 1); const unsigned v = (vi < TCAP) ? tpool[vi] : pool[vi]; ev[i][r] = in ? v : 0u; actq[i] |= in ? (1u << r) : 0u; }
#pragma unroll
                for (int i = 0; i < 4; ++i) validq[i] = actq[i];
                const int Rmax = max(max(Rq[0], Rq[1]), max(Rq[2], Rq[3]));
#pragma unroll 1
                for (int p = 3; p >= 0; --p) { const int shift = 8 * p;
#pragma unroll
                    for (int i = 0; i < 4; ++i) *(LAS u32x4*)(lds + (wid * 4 + i) * 1024 + 16 * lane) = (u32x4){0u, 0u, 0u, 0u};
#pragma unroll
                    for (int r = 0; r < NR; ++r) if (r < Rmax) {
#pragma unroll
                        for (int i = 0; i < 4; ++i) { LAS unsigned* wh = (LAS unsigned*)(lds + (wid * 4 + i) * 1024); if ((actq[i] >> r) & 1u) __hip_atomic_fetch_add(&wh[(ev[i][r] >> shift) & 255u], 1u, __ATOMIC_RELAXED, __HIP_MEMORY_SCOPE_WORKGROUP); } }
                    u32x4 hv[4]; unsigned tot[4], incl[4];
#pragma unroll
                    for (int i = 0; i < 4; ++i) { hv[i] = *(const LAS u32x4*)(lds + (wid * 4 + i) * 1024 + 16 * (63 - lane)); tot[i] = (hv[i].x + hv[i].y) + (hv[i].z + hv[i].w); }
#pragma unroll
                    for (int i = 0; i < 4; ++i) incl[i] = wave_incl_scan(tot[i], lane);
#pragma unroll
                    for (int i = 0; i < 4; ++i) { const unsigned excl = incl[i] - tot[i], need = needq[i]; const bool cross = excl < need && need <= incl[i];
                        unsigned dig = 252u - 4u * (unsigned)lane, ab = excl + hv[i].w + hv[i].z + hv[i].y;
                        if (excl + hv[i].w >= need) { dig += 3u; ab = excl; } else if (excl + hv[i].w + hv[i].z >= need) { dig += 2u; ab = excl + hv[i].w; } else if (excl + hv[i].w + hv[i].z + hv[i].y >= need) { dig += 1u; ab = excl + hv[i].w + hv[i].z; }
                        const unsigned long long bm = __ballot(cross);
                        if (bm) { const int src = __ffsll(bm) - 1; dig = (unsigned)__shfl((int)dig, src); ab = (unsigned)__shfl((int)ab, src);
                            thrq[i] |= dig << shift; needq[i] = need - ab;
                            unsigned keep = 0u;
#pragma unroll
                            for (int r = 0; r < NR; ++r) keep |= (((ev[i][r] >> shift) & 255u) == dig) ? (1u << r) : 0u;
                            actq[i] &= keep; } }
                }
#pragma unroll
                for (int i = 0; i < 4; ++i) { LAS unsigned* bq = bmp + (4 * wid + i) * 256;
#pragma unroll
                    for (int r = 0; r < NR; ++r) if (r < Rmax) { if (((validq[i] >> r) & 1u) && ev[i][r] >= thrq[i]) { const unsigned ix = 8191u - (ev[i][r] & 8191u); __hip_atomic_fetch_or(&bq[ix >> 5], 1u << (ix & 31u), __ATOMIC_RELAXED, __HIP_MEMORY_SCOPE_WORKGROUP); } } }
#pragma unroll 1
                for (int i = 0; i < 4; ++i) if (slowq[i]) { const int c = cq[i], off = offq[i]; LAS unsigned* bq = bmp + (4 * wid + i) * 256;
                    unsigned need = needq[i], thr = 0u;
#pragma unroll 1
                    for (int bit = 31; bit >= 0; --bit) { unsigned cnt1 = 0; const unsigned hm = (bit == 31) ? 0u : (0xffffffffu << (bit + 1));
                        for (int e = lane; e < c; e += 64) { const int vi = off + e; const unsigned v = (vi < TCAP) ? tpool[vi] : pool[vi]; if ((v & hm) == thr && ((v >> bit) & 1u)) ++cnt1; }
#pragma unroll
                        for (int o = 1; o < 64; o <<= 1) cnt1 += __shfl_xor(cnt1, o);
                        if (cnt1 >= need) thr |= 1u << bit; else need -= cnt1; }
                    for (int e = lane; e < c; e += 64) { const int vi = off + e; const unsigned v = (vi < TCAP) ? tpool[vi] : pool[vi]; if (v >= thr) { const unsigned ix = 8191u - (v & 8191u); __hip_atomic_fetch_or(&bq[ix >> 5], 1u << (ix & 31u), __ATOMIC_RELAXED, __HIP_MEMORY_SCOPE_WORKGROUP); } } }
                u32x4 bw[4]; unsigned cntb[4], inb[4];
#pragma unroll
                for (int i = 0; i < 4; ++i) { bw[i] = *(const LAS u32x4*)(bmp + (4 * wid + i) * 256 + 4 * lane); cntb[i] = (unsigned)((__popc(bw[i].x) + __popc(bw[i].y)) + (__popc(bw[i].z) + __popc(bw[i].w))); }
#pragma unroll
                for (int i = 0; i < 4; ++i) inb[i] = wave_incl_scan(cntb[i], lane);
#pragma unroll
                for (int i = 0; i < 4; ++i) { LAS unsigned short* sq = sel + (4 * wid + i) * 256; int pos = (int)(inb[i] - cntb[i]); const unsigned w4[4] = {bw[i].x, bw[i].y, bw[i].z, bw[i].w};
#pragma unroll
                    for (int wi = 0; wi < 4; ++wi) { unsigned w = w4[wi]; while (w) { const int bp = __ffs((int)w) - 1; if (pos < 256) sq[pos] = (unsigned short)((4 * lane + wi) * 32 + bp); ++pos; w &= w - 1u; } } }
            }
        }
        __syncthreads();
#ifndef A_EXP2
        LAS unsigned char* pbuf = lds + wid * 16384;
        LAS unsigned char* vbuf = pbuf + 4096;
        int ln2 = lane0; asm volatile("" : "+v"(ln2));
        const int hh = ln2 & 15, fq = ln2 >> 4;
        typedef int i32x2 __attribute__((ext_vector_type(2)));
        const unsigned char* kgb = kv8b + (ln2 & 7) * 16;
        LAS unsigned char* kstw = vbuf + (ln2 >> 3) * 144 + (ln2 & 7) * 16; const LAS unsigned char* kstr = vbuf + hh * 144 + 8 * fq;
        const unsigned char* vgb = kv8b + 128 + (ln2 & 3) * 16;
#define ATT_LOADK(kk, sqx, b4) { _Pragma("unroll") for (int i8 = 0; i8 < 8; ++i8) { const int kidx = (sqx)[64 * (b4) + 8 * i8 + (ln2 >> 3)]; kk[i8] = *(const u32x4*)(kgb + (size_t)kidx * 256); } }
#define ATT_MMAK(kk, b4) { _Pragma("unroll") for (int i8 = 0; i8 < 8; ++i8) *(LAS u32x4*)(kstw + i8 * (8 * 144)) = kk[i8]; \
    _Pragma("unroll") for (int j4 = 0; j4 < 4; ++j4) { f32x4 a = (f32x4){0.f, 0.f, 0.f, 0.f}; _Pragma("unroll") for (int k4 = 0; k4 < 4; ++k4) a = __builtin_amdgcn_mfma_f32_16x16x32_fp8_fp8(*(const LAS long*)(kstr + j4 * (16 * 144) + 32 * k4), qf[k4], a, 0, 0, 0); S[4 * (b4) + j4] = a; } }
#define ATT_LOADV(slot, sqx, chx) { _Pragma("unroll") for (int p2 = 0; p2 < 2; ++p2) { const unsigned char* vp = vgb + (size_t)(sqx)[32 * (chx) + (ln2 >> 2) + 16 * p2] * 256; vr[slot][0][p2] = *(const u32x4*)vp; vr[slot][1][p2] = *(const u32x4*)(vp + 64); } }
#define ATT_LOADQ(tokx) { _Pragma("unroll") for (int kk = 0; kk < 4; ++kk) { u32x4 w = (u32x4){0u, 0u, 0u, 0u}; if (hh < 8 && (hh >> 2) == (kk >> 1)) w = *(const u32x4*)(C.P + (size_t)(tokx) * NAB + PC_Q + hh * 64 + (kk & 1) * 32 + 8 * fq); qraw[kk] = w; } }
#if defined(DBG_REPEAT) && DBG_REPEAT == 31
#pragma unroll 1
        for (int rep31 = 0; rep31 < 2; ++rep31)
#endif
        {
        u32x4 kA[8], kB[8]; u32x4 qraw[4]; u32x4 vr[3][2][2];
        { const LAS unsigned short* sq0 = sel + (4 * wid) * 256; ATT_LOADQ(tok0 + 4 * wid) ATT_LOADK(kA, sq0, 0) ATT_LOADK(kB, sq0, 1) }
#pragma unroll 1
        for (int iq = 0; iq < 4; ++iq) {
            const int q = 4 * wid + iq, tok = tok0 + q, t = t0 + q, nsel = (t + 1 < TOPK) ? t + 1 : TOPK;
            const LAS unsigned short* sq = sel + q * 256;
            {
                long qf[4];
#pragma unroll
                for (int kk = 0; kk < 4; ++kk) { const u32x2 f8 = bf8_to_fp8(qraw[kk]); qf[kk] = (long)(((unsigned long long)f8.y << 32) | f8.x); }
                f32x4 S[16];
                ATT_MMAK(kA, 0) ATT_LOADK(kA, sq, 2)
                ATT_MMAK(kB, 1) ATT_LOADK(kB, sq, 3)
                ATT_MMAK(kA, 2) ATT_MMAK(kB, 3)
                ATT_LOADV(0, sq, 0) ATT_LOADV(1, sq, 1) ATT_LOADV(2, sq, 2)
                float mx = -INFINITY;
                if (nsel < TOPK) {
                    const int nrel = nsel - 4 * fq;
#pragma unroll
                    for (int tl = 0; tl < 16; ++tl)
#pragma unroll
                        for (int r = 0; r < 4; ++r) S[tl][r] = ((16 * tl + r) < nrel) ? S[tl][r] : -INFINITY; }
#pragma unroll
                for (int tl = 0; tl < 16; ++tl)
#pragma unroll
                    for (int r = 0; r < 4; ++r) mx = fmaxf(mx, S[tl][r]);
                mx = fmaxf(mx, __shfl_xor(mx, 16)); mx = fmaxf(mx, __shfl_xor(mx, 32));
                const float cexp = 0.125f * 1.44269504088896f, moff = -mx * cexp;
                float sm = 0.f;
#pragma unroll
                for (int tl = 0; tl < 16; ++tl)
#pragma unroll
                    for (int r = 0; r < 4; ++r) { const float e = __builtin_amdgcn_exp2f(fmaf(S[tl][r], cexp, moff)); S[tl][r] = e; sm += e; }
                sm += __shfl_xor(sm, 16); sm += __shfl_xor(sm, 32);
                const float inv = 1.0f / sm;
#pragma unroll
                for (int ch = 0; ch < 8; ++ch) { u32x2 w; w.x = pk4_fp8(S[2 * ch][0] * inv, S[2 * ch][1] * inv, S[2 * ch][2] * inv, S[2 * ch][3] * inv);
                    w.y = pk4_fp8(S[2 * ch + 1][0] * inv, S[2 * ch + 1][1] * inv, S[2 * ch + 1][2] * inv, S[2 * ch + 1][3] * inv); *(LAS u32x2*)(pbuf + ch * 512 + lane * 8) = w; }
            }
            if (iq < 3) { const LAS unsigned short* sqn = sq + 256; ATT_LOADK(kA, sqn, 0) ATT_LOADK(kB, sqn, 1) }
            f32x4 O[2][4];
#pragma unroll
            for (int g = 0; g < 2; ++g)
#pragma unroll
                for (int dt = 0; dt < 4; ++dt) O[g][dt] = (f32x4){0.f, 0.f, 0.f, 0.f};
            const int tq8 = hh >> 1, tp8 = hh & 1;
            const LAS unsigned char* vtr = vbuf + ((tq8 < 4) ? (4 * fq + tq8) : (16 + 4 * fq + tq8 - 4)) * 80 + tp8 * 8;
#pragma unroll
            for (int ch = 0; ch < 8; ++ch) {
                const long pf = *(const LAS long*)(pbuf + ch * 512 + lane * 8);
#pragma unroll
                for (int g = 0; g < 2; ++g) {
#pragma unroll
                    for (int p2 = 0; p2 < 2; ++p2) *(LAS u32x4*)(vbuf + ((ln2 >> 2) + 16 * p2) * 80 + (ln2 & 3) * 16) = vr[ch % 3][g][p2];
#pragma unroll
                    for (int dt = 0; dt < 4; ++dt) {
                        const i32x2 t8 = __builtin_amdgcn_ds_read_tr8_b64_v2i32((LAS i32x2*)(vtr + dt * 16));
                        const long vb = (long)(((unsigned long long)(unsigned)t8[1] << 32) | (unsigned)t8[0]);
                        O[g][dt] = __builtin_amdgcn_mfma_f32_16x16x32_fp8_fp8(pf, vb, O[g][dt], 0, 0, 0); }
                }
                if (ch + 3 < 8) ATT_LOADV(ch % 3, sq, ch + 3)
                if (ch == 5 && iq < 3) ATT_LOADQ(tok + 1)
            }
            if (fq < 2) {
#pragma unroll
                for (int dt = 0; dt < 4; ++dt)
#pragma unroll
                    for (int r = 0; r < 4; ++r) { const float ov = (fq == 0) ? O[0][dt][r] : O[1][dt][r];
                        *(LAS bf16_t*)(pbuf + ((4 * fq + r) * 64 + dt * 16 + hh) * 2) = (bf16_t)(pk2(ov, 0.f) & 0xffffu); }
            }
            asm volatile("" ::: "memory");
            { const u32x4 ow = *(const LAS u32x4*)(pbuf + ln2 * 16); *(u32x4*)(C.Y + (size_t)tok * 1024 + 512 + ln2 * 8) = ow; }
        }
        }
#undef ATT_LOADK
#undef ATT_MMAK
#undef ATT_LOADV
#undef ATT_LOADQ
#endif
    }
}


constexpr int H_QE = 0, H_KD = 17408, H_KET = 34816, H_VT = 53248, H_AL = 71680, H_ST = 80896, H_QTOT = 115712, H_BL = 117760, H_SSQ = 118272;
constexpr int PQ = 272, PT = 144;
constexpr size_t WS_HU = 440 * MiB, WS_HLB = 460 * MiB;

__device__ __forceinline__ bf16x8 ldsfrag(const LAS unsigned char* p) { return *(const LAS bf16x8*)p; }

constexpr int H_VRAW = 118784;
__device__ __forceinline__ int hgrn_item_of(int c, int G) {
    if (G != 256) return c;
    const int x = c & 7, j = c >> 3; const int b = x >> 1, seg = 4 * (x & 1) + (j >> 3), h = j & 7;
    return (b << 6) | (h << 3) | seg;
}
template <bool WITH_Q>
__device__ __forceinline__ void hgrn_load(const Ctx& C, size_t tokc, int h, int tid, u32x4 (&kr)[2], u32x4 (&vr)[2], u32x4 (&qr)[2]) {
#pragma unroll
    for (int j = 0; j < 2; ++j) { const int p = tid + 512 * j; const size_t off = (tokc + (size_t)(p >> 4)) * 1024 + (size_t)h * 128 + (p & 15) * 8;
        kr[j] = *(const u32x4*)(C.L1K + off); vr[j] = *(const u32x4*)(C.L1I + off); if (WITH_Q) qr[j] = *(const u32x4*)(C.L1Q + off); }
}
template <bool WITH_Q>
__device__ __forceinline__ float hgrn_stage(LAS unsigned char* lds, int tid, const u32x4 (&kr)[2], const u32x4 (&vr)[2], const u32x4 (&qr)[2]) {
    const int d = tid & 127, tq = tid >> 7;
#pragma unroll
    for (int j = 0; j < 2; ++j) { const int p = tid + 512 * j; const int ro = (p >> 4) * PQ + (p & 15) * 16;
        *(LAS u32x4*)(lds + H_KD + ro) = kr[j]; *(LAS u32x4*)(lds + H_VRAW + ro) = vr[j]; if (WITH_Q) *(LAS u32x4*)(lds + H_QE + ro) = qr[j]; }
    __syncthreads();
    float kf[16], vf[16], c[16];
#pragma unroll
    for (int i = 0; i < 16; ++i) { kf[i] = bf2f(*(const LAS bf16_t*)(lds + H_KD + (tq * 16 + i) * PQ + d * 2)); vf[i] = bf2f(*(const LAS bf16_t*)(lds + H_VRAW + (tq * 16 + i) * PQ + d * 2)); }
    float run = 0.f;
#pragma unroll
    for (int i = 0; i < 16; ++i) { run += __logf(1.0f - kf[i]); c[i] = run; }
    LAS float* qtot = (LAS float*)(lds + H_QTOT);
    qtot[tq * 128 + d] = run;
    { u32x4 w0, w1; w0.x = pk2(vf[0], vf[1]); w0.y = pk2(vf[2], vf[3]); w0.z = pk2(vf[4], vf[5]); w0.w = pk2(vf[6], vf[7]); w1.x = pk2(vf[8], vf[9]); w1.y = pk2(vf[10], vf[11]); w1.z = pk2(vf[12], vf[13]); w1.w = pk2(vf[14], vf[15]);
      *(LAS u32x4*)(lds + H_VT + d * PT + tq * 32) = w0; *(LAS u32x4*)(lds + H_VT + d * PT + tq * 32 + 16) = w1; }
    __syncthreads();
    float pre = 0.f, tot = 0.f;
#pragma unroll
    for (int q4 = 0; q4 < 4; ++q4) { const float x = qtot[q4 * 128 + d]; if (q4 < tq) pre += x; tot += x; }
    if (tq == 0) ((LAS float*)(lds + H_BL))[d] = tot;
    { float ke[16];
#pragma unroll
      for (int i = 0; i < 16; ++i) ke[i] = kf[i] * __expf(tot - (pre + c[i]));
      u32x4 w0, w1; w0.x = pk2(ke[0], ke[1]); w0.y = pk2(ke[2], ke[3]); w0.z = pk2(ke[4], ke[5]); w0.w = pk2(ke[6], ke[7]); w1.x = pk2(ke[8], ke[9]); w1.y = pk2(ke[10], ke[11]); w1.z = pk2(ke[12], ke[13]); w1.w = pk2(ke[14], ke[15]);
      *(LAS u32x4*)(lds + H_KET + d * PT + tq * 32) = w0; *(LAS u32x4*)(lds + H_KET + d * PT + tq * 32 + 16) = w1; }
    if (WITH_Q) {
#pragma unroll
        for (int i = 0; i < 16; ++i) { const float b = pre + c[i]; const float qv = bf2f(*(const LAS bf16_t*)(lds + H_QE + (tq * 16 + i) * PQ + d * 2));
            *(LAS bf16_t*)(lds + H_QE + (tq * 16 + i) * PQ + d * 2) = (bf16_t)(pk2(qv * __expf(b), 0.f) & 0xffffu);
            *(LAS bf16_t*)(lds + H_KD + (tq * 16 + i) * PQ + d * 2) = (bf16_t)(pk2(kf[i] * __expf(-b), 0.f) & 0xffffu); }
    }
    return tot;
}
__device__ __forceinline__ void hgrn_state_update(LAS unsigned char* lds, f32x4 (&S)[8], int wid, int l15, int fq) {
    const LAS float* bl = (const LAS float*)(lds + H_BL);
    float dec[4];
#pragma unroll
    for (int r = 0; r < 4; ++r) dec[r] = __expf(bl[16 * wid + 4 * fq + r]);
    const bf16x8 ka0 = ldsfrag(lds + H_KET + (16 * wid + l15) * PT + 16 * fq), ka1 = ldsfrag(lds + H_KET + (16 * wid + l15) * PT + 64 + 16 * fq);
#pragma unroll
    for (int et = 0; et < 8; ++et) {
#pragma unroll
        for (int r = 0; r < 4; ++r) S[et][r] *= dec[r];
        S[et] = __builtin_amdgcn_mfma_f32_16x16x32_bf16(ka0, ldsfrag(lds + H_VT + (et * 16 + l15) * PT + 16 * fq), S[et], 0, 0, 0);
        S[et] = __builtin_amdgcn_mfma_f32_16x16x32_bf16(ka1, ldsfrag(lds + H_VT + (et * 16 + l15) * PT + 64 + 16 * fq), S[et], 0, 0, 0); }
}

__device__ __forceinline__ void phase_hgrn_local(const Ctx& C, LAS unsigned char* lds) {
    const int tid = threadIdx.x, lane = tid & 63, wid = __builtin_amdgcn_readfirstlane(tid >> 6), l15 = lane & 15, fq = lane >> 4;
    float* Ug = (float*)((unsigned char*)C.ctl + WS_HU); float* LBg = (float*)((unsigned char*)C.ctl + WS_HLB);
    for (int it0 = C.bid; it0 < 256; it0 += C.G) {
        const int item = hgrn_item_of(it0, C.G); const int seg = item & 7, h = (item >> 3) & 7, b = item >> 6;
        if (seg == 7) continue;
        f32x4 S[8];
#pragma unroll
        for (int et = 0; et < 8; ++et) S[et] = (f32x4){0.f, 0.f, 0.f, 0.f};
        float lbacc = 0.f;
        u32x4 kr[2], vr[2], qr[2];
        hgrn_load<false>(C, (size_t)b * SEQ + (size_t)seg * 1024, h, tid, kr, vr, qr);
#pragma unroll 1
        for (int ch = 0; ch < 16; ++ch) {
            const size_t tokc = (size_t)b * SEQ + (size_t)seg * 1024 + (size_t)ch * 64;
            __syncthreads();
            lbacc += hgrn_stage<false>(lds, tid, kr, vr, qr);
            if (ch < 15) hgrn_load<false>(C, tokc + 64, h, tid, kr, vr, qr);
            __syncthreads();
            hgrn_state_update(lds, S, wid, l15, fq);
        }
#pragma unroll
        for (int et = 0; et < 8; ++et) *(f32x4*)(Ug + ((size_t)(item * 8 + wid) * 8 + et) * 256 + lane * 4) = S[et];
        if (tid < 128) LBg[item * 128 + tid] = lbacc;
    }
}

__device__ __forceinline__ void phase_hgrn_chunks(const Ctx& C, LAS unsigned char* lds) {
    const int tid = threadIdx.x, lane = tid & 63, wid = __builtin_amdgcn_readfirstlane(tid >> 6), l15 = lane & 15, fq = lane >> 4;
    const float* Ug = (const float*)((unsigned char*)C.ctl + WS_HU); const float* LBg = (const float*)((unsigned char*)C.ctl + WS_HLB);
    LAS float* ssq = (LAS float*)(lds + H_SSQ);
    for (int it0 = C.bid; it0 < 256; it0 += C.G) {
        const int item = hgrn_item_of(it0, C.G); const int seg = item & 7, h = (item >> 3) & 7, b = item >> 6;
        f32x4 S[8];
#pragma unroll
        for (int et = 0; et < 8; ++et) S[et] = (f32x4){0.f, 0.f, 0.f, 0.f};
#pragma unroll 1
        for (int j = 0; j < seg; ++j) { const int it = item - seg + j; float dec[4];
#pragma unroll
            for (int r = 0; r < 4; ++r) dec[r] = __expf(LBg[it * 128 + 16 * wid + 4 * fq + r]);
#pragma unroll
            for (int et = 0; et < 8; ++et) { const f32x4 u = *(const f32x4*)(Ug + ((size_t)(it * 8 + wid) * 8 + et) * 256 + lane * 4);
#pragma unroll
                for (int r = 0; r < 4; ++r) S[et][r] = S[et][r] * dec[r] + u[r]; } }
        __syncthreads();
        u32x4 kr[2], vr[2], qr[2];
        hgrn_load<true>(C, (size_t)b * SEQ + (size_t)seg * 1024, h, tid, kr, vr, qr);
#pragma unroll 1
        for (int ch = 0; ch < 16; ++ch) {
            const size_t tokc = (size_t)b * SEQ + (size_t)seg * 1024 + (size_t)ch * 64;
#pragma unroll
            for (int et = 0; et < 8; ++et) { u32x2 w; w.x = pk2(S[et][0], S[et][1]); w.y = pk2(S[et][2], S[et][3]); *(LAS u32x2*)(lds + H_ST + (et * 16 + l15) * PQ + (16 * wid + 4 * fq) * 2) = w; }
            (void)hgrn_stage<true>(lds, tid, kr, vr, qr);
            if (ch < 15) hgrn_load<true>(C, tokc + 64, h, tid, kr, vr, qr);
            u32x2 gw[4];
            { const size_t ro = (tokc + (wid & 3) * 16 + l15) * 1024 + (size_t)h * 128;
#pragma unroll
              for (int j = 0; j < 4; ++j) gw[j] = *(const u32x2*)(C.L1G + ro + (4 * (wid >> 2) + j) * 16 + 4 * fq); }
            __syncthreads();
            { const int ti = wid >> 1;
#pragma unroll
              for (int u = 0; u < 2; ++u) { const int si = 2 * (wid & 1) + u; u32x2 w = (u32x2){0u, 0u};
                  if (si <= ti) { f32x4 a = (f32x4){0.f, 0.f, 0.f, 0.f};
#pragma unroll
                      for (int kk = 0; kk < 4; ++kk) a = __builtin_amdgcn_mfma_f32_16x16x32_bf16(ldsfrag(lds + H_KD + (si * 16 + l15) * PQ + kk * 64 + 16 * fq), ldsfrag(lds + H_QE + (ti * 16 + l15) * PQ + kk * 64 + 16 * fq), a, 0, 0, 0);
                      if (si == ti) {
#pragma unroll
                          for (int r = 0; r < 4; ++r) if (4 * fq + r > l15) a[r] = 0.f; }
                      w.x = pk2(a[0], a[1]); w.y = pk2(a[2], a[3]); }
                  *(LAS u32x2*)(lds + H_AL + (ti * 16 + l15) * PT + (si * 16 + 4 * fq) * 2) = w; } }
            hgrn_state_update(lds, S, wid, l15, fq);
            __syncthreads();
            const int ti = wid & 3, eh = wid >> 2;
            f32x4 o[4];
            { const bf16x8 ab0 = ldsfrag(lds + H_AL + (ti * 16 + l15) * PT + 16 * fq), ab1 = ldsfrag(lds + H_AL + (ti * 16 + l15) * PT + 64 + 16 * fq);
              bf16x8 qb[4];
#pragma unroll
              for (int kk = 0; kk < 4; ++kk) qb[kk] = ldsfrag(lds + H_QE + (ti * 16 + l15) * PQ + kk * 64 + 16 * fq);
#pragma unroll
              for (int j = 0; j < 4; ++j) { const int et = 4 * eh + j; f32x4 a = (f32x4){0.f, 0.f, 0.f, 0.f};
                  a = __builtin_amdgcn_mfma_f32_16x16x32_bf16(ldsfrag(lds + H_VT + (et * 16 + l15) * PT + 16 * fq), ab0, a, 0, 0, 0);
                  a = __builtin_amdgcn_mfma_f32_16x16x32_bf16(ldsfrag(lds + H_VT + (et * 16 + l15) * PT + 64 + 16 * fq), ab1, a, 0, 0, 0);
#pragma unroll
                  for (int kk = 0; kk < 4; ++kk) a = __builtin_amdgcn_mfma_f32_16x16x32_bf16(ldsfrag(lds + H_ST + (et * 16 + l15) * PQ + kk * 64 + 16 * fq), qb[kk], a, 0, 0, 0);
                  o[j] = a; } }
            float sq = 0.f;
#pragma unroll
            for (int j = 0; j < 4; ++j) sq += (o[j][0] * o[j][0] + o[j][1] * o[j][1]) + (o[j][2] * o[j][2] + o[j][3] * o[j][3]);
            sq += __shfl_xor(sq, 16); sq += __shfl_xor(sq, 32);
            if (fq == 0) ssq[eh * 64 + ti * 16 + l15] = sq;
            __syncthreads();
            { const float tot = ssq[ti * 16 + l15] + ssq[64 + ti * 16 + l15]; const float rinv = 1.0f / sqrtf(tot * (1.0f / 128.0f) + EPS);
              const size_t ro = (tokc + ti * 16 + l15) * 1024 + (size_t)h * 128;
#pragma unroll
              for (int j = 0; j < 4; ++j) { const int e0 = (4 * eh + j) * 16 + 4 * fq; const f32x4 nw = *(const f32x4*)(C.hgrn_out_norm + e0);
                  u32x2 w; w.x = pk2(o[j][0] * rinv * nw[0] * bf_lo(gw[j].x), o[j][1] * rinv * nw[1] * bf_hi(gw[j].x)); w.y = pk2(o[j][2] * rinv * nw[2] * bf_lo(gw[j].y), o[j][3] * rinv * nw[3] * bf_hi(gw[j].y));
                  *(u32x2*)(C.Y + ro + e0) = w; } }
        }
    }
}

constexpr int NPHASES = 14;
struct Args { const void* in[16]; float* out; unsigned char* ws; int ph_lo, ph_hi; };


typedef const __attribute__((address_space(4))) Args* KArgP;
__device__ __forceinline__ void make_ctx(Ctx& C) {
    KArgP ka = (KArgP)__builtin_amdgcn_kernarg_segment_ptr(); asm volatile("" : "+s"(ka));
    C.x = (const float*)ka->in[0]; C.positions = (const int*)ka->in[1]; C.ln_mix = (const float*)ka->in[2]; C.ln_ffn = (const float*)ka->in[3]; C.ln_final = (const float*)ka->in[4];
    C.w_in_ab = (const float*)ka->in[5]; C.w_pool = (const float*)ka->in[6]; C.pool_scale = (const float*)ka->in[7]; C.idx_k_norm = (const float*)ka->in[8]; C.w_out_ab = (const float*)ka->in[9];
    C.w_in_c = (const float*)ka->in[10]; C.hgrn_lb = (const float*)ka->in[11]; C.hgrn_out_norm = (const float*)ka->in[12]; C.w_out_c = (const float*)ka->in[13]; C.w_gate_up = (const float*)ka->in[14]; C.w_down = (const float*)ka->in[15];
    C.out = ka->out;
    unsigned char* ws = ka->ws;
    C.ctl = (unsigned*)(ws + WS_CTL); C.rope = (float*)(ws + WS_ROPE); C.part = (float*)(ws + WS_PART); C.lbv = (float*)(ws + WS_LB);
    C.W_inab = (bf16_t*)(ws + WS_W_INAB); C.W_pool = (bf16_t*)(ws + WS_W_POOL); C.W_outab = (bf16_t*)(ws + WS_W_OUTAB); C.W_inc = (bf16_t*)(ws + WS_W_INC); C.W_outc = (bf16_t*)(ws + WS_W_OUTC);
    C.W_gu0 = (bf16_t*)(ws + WS_W_GU0); C.W_gu1 = (bf16_t*)(ws + WS_W_GU1); C.W_dn0 = (bf16_t*)(ws + WS_W_DN0); C.W_dn1 = (bf16_t*)(ws + WS_W_DN1);
    C.XB = (bf16_t*)(ws + WS_XB); C.Y = (bf16_t*)(ws + WS_Y); C.P = (bf16_t*)(ws + WS_P); C.ACT = (bf16_t*)(ws + WS_ACT);
    C.L1Q = (bf16_t*)(ws + WS_L1Q); C.L1K = (bf16_t*)(ws + WS_L1K); C.L1I = (bf16_t*)(ws + WS_L1I); C.L1G = (bf16_t*)(ws + WS_L1G); C.ORAW = (bf16_t*)(ws + WS_ORAW);
    C.G = gridDim.x; C.bid = blockIdx.x;
}

#if USE_SIMPLE_GEMM
#define RUN_GEMM(EpiT, gg, EE) pg8::gemm_simple<EpiT>(gg, C.G, C.bid, EE)
#else
#define RUN_GEMM(EpiT, gg, EE) do { if (threadIdx.x == 0) *(LAS int*)(lds + 131072 + 1024) = -1; __syncthreads(); pg8::StaticOrder S_; S_.init((gg).M, (gg).N, C.G, C.bid); pg8::gemm_phase<EpiT, pg8::StaticOrder, true, true>(lds, gg, S_, EE); } while (0)
#endif

__device__ __forceinline__ void xcd_barrier_local(const XcdBarrier& b) {
    asm volatile("s_waitcnt vmcnt(0)" ::: "memory");
    __syncthreads();
    if (threadIdx.x == 0) {
        unsigned* bar = b.bar;
        __builtin_amdgcn_s_waitcnt(0);
        const unsigned nloc = b.st[0];
        const unsigned old = xb_add(&bar[XB_XSUB(b.x)], 1u);
        const unsigned gen = old / nloc;
        if (old + 1u == (gen + 1u) * nloc) xb_add(&bar[XB_XGEN(b.x)], 1u);
        else XB_SPIN(xb_ld(&bar[XB_XGEN(b.x)]) == gen, bar);
        __builtin_amdgcn_fence(__ATOMIC_ACQUIRE, "agent");
        asm volatile("s_waitcnt vmcnt(0)" ::: "memory");
    }
    __syncthreads();
}
constexpr int CW_TAB = 8192;

__global__ void __launch_bounds__(512, 2) mega_fwd(Args a) {
    extern __shared__ __attribute__((aligned(16))) unsigned char lds_raw[];
    LAS unsigned char* lds = (LAS unsigned char*)lds_raw;
    unsigned* const ctl0 = (unsigned*)(a.ws + WS_CTL);

    volatile LAS unsigned* MISC = (volatile LAS unsigned*)(lds + LDS_MISC);
    if (threadIdx.x < 64) MISC[threadIdx.x] = 0u;
    __syncthreads();
    XcdBarrier bar; bar.bar = ctl0 + CW_BAR; bar.x = 0; bar.st = nullptr;
    if (N_LAUNCH_MODE == 1) bar = xcd_barrier_post(ctl0 + CW_BAR, MISC + 8);
    if (N_LAUNCH_MODE == 1 && threadIdx.x == 0) __hip_atomic_store(&ctl0[CW_TAB + blockIdx.x], xb_xcc_id() + 1u, __ATOMIC_RELAXED, __HIP_MEMORY_SCOPE_AGENT);

    const int lo = a.ph_lo, hi = a.ph_hi;
#ifndef ONLY_PHASE
#define ONLY_PHASE -1
#endif
#define IN(k) (lo <= (k) && (k) < hi && (ONLY_PHASE < 0 || ONLY_PHASE == (k)))
#if defined(DBG_REPEAT) && DBG_REPEAT == 90
#define SEAM(k) do { if (N_LAUNCH_MODE == 1 && IN((k) + 1)) { xcd_barrier(bar); if ((k) == 5) for (int rr_ = 0; rr_ < 20; ++rr_) xcd_barrier(bar); } } while (0)
#else
#define SEAM(k) do { if (N_LAUNCH_MODE == 1 && IN((k) + 1)) xcd_barrier(bar); } while (0)
#endif

#if USE_SIMPLE_GEMM || USE_SIMPLE_ATTN || USE_SIMPLE_HGRN
#define SEAM_L(k) SEAM(k)
#else
#define SEAM_L(k) do { if (N_LAUNCH_MODE == 1 && IN((k) + 1)) { if (MISC[10]) xcd_barrier_local(bar); else xcd_barrier(bar); } } while (0)
#endif
    if (IN(0)) { Ctx C; make_ctx(C); phase_prologue(C, lds); __syncthreads();
#if defined(DBG_REPEAT) && DBG_REPEAT == 0
        phase_prologue(C, lds); __syncthreads();
#endif
        SEAM(0);
        if (N_LAUNCH_MODE == 1 && lo == 0) {
            if (threadIdx.x < 64) { bool ok = (gridDim.x == 256u);
                for (unsigned t = threadIdx.x; t < gridDim.x && t < 256u; t += 64u) { const unsigned v = xb_ld(&ctl0[CW_TAB + t]), r = xb_ld(&ctl0[CW_TAB + (t & 7u)]); ok = ok && v != 0u && v == r; }
                unsigned m = 0u;
                for (unsigned i = 0; i < 8u; ++i) m |= 1u << (xb_ld(&ctl0[CW_TAB + i]) & 31u);
                ok = ok && __popc(m) == 8;
                const bool all = __ballot(ok) == ~0ull;
                if (threadIdx.x == 0) MISC[10] = all ? 1u : 0u; }
            __syncthreads(); } }
    if (IN(1)) { Ctx C; make_ctx(C); pg8::Gemm g{C.XB, C.W_inab, NTOK, NAB, 1024}; pg8::EpiScaleBf16 E{C.P, NAB, pg8::RinvTab{C.part, lds}}; RUN_GEMM(pg8::EpiScaleBf16, g, E);
        __syncthreads(); phase_prologue_late(C, lds); __syncthreads();
#if defined(DBG_REPEAT) && DBG_REPEAT == 1
        RUN_GEMM(pg8::EpiScaleBf16, g, E);
#endif
        SEAM(1); }
    if (IN(2)) { Ctx C; make_ctx(C); phase_fixup_pool(C, lds);
#if defined(DBG_REPEAT) && DBG_REPEAT == 2
        phase_fixup_pool(C, lds);
#endif
        SEAM(2); }
#ifdef DBG_ZERO_ATTN
    if (IN(3)) { Ctx C; make_ctx(C); for (int i = C.bid * 512 + threadIdx.x; i < NTOK * 64; i += C.G * 512) { const int tok = i >> 6, c = i & 63; *(u32x4*)(C.Y + (size_t)tok * 1024 + 512 + 8 * c) = (u32x4){0u, 0u, 0u, 0u}; } SEAM(3); }
#else
#if USE_SIMPLE_ATTN
    if (IN(3)) { Ctx C; make_ctx(C); phase_attn_simple(C, lds); __syncthreads(); SEAM(3); }
#else
    if (IN(3)) { Ctx C; make_ctx(C); phase_attn(C, lds); __syncthreads();
#if defined(DBG_REPEAT) && DBG_REPEAT == 3
        phase_attn(C, lds); __syncthreads();
#endif
        SEAM(3); }
#endif
#endif
    if (IN(4)) { Ctx C; make_ctx(C); pg8::Gemm g{C.Y, C.W_outab, NTOK, 1024, 1024}; pg8::EpiResidual<true> E{C.XB, C.part, C.x}; RUN_GEMM(pg8::EpiResidual<true>, g, E); SEAM_L(4); }
    if (IN(5)) { Ctx C; make_ctx(C); pg8::Gemm g{C.XB, C.W_gu0, NTOK, 2 * DFF, 1024}; pg8::EpiSwiGLU E{C.ACT, pg8::RinvTab{C.part, lds}}; RUN_GEMM(pg8::EpiSwiGLU, g, E);
#if defined(DBG_REPEAT) && DBG_REPEAT == 5
        RUN_GEMM(pg8::EpiSwiGLU, g, E);
#endif
        SEAM_L(5); }
    if (IN(6)) { Ctx C; make_ctx(C); pg8::Gemm g{C.ACT, C.W_dn0, NTOK, 1024, DFF}; pg8::EpiResidual<false> E{C.XB, C.part, C.x}; RUN_GEMM(pg8::EpiResidual<false>, g, E); SEAM_L(6); }
    if (IN(7)) { Ctx C; make_ctx(C); pg8::Gemm g{C.XB, C.W_inc, NTOK, NINC, 1024}; pg8::EpiHgrnIn E{C.L1Q, C.L1K, C.L1I, C.L1G, pg8::RinvTab{C.part, lds}, C.lbv}; RUN_GEMM(pg8::EpiHgrnIn, g, E); SEAM_L(7); }
#if USE_SIMPLE_HGRN
    if (IN(8)) { Ctx C; make_ctx(C); phase_hgrn_simple(C); SEAM(8); }
    if (IN(9)) { Ctx C; make_ctx(C); phase_hgrn_post(C); SEAM_L(9); }
#else
    if (IN(8)) { Ctx C; make_ctx(C); phase_hgrn_local(C, lds); __syncthreads();
#if defined(DBG_REPEAT) && DBG_REPEAT == 8
        phase_hgrn_local(C, lds); __syncthreads();
#endif
        SEAM(8); }
    if (IN(9)) { Ctx C; make_ctx(C); phase_hgrn_chunks(C, lds); __syncthreads();
#if defined(DBG_REPEAT) && DBG_REPEAT == 9
        phase_hgrn_chunks(C, lds); __syncthreads();
#endif
        SEAM_L(9); }
#endif
    if (IN(10)) { Ctx C; make_ctx(C); pg8::Gemm g{C.Y, C.W_outc, NTOK, 1024, 1024}; pg8::EpiResidual<false> E{C.XB, C.part, C.x}; RUN_GEMM(pg8::EpiResidual<false>, g, E); SEAM_L(10); }
    if (IN(11)) { Ctx C; make_ctx(C); pg8::Gemm g{C.XB, C.W_gu1, NTOK, 2 * DFF, 1024}; pg8::EpiSwiGLU E{C.ACT, pg8::RinvTab{C.part, lds}}; RUN_GEMM(pg8::EpiSwiGLU, g, E); SEAM_L(11); }
    if (IN(12)) { Ctx C; make_ctx(C); pg8::Gemm g{C.ACT, C.W_dn1, NTOK, 1024, DFF}; pg8::EpiResidual<false> E{C.XB, C.part, C.x}; RUN_GEMM(pg8::EpiResidual<false>, g, E); SEAM_L(12); }
    if (IN(13)) { Ctx C; make_ctx(C); phase_final_norm(C); }
#ifdef DBG_STOP_AFTER
    if (IN(14)) { Ctx C; make_ctx(C); for (int i = C.bid * 512 + threadIdx.x; i < NTOK * 1024; i += C.G * 512) { const int tok = i >> 10, c = i & 1023; float v;
        if (DBG_STOP_AFTER <= 3) v = bf2f(C.P[(size_t)tok * NAB + c]) + bf2f(C.P[(size_t)tok * NAB + 768 + c]) + bf2f(C.Y[(size_t)tok * 1024 + (c & 511)]);
        else if (DBG_STOP_AFTER == 7 || DBG_STOP_AFTER == 8) v = bf2f(C.L1Q[i]) + bf2f(C.L1K[i]) + bf2f(C.L1I[i]) + bf2f(C.L1G[i]) + (DBG_STOP_AFTER == 8 ? bf2f(C.ORAW[i]) : 0.f);
        else if (DBG_STOP_AFTER == 9) v = bf2f(C.Y[i]);
        else if (DBG_STOP_AFTER == 5 || DBG_STOP_AFTER == 11) v = bf2f(C.ACT[(size_t)tok * DFF + c]) + bf2f(C.ACT[(size_t)tok * DFF + 1024 + c]) + bf2f(C.ACT[(size_t)tok * DFF + 1792 + c]);
        else v = C.out[i] + bf2f(C.XB[i]);
        C.out[i] = v; } }
#endif
#undef IN
#undef SEAM
#undef SEAM_L
}

extern "C" void kernel_launch(void* const* d_in, const int* in_sizes, int n_in, void* d_out, int out_size, void* d_ws, size_t ws_size, hipStream_t stream) {
    static int grid = 0;
    if (grid == 0) {
        if (n_in != 16 || in_sizes[0] != NTOK * DM || out_size != NTOK * DM || ws_size < WS_END) {
            fprintf(stderr, "kernel_launch: built for 16 inputs, x/out of %d floats, >= %zu bytes of workspace; got n_in %d, in0 %d, out %d, ws %zu; nothing launched\n", NTOK * DM, (size_t)WS_END, n_in, n_in > 0 ? in_sizes[0] : -1, out_size, ws_size);
            grid = -1; return; }
        int dev = 0, cus = 0, per_cu = 0;
        if (hipGetDevice(&dev) != hipSuccess || hipDeviceGetAttribute(&cus, hipDeviceAttributeMultiprocessorCount, dev) != hipSuccess) { fprintf(stderr, "kernel_launch: device query failed\n"); grid = -1; return; }
        if (hipFuncSetAttribute((const void*)mega_fwd, hipFuncAttributeMaxDynamicSharedMemorySize, LDS_BYTES) != hipSuccess) { fprintf(stderr, "kernel_launch: hipFuncSetAttribute failed\n"); grid = -1; return; }
        if (hipOccupancyMaxActiveBlocksPerMultiprocessor(&per_cu, (const void*)mega_fwd, 512, LDS_BYTES) != hipSuccess || per_cu < 1)
            fprintf(stderr, "kernel_launch: note: occupancy query reports %d workgroups per CU\n", per_cu);
        (void)hipGetLastError();
        grid = cus;
    }
    if (grid < 0) return;
    if (hipMemsetAsync((char*)d_ws + WS_CTL, 0, CTL_ZERO_BYTES, stream) != hipSuccess) { fprintf(stderr, "kernel_launch: hipMemsetAsync failed\n"); return; }
    Args a{};
    for (int i = 0; i < 16; ++i) a.in[i] = d_in[i];
    a.out = (float*)d_out; a.ws = (unsigned char*)d_ws;
    if (N_LAUNCH_MODE == 1) {
        a.ph_lo = 0; a.ph_hi = NPHASES;
        hipLaunchKernelGGL(mega_fwd, dim3(grid), dim3(512), LDS_BYTES, stream, a);
    } else {
#ifdef DBG_STOP_AFTER
        for (int p = 0; p <= DBG_STOP_AFTER; ++p) { a.ph_lo = p; a.ph_hi = p + 1; hipLaunchKernelGGL(mega_fwd, dim3(grid), dim3(512), LDS_BYTES, stream, a); }
        a.ph_lo = 14; a.ph_hi = 15; hipLaunchKernelGGL(mega_fwd, dim3(grid), dim3(512), LDS_BYTES, stream, a);
#else
        for (int p = 0; p < NPHASES; ++p) { a.ph_lo = p; a.ph_hi = p + 1; hipLaunchKernelGGL(mega_fwd, dim3(grid), dim3(512), LDS_BYTES, stream, a); }
#endif
    }
    const hipError_t le = hipPeekAtLastError();
    if (le != hipSuccess) fprintf(stderr, "kernel_launch: launch failed: %s\n", hipGetErrorName(le));
}
```

```cpp
#include <hip/hip_runtime.h>
#include <cstdio>
#include <cstdint>

#ifndef N_LAUNCH_MODE
#define N_LAUNCH_MODE 1
#endif
#ifndef USE_SIMPLE_HGRN
#define USE_SIMPLE_HGRN 0
#endif
#ifndef USE_SIMPLE_ATTN
#define USE_SIMPLE_ATTN 0
#endif
#ifndef USE_SIMPLE_GEMM
#define USE_SIMPLE_GEMM 0
#endif

#define LAS __attribute__((address_space(3)))

constexpr int BATCH = 4, SEQ = 8192, DM = 1024, NTOK = BATCH * SEQ;
constexpr int NAB_REAL = 1604, NAB = 1792;
constexpr int DFF = 2816;
constexpr int NINC = 4096;
constexpr int PC_U = 0, PC_Q = 512, PC_K = 1024, PC_V = 1152, PC_QI = 1280, PC_KI = 1536, PC_WI = 1600;
constexpr float EPS = 1e-6f;
constexpr int TOPK = 256;

constexpr size_t MiB = 1u << 20;
constexpr size_t WS_CTL = 0, CTL_ZERO_BYTES = 1 * MiB;
constexpr size_t WS_ROPE = 1 * MiB;
constexpr size_t WS_PART = 3 * MiB;
constexpr size_t WS_LB = 5 * MiB;
constexpr size_t WS_W_INAB = 6 * MiB;
constexpr size_t WS_W_POOL = WS_W_INAB + (size_t)NAB * DM * 2;
constexpr size_t WS_W_OUTAB = 10 * MiB;
constexpr size_t WS_W_INC = 12 * MiB;
constexpr size_t WS_W_OUTC = 20 * MiB;
constexpr size_t WS_W_GU0 = 22 * MiB, WS_W_GU1 = 33 * MiB;
constexpr size_t WS_W_DN0 = 44 * MiB, WS_W_DN1 = WS_W_DN0 + (size_t)DM * DFF * 2;
constexpr size_t WS_XB = 56 * MiB;
constexpr size_t WS_Y = 120 * MiB;
constexpr size_t WS_P = 184 * MiB;
constexpr size_t WS_ACT = 184 * MiB;
constexpr size_t WS_L1Q = 184 * MiB, WS_L1K = 248 * MiB, WS_L1I = 312 * MiB, WS_L1G = 376 * MiB;
constexpr size_t WS_ORAW = 440 * MiB;
constexpr size_t WS_KV8 = 488 * MiB;
constexpr size_t WS_END = 512 * MiB;
static_assert(WS_W_POOL + 4 * 128 * 128 * 2 <= WS_W_OUTAB && WS_W_DN1 + (size_t)DM * DFF * 2 <= WS_XB && WS_P + (size_t)NTOK * NAB * 2 <= 360 * MiB && WS_ACT + (size_t)NTOK * DFF * 2 <= WS_L1G + 64 * MiB, "ws map");
constexpr int CW_BAR = 4096;

constexpr int LDS_BYTES = 163840;
constexpr int LDS_MISC = 163840 - 256;
namespace pg8 {
#define PG8_LAS __attribute__((address_space(3)))
typedef unsigned short bf16_t;
typedef short bf16x8 __attribute__((ext_vector_type(8)));
typedef float f32x4 __attribute__((ext_vector_type(4)));
typedef unsigned u32x4 __attribute__((ext_vector_type(4)));
constexpr int BM = 256, BK = 64, HALF = 128, HTB = HALF * BK * 2  , STAGE_BYTES = 8 * HTB, NXCD = 8, WGM = 8;

__host__ __device__ __forceinline__ int lds_byte(int r, int c) { const int st = (r >> 4) * 2 + (c >> 5), rr = r & 15, cc = c & 31, ob = rr * 64 + cc * 2; return st * 1024 + (ob ^ (((ob >> 9) & 1) << 5)); }
__host__ __device__ __forceinline__ void stage_rc(int b, int& R, int& C) { const int st = b / 1024, sb = b % 1024, swz = sb ^ (((sb >> 9) & 1) << 5); R = (st >> 1) * 16 + swz / 64; C = (st & 1) * 32 + (swz % 64) / 2; }
__host__ __device__ __forceinline__ int perm32(int rho) { const int n = rho >> 4, i = rho & 15; return 8 * (i >> 2) + 4 * n + (i & 3); }

struct Unit { int pm, pn; };
struct Gemm { const bf16_t* A; const bf16_t* Bt; int M, N, K; };

struct StaticOrder {
    int nM, nN, nwg, G, c;
    __host__ __device__ void init(int M, int N, int G_, int c_) { nM = M / BM; nN = N / BM; nwg = nM * nN; G = G_; c = c_; }
    __host__ __device__ bool next(int i, Unit& u) const {
        const long L = (long)i * G + c; if (L >= nwg) return false;
        int wgid = (int)L; { const int q = nwg / NXCD, r = nwg % NXCD, xcd = wgid % NXCD, off = wgid / NXCD; wgid = (xcd < r ? xcd * (q + 1) : r * (q + 1) + (xcd - r) * q) + off; }
        const int nig = WGM * nN, gid = wgid / nig, fm = gid * WGM, gsz = (nM - fm) < WGM ? (nM - fm) : WGM;
        u.pm = fm + ((wgid % nig) % gsz); u.pn = (wgid % nig) / gsz; return true;
    }
    __device__ __forceinline__ void a_ready(const Unit&) const {}
    __device__ __forceinline__ void done(const Unit&) const {}
};
typedef __bf16 bf16x2_t __attribute__((ext_vector_type(2)));
__device__ __forceinline__ unsigned cvt_pk_bf16(float lo, float hi) { const bf16x2_t v = {(__bf16)lo, (__bf16)hi}; return __builtin_bit_cast(unsigned, v); }

typedef float f32x2 __attribute__((ext_vector_type(2)));
typedef unsigned u32x2 __attribute__((ext_vector_type(2)));

__device__ __forceinline__ float row_rinv(const float* part, int row) {
    const f32x4* p = (const f32x4*)(part + (size_t)row * 16);
    const f32x4 a = p[0], b = p[1], c = p[2], d = p[3];
    const float s = (((a[0] + a[1]) + (a[2] + a[3])) + ((b[0] + b[1]) + (b[2] + b[3]))) + (((c[0] + c[1]) + (c[2] + c[3])) + ((d[0] + d[1]) + (d[2] + d[3])));
    return 1.0f / sqrtf(s * (1.0f / 1024.0f) + 1e-6f);
}
struct RinvTab {
    const float* part; PG8_LAS unsigned char* ldsb;
    __device__ __forceinline__ void prepare(int pm) const {
        PG8_LAS int* cpm = (PG8_LAS int*)(ldsb + 131072 + 1024); PG8_LAS float* rtab = (PG8_LAS float*)(ldsb + 131072);
        if (*cpm != pm) {
            asm volatile("s_waitcnt lgkmcnt(0)" ::: "memory"); __builtin_amdgcn_s_barrier(); asm volatile("" ::: "memory");
            if (threadIdx.x < 256) rtab[threadIdx.x] = row_rinv(part, pm * BM + (int)threadIdx.x);
            if (threadIdx.x == 0) *cpm = pm;
            asm volatile("s_waitcnt vmcnt(0) lgkmcnt(0)" ::: "memory"); __builtin_amdgcn_s_barrier(); asm volatile("" ::: "memory");
        }
    }
    __device__ __forceinline__ float get(int row_in_panel) const { return ((const PG8_LAS float*)(ldsb + 131072))[row_in_panel]; }
};
__device__ __forceinline__ float sigmoid_neg(float x) { return __builtin_amdgcn_rcpf(1.0f + __expf(x)); }
__device__ __forceinline__ float silu_f(float x) { return x * __builtin_amdgcn_rcpf(1.0f + __expf(-x)); }

struct EpiScaleBf16 {
    static constexpr bool PERM = true, AFTER_DRAIN = false;
    bf16_t* O; int ldc; RinvTab rt;
    __device__ __forceinline__ void operator()(const f32x4 (&acc)[2][2][4][2], const Unit& u, int wr, int wc, int fr, int fq) const {
        rt.prepare(u.pm);
        const int row0 = u.pm * BM + wr * 64 + fr, col0 = u.pn * BM + wc * 32 + 8 * fq;
#pragma unroll
        for (int ai = 0; ai < 2; ++ai)
#pragma unroll
            for (int m = 0; m < 4; ++m) { const int row = row0 + ai * HALF + m * 16; const float r = rt.get(row - u.pm * BM); bf16_t* rowp = O + (size_t)row * ldc + col0;
#pragma unroll
                for (int bj = 0; bj < 2; ++bj) { const f32x4 v0 = acc[ai][bj][m][0] * r, v1 = acc[ai][bj][m][1] * r;
                    u32x4 w; w.x = cvt_pk_bf16(v0[0], v0[1]); w.y = cvt_pk_bf16(v0[2], v0[3]); w.z = cvt_pk_bf16(v1[0], v1[1]); w.w = cvt_pk_bf16(v1[2], v1[3]);
                    *(u32x4*)(rowp + bj * HALF) = w; } }
    }
};
template <bool BASE_F32> struct EpiResidual {
    static constexpr bool PERM = true, AFTER_DRAIN = false;
    bf16_t* xb; float* part; const float* xin;
    __device__ __forceinline__ void operator()(const f32x4 (&acc)[2][2][4][2], const Unit& u, int wr, int wc, int fr, int fq) const {
        const int row0 = u.pm * BM + wr * 64 + fr, col0 = u.pn * BM + wc * 32 + 8 * fq;
#pragma unroll
        for (int ai = 0; ai < 2; ++ai)
#pragma unroll
            for (int m = 0; m < 4; ++m) { const int row = row0 + ai * HALF + m * 16; const size_t off = (size_t)row * 1024 + col0; float ss = 0.f;
#pragma unroll
                for (int bj = 0; bj < 2; ++bj) {
                    f32x4 x0, x1;
                    if (BASE_F32) { x0 = *(const f32x4*)(xin + off + bj * HALF) + acc[ai][bj][m][0]; x1 = *(const f32x4*)(xin + off + bj * HALF + 4) + acc[ai][bj][m][1]; }
                    else { const u32x4 b = *(const u32x4*)(xb + off + bj * HALF);
                    x0[0] = __uint_as_float(b.x << 16) + acc[ai][bj][m][0][0]; x0[1] = __uint_as_float(b.x & 0xffff0000u) + acc[ai][bj][m][0][1];
                    x0[2] = __uint_as_float(b.y << 16) + acc[ai][bj][m][0][2]; x0[3] = __uint_as_float(b.y & 0xffff0000u) + acc[ai][bj][m][0][3];
                    x1[0] = __uint_as_float(b.z << 16) + acc[ai][bj][m][1][0]; x1[1] = __uint_as_float(b.z & 0xffff0000u) + acc[ai][bj][m][1][1];
                    x1[2] = __uint_as_float(b.w << 16) + acc[ai][bj][m][1][2]; x1[3] = __uint_as_float(b.w & 0xffff0000u) + acc[ai][bj][m][1][3]; }
                    ss += ((x0[0] * x0[0] + x0[1] * x0[1]) + (x0[2] * x0[2] + x0[3] * x0[3])) + ((x1[0] * x1[0] + x1[1] * x1[1]) + (x1[2] * x1[2] + x1[3] * x1[3]));
                    u32x4 w; w.x = cvt_pk_bf16(x0[0], x0[1]); w.y = cvt_pk_bf16(x0[2], x0[3]); w.z = cvt_pk_bf16(x1[0], x1[1]); w.w = cvt_pk_bf16(x1[2], x1[3]);
                    *(u32x4*)(xb + off + bj * HALF) = w; }
                ss += __shfl_xor(ss, 16); ss += __shfl_xor(ss, 32);
                if (fq == 0) part[(size_t)row * 16 + u.pn * 4 + wc] = ss; }
    }
};
struct EpiSwiGLU {
    static constexpr bool PERM = true, AFTER_DRAIN = false;
    bf16_t* O; RinvTab rt;
    __device__ __forceinline__ void operator()(const f32x4 (&acc)[2][2][4][2], const Unit& u, int wr, int wc, int fr, int fq) const {
        rt.prepare(u.pm);
        const int row0 = u.pm * BM + wr * 64 + fr, f0 = u.pn * HALF + wc * 32 + 8 * fq;
#pragma unroll
        for (int ai = 0; ai < 2; ++ai)
#pragma unroll
            for (int m = 0; m < 4; ++m) { const int row = row0 + ai * HALF + m * 16; const float r = rt.get(row - u.pm * BM);
                float a[8];
#pragma unroll
                for (int n = 0; n < 2; ++n)
#pragma unroll
                    for (int j = 0; j < 4; ++j) { const float g = acc[ai][0][m][n][j] * r, up = acc[ai][1][m][n][j] * r; a[4 * n + j] = silu_f(g) * up; }
                u32x4 w; w.x = cvt_pk_bf16(a[0], a[1]); w.y = cvt_pk_bf16(a[2], a[3]); w.z = cvt_pk_bf16(a[4], a[5]); w.w = cvt_pk_bf16(a[6], a[7]);
                *(u32x4*)(O + (size_t)row * 2816 + f0) = w; }
    }
};
struct EpiHgrnIn {
    static constexpr bool PERM = true, AFTER_DRAIN = false;
    bf16_t *Q1, *K1, *I1, *G1; RinvTab rt; const float* lb;
    __device__ __forceinline__ void operator()(const f32x4 (&acc)[2][2][4][2], const Unit& u, int wr, int wc, int fr, int fq) const {
        rt.prepare(u.pm);
        const int sec = u.pn >> 2; const int row0 = u.pm * BM + wr * 64 + fr, col0 = (u.pn & 3) * BM + wc * 32 + 8 * fq;
        bf16_t* O = sec == 0 ? Q1 : sec == 1 ? K1 : sec == 2 ? I1 : G1;
        float lbc[2][8];
#pragma unroll
        for (int bj = 0; bj < 2; ++bj)
#pragma unroll
            for (int j = 0; j < 8; ++j) lbc[bj][j] = (sec == 1) ? (1.0f - lb[col0 + bj * HALF + j]) : 0.f;
#pragma unroll
        for (int ai = 0; ai < 2; ++ai)
#pragma unroll
            for (int m = 0; m < 4; ++m) { const int row = row0 + ai * HALF + m * 16; const float r = rt.get(row - u.pm * BM); bf16_t* rowp = O + (size_t)row * 1024 + col0;
#pragma unroll
                for (int bj = 0; bj < 2; ++bj) { float a[8];
#pragma unroll
                    for (int n = 0; n < 2; ++n)
#pragma unroll
                        for (int j = 0; j < 4; ++j) { const float v = acc[ai][bj][m][n][j] * r; float o;
                            if (sec == 0) o = v * 0.08838834764831845f; else if (sec == 1) o = lbc[bj][4 * n + j] * sigmoid_neg(v); else if (sec == 2) o = v; else o = silu_f(v);
                            a[4 * n + j] = o; }
                    u32x4 w; w.x = cvt_pk_bf16(a[0], a[1]); w.y = cvt_pk_bf16(a[2], a[3]); w.z = cvt_pk_bf16(a[4], a[5]); w.w = cvt_pk_bf16(a[6], a[7]);
                    *(u32x4*)(rowp + bj * HALF) = w; } }
    }
};

template <class Epi>
__device__ __forceinline__ void gemm_simple(const Gemm g, int G, int c, const Epi& E) {
    const int tid = threadIdx.x, wid = __builtin_amdgcn_readfirstlane(tid >> 6), lane = tid & 63, wr = wid >> 2, wc = wid & 3, fr = lane & 15, fq = lane >> 4;
    const int nN = g.N / BM, nunits = (g.M / BM) * nN, K = g.K;
    for (int ui = c; ui < nunits; ui += G) {
        Unit u; u.pm = ui / nN; u.pn = ui % nN;
        f32x4 acc[2][2][4][2];
#pragma unroll
        for (int a = 0; a < 2; ++a)
#pragma unroll
            for (int b = 0; b < 2; ++b)
#pragma unroll
                for (int m = 0; m < 4; ++m)
#pragma unroll
                    for (int n = 0; n < 2; ++n) acc[a][b][m][n] = (f32x4){0.f, 0.f, 0.f, 0.f};
        const bf16_t* Ab = g.A + (size_t)(u.pm * BM + wr * 64 + fr) * K + fq * 8;
        const bf16_t* Bb = g.Bt + (size_t)(u.pn * BM + wc * 32 + 8 * (fr >> 2) + (fr & 3)) * K + fq * 8;
        for (int kk = 0; kk < K; kk += 32) {
            bf16x8 a[2][4], b[2][2];
#pragma unroll
            for (int ai = 0; ai < 2; ++ai)
#pragma unroll
                for (int m = 0; m < 4; ++m) a[ai][m] = *(const bf16x8*)(Ab + (size_t)(ai * HALF + m * 16) * K + kk);
#pragma unroll
            for (int bj = 0; bj < 2; ++bj)
#pragma unroll
                for (int n = 0; n < 2; ++n) b[bj][n] = *(const bf16x8*)(Bb + (size_t)(bj * HALF + 4 * n) * K + kk);
#pragma unroll
            for (int ai = 0; ai < 2; ++ai)
#pragma unroll
                for (int bj = 0; bj < 2; ++bj)
#pragma unroll
                    for (int m = 0; m < 4; ++m)
#pragma unroll
                        for (int n = 0; n < 2; ++n) acc[ai][bj][m][n] = __builtin_amdgcn_mfma_f32_16x16x32_bf16(b[bj][n], a[ai][m], acc[ai][bj][m][n], 0, 0, 0);
        }
        E(acc, u, wr, wc, fr, fq);
    }
}
template <class Epi, class Sched, bool ALIGN_EPI = false, bool SP2 = false>
__device__ __forceinline__ void gemm_phase(PG8_LAS unsigned char* lds, const Gemm g, const Sched& S, const Epi& E) {
    const int tid = threadIdx.x, wid = __builtin_amdgcn_readfirstlane(tid >> 6), lane = tid & 63, wr = wid >> 2, wc = wid & 3, fr = lane & 15, fq = lane >> 4;
    const int K = g.K, nt = K / BK;
    unsigned voffA[2], voffB[2];
#pragma unroll
    for (int i = 0; i < 2; ++i) { int R, C; stage_rc(tid * 16 + i * 8192, R, C); const int Rb = Epi::PERM ? ((R & ~31) + perm32(R & 31)) : R;
        voffA[i] = (unsigned)(R * K + C) * 2u; voffB[i] = (unsigned)(Rb * K + C) * 2u; }
    const size_t kstep = (size_t)(BK * 2);
    const size_t hstep = (size_t)HALF * K * 2;
    const size_t tstep = 2 * hstep;
    const unsigned ldsw = (unsigned)wid * 1024u;
    const int aoff = lds_byte(wr * 64 + fr, fq * 8), boff = lds_byte(wc * 32 + fr, fq * 8);
#define PG8_SA(b, h) (((b) * 2 + (h)) * HTB)
#define PG8_SB(b, h) ((4 + (b) * 2 + (h)) * HTB)
#define PG8_STAGE(bufoff, gbase, voff) do { _Pragma("unroll") for (int _i = 0; _i < 2; ++_i) \
        __builtin_amdgcn_global_load_lds((const unsigned*)((const char*)(gbase) + (voff)[_i]), (PG8_LAS unsigned*)(lds + (bufoff) + ldsw + _i * 8192), 16, 0, 0); } while (0)
#define PG8_LDA(dst, b, h) do { _Pragma("unroll") for (int m = 0; m < 4; ++m) _Pragma("unroll") for (int k = 0; k < 2; ++k) dst[m][k] = *(const PG8_LAS bf16x8*)(lds + PG8_SA(b, h) + aoff + m * 2048 + k * 1024); } while (0)
#define PG8_LDB(dst, b, h) do { _Pragma("unroll") for (int n = 0; n < 2; ++n) _Pragma("unroll") for (int k = 0; k < 2; ++k) dst[n][k] = *(const PG8_LAS bf16x8*)(lds + PG8_SB(b, h) + boff + n * 2048 + k * 1024); } while (0)
#define PG8_MMA(ai, bj, At, Bt) do { __builtin_amdgcn_s_setprio(1); _Pragma("unroll") for (int m = 0; m < 4; ++m) _Pragma("unroll") for (int n = 0; n < 2; ++n) _Pragma("unroll") for (int k = 0; k < 2; ++k) \
        acc[ai][bj][m][n] = __builtin_amdgcn_mfma_f32_16x16x32_bf16(Bt[n][k], At[m][k], acc[ai][bj][m][n], 0, 0, 0); __builtin_amdgcn_s_setprio(0); } while (0)
#define PG8_WAIT_V(n) asm volatile("s_waitcnt vmcnt(" #n ")" ::: "memory")
#define PG8_WAIT_L(n) asm volatile("s_waitcnt lgkmcnt(" #n ")" ::: "memory")
#define PG8_BAR __builtin_amdgcn_s_barrier()
#define PG8_SCHED __builtin_amdgcn_sched_barrier(0)
    Unit cur, nxt; int ui = 0;
    if (!S.next(0, cur)) return;
    f32x4 acc[2][2][4][2];
#pragma unroll
    for (int a = 0; a < 2; ++a)
#pragma unroll
        for (int b = 0; b < 2; ++b)
#pragma unroll
            for (int m = 0; m < 4; ++m)
#pragma unroll
                for (int n = 0; n < 2; ++n) acc[a][b][m][n] = (f32x4){0.f, 0.f, 0.f, 0.f};
    bf16x8 At[4][2], B0[2][2], B1[2][2];
    const char* cA = (const char*)g.A + (size_t)cur.pm * tstep; const char* cB = (const char*)g.Bt + (size_t)cur.pn * tstep;
    S.a_ready(cur);
    if constexpr (SP2) {
        PG8_STAGE(PG8_SB(0, 0), cB, voffB); PG8_STAGE(PG8_SB(0, 1), cB + hstep, voffB); PG8_STAGE(PG8_SA(0, 0), cA, voffA); PG8_STAGE(PG8_SA(0, 1), cA + hstep, voffA);
        if (wr == 1) PG8_BAR;
        PG8_WAIT_V(2); PG8_BAR;
        PG8_STAGE(PG8_SB(1, 0), cB + kstep, voffB); PG8_STAGE(PG8_SA(1, 0), cA + kstep, voffA); PG8_STAGE(PG8_SB(1, 1), cB + hstep + kstep, voffB);
        PG8_WAIT_V(6); PG8_BAR;
    } else {
        PG8_STAGE(PG8_SB(0, 0), cB, voffB); PG8_STAGE(PG8_SA(0, 0), cA, voffA); PG8_STAGE(PG8_SB(0, 1), cB + hstep, voffB); PG8_STAGE(PG8_SA(0, 1), cA + hstep, voffA);
        if (wr == 1) PG8_BAR;
        PG8_WAIT_V(4); PG8_BAR;
        PG8_STAGE(PG8_SB(1, 0), cB + kstep, voffB); PG8_STAGE(PG8_SA(1, 0), cA + kstep, voffA); PG8_STAGE(PG8_SB(1, 1), cB + hstep + kstep, voffB);
        PG8_WAIT_V(6); PG8_BAR;
    }
    for (;;) {
        const bool has_next = S.next(ui + 1, nxt);
        const char* nA = has_next ? (const char*)g.A + (size_t)nxt.pm * tstep : cA; const char* nB = has_next ? (const char*)g.Bt + (size_t)nxt.pn * tstep : cB;
        for (int t = 0; t < nt; t += 2) {
            const bool last = (t == nt - 2);
            const char* a1 = cA + (size_t)(t + 1) * kstep;
            const char* a2 = last ? nA : cA + (size_t)(t + 2) * kstep; const char* b2 = last ? nB : cB + (size_t)(t + 2) * kstep;
            const char* a3 = a2 + kstep; const char* b3 = b2 + kstep;
            if (last && has_next) S.a_ready(nxt);
            if constexpr (SP2) {
            PG8_LDB(B0, 0, 0); PG8_LDB(B1, 0, 1); PG8_SCHED; PG8_LDA(At, 0, 0); PG8_STAGE(PG8_SA(1, 1), a1 + hstep, voffA);
            PG8_WAIT_V(8); PG8_WAIT_L(0); PG8_BAR; PG8_MMA(0, 0, At, B0); PG8_MMA(0, 1, At, B1); PG8_BAR; PG8_SCHED;
            PG8_LDA(At, 0, 1); PG8_STAGE(PG8_SB(0, 0), b2, voffB); PG8_STAGE(PG8_SB(0, 1), b2 + hstep, voffB); PG8_STAGE(PG8_SA(0, 0), a2, voffA);
            PG8_WAIT_V(8); PG8_WAIT_L(0); PG8_BAR; PG8_MMA(1, 0, At, B0); PG8_MMA(1, 1, At, B1); PG8_BAR; PG8_SCHED;
            PG8_LDB(B0, 1, 0); PG8_LDB(B1, 1, 1); PG8_SCHED; PG8_LDA(At, 1, 0); PG8_STAGE(PG8_SA(0, 1), a2 + hstep, voffA);
            PG8_WAIT_V(8); PG8_WAIT_L(0); PG8_BAR; PG8_MMA(0, 0, At, B0); PG8_MMA(0, 1, At, B1); PG8_BAR; PG8_SCHED;
            PG8_LDA(At, 1, 1); PG8_STAGE(PG8_SB(1, 0), b3, voffB); PG8_STAGE(PG8_SB(1, 1), b3 + hstep, voffB); PG8_STAGE(PG8_SA(1, 0), a3, voffA);
            PG8_WAIT_V(8); PG8_WAIT_L(0); PG8_BAR; PG8_MMA(1, 0, At, B0); PG8_MMA(1, 1, At, B1); PG8_BAR; PG8_SCHED;
            } else {
            PG8_LDB(B0, 0, 0); PG8_SCHED; PG8_LDA(At, 0, 0); PG8_STAGE(PG8_SA(1, 1), a1 + hstep, voffA);
            PG8_WAIT_L(8); PG8_BAR; PG8_WAIT_L(0); PG8_MMA(0, 0, At, B0); PG8_BAR; PG8_SCHED;
            PG8_LDB(B1, 0, 1); PG8_STAGE(PG8_SB(0, 0), b2, voffB);
            PG8_BAR; PG8_WAIT_L(0); PG8_MMA(0, 1, At, B1); PG8_BAR;
            PG8_LDA(At, 0, 1); PG8_STAGE(PG8_SA(0, 0), a2, voffA);
            PG8_BAR; PG8_WAIT_L(0); PG8_MMA(1, 0, At, B0); PG8_BAR; PG8_SCHED;
            PG8_STAGE(PG8_SB(0, 1), b2 + hstep, voffB);
            PG8_WAIT_V(6); PG8_BAR; PG8_MMA(1, 1, At, B1); PG8_BAR;
            PG8_LDB(B0, 1, 0); PG8_SCHED; PG8_LDA(At, 1, 0); PG8_STAGE(PG8_SA(0, 1), a2 + hstep, voffA);
            PG8_WAIT_L(8); PG8_BAR; PG8_WAIT_L(0); PG8_MMA(0, 0, At, B0); PG8_BAR; PG8_SCHED;
            PG8_LDB(B1, 1, 1); PG8_STAGE(PG8_SB(1, 0), b3, voffB);
            PG8_BAR; PG8_WAIT_L(0); PG8_MMA(0, 1, At, B1); PG8_BAR;
            PG8_LDA(At, 1, 1); PG8_STAGE(PG8_SA(1, 0), a3, voffA);
            PG8_BAR; PG8_WAIT_L(0); PG8_MMA(1, 0, At, B0); PG8_BAR; PG8_SCHED;
            PG8_STAGE(PG8_SB(1, 1), b3 + hstep, voffB);
            PG8_WAIT_V(6); PG8_BAR; PG8_MMA(1, 1, At, B1); PG8_BAR;
            }
        }
        if constexpr (ALIGN_EPI) { if (wr == 0) PG8_BAR; }
        if constexpr (!Epi::AFTER_DRAIN) { E(acc, cur, wr, wc, fr, fq); S.done(cur); }
        if (!has_next) break;
#pragma unroll
        for (int a = 0; a < 2; ++a)
#pragma unroll
            for (int b = 0; b < 2; ++b)
#pragma unroll
                for (int m = 0; m < 4; ++m)
#pragma unroll
                    for (int n = 0; n < 2; ++n) acc[a][b][m][n] = (f32x4){0.f, 0.f, 0.f, 0.f};
        cur = nxt; cA = nA; cB = nB; ++ui;
        if constexpr (ALIGN_EPI) { if (wr == 1) PG8_BAR; }
    }
    PG8_WAIT_V(0);
    if constexpr (!ALIGN_EPI) { if (wr == 0) PG8_BAR; }
    PG8_BAR;
    if constexpr (Epi::AFTER_DRAIN) { E.fused(acc, cur, wr, wc, fr, fq, lds, wid, lane); S.done(cur); }
#undef PG8_SA
#undef PG8_SB
#undef PG8_STAGE
#undef PG8_LDA
#undef PG8_LDB
#undef PG8_MMA
#undef PG8_WAIT_V
#undef PG8_WAIT_L
#undef PG8_BAR
#undef PG8_SCHED
}
}

#define XB_TMO      128
#define XB_XCNT(j)  (256  + 64 * (j))
#define XB_XSUB(j)  (1280 + 64 * (j))
#define XB_XGEN(j)  (2304 + 64 * (j))
#define XB_TOP      3328
#define XB_TOPGEN   3392
#define XCD_BAR_WORDS 3456
#define XB_SPIN_CAP (1u << 18)

__device__ __forceinline__ unsigned xb_ld(unsigned* p)              { return __hip_atomic_load(p, __ATOMIC_RELAXED, __HIP_MEMORY_SCOPE_AGENT); }
__device__ __forceinline__ unsigned xb_add(unsigned* p, unsigned v) { return __hip_atomic_fetch_add(p, v, __ATOMIC_RELAXED, __HIP_MEMORY_SCOPE_AGENT); }
__device__ __forceinline__ unsigned xb_xcc_id() { return (unsigned)__builtin_amdgcn_s_getreg((3 << 11) | 20) & 0xFu; }
#define XB_SPIN(cond, bar) do { unsigned _sp = 0; while (cond) { __builtin_amdgcn_s_sleep(1); \
    if ((++_sp & 255u) == 0u) { if (xb_ld(&(bar)[XB_TMO])) break; if (_sp > XB_SPIN_CAP) { atomicAdd(&(bar)[XB_TMO], 1u); break; } } } } while (0)

struct XcdBarrier {
    unsigned* bar; unsigned x;
    volatile LAS unsigned* st;
};

__device__ __forceinline__ XcdBarrier xcd_barrier_post(unsigned* bar, volatile LAS unsigned* st) {
    XcdBarrier b; b.bar = bar; b.x = xb_xcc_id(); b.st = st;
    if (threadIdx.x == 0) (void)xb_add(&bar[XB_XCNT(b.x)], 1u);
    return b;
}
__device__ __forceinline__ void xcd_barrier_complete(unsigned* bar, unsigned x, unsigned& nloc, unsigned& nx) {
    const unsigned G = gridDim.x * gridDim.y * gridDim.z;
    unsigned sum, cnt, mine, sp = 0u;
    for (;;) {
        sum = 0u; cnt = 0u; mine = 0u;
#pragma unroll
        for (unsigned j = 0; j < 16; ++j) { const unsigned c = xb_ld(&bar[XB_XCNT(j)]); sum += c; cnt += (c > 0u) ? 1u : 0u; mine = (j == x) ? c : mine; }
        if (sum == G) break;
        __builtin_amdgcn_s_sleep(1);
        if ((++sp & 255u) == 0u) { if (xb_ld(&bar[XB_TMO])) break; if (sp > XB_SPIN_CAP) { atomicAdd(&bar[XB_TMO], 1u); break; } }
    }
    nloc = mine > 0u ? mine : 1u; nx = cnt > 0u ? cnt : 1u;
}

__device__ __forceinline__ void xcd_barrier(const XcdBarrier& b) {
    asm volatile("s_waitcnt vmcnt(0)" ::: "memory");
    __syncthreads();
    if (threadIdx.x == 0) {
        unsigned* bar = b.bar;
        __builtin_amdgcn_s_waitcnt(0);
        unsigned nloc = b.st[0], nx = b.st[1];
        if (nloc == 0u) { xcd_barrier_complete(bar, b.x, nloc, nx); b.st[0] = nloc; b.st[1] = nx; }
        const unsigned old = xb_add(&bar[XB_XSUB(b.x)], 1u);
        const unsigned gen = old / nloc;
        if (old + 1u == (gen + 1u) * nloc) {
            __builtin_amdgcn_fence(__ATOMIC_RELEASE, "agent");
            asm volatile("s_waitcnt vmcnt(0)" ::: "memory");
            const unsigned og = xb_add(&bar[XB_TOP], 1u);
            const unsigned tg = og / nx;
            if (og + 1u == (tg + 1u) * nx) xb_add(&bar[XB_TOPGEN], 1u);
            else XB_SPIN(xb_ld(&bar[XB_TOPGEN]) == tg, bar);
            __builtin_amdgcn_fence(__ATOMIC_ACQUIRE, "agent");
            xb_add(&bar[XB_XGEN(b.x)], 1u);
            asm volatile("s_waitcnt vmcnt(0)" ::: "memory");
        } else {
            XB_SPIN(xb_ld(&bar[XB_XGEN(b.x)]) == gen, bar);
            __builtin_amdgcn_fence(__ATOMIC_ACQUIRE, "agent");
            asm volatile("s_waitcnt vmcnt(0)" ::: "memory");
        }
    }
    __syncthreads();
}

typedef unsigned short bf16_t;
typedef short bf16x8 __attribute__((ext_vector_type(8)));
typedef float f32x4 __attribute__((ext_vector_type(4)));
typedef unsigned u32x4 __attribute__((ext_vector_type(4)));
typedef unsigned u32x2 __attribute__((ext_vector_type(2)));

struct Ctx {
    const float* x; const int* positions; const float *ln_mix, *ln_ffn, *ln_final, *w_in_ab, *w_pool, *pool_scale, *idx_k_norm, *w_out_ab, *w_in_c, *hgrn_lb, *hgrn_out_norm, *w_out_c, *w_gate_up, *w_down;
    float* out;
    unsigned* ctl; float* rope; float* part; float* lbv;
    bf16_t *W_inab, *W_pool, *W_outab, *W_inc, *W_outc, *W_gu0, *W_gu1, *W_dn0, *W_dn1;
    bf16_t *XB, *Y, *P, *ACT, *L1Q, *L1K, *L1I, *L1G, *ORAW;
    int G, bid;
};

__device__ __forceinline__ float bf_lo(unsigned w) { return __uint_as_float(w << 16); }
__device__ __forceinline__ float bf_hi(unsigned w) { return __uint_as_float(w & 0xffff0000u); }
__device__ __forceinline__ float bf2f(bf16_t b) { return __uint_as_float(((unsigned)b) << 16); }
__device__ __forceinline__ unsigned pk2(float lo, float hi) { return pg8::cvt_pk_bf16(lo, hi); }
__device__ __forceinline__ float wave_sum(float v) {
#pragma unroll
    for (int o = 1; o < 64; o <<= 1) v += __shfl_xor(v, o);
    return v;
}

__device__ __forceinline__ unsigned pk4_fp8(float a, float b, float c, float d) { int w = 0; w = __builtin_amdgcn_cvt_pk_fp8_f32(a, b, w, false); w = __builtin_amdgcn_cvt_pk_fp8_f32(c, d, w, true); return (unsigned)w; }
__device__ __forceinline__ u32x2 bf8_to_fp8(u32x4 w) { u32x2 o; o.x = pk4_fp8(bf_lo(w.x), bf_hi(w.x), bf_lo(w.y), bf_hi(w.y)); o.y = pk4_fp8(bf_lo(w.z), bf_hi(w.z), bf_lo(w.w), bf_hi(w.w)); return o; }

struct RowMapId { __device__ __forceinline__ int operator()(int n) const { return n; } };
struct RowMapAB { __device__ __forceinline__ int operator()(int n) const {
    if (n < PC_Q || (n >= PC_V && n < PC_QI) || n >= PC_WI) return n;
    const int d = n & 63; if (d >= 16) return n;
    return n - d + ((d < 8) ? 2 * d : 2 * (d - 8) + 1); } };
struct RowMapGU { __device__ __forceinline__ int operator()(int n) const {
    if (n < DFF) return 256 * (n >> 7) + (n & 127);
    const int f = n - DFF; return 256 * (f >> 7) + 128 + (f & 127); } };

template <class RowMap>
__device__ __forceinline__ void transpose_item(const float* W, int K, int N, const float* kgain, const float* nscale, bf16_t* WT, RowMap map, LAS float* scr, int item, int lane) {
    const int nblk = (N + 31) >> 5, kb = item / nblk, nb = item - kb * nblk, k0 = 64 * kb, n0 = 32 * nb;
    const int nr = n0 + (lane & 31); const float ns = (nr < N && nscale) ? nscale[nr] : 1.0f;
    float wv[32];
    const int nrc = (nr < N) ? nr : N - 1;
#pragma unroll
    for (int i = 0; i < 32; ++i) wv[i] = W[(size_t)(k0 + 2 * i + (lane >> 5)) * N + nrc];
    float kg[32];
#pragma unroll
    for (int i = 0; i < 32; ++i) kg[i] = kgain ? kgain[k0 + 2 * i + (lane >> 5)] : 1.0f;
#pragma unroll
    for (int i = 0; i < 32; ++i) { const int kk = 2 * i + (lane >> 5); scr[kk * 33 + (lane & 31)] = (nr < N) ? wv[i] * kg[i] * ns : 0.f; }
    asm volatile("s_waitcnt lgkmcnt(0)" ::: "memory");
    const int c = lane & 7;
#pragma unroll
    for (int j = 0; j < 4; ++j) { const int nl = (lane >> 3) + 8 * j; const LAS float* s = scr + (8 * c) * 33 + nl;
        u32x4 o; o.x = pk2(s[0 * 33], s[1 * 33]); o.y = pk2(s[2 * 33], s[3 * 33]); o.z = pk2(s[4 * 33], s[5 * 33]); o.w = pk2(s[6 * 33], s[7 * 33]);
        if (n0 + nl < N) *(u32x4*)(WT + (size_t)map(n0 + nl) * K + k0 + 8 * c) = o; }
    asm volatile("s_waitcnt lgkmcnt(0)" ::: "memory");
}

__device__ __forceinline__ void rope_cs(int pos, int i, float& c, float& s) {
    const double inv = (i == 0) ? 1.0 : (i == 1) ? 0.19392274474868576 : (i == 2) ? 0.03760603093086393 : (i == 3) ? 0.007292664737217109 : (i == 4) ? 0.001414213562373095
                     : (i == 5) ? 0.0002742481756762073 : (i == 6) ? 5.318295896944988e-05 : 1.031338537721246e-05;
    const double a = (double)pos * inv;
    const double kq = rint(a * 0.63661977236758134308);
    double r = fma(-kq, 1.57079632679489655800e+00, a); r = fma(-kq, 6.12323399573676603587e-17, r);
    const double r2 = r * r;
    double sp = -7.6471637318198164759e-13; sp = fma(sp, r2, 1.6059043836821614599e-10); sp = fma(sp, r2, -2.5052108385441718775e-08); sp = fma(sp, r2, 2.7557319223985890653e-06);
    sp = fma(sp, r2, -1.9841269841269841270e-04); sp = fma(sp, r2, 8.3333333333333333333e-03); sp = fma(sp, r2, -1.6666666666666666667e-01); const double sn = fma(sp * r2, r, r);
    double cp = 4.7794773323873852974e-14; cp = fma(cp, r2, -1.1470745597729724714e-11); cp = fma(cp, r2, 2.0876756987868098979e-09); cp = fma(cp, r2, -2.7557319223985890653e-07);
    cp = fma(cp, r2, 2.4801587301587301587e-05); cp = fma(cp, r2, -1.3888888888888888889e-03); cp = fma(cp, r2, 4.1666666666666666667e-02); cp = fma(cp, r2, -0.5); const double cn = fma(cp, r2, 1.0);
    const int q = ((int)kq) & 3;
    const double cc = (q == 0) ? cn : (q == 1) ? -sn : (q == 2) ? -cn : sn;
    const double ss = (q == 0) ? sn : (q == 1) ? cn : (q == 2) ? -sn : -cn;
    c = (float)cc; s = (float)ss;
}

__device__ __forceinline__ void phase_prologue(const Ctx& C, LAS unsigned char* lds) {
    const int tid = threadIdx.x, lane = tid & 63, wave = __builtin_amdgcn_readfirstlane(tid >> 6);
    LAS float* scr = (LAS float*)(lds + wave * 16384);
    const int gw = C.bid * 8 + wave, NGW = C.G * 8;
    constexpr int I_AB = 16 * 51, I_PL = 2 * 4, I_SQ = 16 * 32, I_INC = 16 * 128, I_GU = 16 * 176, I_DN = 44 * 32;
    constexpr int NITEMS = I_AB + 4 * I_PL + I_SQ + I_INC + I_SQ + 2 * I_GU + I_DN;
    for (int it = gw; it < NITEMS; it += NGW) {
        int r = it;
        if (r < I_AB) { transpose_item(C.w_in_ab, 1024, NAB_REAL, C.ln_mix, nullptr, C.W_inab, RowMapAB(), scr, r, lane); continue; } r -= I_AB;
        if (r < 4 * I_PL) { const int g = r / I_PL; transpose_item(C.w_pool + g * 16384, 128, 128, nullptr, C.pool_scale + g * 128, C.W_pool + g * 16384, RowMapId(), scr, r - g * I_PL, lane); continue; } r -= 4 * I_PL;
        if (r < I_SQ) { transpose_item(C.w_out_ab, 1024, 1024, nullptr, nullptr, C.W_outab, RowMapId(), scr, r, lane); continue; } r -= I_SQ;
        if (r < I_INC) { transpose_item(C.w_in_c, 1024, NINC, C.ln_mix + 1024, nullptr, C.W_inc, RowMapId(), scr, r, lane); continue; } r -= I_INC;
        if (r < I_SQ) { transpose_item(C.w_out_c, 1024, 1024, nullptr, nullptr, C.W_outc, RowMapId(), scr, r, lane); continue; } r -= I_SQ;
        if (r < I_GU) { transpose_item(C.w_gate_up, 1024, 2 * DFF, C.ln_ffn, nullptr, C.W_gu0, RowMapGU(), scr, r, lane); continue; } r -= I_GU;
        if (r < I_GU) { transpose_item(C.w_gate_up + (size_t)1024 * 2 * DFF, 1024, 2 * DFF, C.ln_ffn + 1024, nullptr, C.W_gu1, RowMapGU(), scr, r, lane); continue; } r -= I_GU;
        transpose_item(C.w_down, DFF, 1024, nullptr, nullptr, C.W_dn0, RowMapId(), scr, r, lane);
    }
    const int gt = C.bid * 512 + tid, NGT = C.G * 512;
    for (int i = gt; i < (NAB - NAB_REAL) * 1024 / 8; i += NGT) ((u32x4*)(C.W_inab + (size_t)NAB_REAL * 1024))[i] = (u32x4){0u, 0u, 0u, 0u};
    for (int i = gt; i < 1024; i += NGT) C.lbv[i] = 1.0f / (1.0f + expf(C.hgrn_lb[i] - C.hgrn_lb[1024 + i]));
    for (int row0 = 4 * gw; row0 < NTOK; row0 += 4 * NGW) {
        f32x4 v[4][4];
#pragma unroll
        for (int rr = 0; rr < 4; ++rr)
#pragma unroll
            for (int j = 0; j < 4; ++j) v[rr][j] = ((const f32x4*)(C.x + (size_t)(row0 + rr) * 1024) + lane)[64 * j];
#pragma unroll
        for (int rr = 0; rr < 4; ++rr) { const int row = row0 + rr; u32x2* o8 = (u32x2*)(C.XB + (size_t)row * 1024) + lane; float s = 0.f;
#pragma unroll
            for (int j = 0; j < 4; ++j) { const f32x4 x4 = v[rr][j]; s += (x4[0] * x4[0] + x4[1] * x4[1]) + (x4[2] * x4[2] + x4[3] * x4[3]); u32x2 w; w.x = pk2(x4[0], x4[1]); w.y = pk2(x4[2], x4[3]); o8[64 * j] = w; }
            s = wave_sum(s);
            if (lane < 16) C.part[(size_t)row * 16 + lane] = (lane == 0) ? s : 0.f; }
    }
}

__device__ __forceinline__ void phase_prologue_late(const Ctx& C, LAS unsigned char* lds) {
    const int tid = threadIdx.x, lane = tid & 63, wave = __builtin_amdgcn_readfirstlane(tid >> 6);
    LAS float* scr = (LAS float*)(lds + wave * 16384);
    const int half = C.G >> 1; if (C.bid < half) return;
    const int gw = (C.bid - half) * 8 + wave, NGW = (C.G - half) * 8;
    for (int it = gw; it < 44 * 32; it += NGW) transpose_item(C.w_down + (size_t)DFF * 1024, DFF, 1024, nullptr, nullptr, C.W_dn1, RowMapId(), scr, it, lane);
    { const int gt = (C.bid - half) * 512 + tid, NGT = (C.G - half) * 512;
      for (int i = gt; i < NTOK * 8; i += NGT) { const int tok = i >> 3, f = i & 7; float c, s; rope_cs(C.positions[tok], f, c, s); C.rope[(size_t)tok * 16 + f] = c; C.rope[(size_t)tok * 16 + 8 + f] = s; } }
}

__device__ __forceinline__ void phase_fixup_pool(const Ctx& C, LAS unsigned char* lds) {
    const int tid = threadIdx.x, lane = tid & 63, wid = __builtin_amdgcn_readfirstlane(tid >> 6);
    for (int tile = C.bid; tile < NTOK / 128; tile += C.G) {
        const int tok0 = tile * 128;
        for (int it = tid; it < 128 * 16; it += 512) {
            const int tl = it >> 4, slot = it & 15;
            const int tok = tok0 + tl;
            unsigned char* kv8 = (unsigned char*)C.ctl + WS_KV8 + (size_t)tok * 256;
            if (slot == 15) {
                const bf16_t* vp = C.P + (size_t)tok * NAB + PC_V;
#pragma unroll
                for (int q2 = 0; q2 < 8; ++q2) { const u32x2 a = bf8_to_fp8(*(const u32x4*)(vp + 16 * q2)), b = bf8_to_fp8(*(const u32x4*)(vp + 16 * q2 + 8)); *(u32x4*)(kv8 + 128 + 16 * q2) = (u32x4){a.x, a.y, b.x, b.y}; }
                continue; }
            const f32x4* rp = (const f32x4*)(C.rope + (size_t)tok * 16);
            const f32x4 c0 = rp[0], c1 = rp[1], s0 = rp[2], s1 = rp[3];
            const float cs[8] = {c0[0], c0[1], c0[2], c0[3], c1[0], c1[1], c1[2], c1[3]}, sn[8] = {s0[0], s0[1], s0[2], s0[3], s1[0], s1[1], s1[2], s1[3]};
            bf16_t* rowp = C.P + (size_t)tok * NAB;
            if (slot < 14) {
                const int col = (slot < 8) ? PC_Q + 64 * slot : (slot < 10) ? PC_K + 64 * (slot - 8) : PC_QI + 64 * (slot - 10);
                u32x4 w0 = *(u32x4*)(rowp + col), w1 = *(u32x4*)(rowp + col + 8);
                unsigned w[8] = {w0.x, w0.y, w0.z, w0.w, w1.x, w1.y, w1.z, w1.w};
#pragma unroll
                for (int i = 0; i < 8; ++i) { const float x1 = bf_lo(w[i]), x2 = bf_hi(w[i]); w[i] = pk2(x1 * cs[i] - x2 * sn[i], x2 * cs[i] + x1 * sn[i]); }
                *(u32x4*)(rowp + col) = (u32x4){w[0], w[1], w[2], w[3]}; *(u32x4*)(rowp + col + 8) = (u32x4){w[4], w[5], w[6], w[7]};
                if (slot == 8 || slot == 9) {
                    unsigned char* kd = kv8 + 64 * (slot - 8);
                    { const u32x2 a = bf8_to_fp8((u32x4){w[0], w[1], w[2], w[3]}), b = bf8_to_fp8((u32x4){w[4], w[5], w[6], w[7]}); *(u32x4*)kd = (u32x4){a.x, a.y, b.x, b.y}; }
#pragma unroll
                    for (int q2 = 1; q2 < 4; ++q2) { const u32x2 a = bf8_to_fp8(*(const u32x4*)(rowp + col + 16 * q2)), b = bf8_to_fp8(*(const u32x4*)(rowp + col + 16 * q2 + 8)); *(u32x4*)(kd + 16 * q2) = (u32x4){a.x, a.y, b.x, b.y}; } }
            } else {
                unsigned w[32];
#pragma unroll
                for (int q = 0; q < 8; ++q) { const u32x4 t = *(u32x4*)(rowp + PC_KI + 8 * q); w[4 * q] = t.x; w[4 * q + 1] = t.y; w[4 * q + 2] = t.z; w[4 * q + 3] = t.w; }
                float ss = 0.f;
#pragma unroll
                for (int i = 0; i < 32; ++i) { const float a = bf_lo(w[i]), b = bf_hi(w[i]); ss += a * a + b * b; }
                const float r = 1.0f / sqrtf(ss * (1.0f / 64.0f) + EPS);
#pragma unroll
                for (int i = 0; i < 32; ++i) {
                    const int d0 = (i < 8) ? i : 2 * i, d1 = (i < 8) ? i + 8 : 2 * i + 1;
                    float a = bf_lo(w[i]) * r * C.idx_k_norm[d0], b = bf_hi(w[i]) * r * C.idx_k_norm[d1];
                    if (i < 8) { const float x1 = a, x2 = b; a = x1 * cs[i] - x2 * sn[i]; b = x2 * cs[i] + x1 * sn[i]; }
                    w[i] = pk2(a, b); }
#pragma unroll
                for (int q = 0; q < 8; ++q) *(u32x4*)(rowp + PC_KI + 8 * q) = (u32x4){w[4 * q], w[4 * q + 1], w[4 * q + 2], w[4 * q + 3]};
            }
        }
        const int fr = lane & 15, fq = lane >> 4;
        const int tl0 = wid * 16 + fr, tok = tok0 + tl0, t = tok & (SEQ - 1);
        const bool hist = (tok0 & (SEQ - 1)) != 0;
        LAS unsigned char* ubuf = lds; LAS unsigned char* wbuf = lds + 39424;
        u32x4 ur[5], wv[4];
#define POOL_LOAD(gx) { _Pragma("unroll") for (int i = 0; i < 5; ++i) { int p = tid + 512 * i; p = p < 2288 ? p : 2287; const int r = p >> 4, pc = p & 15; const int trow = (r < 15 && !hist) ? tok0 : tok0 - 15 + r; \
            ur[i] = *(const u32x4*)(C.P + (size_t)trow * NAB + PC_U + (gx) * 128 + pc * 8); } \
        _Pragma("unroll") for (int i = 0; i < 4; ++i) wv[i] = *(const u32x4*)(C.W_pool + (gx) * 16384 + (tid + 512 * i) * 8); }
        POOL_LOAD(0)
#pragma unroll 1
        for (int g = 0; g < 4; ++g) {
            __syncthreads();
#pragma unroll
            for (int i = 0; i < 5; ++i) { const int p = tid + 512 * i; if (p < 2288) *(LAS u32x4*)(ubuf + (p >> 4) * 272 + (p & 15) * 16) = ur[i]; }
#pragma unroll
            for (int i = 0; i < 4; ++i) { const int p = tid + 512 * i, d = p >> 4; const int slot = (d & ~31) + 16 * ((d >> 2) & 1) + 4 * ((d >> 3) & 3) + (d & 3); *(LAS u32x4*)(wbuf + slot * 272 + (p & 15) * 16) = wv[i]; }
            __syncthreads();
            if (g < 3) POOL_LOAD(g + 1)
            const int win = 2 << g;
            const int cnt = (t + 1 < win) ? t + 1 : win; const float rc = 1.0f / (float)cnt;
            f32x4 acc[4][2];
#pragma unroll
            for (int a = 0; a < 4; ++a) { acc[a][0] = (f32x4){0.f, 0.f, 0.f, 0.f}; acc[a][1] = (f32x4){0.f, 0.f, 0.f, 0.f}; }
#pragma unroll
            for (int kk = 0; kk < 4; ++kk) {
                const LAS unsigned char* up = ubuf + (15 + tl0) * 272 + kk * 64 + fq * 16;
                float s[8], cur[8];
                { const u32x4 wx = *(const LAS u32x4*)up; cur[0] = bf_lo(wx.x); cur[1] = bf_hi(wx.x); cur[2] = bf_lo(wx.y); cur[3] = bf_hi(wx.y); cur[4] = bf_lo(wx.z); cur[5] = bf_hi(wx.z); cur[6] = bf_lo(wx.w); cur[7] = bf_hi(wx.w); }
#pragma unroll
                for (int i = 0; i < 8; ++i) s[i] = cur[i];
                for (int j = 1; j < win; ++j) {
                    const u32x4 wx = *(const LAS u32x4*)(up - j * 272); const float m = (j <= t) ? 1.0f : 0.0f;
                    s[0] += m * bf_lo(wx.x); s[1] += m * bf_hi(wx.x); s[2] += m * bf_lo(wx.y); s[3] += m * bf_hi(wx.y); s[4] += m * bf_lo(wx.z); s[5] += m * bf_hi(wx.z); s[6] += m * bf_lo(wx.w); s[7] += m * bf_hi(wx.w); }
                u32x4 af; af.x = pk2(s[0] * rc - cur[0], s[1] * rc - cur[1]); af.y = pk2(s[2] * rc - cur[2], s[3] * rc - cur[3]); af.z = pk2(s[4] * rc - cur[4], s[5] * rc - cur[5]); af.w = pk2(s[6] * rc - cur[6], s[7] * rc - cur[7]);
                const bf16x8 a = __builtin_bit_cast(bf16x8, af);
#pragma unroll
                for (int nn = 0; nn < 4; ++nn)
#pragma unroll
                    for (int n = 0; n < 2; ++n) {
                        const bf16x8 bfr = *(const LAS bf16x8*)(wbuf + (32 * nn + 16 * n + fr) * 272 + kk * 64 + fq * 16);
                        acc[nn][n] = __builtin_amdgcn_mfma_f32_16x16x32_bf16(bfr, a, acc[nn][n], 0, 0, 0); }
            }
#pragma unroll
            for (int nn = 0; nn < 4; ++nn) { u32x4 w; w.x = pk2(acc[nn][0][0], acc[nn][0][1]); w.y = pk2(acc[nn][0][2], acc[nn][0][3]); w.z = pk2(acc[nn][1][0], acc[nn][1][1]); w.w = pk2(acc[nn][1][2], acc[nn][1][3]);
                *(u32x4*)(C.Y + (size_t)tok * 1024 + g * 128 + 32 * nn + 8 * fq) = w; }
        }
#undef POOL_LOAD
    }
}

__device__ __forceinline__ unsigned fkey(float f) { const unsigned u = __float_as_uint(f); return u ^ ((unsigned)((int)u >> 31) | 0x80000000u); }

__device__ __forceinline__ void phase_attn_simple(const Ctx& C, LAS unsigned char* lds) {
    const int tid = threadIdx.x, lane = tid & 63, wid = tid >> 6;
    LAS unsigned* sc = (LAS unsigned*)lds;
    LAS float* qif = (LAS float*)(lds + 32768);
    LAS float* qf = (LAS float*)(lds + 32768 + 1024);
    LAS unsigned* hist = (LAS unsigned*)(lds + 32768 + 1024 + 2048);
    LAS unsigned* wsum = hist + 256;
    LAS unsigned* ctl = wsum + 16;
    LAS unsigned short* sel = (LAS unsigned short*)(ctl + 8);
    LAS float* pr = (LAS float*)(sel + 256);
    LAS float* red = pr + 2048;
    LAS float* red2 = red + 64;
    for (int qx = C.bid; qx < NTOK; qx += C.G) {
        const int tok = qx, b = tok >> 13, t = tok & (SEQ - 1), n = t + 1;
        const bf16_t* prow = C.P + (size_t)tok * NAB;
        const bf16_t* pb = C.P + (size_t)(b << 13) * NAB;
        __syncthreads();
        if (tid < 256) qif[tid] = bf2f(prow[PC_QI + tid]);
        qf[tid] = bf2f(prow[PC_Q + tid]);
        if (tid == 0) { ctl[0] = 0u; ctl[1] = TOPK; ctl[2] = 0u; }
        float wi[4];
#pragma unroll
        for (int h = 0; h < 4; ++h) wi[h] = bf2f(prow[PC_WI + h]) * 0.0625f;
        __syncthreads();
        for (int s = tid; s < n; s += 512) {
            asm volatile("" ::: "memory");
            const u32x4* kr = (const u32x4*)(pb + (size_t)s * NAB + PC_KI);
            float d0 = 0.f, d1 = 0.f, d2 = 0.f, d3 = 0.f;
#pragma unroll
            for (int q = 0; q < 8; ++q) { const u32x4 w = kr[q]; const float kv[8] = {bf_lo(w.x), bf_hi(w.x), bf_lo(w.y), bf_hi(w.y), bf_lo(w.z), bf_hi(w.z), bf_lo(w.w), bf_hi(w.w)};
#pragma unroll
                for (int j = 0; j < 8; ++j) { const int d = 8 * q + j; d0 += qif[d] * kv[j]; d1 += qif[64 + d] * kv[j]; d2 += qif[128 + d] * kv[j]; d3 += qif[192 + d] * kv[j]; } }
            float scv = 0.0f;
            scv = fmaf(wi[0], fmaxf(d0, 0.f), scv); scv = fmaf(wi[1], fmaxf(d1, 0.f), scv); scv = fmaf(wi[2], fmaxf(d2, 0.f), scv); scv = fmaf(wi[3], fmaxf(d3, 0.f), scv);
            sc[s] = fkey(scv);
        }
        __syncthreads();
        int nsel;
        if (n <= TOPK) { if (tid < n) sel[tid] = (unsigned short)tid; nsel = n; }
        else {
            nsel = TOPK;
            for (int pass = 0; pass < 4; ++pass) {
                const int shift = 24 - 8 * pass;
                if (tid < 256) hist[tid] = 0u;
                __syncthreads();
                const unsigned prefix = ctl[0]; const unsigned himask = (pass == 0) ? 0u : (0xffffffffu << (shift + 8));
                for (int s = tid; s < n; s += 512) { const unsigned k = sc[s]; if ((k & himask) == prefix) __hip_atomic_fetch_add(&hist[(k >> shift) & 255u], 1u, __ATOMIC_RELAXED, __HIP_MEMORY_SCOPE_WORKGROUP); }
                __syncthreads();
                if (wid == 0) {
                    const unsigned need = ctl[1];
                    const unsigned c0 = hist[255 - 4 * lane], c1 = hist[254 - 4 * lane], c2 = hist[253 - 4 * lane], c3 = hist[252 - 4 * lane];
                    const unsigned tot = c0 + c1 + c2 + c3; unsigned incl = tot;
#pragma unroll
                    for (int o = 1; o < 64; o <<= 1) { const unsigned v = __shfl_up(incl, o); if (lane >= o) incl += v; }
                    const unsigned excl = incl - tot;
                    if (excl < need && need <= incl) {
                        const unsigned r = need - excl; unsigned bin, above;
                        if (r <= c0) { bin = 255 - 4 * lane; above = excl; }
                        else if (r <= c0 + c1) { bin = 254 - 4 * lane; above = excl + c0; }
                        else if (r <= c0 + c1 + c2) { bin = 253 - 4 * lane; above = excl + c0 + c1; }
                        else { bin = 252 - 4 * lane; above = excl + c0 + c1 + c2; }
                        ctl[0] = prefix | (bin << shift); ctl[1] = need - above;
                    }
                }
                __syncthreads();
            }
            const unsigned T = ctl[0], mneed = ctl[1];
            unsigned ceq = 0;
#pragma unroll
            for (int j = 0; j < 16; ++j) { const int s = tid * 16 + j; if (s < n && sc[s] == T) ++ceq; }
            unsigned incl = ceq;
#pragma unroll
            for (int o = 1; o < 64; o <<= 1) { const unsigned v = __shfl_up(incl, o); if (lane >= o) incl += v; }
            if (lane == 63) wsum[wid] = incl;
            __syncthreads();
            unsigned base = 0;
            for (int w = 0; w < wid; ++w) base += wsum[w];
            unsigned rank = base + incl - ceq;
            for (int j = 0; j < 16; ++j) { const int s = tid * 16 + j;
                if (s < n) { const unsigned k = sc[s]; bool take = k > T; if (k == T) { take = rank < mneed; ++rank; }
                    if (take) { const unsigned slot = __hip_atomic_fetch_add(&ctl[2], 1u, __ATOMIC_RELAXED, __HIP_MEMORY_SCOPE_WORKGROUP); if (slot < TOPK) sel[slot] = (unsigned short)s; } } }
        }
        __syncthreads();
        {
            const int j = tid & 255, hh = tid >> 8;
            float sv[4] = {-INFINITY, -INFINITY, -INFINITY, -INFINITY};
            if (j < nsel) {
                const u32x4* kr = (const u32x4*)(pb + (size_t)sel[j] * NAB + PC_K + 64 * hh);
                float d[4] = {0.f, 0.f, 0.f, 0.f};
#pragma unroll
                for (int q = 0; q < 8; ++q) { const u32x4 w = kr[q]; const float kv[8] = {bf_lo(w.x), bf_hi(w.x), bf_lo(w.y), bf_hi(w.y), bf_lo(w.z), bf_hi(w.z), bf_lo(w.w), bf_hi(w.w)};
#pragma unroll
                    for (int e = 0; e < 8; ++e)
#pragma unroll
                        for (int r = 0; r < 4; ++r) d[r] += qf[(4 * hh + r) * 64 + 8 * q + e] * kv[e]; }
#pragma unroll
                for (int r = 0; r < 4; ++r) sv[r] = d[r] * 0.125f;
            }
#pragma unroll
            for (int r = 0; r < 4; ++r) { float m = sv[r];
#pragma unroll
                for (int o = 1; o < 64; o <<= 1) m = fmaxf(m, __shfl_xor(m, o));
                if (lane == 0) red[(4 * hh + r) * 8 + (wid & 3)] = m; }
            __syncthreads();
            float ev[4];
#pragma unroll
            for (int r = 0; r < 4; ++r) { const int h = 4 * hh + r; const float m = fmaxf(fmaxf(red[h * 8], red[h * 8 + 1]), fmaxf(red[h * 8 + 2], red[h * 8 + 3]));
                ev[r] = (j < nsel) ? __expf(sv[r] - m) : 0.f; float sm = ev[r];
#pragma unroll
                for (int o = 1; o < 64; o <<= 1) sm += __shfl_xor(sm, o);
                if (lane == 0) red2[h * 8 + (wid & 3)] = sm; }
            __syncthreads();
#pragma unroll
            for (int r = 0; r < 4; ++r) { const int h = 4 * hh + r; const float sm = (red2[h * 8] + red2[h * 8 + 1]) + (red2[h * 8 + 2] + red2[h * 8 + 3]);
                pr[h * 256 + j] = ev[r] / sm; }
        }
        __syncthreads();
        {
            const int h = tid >> 6, g = h >> 2; float o = 0.f;
            const bf16_t* vb = pb + PC_V + 64 * g + lane;
            for (int j = 0; j < nsel; ++j) o += pr[h * 256 + j] * bf2f(vb[(size_t)sel[j] * NAB]);
            C.Y[(size_t)tok * 1024 + 512 + tid] = (bf16_t)(pk2(o, 0.f) & 0xffffu);
        }
    }
}

__device__ __forceinline__ void phase_hgrn_simple(const Ctx& C) {
    const int tid = threadIdx.x, lane = tid & 63, wid = tid >> 6;
    for (int unit = C.bid; unit < BATCH * 8 * 8; unit += C.G) {
        const int b = unit >> 6, h = (unit >> 3) & 7, sl = unit & 7;
        const int e = sl * 16 + 2 * wid + (lane >> 5), dg = lane & 31;
        const size_t cq = (size_t)h * 128 + 4 * dg, cv = (size_t)h * 128 + e;
        float S0 = 0.f, S1 = 0.f, S2 = 0.f, S3 = 0.f;
        const size_t tok0 = (size_t)b * SEQ;
        for (int t0 = 0; t0 < SEQ; t0 += 8) {
            u32x2 qv[8], kv[8]; bf16_t vv[8];
#pragma unroll
            for (int u = 0; u < 8; ++u) { const size_t ro = (tok0 + t0 + u) * 1024; qv[u] = *(const u32x2*)(C.L1Q + ro + cq); kv[u] = *(const u32x2*)(C.L1K + ro + cq); vv[u] = C.L1I[ro + cv]; }
#pragma unroll
            for (int u = 0; u < 8; ++u) {
                const float k0 = bf_lo(kv[u].x), k1 = bf_hi(kv[u].x), k2 = bf_lo(kv[u].y), k3 = bf_hi(kv[u].y), v = bf2f(vv[u]);
                S0 = (1.0f - k0) * S0 + k0 * v; S1 = (1.0f - k1) * S1 + k1 * v; S2 = (1.0f - k2) * S2 + k2 * v; S3 = (1.0f - k3) * S3 + k3 * v;
                float o = (bf_lo(qv[u].x) * S0 + bf_hi(qv[u].x) * S1) + (bf_lo(qv[u].y) * S2 + bf_hi(qv[u].y) * S3);
#pragma unroll
                for (int off = 1; off < 32; off <<= 1) o += __shfl_xor(o, off);
                if (dg == 0) C.ORAW[(tok0 + t0 + u) * 1024 + cv] = (bf16_t)(pk2(o, 0.f) & 0xffffu);
            }
        }
    }
}
__device__ __forceinline__ void phase_hgrn_post(const Ctx& C) {
    const int tid = threadIdx.x, lane = tid & 63, wave = tid >> 6;
    const int gw = C.bid * 8 + wave, NGW = C.G * 8;
    for (int tok = gw; tok < NTOK; tok += NGW) {
        const size_t ro = (size_t)tok * 1024 + 16 * lane;
        const u32x4 a0 = *(const u32x4*)(C.ORAW + ro), a1 = *(const u32x4*)(C.ORAW + ro + 8), g0 = *(const u32x4*)(C.L1G + ro), g1 = *(const u32x4*)(C.L1G + ro + 8);
        const unsigned aw[8] = {a0.x, a0.y, a0.z, a0.w, a1.x, a1.y, a1.z, a1.w}, gwd[8] = {g0.x, g0.y, g0.z, g0.w, g1.x, g1.y, g1.z, g1.w};
        float ss = 0.f;
#pragma unroll
        for (int i = 0; i < 8; ++i) { const float x = bf_lo(aw[i]), y = bf_hi(aw[i]); ss += x * x + y * y; }
        ss += __shfl_xor(ss, 1); ss += __shfl_xor(ss, 2); ss += __shfl_xor(ss, 4);
        const float r = 1.0f / sqrtf(ss * (1.0f / 128.0f) + EPS);
        const float* nw = C.hgrn_out_norm + 16 * (lane & 7);
        unsigned ow[8];
#pragma unroll
        for (int i = 0; i < 8; ++i) ow[i] = pk2(bf_lo(aw[i]) * r * nw[2 * i] * bf_lo(gwd[i]), bf_hi(aw[i]) * r * nw[2 * i + 1] * bf_hi(gwd[i]));
        *(u32x4*)(C.Y + ro) = (u32x4){ow[0], ow[1], ow[2], ow[3]}; *(u32x4*)(C.Y + ro + 8) = (u32x4){ow[4], ow[5], ow[6], ow[7]};
    }
}
__device__ __forceinline__ void phase_final_norm(const Ctx& C) {
    const int tid = threadIdx.x, lane = tid & 63, wave = tid >> 6;
    const bool grp = C.G == 256;
    const int wv = grp ? (C.bid >> 3) * 8 + wave : C.bid * 8 + wave, NWV = grp ? 256 : C.G * 8, NPASS = grp ? 4096 / 8 : NTOK / 8, rbase = grp ? 4096 * (C.bid & 7) : 0;
    f32x4 g[4];
#pragma unroll
    for (int k = 0; k < 4; ++k) g[k] = *(const f32x4*)(C.ln_final + (k >> 1) * 512 + 8 * lane + 4 * (k & 1));
    for (int ps = wv; ps < NPASS; ps += NWV) { const int row0 = rbase + 8 * ps;
        u32x4 b[8][2]; float pr[8];
#pragma unroll
        for (int rr = 0; rr < 8; ++rr) { const bf16_t* xr = C.XB + (size_t)(row0 + rr) * 1024 + 8 * lane; b[rr][0] = *(const u32x4*)xr; b[rr][1] = *(const u32x4*)(xr + 512); pr[rr] = C.part[(size_t)(row0 + rr) * 16 + (lane & 15)]; }
#pragma unroll
        for (int rr = 0; rr < 8; ++rr) { float s = pr[rr];
            s += __shfl_xor(s, 1); s += __shfl_xor(s, 2); s += __shfl_xor(s, 4); s += __shfl_xor(s, 8);
            const float r = 1.0f / sqrtf(s * (1.0f / 1024.0f) + EPS);
            float* orow = C.out + (size_t)(row0 + rr) * 1024 + 8 * lane;
#pragma unroll
            for (int h = 0; h < 2; ++h) { const u32x4 w = b[rr][h]; f32x4 o0, o1;
                o0[0] = bf_lo(w.x) * r * g[2 * h][0]; o0[1] = bf_hi(w.x) * r * g[2 * h][1]; o0[2] = bf_lo(w.y) * r * g[2 * h][2]; o0[3] = bf_hi(w.y) * r * g[2 * h][3];
                o1[0] = bf_lo(w.z) * r * g[2 * h + 1][0]; o1[1] = bf_hi(w.z) * r * g[2 * h + 1][1]; o1[2] = bf_lo(w.w) * r * g[2 * h + 1][2]; o1[3] = bf_hi(w.w) * r * g[2 * h + 1][3];
                *(f32x4*)(orow + 512 * h) = o0; *(f32x4*)(orow + 512 * h + 4) = o1; } }
    }
}

typedef float f32x16 __attribute__((ext_vector_type(16)));
typedef float f32x2 __attribute__((ext_vector_type(2)));
constexpr int AQ = 32;
constexpr int A_SEL = 131072;
constexpr int A_QS = A_SEL + AQ * 256 * 2;
constexpr int VROW = 144;

__device__ __forceinline__ float relu_f(float x) { const int b = __float_as_int(x); return __int_as_float(b > 0 ? b : 0); }
__device__ __forceinline__ void idx_tile16(const bf16x8 k0, const bf16x8 k1, const bf16x8 (&qb)[4][2], const float (&wq)[4], float (&sc)[4]) {
#pragma unroll
    for (int r = 0; r < 4; ++r) sc[r] = 0.0f;
#pragma unroll
    for (int h = 0; h < 4; ++h) { f32x4 a = (f32x4){0.f, 0.f, 0.f, 0.f};
        a = __builtin_amdgcn_mfma_f32_16x16x32_bf16(k0, qb[h][0], a, 0, 0, 0); a = __builtin_amdgcn_mfma_f32_16x16x32_bf16(k1, qb[h][1], a, 0, 0, 0);
#pragma unroll
        for (int r = 0; r < 4; ++r) sc[r] = fmaf(wq[h], relu_f(a[r]), sc[r]); }
}


__device__ __forceinline__ unsigned wave_incl_scan(unsigned v, int lane) {
    v += (unsigned)__builtin_amdgcn_update_dpp(0, (int)v, 0x111, 0xf, 0xf, false);
    v += (unsigned)__builtin_amdgcn_update_dpp(0, (int)v, 0x112, 0xf, 0xf, false);
    v += (unsigned)__builtin_amdgcn_update_dpp(0, (int)v, 0x114, 0xf, 0xf, false);
    v += (unsigned)__builtin_amdgcn_update_dpp(0, (int)v, 0x118, 0xf, 0xf, false);
    const unsigned r0 = (unsigned)__builtin_amdgcn_readlane((int)v, 15), r1 = (unsigned)__builtin_amdgcn_readlane((int)v, 31), r2 = (unsigned)__builtin_amdgcn_readlane((int)v, 47);
    const int row = lane >> 4;
    return v + (row >= 1 ? r0 : 0u) + (row >= 2 ? r1 : 0u) + (row >= 3 ? r2 : 0u);
}

__device__ __forceinline__ void phase_attn(const Ctx& C, LAS unsigned char* lds) {
    const int tid = threadIdx.x, lane0 = tid & 63, wid = __builtin_amdgcn_readfirstlane(tid >> 6);
    LAS unsigned* hist = (LAS unsigned*)lds;
    LAS unsigned short* sel = (LAS unsigned short*)(lds + A_SEL);
    LAS unsigned* tpool = (LAS unsigned*)(lds + 65536); constexpr int TCAP = 16384;
    LAS unsigned* dummy = (LAS unsigned*)(lds + A_QS + 1024) + tid;
    LAS unsigned* bmp = (LAS unsigned*)(lds + 32768);
    LAS int* q_bin = (LAS int*)(lds + A_QS); LAS int* q_need = q_bin + 32; LAS int* q_cnt = q_bin + 64; LAS int* q_off = q_bin + 96; LAS int* q_selc = q_bin + 128; LAS int* q_tiec = q_bin + 160;
    unsigned* pool = (unsigned*)((unsigned char*)C.ctl + (C.bid < 64 ? WS_XB + (size_t)C.bid * MiB : 296 * MiB + (size_t)(C.bid - 64) * MiB));
    const int nbw = C.G >> 2, ntile = SEQ / AQ, jb = C.bid >> 2;
    for (int ui = 0; ui * nbw < ntile; ++ui) {
        const int rank = ui * nbw + ((ui & 1) ? (nbw - 1 - jb) : jb);
        if (jb >= nbw || rank >= ntile) continue;
        const int tile = (ntile - 1) - rank, b = C.bid & 3, t0 = tile * AQ, tok0 = b * SEQ + t0;
        const bf16_t* pb = C.P + (size_t)(b * SEQ) * NAB;
        const unsigned char* kv8b = (const unsigned char*)C.ctl + WS_KV8 + (size_t)(b * SEQ) * 256;
        __syncthreads();
        int ln = lane0; asm volatile("" : "+v"(ln)); const int lane = ln;
        if (t0 < TOPK) {
            int tf = tid; asm volatile("" : "+v"(tf));
            for (int i = tf; i < AQ * 256; i += 512) { const int q = i >> 8, j = i & 255; sel[i] = (unsigned short)((j <= t0 + q) ? j : 0); }
        } else {
            for (int i = tid; i < AQ * 1024 / 4; i += 512) ((LAS u32x4*)hist)[i] = (u32x4){0u, 0u, 0u, 0u};
            const int qc = ln & 15, fq = ln >> 4;
            bf16x8 qb[2][4][2]; float wq[2][4];
#pragma unroll
            for (int hf = 0; hf < 2; ++hf) { const bf16_t* qrow = C.P + (size_t)(tok0 + 16 * hf + qc) * NAB;
#pragma unroll
              for (int h = 0; h < 4; ++h) { wq[hf][h] = bf2f(qrow[PC_WI + h]) * 0.0625f;
#pragma unroll
                  for (int ks = 0; ks < 2; ++ks) qb[hf][h][ks] = *(const bf16x8*)(qrow + PC_QI + h * 64 + ks * 32 + 8 * fq); } }
            const int kdiag0 = 2 * tile;
            const bf16_t* kbase = pb + (size_t)qc * NAB + PC_KI + 8 * fq;
            __syncthreads();
            bf16x8 kr[4][2]; const int kmaxt = kdiag0 + 1;
#define IDX_RING_LOAD(j, ktx) { const int ktc_ = ((ktx) <= kmaxt) ? (ktx) : kmaxt; const bf16_t* kp_ = kbase + (size_t)(ktc_ * 16) * NAB; kr[j][0] = *(const bf16x8*)kp_; kr[j][1] = *(const bf16x8*)(kp_ + 32); }
#pragma unroll
            for (int j = 0; j < 4; ++j) IDX_RING_LOAD(j, wid + 8 * j)
            for (int kt0 = wid; kt0 <= kmaxt; kt0 += 32) {
#pragma unroll
                for (int j = 0; j < 4; ++j) { const int kt = kt0 + 8 * j;
                    if (kt <= kmaxt) {
#pragma unroll
                        for (int hf = 0; hf < 2; ++hf) if (kt <= kdiag0 + hf) {
                            float sc[4]; idx_tile16(kr[j][0], kr[j][1], qb[hf], wq[hf], sc);
                            const int qn = 16 * hf + qc; LAS unsigned* hrow = hist + qn * 1024;
                            if (kt != kdiag0 + hf) {
#pragma unroll
                                for (int r = 0; r < 4; ++r) { const unsigned bin = fkey(sc[r]) >> 21;
                                    __hip_atomic_fetch_add(&hrow[(bin >> 1) ^ (unsigned)qn], (bin & 1u) ? 65536u : 1u, __ATOMIC_RELAXED, __HIP_MEMORY_SCOPE_WORKGROUP); }
                            } else {
#pragma unroll
                                for (int r = 0; r < 4; ++r) { const unsigned bin = fkey(sc[r]) >> 21;
                                    __hip_atomic_fetch_add(&hrow[(bin >> 1) ^ (unsigned)qn], (4 * fq + r <= qc) ? ((bin & 1u) ? 65536u : 1u) : 0u, __ATOMIC_RELAXED, __HIP_MEMORY_SCOPE_WORKGROUP); } } } }
                    IDX_RING_LOAD(j, kt + 32) }
            }
            __syncthreads();
#if defined(DBG_REPEAT) && DBG_REPEAT == 35
#pragma unroll 1
            for (int i8 = 0; i8 < 8; ++i8) { const int i = i8 & 3; const int q = 4 * wid + i;
#else
#pragma unroll 1
            for (int i = 0; i < 4; ++i) { const int q = 4 * wid + i;
#endif
                unsigned tot = 0;
#pragma unroll
                for (int j = 0; j < 16; ++j) { const unsigned w = hist[q * 1024 + ((1023 - 16 * lane - ((j + lane + (lane >> 4)) & 15)) ^ q)]; tot += (w & 0xffffu) + (w >> 16); }
                const unsigned incl = wave_incl_scan(tot, lane);
                const unsigned excl = incl - tot;
                if (excl < TOPK && TOPK <= incl) {
                    unsigned hw[16];
#pragma unroll
                    for (int j = 0; j < 16; ++j) hw[j] = hist[q * 1024 + ((1023 - 16 * lane - j) ^ q)];
                    unsigned run = excl; int fbin = -1; unsigned fabove = 0, fcnt = 0;
#pragma unroll
                    for (int j = 0; j < 16; ++j) {
                        const unsigned chi = hw[j] >> 16, clo = hw[j] & 0xffffu; const int wbin = 2 * (1023 - 16 * lane - j);
                        if (fbin < 0 && run + chi >= TOPK) { fbin = wbin + 1; fabove = run; fcnt = chi; } run += chi;
                        if (fbin < 0 && run + clo >= TOPK) { fbin = wbin; fabove = run; fcnt = clo; } run += clo; }
                    q_bin[q] = fbin; q_need[q] = TOPK - (int)fabove; q_cnt[q] = (int)fcnt; q_selc[q] = 0; q_tiec[q] = 0;
                } }
            __syncthreads();
            for (int i = tid; i < AQ * 256 / 4; i += 512) ((LAS u32x4*)bmp)[i] = (u32x4){0u, 0u, 0u, 0u};
            if (tid < 32) { int tq = tid; asm volatile("" : "+v"(tq));
                int c = q_cnt[tq], incl = c;
#pragma unroll
                for (int o = 1; o < 32; o <<= 1) { const int v = __shfl_up(incl, o); if (tq >= o) incl += v; }
                q_off[tq] = incl - c; }
            __syncthreads();
            unsigned mybin[2]; int myoff[2];
#pragma unroll
            for (int hf = 0; hf < 2; ++hf) { mybin[hf] = (unsigned)q_bin[16 * hf + qc]; myoff[hf] = q_off[16 * hf + qc]; }
#if defined(DBG_REPEAT) && (DBG_REPEAT == 34 || DBG_REPEAT == 36)
#pragma unroll 1
            for (int rep34 = 0; rep34 < 2; ++rep34) {
            if (rep34 && DBG_REPEAT == 34) { __syncthreads(); if (tid < 32) q_tiec[tid] = 0; __syncthreads(); }
#endif
#pragma unroll
            for (int j = 0; j < 4; ++j) IDX_RING_LOAD(j, wid + 8 * j)
            for (int kt0 = wid; kt0 <= kmaxt; kt0 += 32) {
#pragma unroll
                for (int j = 0; j < 4; ++j) { const int kt = kt0 + 8 * j;
                    if (kt <= kmaxt) {
#pragma unroll
                for (int hf = 0; hf < 2; ++hf) if (kt <= kdiag0 + hf) {
                    float sc[4]; idx_tile16(kr[j][0], kr[j][1], qb[hf], wq[hf], sc);
                    const bool diag = kt == kdiag0 + hf; const int qn = 16 * hf + qc; const int s0 = kt * 16 + 4 * fq;
                    unsigned amask = 0u, ent[4]; int nt = 0; bool ist[4];
#pragma unroll
                    for (int r = 0; r < 4; ++r) { const unsigned key = fkey(sc[r]); const unsigned bin = key >> 21;
                        amask |= (bin > mybin[hf]) ? (1u << r) : 0u; ist[r] = bin == mybin[hf];
                        ent[r] = (((key >> 2) & 0x7ffffu) << 13) | (unsigned)(8191 - (s0 + r)); }
                    if (diag) {
#pragma unroll
                        for (int r = 0; r < 4; ++r) { const bool v = 4 * fq + r <= qc; amask &= v ? ~0u : ~(1u << r); ist[r] = ist[r] && v; } }
#pragma unroll
                    for (int r = 0; r < 4; ++r) nt += ist[r] ? 1 : 0;
                    __hip_atomic_fetch_or(&bmp[qn * 256 + (s0 >> 5)], amask << (s0 & 31), __ATOMIC_RELAXED, __HIP_MEMORY_SCOPE_WORKGROUP);
#if defined(DBG_REPEAT) && DBG_REPEAT == 36
                    int vi = myoff[hf]; if (rep34 == 0) vi += __hip_atomic_fetch_add(&q_tiec[qn], nt, __ATOMIC_RELAXED, __HIP_MEMORY_SCOPE_WORKGROUP);
                    if (rep34) { for (int r = 0; r < 4; ++r) ist[r] = false; nt = 0; }
#else
                    int vi = myoff[hf] + __hip_atomic_fetch_add(&q_tiec[qn], nt, __ATOMIC_RELAXED, __HIP_MEMORY_SCOPE_WORKGROUP);
#endif
                    if (__ballot(nt > 0 && vi + nt > TCAP) == 0ull) {
#pragma unroll
                        for (int r = 0; r < 4; ++r) { LAS unsigned* dst = ist[r] ? (tpool + vi) : dummy; *dst = ent[r]; vi += ist[r] ? 1 : 0; }
                    } else {
#pragma unroll
                        for (int r = 0; r < 4; ++r) if (ist[r]) { if (vi < TCAP) tpool[vi] = ent[r]; else pool[vi] = ent[r]; ++vi; } } }
                    }
                    IDX_RING_LOAD(j, kt + 32) }
            }
#if defined(DBG_REPEAT) && (DBG_REPEAT == 34 || DBG_REPEAT == 36)
            }
#endif
#undef IDX_RING_LOAD
            __syncthreads();
#if defined(DBG_REPEAT) && DBG_REPEAT == 33
#pragma unroll 1
            for (int rep33 = 0; rep33 < 2; ++rep33)
#endif
            {
                int cq[4], offq[4], Rq[4]; unsigned needq[4], thrq[4], actq[4], validq[4]; constexpr int NR = 10; unsigned ev[4][NR]; bool slowq[4];
#pragma unroll
                for (int i = 0; i < 4; ++i) { const int q = 4 * wid + i; cq[i] = q_cnt[q]; offq[i] = q_off[q]; const int m = q_need[q];
                    needq[i] = (unsigned)(m < cq[i] ? m : cq[i]);
                    slowq[i] = cq[i] > 64 * NR; Rq[i] = slowq[i] ? 0 : (cq[i] + 63) >> 6; thrq[i] = 0u; actq[i] = 0u; }
#pragma unroll
                for (int i = 0; i < 4; ++i)
#pragma unroll
                    for (int r = 0; r < NR; ++r) { const int e = lane + 64 * r; const bool in = e < cq[i] && !slowq[i]; const int vi = offq[i] + (e < cq[i] ? e : cq[i] - 1); const unsigned v = (vi < TCAP) ? tpool[vi] : pool[vi]; ev[i][r] = in ? v : 0u; actq[i] |= in ? (1u << r) : 0u; }
#pragma unroll
                for (int i = 0; i < 4; ++i) validq[i] = actq[i];
                const int Rmax = max(max(Rq[0], Rq[1]), max(Rq[2], Rq[3]));
#pragma unroll 1
                for (int p = 3; p >= 0; --p) { const int shift = 8 * p;
#pragma unroll
                    for (int i = 0; i < 4; ++i) *(LAS u32x4*)(lds + (wid * 4 + i) * 1024 + 16 * lane) = (u32x4){0u, 0u, 0u, 0u};
#pragma unroll
                    for (int r = 0; r < NR; ++r) if (r < Rmax) {
#pragma unroll
                        for (int i = 0; i < 4; ++i) { LAS unsigned* wh = (LAS unsigned*)(lds + (wid * 4 + i) * 1024); if ((actq[i] >> r) & 1u) __hip_atomic_fetch_add(&wh[(ev[i][r] >> shift) & 255u], 1u, __ATOMIC_RELAXED, __HIP_MEMORY_SCOPE_WORKGROUP); } }
                    u32x4 hv[4]; unsigned tot[4], incl[4];
#pragma unroll
                    for (int i = 0; i < 4; ++i) { hv[i] = *(const LAS u32x4*)(lds + (wid * 4 + i) * 1024 + 16 * (63 - lane)); tot[i] = (hv[i].x + hv[i].y) + (hv[i].z + hv[i].w); }
#pragma unroll
                    for (int i = 0; i < 4; ++i) incl[i] = wave_incl_scan(tot[i], lane);
#pragma unroll
                    for (int i = 0; i < 4; ++i) { const unsigned excl = incl[i] - tot[i], need = needq[i]; const bool cross = excl < need && need <= incl[i];
                        unsigned dig = 252u - 4u * (unsigned)lane, ab = excl + hv[i].w + hv[i].z + hv[i].y;
                        if (excl + hv[i].w >= need) { dig += 3u; ab = excl; } else if (excl + hv[i].w + hv[i].z >= need) { dig += 2u; ab = excl + hv[i].w; } else if (excl + hv[i].w + hv[i].z + hv[i].y >= need) { dig += 1u; ab = excl + hv[i].w + hv[i].z; }
                        const unsigned long long bm = __ballot(cross);
                        if (bm) { const int src = __ffsll(bm) - 1; dig = (unsigned)__shfl((int)dig, src); ab = (unsigned)__shfl((int)ab, src);
                            thrq[i] |= dig << shift; needq[i] = need - ab;
                            unsigned keep = 0u;
#pragma unroll
                            for (int r = 0; r < NR; ++r) keep |= (((ev[i][r] >> shift) & 255u) == dig) ? (1u << r) : 0u;
                            actq[i] &= keep; } }
                }
#pragma unroll
                for (int i = 0; i < 4; ++i) { LAS unsigned* bq = bmp + (4 * wid + i) * 256;
#pragma unroll
                    for (int r = 0; r < NR; ++r) if (r < Rmax) { if (((validq[i] >> r) & 1u) && ev[i][r] >= thrq[i]) { const unsigned ix = 8191u - (ev[i][r] & 8191u); __hip_atomic_fetch_or(&bq[ix >> 5], 1u << (ix & 31u), __ATOMIC_RELAXED, __HIP_MEMORY_SCOPE_WORKGROUP); } } }
#pragma unroll 1
                for (int i = 0; i < 4; ++i) if (slowq[i]) { const int c = cq[i], off = offq[i]; LAS unsigned* bq = bmp + (4 * wid + i) * 256;
                    unsigned need = needq[i], thr = 0u;
#pragma unroll 1
                    for (int bit = 31; bit >= 0; --bit) { unsigned cnt1 = 0; const unsigned hm = (bit == 31) ? 0u : (0xffffffffu << (bit + 1));
                        for (int e = lane; e < c; e += 64) { const int vi = off + e; const unsigned v = (vi < TCAP) ? tpool[vi] : pool[vi]; if ((v & hm) == thr && ((v >> bit) & 1u)) ++cnt1; }
#pragma unroll
                        for (int o = 1; o < 64; o <<= 1) cnt1 += __shfl_xor(cnt1, o);
                        if (cnt1 >= need) thr |= 1u << bit; else need -= cnt1; }
                    for (int e = lane; e < c; e += 64) { const int vi = off + e; const unsigned v = (vi < TCAP) ? tpool[vi] : pool[vi]; if (v >= thr) { const unsigned ix = 8191u - (v & 8191u); __hip_atomic_fetch_or(&bq[ix >> 5], 1u << (ix & 31u), __ATOMIC_RELAXED, __HIP_MEMORY_SCOPE_WORKGROUP); } } }
                u32x4 bw[4]; unsigned cntb[4], inb[4];
#pragma unroll
                for (int i = 0; i < 4; ++i) { bw[i] = *(const LAS u32x4*)(bmp + (4 * wid + i) * 256 + 4 * lane); cntb[i] = (unsigned)((__popc(bw[i].x) + __popc(bw[i].y)) + (__popc(bw[i].z) + __popc(bw[i].w))); }
#pragma unroll
                for (int i = 0; i < 4; ++i) inb[i] = wave_incl_scan(cntb[i], lane);
#pragma unroll
                for (int i = 0; i < 4; ++i) { LAS unsigned short* sq = sel + (4 * wid + i) * 256; int pos = (int)(inb[i] - cntb[i]); const unsigned w4[4] = {bw[i].x, bw[i].y, bw[i].z, bw[i].w};
#pragma unroll
                    for (int wi = 0; wi < 4; ++wi) { unsigned w = w4[wi]; while (w) { const int bp = __ffs((int)w) - 1; if (pos < 256) sq[pos] = (unsigned short)((4 * lane + wi) * 32 + bp); ++pos; w &= w - 1u; } } }
            }
        }
        __syncthreads();
#ifndef A_EXP2
        LAS unsigned char* pbuf = lds + wid * 16384;
        LAS unsigned char* vbuf = pbuf + 4096;
        int ln2 = lane0; asm volatile("" : "+v"(ln2));
        const int hh = ln2 & 15, fq = ln2 >> 4;
        typedef int i32x2 __attribute__((ext_vector_type(2)));
        const unsigned char* kgb = kv8b + (ln2 & 7) * 16;
        LAS unsigned char* kstw = vbuf + (ln2 >> 3) * 144 + (ln2 & 7) * 16; const LAS unsigned char* kstr = vbuf + hh * 144 + 8 * fq;
        const unsigned char* vgb = kv8b + 128 + (ln2 & 3) * 16;
#define ATT_LOADK(kk, sqx, b4) { _Pragma("unroll") for (int i8 = 0; i8 < 8; ++i8) { const int kidx = (sqx)[64 * (b4) + 8 * i8 + (ln2 >> 3)]; kk[i8] = *(const u32x4*)(kgb + (size_t)kidx * 256); } }
#define ATT_MMAK(kk, b4) { _Pragma("unroll") for (int i8 = 0; i8 < 8; ++i8) *(LAS u32x4*)(kstw + i8 * (8 * 144)) = kk[i8]; \
    _Pragma("unroll") for (int j4 = 0; j4 < 4; ++j4) { f32x4 a = (f32x4){0.f, 0.f, 0.f, 0.f}; _Pragma("unroll") for (int k4 = 0; k4 < 4; ++k4) a = __builtin_amdgcn_mfma_f32_16x16x32_fp8_fp8(*(const LAS long*)(kstr + j4 * (16 * 144) + 32 * k4), qf[k4], a, 0, 0, 0); S[4 * (b4) + j4] = a; } }
#define ATT_LOADV(slot, sqx, chx) { _Pragma("unroll") for (int p2 = 0; p2 < 2; ++p2) { const unsigned char* vp = vgb + (size_t)(sqx)[32 * (chx) + (ln2 >> 2) + 16 * p2] * 256; vr[slot][0][p2] = *(const u32x4*)vp; vr[slot][1][p2] = *(const u32x4*)(vp + 64); } }
#define ATT_LOADQ(tokx) { _Pragma("unroll") for (int kk = 0; kk < 4; ++kk) { u32x4 w = (u32x4){0u, 0u, 0u, 0u}; if (hh < 8 && (hh >> 2) == (kk >> 1)) w = *(const u32x4*)(C.P + (size_t)(tokx) * NAB + PC_Q + hh * 64 + (kk & 1) * 32 + 8 * fq); qraw[kk] = w; } }
#if defined(DBG_REPEAT) && DBG_REPEAT == 31
#pragma unroll 1
        for (int rep31 = 0; rep31 < 2; ++rep31)
#endif
        {
        u32x4 kA[8], kB[8]; u32x4 qraw[4]; u32x4 vr[3][2][2];
        { const LAS unsigned short* sq0 = sel + (4 * wid) * 256; ATT_LOADQ(tok0 + 4 * wid) ATT_LOADK(kA, sq0, 0) ATT_LOADK(kB, sq0, 1) }
#pragma unroll 1
        for (int iq = 0; iq < 4; ++iq) {
            const int q = 4 * wid + iq, tok = tok0 + q, t = t0 + q, nsel = (t + 1 < TOPK) ? t + 1 : TOPK;
            const LAS unsigned short* sq = sel + q * 256;
            {
                long qf[4];
#pragma unroll
                for (int kk = 0; kk < 4; ++kk) { const u32x2 f8 = bf8_to_fp8(qraw[kk]); qf[kk] = (long)(((unsigned long long)f8.y << 32) | f8.x); }
                f32x4 S[16];
                ATT_MMAK(kA, 0) ATT_LOADK(kA, sq, 2)
                ATT_MMAK(kB, 1) ATT_LOADK(kB, sq, 3)
                ATT_MMAK(kA, 2) ATT_MMAK(kB, 3)
                ATT_LOADV(0, sq, 0) ATT_LOADV(1, sq, 1) ATT_LOADV(2, sq, 2)
                float mx = -INFINITY;
                if (nsel < TOPK) {
                    const int nrel = nsel - 4 * fq;
#pragma unroll
                    for (int tl = 0; tl < 16; ++tl)
#pragma unroll
                        for (int r = 0; r < 4; ++r) S[tl][r] = ((16 * tl + r) < nrel) ? S[tl][r] : -INFINITY; }
#pragma unroll
                for (int tl = 0; tl < 16; ++tl)
#pragma unroll
                    for (int r = 0; r < 4; ++r) mx = fmaxf(mx, S[tl][r]);
                mx = fmaxf(mx, __shfl_xor(mx, 16)); mx = fmaxf(mx, __shfl_xor(mx, 32));
                const float cexp = 0.125f * 1.44269504088896f, moff = -mx * cexp;
                float sm = 0.f;
#pragma unroll
                for (int tl = 0; tl < 16; ++tl)
#pragma unroll
                    for (int r = 0; r < 4; ++r) { const float e = __builtin_amdgcn_exp2f(fmaf(S[tl][r], cexp, moff)); S[tl][r] = e; sm += e; }
                sm += __shfl_xor(sm, 16); sm += __shfl_xor(sm, 32);
                const float inv = 1.0f / sm;
#pragma unroll
                for (int ch = 0; ch < 8; ++ch) { u32x2 w; w.x = pk4_fp8(S[2 * ch][0] * inv, S[2 * ch][1] * inv, S[2 * ch][2] * inv, S[2 * ch][3] * inv);
                    w.y = pk4_fp8(S[2 * ch + 1][0] * inv, S[2 * ch + 1][1] * inv, S[2 * ch + 1][2] * inv, S[2 * ch + 1][3] * inv); *(LAS u32x2*)(pbuf + ch * 512 + lane * 8) = w; }
            }
            if (iq < 3) { const LAS unsigned short* sqn = sq + 256; ATT_LOADK(kA, sqn, 0) ATT_LOADK(kB, sqn, 1) }
            f32x4 O[2][4];
#pragma unroll
            for (int g = 0; g < 2; ++g)
#pragma unroll
                for (int dt = 0; dt < 4; ++dt) O[g][dt] = (f32x4){0.f, 0.f, 0.f, 0.f};
            const int tq8 = hh >> 1, tp8 = hh & 1;
            const LAS unsigned char* vtr = vbuf + ((tq8 < 4) ? (4 * fq + tq8) : (16 + 4 * fq + tq8 - 4)) * 80 + tp8 * 8;
#pragma unroll
            for (int ch = 0; ch < 8; ++ch) {
                const long pf = *(const LAS long*)(pbuf + ch * 512 + lane * 8);
#pragma unroll
                for (int g = 0; g < 2; ++g) {
#pragma unroll
                    for (int p2 = 0; p2 < 2; ++p2) *(LAS u32x4*)(vbuf + ((ln2 >> 2) + 16 * p2) * 80 + (ln2 & 3) * 16) = vr[ch % 3][g][p2];
#pragma unroll
                    for (int dt = 0; dt < 4; ++dt) {
                        const i32x2 t8 = __builtin_amdgcn_ds_read_tr8_b64_v2i32((LAS i32x2*)(vtr + dt * 16));
                        const long vb = (long)(((unsigned long long)(unsigned)t8[1] << 32) | (unsigned)t8[0]);
                        O[g][dt] = __builtin_amdgcn_mfma_f32_16x16x32_fp8_fp8(pf, vb, O[g][dt], 0, 0, 0); }
                }
                if (ch + 3 < 8) ATT_LOADV(ch % 3, sq, ch + 3)
                if (ch == 5 && iq < 3) ATT_LOADQ(tok + 1)
            }
            if (fq < 2) {
#pragma unroll
                for (int dt = 0; dt < 4; ++dt)
#pragma unroll
                    for (int r = 0; r < 4; ++r) { const float ov = (fq == 0) ? O[0][dt][r] : O[1][dt][r];
                        *(LAS bf16_t*)(pbuf + ((4 * fq + r) * 64 + dt * 16 + hh) * 2) = (bf16_t)(pk2(ov, 0.f) & 0xffffu); }
            }
            asm volatile("" ::: "memory");
            { const u32x4 ow = *(const LAS u32x4*)(pbuf + ln2 * 16); *(u32x4*)(C.Y + (size_t)tok * 1024 + 512 + ln2 * 8) = ow; }
        }
        }
#undef ATT_LOADK
#undef ATT_MMAK
#undef ATT_LOADV
#undef ATT_LOADQ
#endif
    }
}


constexpr int H_QE = 0, H_KD = 17408, H_KET = 34816, H_VT = 53248, H_AL = 71680, H_ST = 80896, H_QTOT = 115712, H_BL = 117760, H_SSQ = 118272;
constexpr int PQ = 272, PT = 144;
constexpr size_t WS_HU = 440 * MiB, WS_HLB = 460 * MiB;

__device__ __forceinline__ bf16x8 ldsfrag(const LAS unsigned char* p) { return *(const LAS bf16x8*)p; }

constexpr int H_VRAW = 118784;
__device__ __forceinline__ int hgrn_item_of(int c, int G) {
    if (G != 256) return c;
    const int x = c & 7, j = c >> 3; const int b = x >> 1, seg = 4 * (x & 1) + (j >> 3), h = j & 7;
    return (b << 6) | (h << 3) | seg;
}
template <bool WITH_Q>
__device__ __forceinline__ void hgrn_load(const Ctx& C, size_t tokc, int h, int tid, u32x4 (&kr)[2], u32x4 (&vr)[2], u32x4 (&qr)[2]) {
#pragma unroll
    for (int j = 0; j < 2; ++j) { const int p = tid + 512 * j; const size_t off = (tokc + (size_t)(p >> 4)) * 1024 + (size_t)h * 128 + (p & 15) * 8;
        kr[j] = *(const u32x4*)(C.L1K + off); vr[j] = *(const u32x4*)(C.L1I + off); if (WITH_Q) qr[j] = *(const u32x4*)(C.L1Q + off); }
}
template <bool WITH_Q>
__device__ __forceinline__ float hgrn_stage(LAS unsigned char* lds, int tid, const u32x4 (&kr)[2], const u32x4 (&vr)[2], const u32x4 (&qr)[2]) {
    const int d = tid & 127, tq = tid >> 7;
#pragma unroll
    for (int j = 0; j < 2; ++j) { const int p = tid + 512 * j; const int ro = (p >> 4) * PQ + (p & 15) * 16;
        *(LAS u32x4*)(lds + H_KD + ro) = kr[j]; *(LAS u32x4*)(lds + H_VRAW + ro) = vr[j]; if (WITH_Q) *(LAS u32x4*)(lds + H_QE + ro) = qr[j]; }
    __syncthreads();
    float kf[16], vf[16], c[16];
#pragma unroll
    for (int i = 0; i < 16; ++i) { kf[i] = bf2f(*(const LAS bf16_t*)(lds + H_KD + (tq * 16 + i) * PQ + d * 2)); vf[i] = bf2f(*(const LAS bf16_t*)(lds + H_VRAW + (tq * 16 + i) * PQ + d * 2)); }
    float run = 0.f;
#pragma unroll
    for (int i = 0; i < 16; ++i) { run += __logf(1.0f - kf[i]); c[i] = run; }
    LAS float* qtot = (LAS float*)(lds + H_QTOT);
    qtot[tq * 128 + d] = run;
    { u32x4 w0, w1; w0.x = pk2(vf[0], vf[1]); w0.y = pk2(vf[2], vf[3]); w0.z = pk2(vf[4], vf[5]); w0.w = pk2(vf[6], vf[7]); w1.x = pk2(vf[8], vf[9]); w1.y = pk2(vf[10], vf[11]); w1.z = pk2(vf[12], vf[13]); w1.w = pk2(vf[14], vf[15]);
      *(LAS u32x4*)(lds + H_VT + d * PT + tq * 32) = w0; *(LAS u32x4*)(lds + H_VT + d * PT + tq * 32 + 16) = w1; }
    __syncthreads();
    float pre = 0.f, tot = 0.f;
#pragma unroll
    for (int q4 = 0; q4 < 4; ++q4) { const float x = qtot[q4 * 128 + d]; if (q4 < tq) pre += x; tot += x; }
    if (tq == 0) ((LAS float*)(lds + H_BL))[d] = tot;
    { float ke[16];
#pragma unroll
      for (int i = 0; i < 16; ++i) ke[i] = kf[i] * __expf(tot - (pre + c[i]));
      u32x4 w0, w1; w0.x = pk2(ke[0], ke[1]); w0.y = pk2(ke[2], ke[3]); w0.z = pk2(ke[4], ke[5]); w0.w = pk2(ke[6], ke[7]); w1.x = pk2(ke[8], ke[9]); w1.y = pk2(ke[10], ke[11]); w1.z = pk2(ke[12], ke[13]); w1.w = pk2(ke[14], ke[15]);
      *(LAS u32x4*)(lds + H_KET + d * PT + tq * 32) = w0; *(LAS u32x4*)(lds + H_KET + d * PT + tq * 32 + 16) = w1; }
    if (WITH_Q) {
#pragma unroll
        for (int i = 0; i < 16; ++i) { const float b = pre + c[i]; const float qv = bf2f(*(const LAS bf16_t*)(lds + H_QE + (tq * 16 + i) * PQ + d * 2));
            *(LAS bf16_t*)(lds + H_QE + (tq * 16 + i) * PQ + d * 2) = (bf16_t)(pk2(qv * __expf(b), 0.f) & 0xffffu);
            *(LAS bf16_t*)(lds + H_KD + (tq * 16 + i) * PQ + d * 2) = (bf16_t)(pk2(kf[i] * __expf(-b), 0.f) & 0xffffu); }
    }
    return tot;
}
__device__ __forceinline__ void hgrn_state_update(LAS unsigned char* lds, f32x4 (&S)[8], int wid, int l15, int fq) {
    const LAS float* bl = (const LAS float*)(lds + H_BL);
    float dec[4];
#pragma unroll
    for (int r = 0; r < 4; ++r) dec[r] = __expf(bl[16 * wid + 4 * fq + r]);
    const bf16x8 ka0 = ldsfrag(lds + H_KET + (16 * wid + l15) * PT + 16 * fq), ka1 = ldsfrag(lds + H_KET + (16 * wid + l15) * PT + 64 + 16 * fq);
#pragma unroll
    for (int et = 0; et < 8; ++et) {
#pragma unroll
        for (int r = 0; r < 4; ++r) S[et][r] *= dec[r];
        S[et] = __builtin_amdgcn_mfma_f32_16x16x32_bf16(ka0, ldsfrag(lds + H_VT + (et * 16 + l15) * PT + 16 * fq), S[et], 0, 0, 0);
        S[et] = __builtin_amdgcn_mfma_f32_16x16x32_bf16(ka1, ldsfrag(lds + H_VT + (et * 16 + l15) * PT + 64 + 16 * fq), S[et], 0, 0, 0); }
}

__device__ __forceinline__ void phase_hgrn_local(const Ctx& C, LAS unsigned char* lds) {
    const int tid = threadIdx.x, lane = tid & 63, wid = __builtin_amdgcn_readfirstlane(tid >> 6), l15 = lane & 15, fq = lane >> 4;
    float* Ug = (float*)((unsigned char*)C.ctl + WS_HU); float* LBg = (float*)((unsigned char*)C.ctl + WS_HLB);
    for (int it0 = C.bid; it0 < 256; it0 += C.G) {
        const int item = hgrn_item_of(it0, C.G); const int seg = item & 7, h = (item >> 3) & 7, b = item >> 6;
        if (seg == 7) continue;
        f32x4 S[8];
#pragma unroll
        for (int et = 0; et < 8; ++et) S[et] = (f32x4){0.f, 0.f, 0.f, 0.f};
        float lbacc = 0.f;
        u32x4 kr[2], vr[2], qr[2];
        hgrn_load<false>(C, (size_t)b * SEQ + (size_t)seg * 1024, h, tid, kr, vr, qr);
#pragma unroll 1
        for (int ch = 0; ch < 16; ++ch) {
            const size_t tokc = (size_t)b * SEQ + (size_t)seg * 1024 + (size_t)ch * 64;
            __syncthreads();
            lbacc += hgrn_stage<false>(lds, tid, kr, vr, qr);
            if (ch < 15) hgrn_load<false>(C, tokc + 64, h, tid, kr, vr, qr);
            __syncthreads();
            hgrn_state_update(lds, S, wid, l15, fq);
        }
#pragma unroll
        for (int et = 0; et < 8; ++et) *(f32x4*)(Ug + ((size_t)(item * 8 + wid) * 8 + et) * 256 + lane * 4) = S[et];
        if (tid < 128) LBg[item * 128 + tid] = lbacc;
    }
}

__device__ __forceinline__ void phase_hgrn_chunks(const Ctx& C, LAS unsigned char* lds) {
    const int tid = threadIdx.x, lane = tid & 63, wid = __builtin_amdgcn_readfirstlane(tid >> 6), l15 = lane & 15, fq = lane >> 4;
    const float* Ug = (const float*)((unsigned char*)C.ctl + WS_HU); const float* LBg = (const float*)((unsigned char*)C.ctl + WS_HLB);
    LAS float* ssq = (LAS float*)(lds + H_SSQ);
    for (int it0 = C.bid; it0 < 256; it0 += C.G) {
        const int item = hgrn_item_of(it0, C.G); const int seg = item & 7, h = (item >> 3) & 7, b = item >> 6;
        f32x4 S[8];
#pragma unroll
        for (int et = 0; et < 8; ++et) S[et] = (f32x4){0.f, 0.f, 0.f, 0.f};
#pragma unroll 1
        for (int j = 0; j < seg; ++j) { const int it = item - seg + j; float dec[4];
#pragma unroll
            for (int r = 0; r < 4; ++r) dec[r] = __expf(LBg[it * 128 + 16 * wid + 4 * fq + r]);
#pragma unroll
            for (int et = 0; et < 8; ++et) { const f32x4 u = *(const f32x4*)(Ug + ((size_t)(it * 8 + wid) * 8 + et) * 256 + lane * 4);
#pragma unroll
                for (int r = 0; r < 4; ++r) S[et][r] = S[et][r] * dec[r] + u[r]; } }
        __syncthreads();
        u32x4 kr[2], vr[2], qr[2];
        hgrn_load<true>(C, (size_t)b * SEQ + (size_t)seg * 1024, h, tid, kr, vr, qr);
#pragma unroll 1
        for (int ch = 0; ch < 16; ++ch) {
            const size_t tokc = (size_t)b * SEQ + (size_t)seg * 1024 + (size_t)ch * 64;
#pragma unroll
            for (int et = 0; et < 8; ++et) { u32x2 w; w.x = pk2(S[et][0], S[et][1]); w.y = pk2(S[et][2], S[et][3]); *(LAS u32x2*)(lds + H_ST + (et * 16 + l15) * PQ + (16 * wid + 4 * fq) * 2) = w; }
            (void)hgrn_stage<true>(lds, tid, kr, vr, qr);
            if (ch < 15) hgrn_load<true>(C, tokc + 64, h, tid, kr, vr, qr);
            u32x2 gw[4];
            { const size_t ro = (tokc + (wid & 3) * 16 + l15) * 1024 + (size_t)h * 128;
#pragma unroll
              for (int j = 0; j < 4; ++j) gw[j] = *(const u32x2*)(C.L1G + ro + (4 * (wid >> 2) + j) * 16 + 4 * fq); }
            __syncthreads();
            { const int ti = wid >> 1;
#pragma unroll
              for (int u = 0; u < 2; ++u) { const int si = 2 * (wid & 1) + u; u32x2 w = (u32x2){0u, 0u};
                  if (si <= ti) { f32x4 a = (f32x4){0.f, 0.f, 0.f, 0.f};
#pragma unroll
                      for (int kk = 0; kk < 4; ++kk) a = __builtin_amdgcn_mfma_f32_16x16x32_bf16(ldsfrag(lds + H_KD + (si * 16 + l15) * PQ + kk * 64 + 16 * fq), ldsfrag(lds + H_QE + (ti * 16 + l15) * PQ + kk * 64 + 16 * fq), a, 0, 0, 0);
                      if (si == ti) {
#pragma unroll
                          for (int r = 0; r < 4; ++r) if (4 * fq + r > l15) a[r] = 0.f; }
                      w.x = pk2(a[0], a[1]); w.y = pk2(a[2], a[3]); }
                  *(LAS u32x2*)(lds + H_AL + (ti * 16 + l15) * PT + (si * 16 + 4 * fq) * 2) = w; } }
            hgrn_state_update(lds, S, wid, l15, fq);
            __syncthreads();
            const int ti = wid & 3, eh = wid >> 2;
            f32x4 o[4];
            { const bf16x8 ab0 = ldsfrag(lds + H_AL + (ti * 16 + l15) * PT + 16 * fq), ab1 = ldsfrag(lds + H_AL + (ti * 16 + l15) * PT + 64 + 16 * fq);
              bf16x8 qb[4];
#pragma unroll
              for (int kk = 0; kk < 4; ++kk) qb[kk] = ldsfrag(lds + H_QE + (ti * 16 + l15) * PQ + kk * 64 + 16 * fq);
#pragma unroll
              for (int j = 0; j < 4; ++j) { const int et = 4 * eh + j; f32x4 a = (f32x4){0.f, 0.f, 0.f, 0.f};
                  a = __builtin_amdgcn_mfma_f32_16x16x32_bf16(ldsfrag(lds + H_VT + (et * 16 + l15) * PT + 16 * fq), ab0, a, 0, 0, 0);
                  a = __builtin_amdgcn_mfma_f32_16x16x32_bf16(ldsfrag(lds + H_VT + (et * 16 + l15) * PT + 64 + 16 * fq), ab1, a, 0, 0, 0);
#pragma unroll
                  for (int kk = 0; kk < 4; ++kk) a = __builtin_amdgcn_mfma_f32_16x16x32_bf16(ldsfrag(lds + H_ST + (et * 16 + l15) * PQ + kk * 64 + 16 * fq), qb[kk], a, 0, 0, 0);
                  o[j] = a; } }
            float sq = 0.f;
#pragma unroll
            for (int j = 0; j < 4; ++j) sq += (o[j][0] * o[j][0] + o[j][1] * o[j][1]) + (o[j][2] * o[j][2] + o[j][3] * o[j][3]);
            sq += __shfl_xor(sq, 16); sq += __shfl_xor(sq, 32);
            if (fq == 0) ssq[eh * 64 + ti * 16 + l15] = sq;
            __syncthreads();
            { const float tot = ssq[ti * 16 + l15] + ssq[64 + ti * 16 + l15]; const float rinv = 1.0f / sqrtf(tot * (1.0f / 128.0f) + EPS);
              const size_t ro = (tokc + ti * 16 + l15) * 1024 + (size_t)h * 128;
#pragma unroll
              for (int j = 0; j < 4; ++j) { const int e0 = (4 * eh + j) * 16 + 4 * fq; const f32x4 nw = *(const f32x4*)(C.hgrn_out_norm + e0);
                  u32x2 w; w.x = pk2(o[j][0] * rinv * nw[0] * bf_lo(gw[j].x), o[j][1] * rinv * nw[1] * bf_hi(gw[j].x)); w.y = pk2(o[j][2] * rinv * nw[2] * bf_lo(gw[j].y), o[j][3] * rinv * nw[3] * bf_hi(gw[j].y));
                  *(u32x2*)(C.Y + ro + e0) = w; } }
        }
    }
}

constexpr int NPHASES = 14;
struct Args { const void* in[16]; float* out; unsigned char* ws; int ph_lo, ph_hi; };


typedef const __attribute__((address_space(4))) Args* KArgP;
__device__ __forceinline__ void make_ctx(Ctx& C) {
    KArgP ka = (KArgP)__builtin_amdgcn_kernarg_segment_ptr(); asm volatile("" : "+s"(ka));
    C.x = (const float*)ka->in[0]; C.positions = (const int*)ka->in[1]; C.ln_mix = (const float*)ka->in[2]; C.ln_ffn = (const float*)ka->in[3]; C.ln_final = (const float*)ka->in[4];
    C.w_in_ab = (const float*)ka->in[5]; C.w_pool = (const float*)ka->in[6]; C.pool_scale = (const float*)ka->in[7]; C.idx_k_norm = (const float*)ka->in[8]; C.w_out_ab = (const float*)ka->in[9];
    C.w_in_c = (const float*)ka->in[10]; C.hgrn_lb = (const float*)ka->in[11]; C.hgrn_out_norm = (const float*)ka->in[12]; C.w_out_c = (const float*)ka->in[13]; C.w_gate_up = (const float*)ka->in[14]; C.w_down = (const float*)ka->in[15];
    C.out = ka->out;
    unsigned char* ws = ka->ws;
    C.ctl = (unsigned*)(ws + WS_CTL); C.rope = (float*)(ws + WS_ROPE); C.part = (float*)(ws + WS_PART); C.lbv = (float*)(ws + WS_LB);
    C.W_inab = (bf16_t*)(ws + WS_W_INAB); C.W_pool = (bf16_t*)(ws + WS_W_POOL); C.W_outab = (bf16_t*)(ws + WS_W_OUTAB); C.W_inc = (bf16_t*)(ws + WS_W_INC); C.W_outc = (bf16_t*)(ws + WS_W_OUTC);
    C.W_gu0 = (bf16_t*)(ws + WS_W_GU0); C.W_gu1 = (bf16_t*)(ws + WS_W_GU1); C.W_dn0 = (bf16_t*)(ws + WS_W_DN0); C.W_dn1 = (bf16_t*)(ws + WS_W_DN1);
    C.XB = (bf16_t*)(ws + WS_XB); C.Y = (bf16_t*)(ws + WS_Y); C.P = (bf16_t*)(ws + WS_P); C.ACT = (bf16_t*)(ws + WS_ACT);
    C.L1Q = (bf16_t*)(ws + WS_L1Q); C.L1K = (bf16_t*)(ws + WS_L1K); C.L1I = (bf16_t*)(ws + WS_L1I); C.L1G = (bf16_t*)(ws + WS_L1G); C.ORAW = (bf16_t*)(ws + WS_ORAW);
    C.G = gridDim.x; C.bid = blockIdx.x;
}

#if USE_SIMPLE_GEMM
#define RUN_GEMM(EpiT, gg, EE) pg8::gemm_simple<EpiT>(gg, C.G, C.bid, EE)
#else
#define RUN_GEMM(EpiT, gg, EE) do { if (threadIdx.x == 0) *(LAS int*)(lds + 131072 + 1024) = -1; __syncthreads(); pg8::StaticOrder S_; S_.init((gg).M, (gg).N, C.G, C.bid); pg8::gemm_phase<EpiT, pg8::StaticOrder, true, true>(lds, gg, S_, EE); } while (0)
#endif

__device__ __forceinline__ void xcd_barrier_local(const XcdBarrier& b) {
    asm volatile("s_waitcnt vmcnt(0)" ::: "memory");
    __syncthreads();
    if (threadIdx.x == 0) {
        unsigned* bar = b.bar;
        __builtin_amdgcn_s_waitcnt(0);
        const unsigned nloc = b.st[0];
        const unsigned old = xb_add(&bar[XB_XSUB(b.x)], 1u);
        const unsigned gen = old / nloc;
        if (old + 1u == (gen + 1u) * nloc) xb_add(&bar[XB_XGEN(b.x)], 1u);
        else XB_SPIN(xb_ld(&bar[XB_XGEN(b.x)]) == gen, bar);
        __builtin_amdgcn_fence(__ATOMIC_ACQUIRE, "agent");
        asm volatile("s_waitcnt vmcnt(0)" ::: "memory");
    }
    __syncthreads();
}
constexpr int CW_TAB = 8192;

__global__ void __launch_bounds__(512, 2) mega_fwd(Args a) {
    extern __shared__ __attribute__((aligned(16))) unsigned char lds_raw[];
    LAS unsigned char* lds = (LAS unsigned char*)lds_raw;
    unsigned* const ctl0 = (unsigned*)(a.ws + WS_CTL);

    volatile LAS unsigned* MISC = (volatile LAS unsigned*)(lds + LDS_MISC);
    if (threadIdx.x < 64) MISC[threadIdx.x] = 0u;
    __syncthreads();
    XcdBarrier bar; bar.bar = ctl0 + CW_BAR; bar.x = 0; bar.st = nullptr;
    if (N_LAUNCH_MODE == 1) bar = xcd_barrier_post(ctl0 + CW_BAR, MISC + 8);
    if (N_LAUNCH_MODE == 1 && threadIdx.x == 0) __hip_atomic_store(&ctl0[CW_TAB + blockIdx.x], xb_xcc_id() + 1u, __ATOMIC_RELAXED, __HIP_MEMORY_SCOPE_AGENT);

    const int lo = a.ph_lo, hi = a.ph_hi;
#ifndef ONLY_PHASE
#define ONLY_PHASE -1
#endif
#define IN(k) (lo <= (k) && (k) < hi && (ONLY_PHASE < 0 || ONLY_PHASE == (k)))
#if defined(DBG_REPEAT) && DBG_REPEAT == 90
#define SEAM(k) do { if (N_LAUNCH_MODE == 1 && IN((k) + 1)) { xcd_barrier(bar); if ((k) == 5) for (int rr_ = 0; rr_ < 20; ++rr_) xcd_barrier(bar); } } while (0)
#else
#define SEAM(k) do { if (N_LAUNCH_MODE == 1 && IN((k) + 1)) xcd_barrier(bar); } while (0)
#endif

#if USE_SIMPLE_GEMM || USE_SIMPLE_ATTN || USE_SIMPLE_HGRN
#define SEAM_L(k) SEAM(k)
#else
#define SEAM_L(k) do { if (N_LAUNCH_MODE == 1 && IN((k) + 1)) { if (MISC[10]) xcd_barrier_local(bar); else xcd_barrier(bar); } } while (0)
#endif
    if (IN(0)) { Ctx C; make_ctx(C); phase_prologue(C, lds); __syncthreads();
#if defined(DBG_REPEAT) && DBG_REPEAT == 0
        phase_prologue(C, lds); __syncthreads();
#endif
        SEAM(0);
        if (N_LAUNCH_MODE == 1 && lo == 0) {
            if (threadIdx.x < 64) { bool ok = (gridDim.x == 256u);
                for (unsigned t = threadIdx.x; t < gridDim.x && t < 256u; t += 64u) { const unsigned v = xb_ld(&ctl0[CW_TAB + t]), r = xb_ld(&ctl0[CW_TAB + (t & 7u)]); ok = ok && v != 0u && v == r; }
                unsigned m = 0u;
                for (unsigned i = 0; i < 8u; ++i) m |= 1u << (xb_ld(&ctl0[CW_TAB + i]) & 31u);
                ok = ok && __popc(m) == 8;
                const bool all = __ballot(ok) == ~0ull;
                if (threadIdx.x == 0) MISC[10] = all ? 1u : 0u; }
            __syncthreads(); } }
    if (IN(1)) { Ctx C; make_ctx(C); pg8::Gemm g{C.XB, C.W_inab, NTOK, NAB, 1024}; pg8::EpiScaleBf16 E{C.P, NAB, pg8::RinvTab{C.part, lds}}; RUN_GEMM(pg8::EpiScaleBf16, g, E);
        __syncthreads(); phase_prologue_late(C, lds); __syncthreads();
#if defined(DBG_REPEAT) && DBG_REPEAT == 1
        RUN_GEMM(pg8::EpiScaleBf16, g, E);
#endif
        SEAM(1); }
    if (IN(2)) { Ctx C; make_ctx(C); phase_fixup_pool(C, lds);
#if defined(DBG_REPEAT) && DBG_REPEAT == 2
        phase_fixup_pool(C, lds);
#endif
        SEAM(2); }
#ifdef DBG_ZERO_ATTN
    if (IN(3)) { Ctx C; make_ctx(C); for (int i = C.bid * 512 + threadIdx.x; i < NTOK * 64; i += C.G * 512) { const int tok = i >> 6, c = i & 63; *(u32x4*)(C.Y + (size_t)tok * 1024 + 512 + 8 * c) = (u32x4){0u, 0u, 0u, 0u}; } SEAM(3); }
#else
#if USE_SIMPLE_ATTN
    if (IN(3)) { Ctx C; make_ctx(C); phase_attn_simple(C, lds); __syncthreads(); SEAM(3); }
#else
    if (IN(3)) { Ctx C; make_ctx(C); phase_attn(C, lds); __syncthreads();
#if defined(DBG_REPEAT) && DBG_REPEAT == 3
        phase_attn(C, lds); __syncthreads();
#endif
        SEAM(3); }
#endif
#endif
    if (IN(4)) { Ctx C; make_ctx(C); pg8::Gemm g{C.Y, C.W_outab, NTOK, 1024, 1024}; pg8::EpiResidual<true> E{C.XB, C.part, C.x}; RUN_GEMM(pg8::EpiResidual<true>, g, E); SEAM_L(4); }
    if (IN(5)) { Ctx C; make_ctx(C); pg8::Gemm g{C.XB, C.W_gu0, NTOK, 2 * DFF, 1024}; pg8::EpiSwiGLU E{C.ACT, pg8::RinvTab{C.part, lds}}; RUN_GEMM(pg8::EpiSwiGLU, g, E);
#if defined(DBG_REPEAT) && DBG_REPEAT == 5
        RUN_GEMM(pg8::EpiSwiGLU, g, E);
#endif
        SEAM_L(5); }
    if (IN(6)) { Ctx C; make_ctx(C); pg8::Gemm g{C.ACT, C.W_dn0, NTOK, 1024, DFF}; pg8::EpiResidual<false> E{C.XB, C.part, C.x}; RUN_GEMM(pg8::EpiResidual<false>, g, E); SEAM_L(6); }
    if (IN(7)) { Ctx C; make_ctx(C); pg8::Gemm g{C.XB, C.W_inc, NTOK, NINC, 1024}; pg8::EpiHgrnIn E{C.L1Q, C.L1K, C.L1I, C.L1G, pg8::RinvTab{C.part, lds}, C.lbv}; RUN_GEMM(pg8::EpiHgrnIn, g, E); SEAM_L(7); }
#if USE_SIMPLE_HGRN
    if (IN(8)) { Ctx C; make_ctx(C); phase_hgrn_simple(C); SEAM(8); }
    if (IN(9)) { Ctx C; make_ctx(C); phase_hgrn_post(C); SEAM_L(9); }
#else
    if (IN(8)) { Ctx C; make_ctx(C); phase_hgrn_local(C, lds); __syncthreads();
#if defined(DBG_REPEAT) && DBG_REPEAT == 8
        phase_hgrn_local(C, lds); __syncthreads();
#endif
        SEAM(8); }
    if (IN(9)) { Ctx C; make_ctx(C); phase_hgrn_chunks(C, lds); __syncthreads();
#if defined(DBG_REPEAT) && DBG_REPEAT == 9
        phase_hgrn_chunks(C, lds); __syncthreads();
#endif
        SEAM_L(9); }
#endif
    if (IN(10)) { Ctx C; make_ctx(C); pg8::Gemm g{C.Y, C.W_outc, NTOK, 1024, 1024}; pg8::EpiResidual<false> E{C.XB, C.part, C.x}; RUN_GEMM(pg8::EpiResidual<false>, g, E); SEAM_L(10); }
    if (IN(11)) { Ctx C; make_ctx(C); pg8::Gemm g{C.XB, C.W_gu1, NTOK, 2 * DFF, 1024}; pg8::EpiSwiGLU E{C.ACT, pg8::RinvTab{C.part, lds}}; RUN_GEMM(pg8::EpiSwiGLU, g, E); SEAM_L(11); }
    if (IN(12)) { Ctx C; make_ctx(C); pg8::Gemm g{C.ACT, C.W_dn1, NTOK, 1024, DFF}; pg8::EpiResidual<false> E{C.XB, C.part, C.x}; RUN_GEMM(pg8::EpiResidual<false>, g, E); SEAM_L(12); }
    if (IN(13)) { Ctx C; make_ctx(C); phase_final_norm(C);
#if defined(DBG_REPEAT) && DBG_REPEAT == 13
        phase_final_norm(C);
#endif
    }
#ifdef DBG_STOP_AFTER
    if (IN(14)) { Ctx C; make_ctx(C); for (int i = C.bid * 512 + threadIdx.x; i < NTOK * 1024; i += C.G * 512) { const int tok = i >> 10, c = i & 1023; float v;
        if (DBG_STOP_AFTER <= 3) v = bf2f(C.P[(size_t)tok * NAB + c]) + bf2f(C.P[(size_t)tok * NAB + 768 + c]) + bf2f(C.Y[(size_t)tok * 1024 + (c & 511)]);
        else if (DBG_STOP_AFTER == 7 || DBG_STOP_AFTER == 8) v = bf2f(C.L1Q[i]) + bf2f(C.L1K[i]) + bf2f(C.L1I[i]) + bf2f(C.L1G[i]) + (DBG_STOP_AFTER == 8 ? bf2f(C.ORAW[i]) : 0.f);
        else if (DBG_STOP_AFTER == 9) v = bf2f(C.Y[i]);
        else if (DBG_STOP_AFTER == 5 || DBG_STOP_AFTER == 11) v = bf2f(C.ACT[(size_t)tok * DFF + c]) + bf2f(C.ACT[(size_t)tok * DFF + 1024 + c]) + bf2f(C.ACT[(size_t)tok * DFF + 1792 + c]);
        else v = C.out[i] + bf2f(C.XB[i]);
        C.out[i] = v; } }
#endif
#undef IN
#undef SEAM
#undef SEAM_L
}

extern "C" void kernel_launch(void* const* d_in, const int* in_sizes, int n_in, void* d_out, int out_size, void* d_ws, size_t ws_size, hipStream_t stream) {
    static int grid = 0;
    if (grid == 0) {
        if (n_in != 16 || in_sizes[0] != NTOK * DM || out_size != NTOK * DM || ws_size < WS_END) {
            fprintf(stderr, "kernel_launch: built for 16 inputs, x/out of %d floats, >= %zu bytes of workspace; got n_in %d, in0 %d, out %d, ws %zu; nothing launched\n", NTOK * DM, (size_t)WS_END, n_in, n_in > 0 ? in_sizes[0] : -1, out_size, ws_size);
            grid = -1; return; }
        int dev = 0, cus = 0, per_cu = 0;
        if (hipGetDevice(&dev) != hipSuccess || hipDeviceGetAttribute(&cus, hipDeviceAttributeMultiprocessorCount, dev) != hipSuccess) { fprintf(stderr, "kernel_launch: device query failed\n"); grid = -1; return; }
        if (hipFuncSetAttribute((const void*)mega_fwd, hipFuncAttributeMaxDynamicSharedMemorySize, LDS_BYTES) != hipSuccess) { fprintf(stderr, "kernel_launch: hipFuncSetAttribute failed\n"); grid = -1; return; }
        if (hipOccupancyMaxActiveBlocksPerMultiprocessor(&per_cu, (const void*)mega_fwd, 512, LDS_BYTES) != hipSuccess || per_cu < 1)
            fprintf(stderr, "kernel_launch: note: occupancy query reports %d workgroups per CU\n", per_cu);
        (void)hipGetLastError();
        grid = cus;
    }
    if (grid < 0) return;
    if (hipMemsetAsync((char*)d_ws + WS_CTL, 0, CTL_ZERO_BYTES, stream) != hipSuccess) { fprintf(stderr, "kernel_launch: hipMemsetAsync failed\n"); return; }
    Args a{};
    for (int i = 0; i < 16; ++i) a.in[i] = d_in[i];
    a.out = (float*)d_out; a.ws = (unsigned char*)d_ws;
    if (N_LAUNCH_MODE == 1) {
        a.ph_lo = 0; a.ph_hi = NPHASES;
        hipLaunchKernelGGL(mega_fwd, dim3(grid), dim3(512), LDS_BYTES, stream, a);
    } else {
#ifdef DBG_STOP_AFTER
        for (int p = 0; p <= DBG_STOP_AFTER; ++p) { a.ph_lo = p; a.ph_hi = p + 1; hipLaunchKernelGGL(mega_fwd, dim3(grid), dim3(512), LDS_BYTES, stream, a); }
        a.ph_lo = 14; a.ph_hi = 15; hipLaunchKernelGGL(mega_fwd, dim3(grid), dim3(512), LDS_BYTES, stream, a);
#else
        for (int p = 0; p < NPHASES; ++p) { a.ph_lo = p; a.ph_hi = p + 1; hipLaunchKernelGGL(mega_fwd, dim3(grid), dim3(512), LDS_BYTES, stream, a); }
#endif
    }
    const hipError_t le = hipPeekAtLastError();
    if (le != hipSuccess) fprintf(stderr, "kernel_launch: launch failed: %s\n", hipGetErrorName(le));
}
```
